# Optimizing an MI355X kernel written in HIP

```python
import math
import jax, jax.numpy as jnp
from jax import lax
import numpy as np

D_MODEL = 1024
BATCH = 8
SEQ = 4096
DEPTH = 2

SSM_GROUPS = 32
SSM_GROUP_CH = 16
SSM_WIDTH = SSM_GROUPS * SSM_GROUP_CH
SSM_STATE = 64
DT_MIN = 0.001
DT_MAX = 0.1
N_HEADS = 8
HEAD_DIM = 64
ATTN_WIDTH = N_HEADS * HEAD_DIM
MOBA_BLOCK = 256
MOBA_TOPK = 3
Q_BLOCK = 128
ROPE_THETA = 10000.0
D_IN = SSM_WIDTH + 3 * ATTN_WIDTH + 2 * D_MODEL
N_GROUPS = 4
EXPERTS_PER_GROUP = 8
N_EXPERTS = N_GROUPS * EXPERTS_PER_GROUP
EXPERT_TOPK = 2
D_EXPERT = 512
EXPERT_ROWS = 256
NORM_EPS = 1e-6

kernel_name = "hybrid_s5_moba_hmoe_trunk"


def rms_norm(x, gain):
    xf = x.astype(jnp.float32)
    y = xf * lax.rsqrt(jnp.mean(xf * xf, axis=-1, keepdims=True) + NORM_EPS)
    return (y * gain.astype(jnp.float32)).astype(x.dtype)


def rope_tables(seq, dh):
    inv = ROPE_THETA ** (-jnp.arange(0, dh, 2, dtype=jnp.float32) / dh)
    ang = jnp.arange(seq, dtype=jnp.float32)[:, None] * inv[None, :]
    return jnp.cos(ang), jnp.sin(ang)


def apply_rope(x, cos, sin):
    half = x.shape[-1] // 2
    xf = x.astype(jnp.float32)
    x1, x2 = xf[..., :half], xf[..., half:]
    return jnp.concatenate([x1 * cos - x2 * sin, x2 * cos + x1 * sin], axis=-1).astype(x.dtype)


def _complex_linear_combine(left, right):
    ar1, ai1, br1, bi1 = left
    ar2, ai2, br2, bi2 = right
    ar = ar2 * ar1 - ai2 * ai1
    ai = ar2 * ai1 + ai2 * ar1
    br = ar2 * br1 - ai2 * bi1 + br2
    bi = ar2 * bi1 + ai2 * br1 + bi2
    return ar, ai, br, bi


def s5_branch(u, a_re, a_im, log_dt, b_re, b_im, c_re, c_im, d_skip, w_glu):
    bsz, seq, _ = u.shape
    ug = u.astype(jnp.float32).reshape(bsz, seq, SSM_GROUPS, SSM_GROUP_CH)
    dt = jnp.exp(log_dt.astype(jnp.float32))[:, None]
    lam_re = a_re.astype(jnp.float32)
    lam_im = a_im.astype(jnp.float32)
    decay = jnp.exp(lam_re * dt)
    abar_re = decay * jnp.cos(lam_im * dt)
    abar_im = decay * jnp.sin(lam_im * dt)
    den = lam_re * lam_re + lam_im * lam_im
    num_re = abar_re - 1.0
    f_re = (num_re * lam_re + abar_im * lam_im) / den
    f_im = (abar_im * lam_re - num_re * lam_im) / den
    bf_re = b_re.astype(jnp.float32)
    bf_im = b_im.astype(jnp.float32)
    bbar_re = f_re[..., None] * bf_re - f_im[..., None] * bf_im
    bbar_im = f_re[..., None] * bf_im + f_im[..., None] * bf_re
    bu_re = jnp.einsum('bsgh,gph->bsgp', ug, bbar_re)
    bu_im = jnp.einsum('bsgh,gph->bsgp', ug, bbar_im)
    a_r = jnp.broadcast_to(abar_re, bu_re.shape)
    a_i = jnp.broadcast_to(abar_im, bu_re.shape)
    _, _, s_re, s_im = lax.associative_scan(_complex_linear_combine, (a_r, a_i, bu_re, bu_im), axis=1)
    y = (jnp.einsum('bsgp,ghp->bsgh', s_re, c_re.astype(jnp.float32))
         - jnp.einsum('bsgp,ghp->bsgh', s_im, c_im.astype(jnp.float32))
         + d_skip.astype(jnp.float32).reshape(SSM_GROUPS, SSM_GROUP_CH) * ug)
    z = jax.nn.gelu(y.reshape(bsz, seq, SSM_WIDTH)).astype(u.dtype)
    val, gate = jnp.split(z @ w_glu, 2, axis=-1)
    return val * jax.nn.sigmoid(gate)


def moba_attention(q, k, v):
    bsz, nh, seq, dh = q.shape
    nb = -(-seq // MOBA_BLOCK)
    pad = nb * MOBA_BLOCK - seq
    nqb = seq // Q_BLOCK
    n_sel = min(MOBA_TOPK, nb - 1)
    scale = dh ** -0.5
    neg = jnp.finfo(jnp.float32).min
    kp = jnp.pad(k, ((0, 0), (0, 0), (0, pad), (0, 0)))
    vp = jnp.pad(v, ((0, 0), (0, 0), (0, pad), (0, 0)))
    kblk = kp.reshape(bsz, nh, nb, MOBA_BLOCK, dh)
    vblk = vp.reshape(bsz, nh, nb, MOBA_BLOCK, dh)

    def to_qblocks(t):
        return t.reshape(bsz, nh, nqb, Q_BLOCK, t.shape[-1]).transpose(0, 2, 1, 3, 4).reshape(
            bsz * nqb, nh, Q_BLOCK, t.shape[-1])

    qr = to_qblocks(q)
    q_blk = jnp.arange(seq) // MOBA_BLOCK
    if n_sel > 0:
        kmean = jnp.mean(kblk.astype(jnp.float32), axis=3)
        gate = jnp.einsum('bhsd,bhnd->bhsn', q.astype(jnp.float32), kmean)
        fully_past = jnp.arange(nb)[None, :] < q_blk[:, None]
        gate = jnp.where(fully_past, gate, neg)
        _, sel = lax.top_k(gate, n_sel)
        valid = sel < q_blk[:, None]
        sel_r = to_qblocks(sel)
        valid_r = to_qblocks(valid)
    else:
        sel_r = jnp.zeros((bsz * nqb, nh, Q_BLOCK, 0), jnp.int32)
        valid_r = jnp.zeros((bsz * nqb, nh, Q_BLOCK, 0), jnp.bool_)
    b_idx = jnp.repeat(jnp.arange(bsz), nqb)
    j_idx = jnp.tile(jnp.arange(nqb), bsz)
    hidx = jnp.arange(nh)[:, None, None]

    def step(args):
        qb, sel_b, valid_b, b, j = args
        q_start = j * Q_BLOCK
        cur = q_start // MOBA_BLOCK
        kb = kblk[b]
        vb = vblk[b]
        k_cur = kb[:, cur]
        v_cur = vb[:, cur]
        qpos = q_start + jnp.arange(Q_BLOCK)
        kpos = cur * MOBA_BLOCK + jnp.arange(MOBA_BLOCK)
        s_cur = jnp.einsum('hqd,hkd->hqk', qb, k_cur, preferred_element_type=jnp.float32) * scale
        s_cur = jnp.where(kpos[None, None, :] <= qpos[None, :, None], s_cur, neg)
        if n_sel == 0:
            p = jax.nn.softmax(s_cur, axis=-1).astype(vb.dtype)
            out = jnp.einsum('hqk,hkd->hqd', p, v_cur)
        else:
            k_sel = kb[hidx, sel_b]
            v_sel = vb[hidx, sel_b]
            s_past = jnp.einsum('hqd,hqnkd->hqnk', qb, k_sel, preferred_element_type=jnp.float32) * scale
            s_past = jnp.where(valid_b[..., None], s_past, neg)
            s = jnp.concatenate([s_past.reshape(nh, Q_BLOCK, n_sel * MOBA_BLOCK), s_cur], axis=-1)
            p = jax.nn.softmax(s, axis=-1).astype(vb.dtype)
            p_past = p[..., :n_sel * MOBA_BLOCK].reshape(nh, Q_BLOCK, n_sel, MOBA_BLOCK)
            p_cur = p[..., n_sel * MOBA_BLOCK:]
            out = (jnp.einsum('hqnk,hqnkd->hqd', p_past, v_sel)
                   + jnp.einsum('hqk,hkd->hqd', p_cur, v_cur))
        return out.astype(q.dtype)

    outs = lax.map(step, (qr, sel_r, valid_r, b_idx, j_idx))
    outs = outs.reshape(bsz, nqb, nh, Q_BLOCK, dh).transpose(0, 1, 3, 2, 4)
    return outs.reshape(bsz, seq, nh * dh)


def hier_moe(h, w_group, b_group, w_expert, b_expert, w_gate_up, w_down):
    bsz, seq, d = h.shape
    n = bsz * seq
    xt = h.reshape(n, d)
    glog = (xt @ w_group).astype(jnp.float32) + b_group.astype(jnp.float32)
    gprob = jax.nn.softmax(glog, axis=-1)
    g_top = jnp.argmax(glog, axis=-1)
    p_g = jnp.take_along_axis(gprob, g_top[:, None], axis=-1)[:, 0]
    elog = ((xt @ w_expert).astype(jnp.float32) + b_expert.astype(jnp.float32)).reshape(
        n, N_GROUPS, EXPERTS_PER_GROUP)
    elog = jnp.take_along_axis(elog, g_top[:, None, None], axis=1)[:, 0]
    eprob = jax.nn.softmax(elog, axis=-1)
    top_p, top_e = lax.top_k(eprob, EXPERT_TOPK)
    top_p = top_p / jnp.sum(top_p, axis=-1, keepdims=True)
    weights = p_g[:, None] * top_p
    expert_id = g_top[:, None] * EXPERTS_PER_GROUP + top_e
    n_assign = n * EXPERT_TOPK
    flat_e = expert_id.reshape(-1).astype(jnp.int32)
    flat_tok = jnp.repeat(jnp.arange(n, dtype=jnp.int32), EXPERT_TOPK)
    flat_w = weights.reshape(-1)
    order = jnp.argsort(flat_e)
    se, stok, sw = flat_e[order], flat_tok[order], flat_w[order]
    counts = jnp.bincount(flat_e, length=N_EXPERTS)
    padded = (counts + EXPERT_ROWS - 1) // EXPERT_ROWS * EXPERT_ROWS
    start = jnp.cumsum(counts) - counts
    pend = jnp.cumsum(padded)
    pstart = pend - padded
    dest = pstart[se] + (jnp.arange(n_assign) - start[se])
    cap = n_assign + N_EXPERTS * EXPERT_ROWS
    nblk = cap // EXPERT_ROWS
    slot_tok = jnp.zeros((cap,), jnp.int32).at[dest].set(stok)
    slot_w = jnp.zeros((cap,), jnp.float32).at[dest].set(sw)
    blk_e = jnp.minimum(jnp.searchsorted(pend, jnp.arange(nblk) * EXPERT_ROWS, side='right'),
                        N_EXPERTS - 1)

    def expert_block(args):
        tok, e = args
        xb = xt[tok]
        gt, up = jnp.split(xb @ w_gate_up[e], 2, axis=-1)
        return (jax.nn.silu(gt) * up) @ w_down[e]

    yb = lax.map(expert_block, (slot_tok.reshape(nblk, EXPERT_ROWS), blk_e))
    y = yb.reshape(cap, d) * slot_w[:, None].astype(h.dtype)
    out = jax.ops.segment_sum(y, slot_tok, num_segments=n)
    return out.reshape(bsz, seq, d)


def setup_inputs(seed: int = 0) -> dict:
    key = jax.random.key(seed)
    ks = jax.random.split(key, 24)
    L = DEPTH
    f32 = jnp.float32

    def nrm(k, shape, scale):
        return jax.random.normal(k, shape, f32) * scale

    x = jax.random.normal(ks[0], (BATCH, SEQ, D_MODEL), f32)
    norm1_g = 1.0 + nrm(ks[1], (L, D_MODEL), 0.01)
    w_in = nrm(ks[2], (L, D_MODEL, D_IN), D_MODEL ** -0.5)
    ssm_a_re = -0.5 + nrm(ks[3], (L, SSM_GROUPS, SSM_STATE), 0.01)
    ssm_a_im = math.pi * jnp.arange(SSM_STATE, dtype=f32)[None, None, :] + nrm(
        ks[4], (L, SSM_GROUPS, SSM_STATE), 0.01)
    ssm_log_dt = jax.random.uniform(ks[5], (L, SSM_GROUPS), f32, math.log(DT_MIN), math.log(DT_MAX))
    ssm_b_re = nrm(ks[6], (L, SSM_GROUPS, SSM_STATE, SSM_GROUP_CH), (2 * SSM_GROUP_CH) ** -0.5)
    ssm_b_im = nrm(ks[7], (L, SSM_GROUPS, SSM_STATE, SSM_GROUP_CH), (2 * SSM_GROUP_CH) ** -0.5)
    ssm_c_re = nrm(ks[8], (L, SSM_GROUPS, SSM_GROUP_CH, SSM_STATE), (2 * SSM_STATE) ** -0.5)
    ssm_c_im = nrm(ks[9], (L, SSM_GROUPS, SSM_GROUP_CH, SSM_STATE), (2 * SSM_STATE) ** -0.5)
    ssm_d = nrm(ks[10], (L, SSM_WIDTH), 1.0)
    w_glu = nrm(ks[11], (L, SSM_WIDTH, 2 * D_MODEL), SSM_WIDTH ** -0.5)
    q_norm_g = 1.0 + nrm(ks[12], (L, HEAD_DIM), 0.01)
    k_norm_g = 1.0 + nrm(ks[13], (L, HEAD_DIM), 0.01)
    w_attn = nrm(ks[14], (L, ATTN_WIDTH, D_MODEL), ATTN_WIDTH ** -0.5)
    w_out = nrm(ks[15], (L, D_MODEL, D_MODEL), D_MODEL ** -0.5)
    norm2_g = 1.0 + nrm(ks[16], (L, D_MODEL), 0.01)
    router_w_group = nrm(ks[17], (L, D_MODEL, N_GROUPS), D_MODEL ** -0.5)
    router_b_group = nrm(ks[18], (L, N_GROUPS), 0.01)
    router_w_expert = nrm(ks[19], (L, D_MODEL, N_EXPERTS), D_MODEL ** -0.5)
    router_b_expert = nrm(ks[20], (L, N_EXPERTS), 0.01)
    w_gate_up = nrm(ks[21], (L, N_EXPERTS, D_MODEL, 2 * D_EXPERT), D_MODEL ** -0.5)
    w_down = nrm(ks[22], (L, N_EXPERTS, D_EXPERT, D_MODEL), D_EXPERT ** -0.5)
    return {"x": x, "norm1_g": norm1_g, "w_in": w_in, "ssm_a_re": ssm_a_re, "ssm_a_im": ssm_a_im,
            "ssm_log_dt": ssm_log_dt, "ssm_b_re": ssm_b_re, "ssm_b_im": ssm_b_im, "ssm_c_re": ssm_c_re,
            "ssm_c_im": ssm_c_im, "ssm_d": ssm_d, "w_glu": w_glu, "q_norm_g": q_norm_g,
            "k_norm_g": k_norm_g, "w_attn": w_attn, "w_out": w_out, "norm2_g": norm2_g,
            "router_w_group": router_w_group, "router_b_group": router_b_group,
            "router_w_expert": router_w_expert, "router_b_expert": router_b_expert,
            "w_gate_up": w_gate_up, "w_down": w_down}


def reference(x, norm1_g, w_in, ssm_a_re, ssm_a_im, ssm_log_dt, ssm_b_re, ssm_b_im, ssm_c_re, ssm_c_im,
              ssm_d, w_glu, q_norm_g, k_norm_g, w_attn, w_out, norm2_g, router_w_group, router_b_group,
              router_w_expert, router_b_expert, w_gate_up, w_down):
    bsz, seq, _ = x.shape
    cos, sin = rope_tables(seq, HEAD_DIM)
    splits = [SSM_WIDTH, SSM_WIDTH + ATTN_WIDTH, SSM_WIDTH + 2 * ATTN_WIDTH,
              SSM_WIDTH + 3 * ATTN_WIDTH, SSM_WIDTH + 3 * ATTN_WIDTH + D_MODEL]
    for l in range(DEPTH):
        h = rms_norm(x, norm1_g[l])
        proj = h @ w_in[l]
        u, q, k, v, g_ssm, g_attn = jnp.split(proj, splits, axis=-1)
        y_ssm = s5_branch(u, ssm_a_re[l], ssm_a_im[l], ssm_log_dt[l], ssm_b_re[l], ssm_b_im[l],
                          ssm_c_re[l], ssm_c_im[l], ssm_d[l], w_glu[l])
        q = q.reshape(bsz, seq, N_HEADS, HEAD_DIM).transpose(0, 2, 1, 3)
        k = k.reshape(bsz, seq, N_HEADS, HEAD_DIM).transpose(0, 2, 1, 3)
        v = v.reshape(bsz, seq, N_HEADS, HEAD_DIM).transpose(0, 2, 1, 3)
        q = apply_rope(rms_norm(q, q_norm_g[l]), cos, sin)
        k = apply_rope(rms_norm(k, k_norm_g[l]), cos, sin)
        y_attn = moba_attention(q, k, v) @ w_attn[l]
        mixed = jax.nn.sigmoid(g_ssm) * y_ssm + jax.nn.sigmoid(g_attn) * y_attn
        x = x + mixed @ w_out[l]
        h2 = rms_norm(x, norm2_g[l])
        x = x + hier_moe(h2, router_w_group[l], router_b_group[l], router_w_expert[l],
                         router_b_expert[l], w_gate_up[l], w_down[l])
    return x
```

```cpp
#include <hip/hip_runtime.h>
#include <cstdint>
#include <cstdio>
#include <cmath>

#define DEVI __device__ __forceinline__
typedef unsigned short bf16_t;
typedef short bf16x8 __attribute__((ext_vector_type(8)));
typedef float f32x4 __attribute__((ext_vector_type(4)));
typedef float f32x16 __attribute__((ext_vector_type(16)));
typedef unsigned u32x4 __attribute__((ext_vector_type(4)));
typedef unsigned u32x2 __attribute__((ext_vector_type(2)));

constexpr int D = 1024, BATCH = 8, SEQ = 4096, NTOK = BATCH * SEQ, DEPTH = 2;
constexpr int SSM_G = 32, SSM_C = 16, SSM_W = 512, SSM_P = 64;
constexpr int NH = 8, HD = 64, AW = 512, MOBA_B = 256, NBLK = SEQ / MOBA_B;
constexpr int D_IN = 4096;
constexpr int NEXP = 32, DEXP = 512;
constexpr int CHL = 32, NCH = SEQ / CHL, UK = 640, UROWS = BATCH * NCH;
constexpr int SLOT_CAP = 2 * NTOK + NEXP * 256;
constexpr int LIST_CAP = NTOK;
constexpr float NORM_EPS = 1e-6f;
constexpr float QSCALE = 0.125f * 1.4426950408889634f;

constexpr size_t MiB = 1u << 20;
constexpr size_t WS_CTL = 0, CTL_BYTES = 1 * MiB;
constexpr size_t WS_ROPE = 1 * MiB;
constexpr size_t WS_MISC = 2 * MiB;
constexpr size_t WS_REC = 4 * MiB;
constexpr size_t WS_LIST = 5 * MiB;
constexpr size_t WS_S5TC = 16 * MiB;
constexpr size_t WS_S5BS = 56 * MiB;
constexpr size_t WS_H = 284 * MiB;
constexpr size_t WS_UCAT = 348 * MiB;
constexpr size_t WS_Q = 388 * MiB, WS_K = 420 * MiB, WS_V = 452 * MiB;
constexpr size_t WS_SG = 484 * MiB;
constexpr size_t WS_Z = 612 * MiB;
constexpr size_t WS_ATT = 644 * MiB;
constexpr size_t WS_MIXA = 676 * MiB, WS_MIXED = 740 * MiB;
constexpr size_t WS_SL = 804 * MiB;
constexpr size_t WS_END = 820 * MiB;
constexpr size_t WS_HMID = WS_UCAT;
constexpr size_t WS_YBUF = WS_SG;
constexpr size_t WS_QRAW = WS_MIXA, WS_KRAW = WS_MIXED;
constexpr size_t MISC_AL = 0;
constexpr size_t MISC_KSUM = 64 * 1024;
constexpr size_t MISC_PSTART = 512 * 1024;
constexpr int CW_CNT = 64;

DEVI float bf2f(bf16_t v) { return __uint_as_float((unsigned)v << 16); }
DEVI bf16_t f2bf(float f) { unsigned u = __float_as_uint(f); return (bf16_t)((u + 0x7fffu + ((u >> 16) & 1u)) >> 16); }
DEVI unsigned pk2(float lo, float hi) { return (unsigned)f2bf(lo) | ((unsigned)f2bf(hi) << 16); }
DEVI float sigmoidf_(float x) { return 1.f / (1.f + __expf(-x)); }
DEVI float gelu_tanh(float x) { const float u = 0.7978845608028654f * (x + 0.044715f * x * x * x); return 0.5f * x * (1.f + tanhf(u)); }
DEVI float wave_sum(float v) {
#pragma unroll
    for (int o = 1; o < 64; o <<= 1) v += __shfl_xor(v, o);
    return v;
}
DEVI float wave_max(float v) {
#pragma unroll
    for (int o = 1; o < 64; o <<= 1) v = fmaxf(v, __shfl_xor(v, o));
    return v;
}

__global__ void __launch_bounds__(256) s_rope_table(float* rope) {
    const int idx = blockIdx.x * 256 + threadIdx.x;
    if (idx >= SEQ * 32) return;
    const int s = idx >> 5, i = idx & 31;
    const float inv = powf(10000.0f, -(float)(2 * i) / 64.0f);
    const float ang = (float)s * inv;
    float sn, cs; sincosf(ang, &sn, &cs);
    rope[2 * idx] = cs; rope[2 * idx + 1] = sn;
}

DEVI void s5_tables_item(int l, int g, const float* a_re, const float* a_im, const float* log_dt, const float* b_re, const float* b_im,
                         const float* c_re, const float* c_im, bf16_t* TC, bf16_t* BS, float* AL, float* lds, int tid, int nthr) {
    float2* pw = (float2*)lds;
    float2* Cc = pw + 33 * 64;
    float2* Bb = Cc + 16 * 64;
    float* Kt = (float*)(Bb + 64 * 16);
    const int lg = l * SSM_G + g;
    const float dt = expf(log_dt[lg]);
    for (int i = tid; i < 33 * 64; i += nthr) {
        const int tau = i >> 6, p = i & 63;
        const float lr = a_re[lg * 64 + p], li = a_im[lg * 64 + p];
        const float mag = expf(lr * dt * (float)tau);
        float sn, cs; sincosf(li * dt * (float)tau, &sn, &cs);
        pw[i] = make_float2(mag * cs, mag * sn);
    }
    for (int i = tid; i < 16 * 64; i += nthr) {
        Cc[i] = make_float2(c_re[(size_t)lg * 1024 + i], c_im[(size_t)lg * 1024 + i]);
    }
    for (int i = tid; i < 64 * 16; i += nthr) {
        const int p = i >> 4;
        const float lr = a_re[lg * 64 + p], li = a_im[lg * 64 + p];
        const float mag = expf(lr * dt);
        float sn, cs; sincosf(li * dt, &sn, &cs);
        const float abr = mag * cs, abi = mag * sn;
        const float den = lr * lr + li * li, nre = abr - 1.0f;
        const float fre = (nre * lr + abi * li) / den, fim = (abi * lr - nre * li) / den;
        const float br = b_re[(size_t)lg * 1024 + i], bi = b_im[(size_t)lg * 1024 + i];
        Bb[i] = make_float2(fre * br - fim * bi, fre * bi + fim * br);
    }
    __syncthreads();
    for (int i = tid; i < 32 * 256; i += nthr) {
        const int tau = i >> 8, co = (i >> 4) & 15, ci = i & 15;
        float acc = 0.f;
        for (int p = 0; p < 64; ++p) {
            const float2 c = Cc[co * 64 + p], w = pw[tau * 64 + p], b = Bb[p * 16 + ci];
            const float xr = c.x * w.x - c.y * w.y, xi = c.x * w.y + c.y * w.x;
            acc += xr * b.x - xi * b.y;
        }
        Kt[i] = acc;
    }
    __syncthreads();
    for (int i = tid; i < 512 * 640; i += nthr) {
        const int n = i / 640, k = i % 640, t = n >> 4, co = n & 15;
        float v;
        if (k < 512) { const int tp = k >> 4, ci = k & 15; v = (t >= tp) ? Kt[((t - tp) * 16 + co) * 16 + ci] : 0.f; }
        else { const int p = (k - 512) & 63; const float2 c = Cc[co * 64 + p], w = pw[(t + 1) * 64 + p];
            const float xr = c.x * w.x - c.y * w.y, xi = c.x * w.y + c.y * w.x; v = (k < 576) ? xr : -xi; }
        TC[i] = f2bf(v);
    }
    for (int i = tid; i < 128 * 512; i += nthr) {
        const int row = i >> 9, k = i & 511, p = row & 63, tp = k >> 4, ci = k & 15;
        const float2 w = pw[(31 - tp) * 64 + p], b = Bb[p * 16 + ci];
        BS[i] = f2bf(row < 64 ? (w.x * b.x - w.y * b.y) : (w.x * b.y + w.y * b.x));
    }
    for (int i = tid; i < 64; i += nthr) { AL[2 * i] = pw[32 * 64 + i].x; AL[2 * i + 1] = pw[32 * 64 + i].y; }
    __syncthreads();
}
__global__ void __launch_bounds__(512) s_s5_tables(const float* a_re, const float* a_im, const float* log_dt, const float* b_re, const float* b_im,
                                                   const float* c_re, const float* c_im, bf16_t* TC, bf16_t* BS, float* AL) {
    extern __shared__ __attribute__((aligned(16))) unsigned char dyn_lds[];
    const int l = blockIdx.x / SSM_G, g = blockIdx.x % SSM_G;
    s5_tables_item(l, g, a_re, a_im, log_dt, b_re, b_im, c_re, c_im, TC + (size_t)blockIdx.x * 512 * 640, BS + (size_t)blockIdx.x * 128 * 512,
                   AL + (size_t)blockIdx.x * 128, (float*)dyn_lds, threadIdx.x, 512);
}

__global__ void __launch_bounds__(256) s_rmsnorm(const float* x, const float* g, bf16_t* out) {
    const int row = blockIdx.x * 4 + (threadIdx.x >> 6), lane = threadIdx.x & 63;
    const f32x4* xr = (const f32x4*)(x + (size_t)row * D) + lane;
    f32x4 v[4]; float s = 0.f;
#pragma unroll
    for (int j = 0; j < 4; ++j) { v[j] = xr[64 * j]; s += (v[j].x * v[j].x + v[j].y * v[j].y) + (v[j].z * v[j].z + v[j].w * v[j].w); }
    const float rstd = 1.0f / sqrtf(wave_sum(s) * (1.0f / D) + NORM_EPS);
#pragma unroll
    for (int j = 0; j < 4; ++j) {
        const f32x4 gg = *((const f32x4*)g + lane + 64 * j);
        u32x2 o; o.x = pk2(v[j].x * rstd * gg.x, v[j].y * rstd * gg.y); o.y = pk2(v[j].z * rstd * gg.z, v[j].w * rstd * gg.w);
        *((u32x2*)(out + (size_t)row * D) + lane + 64 * j) = o;
    }
}

template <int BMODE, class RowF, class Epi>
__global__ void __launch_bounds__(256) sg_kernel(RowF rowf, const void* Bv, size_t bstride, int ldb, int K, int nct, int cstep, int off2, Epi epi) {
    const int lane = threadIdx.x & 63, r = lane & 31, h = lane >> 5;
    const int wave = (blockIdx.x * 256 + threadIdx.x) >> 6, nw = gridDim.x * 4;
    const int nrows = rowf.nrows(), nrt = (nrows + 31) / 32;
    const float* Bf = (const float*)Bv + (size_t)blockIdx.y * bstride;
    const bf16_t* Bt = (const bf16_t*)Bv + (size_t)blockIdx.y * bstride;
    for (int tile = wave; tile < nrt * nct; tile += nw) {
        const int rt = tile / nct, ct = tile % nct, c0 = ct * cstep, c1 = c0 + off2;
        const int arow_i = rt * 32 + r;
        const bf16_t* arow = (arow_i < nrows) ? rowf(arow_i) : nullptr;
        f32x16 acc0 = {}, acc1 = {};
        for (int k = 0; k < K; k += 16) {
            bf16x8 a = {};
            if (arow) a = *(const bf16x8*)(arow + k + 8 * h);
            bf16x8 b0, b1;
            if (BMODE == 0) {
#pragma unroll
                for (int j = 0; j < 8; ++j) { b0[j] = (short)f2bf(Bf[(size_t)(k + 8 * h + j) * ldb + c0 + r]); b1[j] = (short)f2bf(Bf[(size_t)(k + 8 * h + j) * ldb + c1 + r]); }
            } else {
                b0 = *(const bf16x8*)(Bt + (size_t)(c0 + r) * ldb + k + 8 * h);
                b1 = *(const bf16x8*)(Bt + (size_t)(c1 + r) * ldb + k + 8 * h);
            }
            acc0 = __builtin_amdgcn_mfma_f32_32x32x16_bf16(a, b0, acc0, 0, 0, 0);
            acc1 = __builtin_amdgcn_mfma_f32_32x32x16_bf16(a, b1, acc1, 0, 0, 0);
        }
#pragma unroll
        for (int reg = 0; reg < 16; ++reg) {
            const int row = rt * 32 + (reg & 3) + 8 * (reg >> 2) + 4 * h;
            if (row < nrows) epi(row, c0 + r, c1 + r, acc0[reg], acc1[reg]);
        }
    }
}

struct RowPlain { const bf16_t* A; int lda; int n; size_t ystride;
    DEVI int nrows() const { return n; }
    DEVI const bf16_t* operator()(int r) const { return A + (size_t)blockIdx.y * ystride + (size_t)r * lda; } };

struct EpiG1s { bf16_t* ucat; float* qraw; float* kraw; bf16_t* v; bf16_t* sg;
    DEVI void one(int row, int c, float a) const {
        if (c < 512) { const int b = row >> 12, s = row & 4095, g = c >> 4, ci = c & 15;
            ucat[((size_t)g * UROWS + b * NCH + (s >> 5)) * UK + (s & 31) * 16 + ci] = f2bf(a); }
        else if (c < 1024) qraw[(size_t)row * 512 + (c - 512)] = a;
        else if (c < 1536) kraw[(size_t)row * 512 + (c - 1024)] = a;
        else if (c < 2048) v[(size_t)row * 512 + (c - 1536)] = f2bf(a);
        else sg[(size_t)row * 2048 + (c - 2048)] = f2bf(sigmoidf_(a));
    }
    DEVI void operator()(int row, int c0, int c1, float a0, float a1) const { one(row, c0, a0); one(row, c1, a1); } };

__global__ void __launch_bounds__(256) s_qkpost(const float* qraw, const float* kraw, const float* qg, const float* kg, const float* rope, bf16_t* Q, bf16_t* K) {
    const int idx = blockIdx.x * 256 + threadIdx.x;
    const int which = idx & 1, hh = (idx >> 1) & 7, tok = idx >> 4;
    if (tok >= NTOK) return;
    const float* src = (which ? kraw : qraw) + (size_t)tok * 512 + hh * 64;
    const float* gn = which ? kg : qg;
    float x[64]; float ss = 0.f;
#pragma unroll
    for (int i = 0; i < 16; ++i) { const f32x4 t = *((const f32x4*)src + i); x[4 * i] = t.x; x[4 * i + 1] = t.y; x[4 * i + 2] = t.z; x[4 * i + 3] = t.w; ss += (t.x * t.x + t.y * t.y) + (t.z * t.z + t.w * t.w); }
    const float rstd = 1.0f / sqrtf(ss * (1.0f / 64.0f) + NORM_EPS);
    const int s = tok & (SEQ - 1);
    const float sc = which ? 1.0f : QSCALE;
    bf16_t* dst = (which ? K : Q) + (size_t)tok * 512 + hh * 64;
#pragma unroll
    for (int i = 0; i < 32; ++i) {
        const float x1 = x[i] * rstd * gn[i], x2 = x[i + 32] * rstd * gn[i + 32];
        const float cs = rope[(s * 32 + i) * 2], sn = rope[(s * 32 + i) * 2 + 1];
        dst[i] = f2bf((x1 * cs - x2 * sn) * sc);
        dst[i + 32] = f2bf((x2 * cs + x1 * sn) * sc);
    }
}
__global__ void __launch_bounds__(256) s_ksum(const bf16_t* K, float* ksum) {
    const int w = blockIdx.x * 4 + (threadIdx.x >> 6), lane = threadIdx.x & 63;
    const int blk = w & 15, hh = (w >> 4) & 7, b = w >> 7;
    float s = 0.f;
    for (int r = 0; r < 256; ++r) s += bf2f(K[((size_t)b * SEQ + blk * 256 + r) * 512 + hh * 64 + lane]);
    ksum[(size_t)w * 64 + lane] = s;
}

__global__ void __launch_bounds__(256) s_attn(const bf16_t* Q, const bf16_t* K, const bf16_t* V, const float* ksum, bf16_t* O) {
    const int w = blockIdx.x * 4 + (threadIdx.x >> 6), lane = threadIdx.x & 63;
    const int s = w & (SEQ - 1), hh = (w >> 12) & 7, b = w >> 15;
    const int qb = s >> 8;
    const bf16_t* qp = Q + ((size_t)b * SEQ + s) * 512 + hh * 64;
    float q[64];
#pragma unroll
    for (int i = 0; i < 8; ++i) { const bf16x8 t = *((const bf16x8*)qp + i);
#pragma unroll
        for (int j = 0; j < 8; ++j) q[8 * i + j] = bf2f((bf16_t)t[j]); }
    float gsc = -INFINITY;
    if (lane < qb) { const float* km = ksum + ((size_t)(b * 8 + hh) * 16 + lane) * 64; float a = 0.f;
#pragma unroll
        for (int i = 0; i < 64; ++i) a += q[i] * km[i];
        gsc = a; }
    int blks[4]; int nsel = 0;
#pragma unroll
    for (int t = 0; t < 3; ++t) {
        float best = -INFINITY; int bi = -1;
        for (int j = 0; j < 15; ++j) { const float v = __shfl(gsc, j); const bool used = (t > 0 && j == blks[0]) || (t > 1 && j == blks[1]); if (j < qb && !used && v > best) { best = v; bi = j; } }
        blks[t] = bi; if (bi >= 0) nsel = t + 1;
    }
    blks[3] = qb;
    float sc[4][4]; float m = -INFINITY;
#pragma unroll
    for (int t = 0; t < 4; ++t) {
        const bool on = (t == 3) || (t < nsel);
        const int blk = on ? blks[t] : 0;
#pragma unroll
        for (int i = 0; i < 4; ++i) {
            const int key = blk * 256 + lane + 64 * i;
            float a = -INFINITY;
            if (on && (t < 3 || key <= s)) {
                const bf16_t* kp = K + ((size_t)b * SEQ + key) * 512 + hh * 64; a = 0.f;
#pragma unroll
                for (int c = 0; c < 8; ++c) { const bf16x8 kk = *((const bf16x8*)kp + c);
#pragma unroll
                    for (int j = 0; j < 8; ++j) a += q[8 * c + j] * bf2f((bf16_t)kk[j]); }
            }
            sc[t][i] = a; m = fmaxf(m, a);
        }
    }
    m = wave_max(m);
    float l = 0.f;
#pragma unroll
    for (int t = 0; t < 4; ++t)
#pragma unroll
        for (int i = 0; i < 4; ++i) { const float p = exp2f(sc[t][i] - m); sc[t][i] = p; l += p; }
    l = wave_sum(l);
    float o = 0.f;
#pragma unroll
    for (int t = 0; t < 4; ++t) {
        const bool on = (t == 3) || (t < nsel);
        if (!on) continue;
        const int blk = blks[t];
#pragma unroll
        for (int i = 0; i < 4; ++i) {
            const float pv = sc[t][i];
            for (int j = 0; j < 64; ++j) {
                const float p = __shfl(pv, j);
                const int key = blk * 256 + j + 64 * i;
                if (p != 0.f) o += p * bf2f(V[((size_t)b * SEQ + key) * 512 + hh * 64 + lane]);
            }
        }
    }
    O[((size_t)b * SEQ + s) * 512 + hh * 64 + lane] = f2bf(o / l);
}

struct EpiS5A { float* sl; DEVI void operator()(int row, int c0, int c1, float a0, float a1) const { float* p = sl + ((size_t)blockIdx.y * UROWS + row) * 128; p[c0] = a0; p[c1] = a1; } };
__global__ void __launch_bounds__(256) s_s5_scan(const float* sl, const float* AL, bf16_t* ucat) {
    const int idx = blockIdx.x * 256 + threadIdx.x;
    const int p = idx & 63, b = (idx >> 6) & 7, g = idx >> 9;
    const float ar = AL[(g * 64 + p) * 2], ai = AL[(g * 64 + p) * 2 + 1];
    float hr = 0.f, hi = 0.f;
    for (int c = 0; c < NCH; ++c) {
        const size_t row = (size_t)g * UROWS + b * NCH + c;
        ucat[row * UK + 512 + p] = f2bf(hr); ucat[row * UK + 576 + p] = f2bf(hi);
        const float sr = sl[row * 128 + p], si = sl[row * 128 + 64 + p];
        const float nr = ar * hr - ai * hi + sr, ni = ar * hi + ai * hr + si; hr = nr; hi = ni;
    }
}
struct EpiS5C { const bf16_t* ucat; const float* dskip; bf16_t* z;
    DEVI void one(int row, int n, float a) const {
        const int g = blockIdx.y, t = n >> 4, co = n & 15, b = row >> 7, c = row & 127;
        const float u = bf2f(ucat[((size_t)g * UROWS + row) * UK + n]);
        const float y = a + dskip[g * 16 + co] * u;
        z[((size_t)b * SEQ + c * CHL + t) * 512 + g * 16 + co] = f2bf(gelu_tanh(y));
    }
    DEVI void operator()(int row, int c0, int c1, float a0, float a1) const { one(row, c0, a0); one(row, c1, a1); } };

struct EpiG3s { const bf16_t* sg; bf16_t* mixa;
    DEVI void operator()(int row, int c0, int c1, float val, float gate) const { mixa[(size_t)row * 1024 + c0] = f2bf(bf2f(sg[(size_t)row * 2048 + c0]) * val * sigmoidf_(gate)); } };
struct EpiG4s { const bf16_t* sg; const bf16_t* mixa; bf16_t* mixed;
    DEVI void one(int row, int c, float a) const { mixed[(size_t)row * 1024 + c] = f2bf(bf2f(mixa[(size_t)row * 1024 + c]) + bf2f(sg[(size_t)row * 2048 + 1024 + c]) * a); }
    DEVI void operator()(int row, int c0, int c1, float a0, float a1) const { one(row, c0, a0); one(row, c1, a1); } };
struct EpiG5s { const float* xin; float* xout;
    DEVI void operator()(int row, int c0, int c1, float a0, float a1) const { xout[(size_t)row * 1024 + c0] = xin[(size_t)row * 1024 + c0] + a0; xout[(size_t)row * 1024 + c1] = xin[(size_t)row * 1024 + c1] + a1; } };

__global__ void __launch_bounds__(256) s_norm_router(const float* x, const float* g, const float* wg, const float* bg, const float* we, const float* be,
                                                     bf16_t* h2, unsigned* cnt, int* list, unsigned* rec) {
    const int row = blockIdx.x * 4 + (threadIdx.x >> 6), lane = threadIdx.x & 63;
    const f32x4* xr = (const f32x4*)(x + (size_t)row * D) + lane;
    f32x4 v[4]; float s = 0.f;
#pragma unroll
    for (int j = 0; j < 4; ++j) { v[j] = xr[64 * j]; s += (v[j].x * v[j].x + v[j].y * v[j].y) + (v[j].z * v[j].z + v[j].w * v[j].w); }
    const float rstd = 1.0f / sqrtf(wave_sum(s) * (1.0f / D) + NORM_EPS);
    float acc[36];
#pragma unroll
    for (int o = 0; o < 36; ++o) acc[o] = 0.f;
#pragma unroll
    for (int j = 0; j < 4; ++j) {
        const f32x4 gg = *((const f32x4*)g + lane + 64 * j);
        const float hv[4] = {v[j].x * rstd * gg.x, v[j].y * rstd * gg.y, v[j].z * rstd * gg.z, v[j].w * rstd * gg.w};
        u32x2 o; o.x = pk2(hv[0], hv[1]); o.y = pk2(hv[2], hv[3]);
        *((u32x2*)(h2 + (size_t)row * D) + lane + 64 * j) = o;
#pragma unroll
        for (int e = 0; e < 4; ++e) {
            const int k = 4 * lane + 256 * j + e;
            const f32x4 w4 = *(const f32x4*)(wg + (size_t)k * 4);
            acc[0] += hv[e] * w4.x; acc[1] += hv[e] * w4.y; acc[2] += hv[e] * w4.z; acc[3] += hv[e] * w4.w;
#pragma unroll
            for (int q = 0; q < 8; ++q) { const f32x4 w = *(const f32x4*)(we + (size_t)k * 32 + 4 * q);
                acc[4 + 4 * q] += hv[e] * w.x; acc[5 + 4 * q] += hv[e] * w.y; acc[6 + 4 * q] += hv[e] * w.z; acc[7 + 4 * q] += hv[e] * w.w; }
        }
    }
#pragma unroll
    for (int o = 0; o < 36; ++o) acc[o] = wave_sum(acc[o]);
    if (lane == 0) {
        float gl[4]; int gt = 0; float gm = -INFINITY;
#pragma unroll
        for (int i = 0; i < 4; ++i) { gl[i] = acc[i] + bg[i]; if (gl[i] > gm) { gm = gl[i]; gt = i; } }
        float gs = 0.f;
#pragma unroll
        for (int i = 0; i < 4; ++i) gs += __expf(gl[i] - gm);
        const float pg = 1.0f / gs;
        float el[8]; float em = -INFINITY;
#pragma unroll
        for (int i = 0; i < 8; ++i) { float t = 0.f;
#pragma unroll
            for (int gq = 0; gq < 4; ++gq) t = (gq == gt) ? acc[4 + gq * 8 + i] + be[gq * 8 + i] : t;
            el[i] = t; em = fmaxf(em, t); }
        int i1 = 0; float v1 = -INFINITY;
#pragma unroll
        for (int i = 0; i < 8; ++i) if (el[i] > v1) { v1 = el[i]; i1 = i; }
        int i2 = 0; float v2 = -INFINITY;
#pragma unroll
        for (int i = 0; i < 8; ++i) if (i != i1 && el[i] > v2) { v2 = el[i]; i2 = i; }
        const float p1 = __expf(v1 - em), p2 = __expf(v2 - em);
        const float w0 = pg * p1 / (p1 + p2), w1 = pg * p2 / (p1 + p2);
        const int e0 = gt * 8 + i1, e1 = gt * 8 + i2;
        const unsigned pos0 = atomicAdd(cnt + e0, 1u), pos1 = atomicAdd(cnt + e1, 1u);
        list[(size_t)e0 * LIST_CAP + pos0] = row; list[(size_t)e1 * LIST_CAP + pos1] = row;
        unsigned* rp = rec + (size_t)row * 8;
        rp[0] = (unsigned)e0; rp[1] = (unsigned)e1; rp[2] = pos0; rp[3] = pos1; rp[4] = __float_as_uint(w0); rp[5] = __float_as_uint(w1);
    }
}
__global__ void s_offsets(const unsigned* cnt, int* pstart) {
    if (threadIdx.x == 0 && blockIdx.x == 0) { int a = 0; for (int e = 0; e < NEXP; ++e) { pstart[e] = a; a += (int)((cnt[e] + 255u) / 256u) * 256; } pstart[NEXP] = a; }
}
struct RowM1 { const bf16_t* h2; const int* list; const unsigned* cnt;
    DEVI int nrows() const { return (int)cnt[blockIdx.y]; }
    DEVI const bf16_t* operator()(int r) const { return h2 + (size_t)list[(size_t)blockIdx.y * LIST_CAP + r] * D; } };
struct EpiM1s { bf16_t* hmid; const int* pstart;
    DEVI void operator()(int row, int c0, int c1, float gt, float up) const { hmid[((size_t)pstart[blockIdx.y] + row) * 512 + c0] = f2bf(gt * sigmoidf_(gt) * up); } };
struct RowM2 { const bf16_t* hmid; const int* pstart; const unsigned* cnt;
    DEVI int nrows() const { return (int)cnt[blockIdx.y]; }
    DEVI const bf16_t* operator()(int r) const { return hmid + ((size_t)pstart[blockIdx.y] + r) * 512; } };
struct EpiM2s { bf16_t* ybuf; const int* pstart;
    DEVI void operator()(int row, int c0, int c1, float a0, float a1) const { bf16_t* p = ybuf + ((size_t)pstart[blockIdx.y] + row) * 1024; p[c0] = f2bf(a0); p[c1] = f2bf(a1); } };
__global__ void __launch_bounds__(256) s_combine(float* x, const bf16_t* ybuf, const unsigned* rec, const int* pstart) {
    const int row = blockIdx.x * 4 + (threadIdx.x >> 6), lane = threadIdx.x & 63;
    const unsigned* rp = rec + (size_t)row * 8;
    const int e0 = (int)rp[0], e1 = (int)rp[1]; const unsigned pos0 = rp[2], pos1 = rp[3];
    const float w0 = __uint_as_float(rp[4]), w1 = __uint_as_float(rp[5]);
    const bf16_t* y0 = ybuf + ((size_t)pstart[e0] + pos0) * 1024; const bf16_t* y1 = ybuf + ((size_t)pstart[e1] + pos1) * 1024;
    f32x4* xr = (f32x4*)(x + (size_t)row * D) + lane;
#pragma unroll
    for (int j = 0; j < 4; ++j) {
        f32x4 v = xr[64 * j];
        const u32x2 a = *((const u32x2*)y0 + lane + 64 * j), b = *((const u32x2*)y1 + lane + 64 * j);
        v.x += w0 * __uint_as_float(a.x << 16) + w1 * __uint_as_float(b.x << 16);
        v.y += w0 * __uint_as_float(a.x & 0xffff0000u) + w1 * __uint_as_float(b.x & 0xffff0000u);
        v.z += w0 * __uint_as_float(a.y << 16) + w1 * __uint_as_float(b.y << 16);
        v.w += w0 * __uint_as_float(a.y & 0xffff0000u) + w1 * __uint_as_float(b.y & 0xffff0000u);
        xr[64 * j] = v;
    }
}

extern "C" void kernel_launch(void* const* d_in, const int* in_sizes, int n_in, void* d_out, int out_size, void* d_ws, size_t ws_size, hipStream_t stream) {
    if (n_in != 23 || ws_size < WS_END) { fprintf(stderr, "kernel_launch: unexpected n_in %d or ws_size %zu\n", n_in, ws_size); return; }
    const float* x_in = (const float*)d_in[0];
    const float* norm1_g = (const float*)d_in[1];
    const float* w_in = (const float*)d_in[2];
    const float* a_re = (const float*)d_in[3];
    const float* a_im = (const float*)d_in[4];
    const float* log_dt = (const float*)d_in[5];
    const float* b_re = (const float*)d_in[6];
    const float* b_im = (const float*)d_in[7];
    const float* c_re = (const float*)d_in[8];
    const float* c_im = (const float*)d_in[9];
    const float* ssm_d = (const float*)d_in[10];
    const float* w_glu = (const float*)d_in[11];
    const float* qng = (const float*)d_in[12];
    const float* kng = (const float*)d_in[13];
    const float* w_attn = (const float*)d_in[14];
    const float* w_out = (const float*)d_in[15];
    const float* norm2_g = (const float*)d_in[16];
    const float* wgrp = (const float*)d_in[17];
    const float* bgrp = (const float*)d_in[18];
    const float* wexp = (const float*)d_in[19];
    const float* bexp = (const float*)d_in[20];
    const float* w_gu = (const float*)d_in[21];
    const float* w_dn = (const float*)d_in[22];
    unsigned char* ws = (unsigned char*)d_ws;
    float* X = (float*)d_out;
    unsigned* ctl = (unsigned*)(ws + WS_CTL);
    float* rope = (float*)(ws + WS_ROPE);
    float* AL = (float*)(ws + WS_MISC + MISC_AL);
    float* ksum = (float*)(ws + WS_MISC + MISC_KSUM);
    int* pstart = (int*)(ws + WS_MISC + MISC_PSTART);
    unsigned* rec = (unsigned*)(ws + WS_REC);
    int* list = (int*)(ws + WS_LIST);
    bf16_t* TC = (bf16_t*)(ws + WS_S5TC);
    bf16_t* BS = (bf16_t*)(ws + WS_S5BS);
    bf16_t* H = (bf16_t*)(ws + WS_H);
    bf16_t* UCAT = (bf16_t*)(ws + WS_UCAT);
    bf16_t* Qb = (bf16_t*)(ws + WS_Q); bf16_t* Kb = (bf16_t*)(ws + WS_K); bf16_t* Vb = (bf16_t*)(ws + WS_V);
    bf16_t* SG = (bf16_t*)(ws + WS_SG);
    bf16_t* Z = (bf16_t*)(ws + WS_Z);
    bf16_t* ATT = (bf16_t*)(ws + WS_ATT);
    bf16_t* MIXA = (bf16_t*)(ws + WS_MIXA); bf16_t* MIXED = (bf16_t*)(ws + WS_MIXED);
    float* SL = (float*)(ws + WS_SL);
    bf16_t* HMID = (bf16_t*)(ws + WS_HMID); bf16_t* YBUF = (bf16_t*)(ws + WS_YBUF);
    float* QRAW = (float*)(ws + WS_QRAW); float* KRAW = (float*)(ws + WS_KRAW);

    static bool attr_done = false;
    if (!attr_done) { hipFuncSetAttribute((const void*)s_s5_tables, hipFuncAttributeMaxDynamicSharedMemorySize, 96 * 1024); attr_done = true; }

    hipMemsetAsync(ws + WS_CTL, 0, CTL_BYTES, stream);
    s_rope_table<<<SEQ * 32 / 256, 256, 0, stream>>>(rope);
    s_s5_tables<<<DEPTH * SSM_G, 512, 96 * 1024, stream>>>(a_re, a_im, log_dt, b_re, b_im, c_re, c_im, TC, BS, AL);
    const int SGB = 2048;
    for (int l = 0; l < DEPTH; ++l) {
        const float* xin = (l == 0) ? x_in : X;
        s_rmsnorm<<<NTOK / 4, 256, 0, stream>>>(xin, norm1_g + l * D, H);
        sg_kernel<0, RowPlain, EpiG1s><<<dim3(SGB, 1), 256, 0, stream>>>(RowPlain{H, D, NTOK, 0}, w_in + (size_t)l * D * D_IN, 0, D_IN, D, D_IN / 64, 64, 32,
                                                                      EpiG1s{UCAT, QRAW, KRAW, Vb, SG});
        s_qkpost<<<NTOK * 16 / 256, 256, 0, stream>>>(QRAW, KRAW, qng + l * 64, kng + l * 64, rope, Qb, Kb);
        s_ksum<<<BATCH * NH * NBLK / 4, 256, 0, stream>>>(Kb, ksum);
        sg_kernel<1, RowPlain, EpiS5A><<<dim3(64, SSM_G), 256, 0, stream>>>(RowPlain{UCAT, UK, UROWS, (size_t)UROWS * UK}, BS + (size_t)l * SSM_G * 128 * 512, (size_t)128 * 512, 512, 512, 2, 64, 32, EpiS5A{SL});
        s_s5_scan<<<SSM_G * BATCH * 64 / 256, 256, 0, stream>>>(SL, AL + (size_t)l * SSM_G * 128, UCAT);
        sg_kernel<1, RowPlain, EpiS5C><<<dim3(64, SSM_G), 256, 0, stream>>>(RowPlain{UCAT, UK, UROWS, (size_t)UROWS * UK}, TC + (size_t)l * SSM_G * 512 * 640, (size_t)512 * 640, 640, 640, 8, 64, 32,
                                                                          EpiS5C{UCAT, ssm_d + l * SSM_W, Z});
        sg_kernel<0, RowPlain, EpiG3s><<<dim3(SGB, 1), 256, 0, stream>>>(RowPlain{Z, 512, NTOK, 0}, w_glu + (size_t)l * 512 * 2048, 0, 2048, 512, 32, 32, 1024, EpiG3s{SG, MIXA});
        s_attn<<<BATCH * NH * SEQ / 4, 256, 0, stream>>>(Qb, Kb, Vb, ksum, ATT);
        sg_kernel<0, RowPlain, EpiG4s><<<dim3(SGB, 1), 256, 0, stream>>>(RowPlain{ATT, 512, NTOK, 0}, w_attn + (size_t)l * 512 * 1024, 0, 1024, 512, 16, 64, 32, EpiG4s{SG, MIXA, MIXED});
        sg_kernel<0, RowPlain, EpiG5s><<<dim3(SGB, 1), 256, 0, stream>>>(RowPlain{MIXED, 1024, NTOK, 0}, w_out + (size_t)l * 1024 * 1024, 0, 1024, 1024, 16, 64, 32, EpiG5s{xin, X});
        unsigned* cnt = ctl + CW_CNT + l * NEXP;
        s_norm_router<<<NTOK / 4, 256, 0, stream>>>(X, norm2_g + l * D, wgrp + (size_t)l * D * 4, bgrp + l * 4, wexp + (size_t)l * D * 32, bexp + l * 32, H, cnt, list, rec);
        s_offsets<<<1, 64, 0, stream>>>(cnt, pstart);
        sg_kernel<0, RowM1, EpiM1s><<<dim3(128, NEXP), 256, 0, stream>>>(RowM1{H, list, cnt}, w_gu + (size_t)l * NEXP * 1024 * 1024, (size_t)1024 * 1024, 1024, 1024, 16, 32, 512, EpiM1s{HMID, pstart});
        sg_kernel<0, RowM2, EpiM2s><<<dim3(128, NEXP), 256, 0, stream>>>(RowM2{HMID, pstart, cnt}, w_dn + (size_t)l * NEXP * 512 * 1024, (size_t)512 * 1024, 1024, 512, 16, 64, 32, EpiM2s{YBUF, pstart});
        s_combine<<<NTOK / 4, 256, 0, stream>>>(X, YBUF, rec, pstart);
    }
}
```

```cpp
#include <hip/hip_runtime.h>
#include <hip/hip_bf16.h>
#include <cstdint>
#include <cstdio>
#include <cmath>

#define DEVI __device__ __forceinline__
#define GAS __attribute__((address_space(1)))
#define LAS __attribute__((address_space(3)))
typedef unsigned short bf16_t;
typedef short bf16x8 __attribute__((ext_vector_type(8)));
typedef float f32x4 __attribute__((ext_vector_type(4)));
typedef float f32x16 __attribute__((ext_vector_type(16)));
typedef unsigned u32x4 __attribute__((ext_vector_type(4)));
typedef unsigned u32x2 __attribute__((ext_vector_type(2)));
typedef float cf32 __attribute__((ext_vector_type(2)));

#ifndef OPT_G1
#define OPT_G1 1
#endif
#ifndef G1_RAWQK
#define G1_RAWQK 0
#endif
#ifndef OPT_S5
#define OPT_S5 1
#endif
#ifndef OPT_G3
#define OPT_G3 1
#endif
#ifndef OPT_G4
#define OPT_G4 1
#endif
#ifndef OPT_G5
#define OPT_G5 1
#endif
#ifndef OPT_ATT
#define OPT_ATT 1
#endif
#ifndef REP_MASK
#define REP_MASK 0ull
#endif
#ifndef BAR_TWICE
#define BAR_TWICE 0
#endif
#ifndef G1_ALIGN
#define G1_ALIGN true
#endif
#ifndef OPT_RT
#define OPT_RT 1
#endif
#ifndef OPT_M1
#define OPT_M1 1
#endif
#ifndef OPT_M2
#define OPT_M2 1
#endif
#ifndef MK_PER_PHASE
#define MK_PER_PHASE 0
#endif

constexpr int D = 1024, BATCH = 8, SEQ = 4096, NTOK = BATCH * SEQ, DEPTH = 2;
constexpr int SSM_G = 32, SSM_C = 16, SSM_W = 512, SSM_P = 64;
constexpr int NH = 8, HD = 64, AW = 512, MOBA_B = 256, NBLK = SEQ / MOBA_B;
constexpr int D_IN = 4096;
constexpr int NEXP = 32, DEXP = 512;
constexpr int CHL = 32, NCH = SEQ / CHL, UK = 640, UROWS = BATCH * NCH;
constexpr int SLOT_CAP = 2 * NTOK + NEXP * 256;
constexpr int LIST_CAP = NTOK;
constexpr float NORM_EPS = 1e-6f;
constexpr float QSCALE = 0.125f * 1.4426950408889634f;
constexpr int NWAVES = 8, NTHR = 512;

constexpr size_t MiB = 1u << 20;
constexpr size_t WS_CTL = 0, CTL_BYTES = 1 * MiB;
constexpr size_t WS_ROPE = 1 * MiB;
constexpr size_t WS_MISC = 2 * MiB;
constexpr size_t WS_REC = 4 * MiB;
constexpr size_t WS_LIST = 5 * MiB;
constexpr size_t WS_S5TC = 16 * MiB;
constexpr size_t WS_S5BS = 56 * MiB;
constexpr size_t WS_WIN = 66 * MiB, WS_WGLU = 82 * MiB, WS_WATT = 86 * MiB, WS_WOUT = 88 * MiB, WS_WGU = 92 * MiB, WS_WDN = 220 * MiB;
constexpr size_t WS_H = 284 * MiB;
constexpr size_t WS_UCAT = 348 * MiB;
constexpr size_t WS_Q = 388 * MiB, WS_K = 420 * MiB, WS_V = 452 * MiB;
constexpr size_t WS_SG = 484 * MiB;
constexpr size_t WS_Z = 612 * MiB;
constexpr size_t WS_ATT = 644 * MiB;
constexpr size_t WS_MIXA = 676 * MiB, WS_MIXED = 740 * MiB;
constexpr size_t WS_SL = 804 * MiB;
constexpr size_t WS_XB = 820 * MiB;
constexpr size_t WS_END = 884 * MiB;
constexpr size_t WS_HMID = WS_UCAT;
constexpr size_t WS_YBUF = WS_SG;
constexpr size_t WS_QRAW = WS_MIXA, WS_KRAW = WS_MIXED;
constexpr size_t MISC_AL = 0;
constexpr size_t MISC_KSUM = 64 * 1024;
constexpr size_t MISC_SEL = 512 * 1024;
constexpr size_t MISC_WR = 1536 * 1024;
constexpr int CW_CNT = 64;
constexpr int CW_CVQ = 1024;
constexpr int CW_BAR = 4096;
constexpr int MAX_LAUNCHES = 64;

constexpr int RING_BYTES = 131072;
constexpr int LDSCTL_OFF = RING_BYTES;
constexpr int GTAB_OFF = RING_BYTES + 1024;
constexpr int LDS_BYTES = 160 * 1024;

DEVI float bf2f(bf16_t v) { return __uint_as_float((unsigned)v << 16); }
DEVI bf16_t f2bf(float f) { unsigned u = __float_as_uint(f); return (bf16_t)((u + 0x7fffu + ((u >> 16) & 1u)) >> 16); }
DEVI unsigned pk2(float lo, float hi) { return (unsigned)f2bf(lo) | ((unsigned)f2bf(hi) << 16); }
DEVI float sigmoidf_(float x) { return 1.f / (1.f + __expf(-x)); }
DEVI float gelu_tanh(float x) { const float u = 0.7978845608028654f * (x + 0.044715f * x * x * x); return 0.5f * x * (1.f + tanhf(u)); }
DEVI float xshfl(float v, int o, int lane) { return __int_as_float(__builtin_amdgcn_ds_bpermute((lane ^ o) << 2, __float_as_int(v))); }
DEVI float wave_sum(float v, int lane) {
#pragma unroll
    for (int o = 1; o < 64; o <<= 1) v += xshfl(v, o, lane);
    return v;
}
DEVI float wave_max(float v) {
#pragma unroll
    for (int o = 1; o < 64; o <<= 1) v = fmaxf(v, __shfl_xor(v, o));
    return v;
}

#define XB_TMO      128
#define XB_XCNT(j)  (256  + 64 * (j))
#define XB_XSUB(j)  (1280 + 64 * (j))
#define XB_XGEN(j)  (2304 + 64 * (j))
#define XB_TOP      3328
#define XB_TOPGEN   3392
#define XCD_BAR_WORDS 3456
#define XB_SPIN_CAP (1u << 18)
DEVI unsigned xb_ld(unsigned* p)              { return __hip_atomic_load(p, __ATOMIC_RELAXED, __HIP_MEMORY_SCOPE_AGENT); }
DEVI unsigned xb_add(unsigned* p, unsigned v) { return __hip_atomic_fetch_add(p, v, __ATOMIC_RELAXED, __HIP_MEMORY_SCOPE_AGENT); }
DEVI unsigned xb_xcc_id() { return (unsigned)__builtin_amdgcn_s_getreg((3 << 11) | 20) & 0xFu; }
#define XB_SPIN(cond, bar) do { unsigned _sp = 0; while (cond) { __builtin_amdgcn_s_sleep(1); \
    if ((++_sp & 255u) == 0u) { if (xb_ld(&(bar)[XB_TMO])) break; if (_sp > XB_SPIN_CAP) { atomicAdd(&(bar)[XB_TMO], 1u); break; } } } } while (0)
struct XcdBarrier { unsigned* bar; unsigned x; volatile LAS unsigned* st; };
DEVI XcdBarrier xcd_barrier_post(unsigned* bar, volatile LAS unsigned* st) {
    XcdBarrier b; b.bar = bar; b.x = xb_xcc_id(); b.st = st;
    if (threadIdx.x == 0) (void)xb_add(&bar[XB_XCNT(b.x)], 1u);
    return b;
}
DEVI void xcd_barrier_complete(unsigned* bar, unsigned x, unsigned& nloc, unsigned& nx) {
    const unsigned G = gridDim.x * gridDim.y * gridDim.z;
    unsigned sum, cnt, mine, sp = 0u;
    for (;;) {
        sum = 0u; cnt = 0u; mine = 0u;
#pragma unroll
        for (unsigned j = 0; j < 16; ++j) { const unsigned c = xb_ld(&bar[XB_XCNT(j)]); sum += c; cnt += (c > 0u) ? 1u : 0u; mine = (j == x) ? c : mine; }
        if (sum == G) break;
        __builtin_amdgcn_s_sleep(1);
        if ((++sp & 255u) == 0u) { if (xb_ld(&bar[XB_TMO])) break; if (sp > XB_SPIN_CAP) { atomicAdd(&bar[XB_TMO], 1u); break; } }
    }
    nloc = mine > 0u ? mine : 1u; nx = cnt > 0u ? cnt : 1u;
}
DEVI void xcd_barrier(const XcdBarrier& b) {
    asm volatile("s_waitcnt vmcnt(0)" ::: "memory");
    __syncthreads();
    if (threadIdx.x == 0) {
        unsigned* bar = b.bar;
        __builtin_amdgcn_s_waitcnt(0);
        unsigned nloc = b.st[0], nx = b.st[1];
        if (nloc == 0u) { xcd_barrier_complete(bar, b.x, nloc, nx); b.st[0] = nloc; b.st[1] = nx; }
        const unsigned old = xb_add(&bar[XB_XSUB(b.x)], 1u);
        const unsigned gen = old / nloc;
        if (old + 1u == (gen + 1u) * nloc) {
            __builtin_amdgcn_fence(__ATOMIC_RELEASE, "agent");
            asm volatile("s_waitcnt vmcnt(0)" ::: "memory");
            const unsigned og = xb_add(&bar[XB_TOP], 1u);
            const unsigned tg = og / nx;
            if (og + 1u == (tg + 1u) * nx) xb_add(&bar[XB_TOPGEN], 1u);
            else XB_SPIN(xb_ld(&bar[XB_TOPGEN]) == tg, bar);
            __builtin_amdgcn_fence(__ATOMIC_ACQUIRE, "agent");
            xb_add(&bar[XB_XGEN(b.x)], 1u);
            asm volatile("s_waitcnt vmcnt(0)" ::: "memory");
        } else {
            XB_SPIN(xb_ld(&bar[XB_XGEN(b.x)]) == gen, bar);
            __builtin_amdgcn_fence(__ATOMIC_ACQUIRE, "agent");
            asm volatile("s_waitcnt vmcnt(0)" ::: "memory");
        }
    }
    __syncthreads();
}

struct Args { const float* in[23]; float* out; unsigned char* ws; int ph_lo, ph_hi, li, pad; };
struct Frame { int tid, lane, wave, gw, NGW, gt, NGT, G; LAS unsigned char* lds; };

DEVI void ph_rope_table(const Frame& F, float* rope) {
    for (int idx = F.gt; idx < SEQ * 32; idx += F.NGT) {
        const int s = idx >> 5, i = idx & 31;
        const float inv = powf(10000.0f, -(float)(2 * i) / 64.0f);
        const float ang = (float)s * inv;
        float sn, cs; sincosf(ang, &sn, &cs);
        rope[2 * idx] = cs; rope[2 * idx + 1] = sn;
    }
}
DEVI void s5_tables_item(int l, int g, const float* a_re, const float* a_im, const float* log_dt, const float* b_re, const float* b_im,
                         const float* c_re, const float* c_im, bf16_t* TC, bf16_t* BS, float* AL, LAS float* lds, int tid, int nthr, int part) {
    LAS cf32* pw = (LAS cf32*)lds;
    LAS cf32* Cc = pw + 33 * 64;
    LAS cf32* Bb = Cc + 16 * 64;
    LAS cf32* fp = Bb + 64 * 16;
    LAS float* Kt = (LAS float*)(fp + 64);
    const int lg = l * SSM_G + g;
    const float dt = expf(log_dt[lg]);
    for (int i = tid; i < 33 * 64; i += nthr) {
        const int tau = i >> 6, p = i & 63;
        const float lr = a_re[lg * 64 + p], li = a_im[lg * 64 + p];
        const float mag = expf(lr * dt * (float)tau);
        float sn, cs; sincosf(li * dt * (float)tau, &sn, &cs);
        pw[i] = (cf32){mag * cs, mag * sn};
    }
    for (int i = tid; i < 16 * 64; i += nthr) Cc[i] = (cf32){c_re[(size_t)lg * 1024 + i], c_im[(size_t)lg * 1024 + i]};
    __syncthreads();
    for (int p = tid; p < 64; p += nthr) {
        const float lr = a_re[lg * 64 + p], li = a_im[lg * 64 + p];
        const cf32 ab = pw[64 + p];
        const float den = lr * lr + li * li, nre = ab.x - 1.0f;
        fp[p] = (cf32){(nre * lr + ab.y * li) / den, (ab.y * lr - nre * li) / den};
    }
    __syncthreads();
    for (int i = tid; i < 64 * 16; i += nthr) {
        const cf32 f = fp[i >> 4];
        const float br = b_re[(size_t)lg * 1024 + i], bi = b_im[(size_t)lg * 1024 + i];
        Bb[i] = (cf32){f.x * br - f.y * bi, f.x * bi + f.y * br};
    }
    __syncthreads();
    for (int i = tid; i < 8 * 256; i += nthr) {
        const int tau = 8 * part + (i >> 8), co = (i >> 4) & 15, ci = i & 15;
        float acc = 0.f;
        for (int p = 0; p < 64; ++p) {
            const cf32 c = Cc[co * 64 + p], w = pw[tau * 64 + p], b = Bb[p * 16 + ci];
            const float xr = c.x * w.x - c.y * w.y, xi = c.x * w.y + c.y * w.x;
            acc += xr * b.x - xi * b.y;
        }
        Kt[i] = acc;
    }
    __syncthreads();
    for (int i = tid; i < 512 * 512; i += nthr) {
        const int n = i >> 9, kk = i & 511, t = n >> 4, co = n & 15, tp = kk >> 4, ci = kk & 15, tau = t - tp;
        if (tau >= 0) { if ((tau >> 3) == part) TC[(size_t)n * 640 + kk] = f2bf(Kt[((tau & 7) * 16 + co) * 16 + ci]); }
        else if (((-tau - 1) >> 3) == part) TC[(size_t)n * 640 + kk] = 0;
    }
    for (int i = part * 128 * 128 + tid; i < (part + 1) * 128 * 128; i += nthr) {
        const int n = i >> 7, kc = i & 127, t = n >> 4, co = n & 15, p = kc & 63;
        const cf32 c = Cc[co * 64 + p], w = pw[(t + 1) * 64 + p];
        const float xr = c.x * w.x - c.y * w.y, xi = c.x * w.y + c.y * w.x;
        TC[(size_t)n * 640 + 512 + kc] = f2bf(kc < 64 ? xr : -xi);
    }
    for (int i = part * 32 * 512 + tid; i < (part + 1) * 32 * 512; i += nthr) {
        const int row = i >> 9, kk = i & 511, p = row & 63, tp = kk >> 4, ci = kk & 15;
        const cf32 w = pw[(31 - tp) * 64 + p], b = Bb[p * 16 + ci];
        BS[i] = f2bf(row < 64 ? (w.x * b.x - w.y * b.y) : (w.x * b.y + w.y * b.x));
    }
    if (part == 0) for (int i = tid; i < 64; i += nthr) { AL[2 * i] = pw[32 * 64 + i].x; AL[2 * i + 1] = pw[32 * 64 + i].y; }
    __syncthreads();
}

DEVI void ph_rmsnorm(const Frame& F, const float* x, const float* g, bf16_t* out) {
    constexpr int R = 4;
    for (int row0 = F.gw; row0 < NTOK; row0 += R * F.NGW) {
        f32x4 v[R][4];
#pragma unroll
        for (int u = 0; u < R; ++u) { const int row = (row0 + u * F.NGW < NTOK) ? row0 + u * F.NGW : row0; const f32x4* xr = (const f32x4*)(x + (size_t)row * D) + F.lane;
#pragma unroll
            for (int j = 0; j < 4; ++j) v[u][j] = xr[64 * j]; }
#pragma unroll
        for (int u = 0; u < R; ++u) { const int row = row0 + u * F.NGW; if (row >= NTOK) continue;
            float s = 0.f;
#pragma unroll
            for (int j = 0; j < 4; ++j) s += (v[u][j].x * v[u][j].x + v[u][j].y * v[u][j].y) + (v[u][j].z * v[u][j].z + v[u][j].w * v[u][j].w);
            const float rstd = 1.0f / sqrtf(wave_sum(s, F.lane) * (1.0f / D) + NORM_EPS);
#pragma unroll
            for (int j = 0; j < 4; ++j) { const f32x4 gg = *((const f32x4*)g + F.lane + 64 * j);
                u32x2 o; o.x = pk2(v[u][j].x * rstd * gg.x, v[u][j].y * rstd * gg.y); o.y = pk2(v[u][j].z * rstd * gg.z, v[u][j].w * rstd * gg.w);
                *((u32x2*)(out + (size_t)row * D) + F.lane + 64 * j) = o; } }
    }
}

template <int BMODE, class RowF, class Epi>
DEVI void sg_phase(const Frame& F, int ny, const RowF& rowf, const void* Bv, size_t bstride, int ldb, int K, int nct, int cstep, int off2, const Epi& epi) {
    const int lane = F.lane, r = lane & 31, h = lane >> 5;
    int base = 0;
    for (int y = 0; y < ny; ++y) {
        const int nrows = rowf.nrows(y), nrt = (nrows + 31) / 32, ntile = nrt * nct;
        const float* Bf = (const float*)Bv + (size_t)y * bstride;
        const bf16_t* Bt = (const bf16_t*)Bv + (size_t)y * bstride;
        int first = (F.gw - base % F.NGW + F.NGW) % F.NGW;
        for (int tile = first; tile < ntile; tile += F.NGW) {
            const int rt = tile / nct, ct = tile % nct, c0 = ct * cstep, c1 = c0 + off2;
            const int arow_i = rt * 32 + r;
            const bf16_t* arow = (arow_i < nrows) ? rowf(y, arow_i) : nullptr;
            f32x16 acc0 = {}, acc1 = {};
            for (int k = 0; k < K; k += 16) {
                bf16x8 a = {};
                if (arow) a = *(const bf16x8*)(arow + k + 8 * h);
                bf16x8 b0, b1;
                if (BMODE == 0) {
#pragma unroll
                    for (int j = 0; j < 8; ++j) { b0[j] = (short)f2bf(Bf[(size_t)(k + 8 * h + j) * ldb + c0 + r]); b1[j] = (short)f2bf(Bf[(size_t)(k + 8 * h + j) * ldb + c1 + r]); }
                } else {
                    b0 = *(const bf16x8*)(Bt + (size_t)(c0 + r) * ldb + k + 8 * h);
                    b1 = *(const bf16x8*)(Bt + (size_t)(c1 + r) * ldb + k + 8 * h);
                }
                acc0 = __builtin_amdgcn_mfma_f32_32x32x16_bf16(a, b0, acc0, 0, 0, 0);
                acc1 = __builtin_amdgcn_mfma_f32_32x32x16_bf16(a, b1, acc1, 0, 0, 0);
            }
#pragma unroll
            for (int reg = 0; reg < 16; ++reg) {
                const int row = rt * 32 + (reg & 3) + 8 * (reg >> 2) + 4 * h;
                if (row < nrows) epi(y, row, c0 + r, c1 + r, acc0[reg], acc1[reg]);
            }
        }
        base += ntile;
    }
}

struct RowPlain { const bf16_t* A; int lda; int n; size_t ystride;
    DEVI int nrows(int) const { return n; }
    DEVI const bf16_t* operator()(int y, int r) const { return A + (size_t)y * ystride + (size_t)r * lda; } };

struct EpiG1sPerm;
struct EpiG1s { bf16_t* ucat; float* qraw; float* kraw; bf16_t* v; bf16_t* sg;
    DEVI void one(int row, int c, float a) const {
        if (c < 512) { const int b = row >> 12, s = row & 4095, g = c >> 4, ci = c & 15;
            ucat[((size_t)g * UROWS + b * NCH + (s >> 5)) * UK + (s & 31) * 16 + ci] = f2bf(a); }
        else if (c < 1024) qraw[(size_t)row * 512 + (c - 512)] = a;
        else if (c < 1536) kraw[(size_t)row * 512 + (c - 1024)] = a;
        else if (c < 2048) v[(size_t)row * 512 + (c - 1536)] = f2bf(a);
        else sg[(size_t)row * 2048 + (c - 2048)] = f2bf(sigmoidf_(a));
    }
    DEVI void operator()(int, int row, int c0, int c1, float a0, float a1) const { one(row, c0, a0); one(row, c1, a1); } };

DEVI int g1_unperm(int cp) { const int pn = cp >> 8, tc = cp & 255; if (pn < 2 || pn >= 6) return cp; const int sec = pn < 4 ? 512 : 1024, hh = (pn & 1) * 4 + ((tc >> 5) & 3); return sec + hh * 64 + 32 * (tc >> 7) + (tc & 31); }
#ifndef G1_FIX_MASK
#define G1_FIX_MASK 0
#endif
DEVI bool g1_sel(int c) { const int sec = c < 512 ? 1 : c < 1024 ? 2 : c < 1536 ? 4 : c < 2048 ? 8 : 16; return (G1_FIX_MASK & sec) != 0; }
struct EpiG1sPerm { EpiG1s e; DEVI void operator()(int, int row, int c0, int c1, float a0, float a1) const { e.one(row, g1_unperm(c0), a0); e.one(row, g1_unperm(c1), a1); } };
struct EpiG1sFix { EpiG1s e; DEVI void operator()(int, int row, int c0, int c1, float a0, float a1) const { const int n0 = g1_unperm(c0), n1 = g1_unperm(c1); if (g1_sel(n0)) e.one(row, n0, a0); if (g1_sel(n1)) e.one(row, n1, a1); } };
DEVI void ph_qkpost(const Frame& F, const float* qraw, const float* kraw, const float* qg, const float* kg, const float* rope, bf16_t* Q, bf16_t* K) {
    for (int idx = F.gt; idx < NTOK * 16; idx += F.NGT) {
        const int which = idx & 1, hh = (idx >> 1) & 7, tok = idx >> 4;
        const float* src = (which ? kraw : qraw) + (size_t)tok * 512 + hh * 64;
        const float* gn = which ? kg : qg;
        float x[64]; float ss = 0.f;
#pragma unroll
        for (int i = 0; i < 16; ++i) { const f32x4 t = *((const f32x4*)src + i); x[4 * i] = t.x; x[4 * i + 1] = t.y; x[4 * i + 2] = t.z; x[4 * i + 3] = t.w; ss += (t.x * t.x + t.y * t.y) + (t.z * t.z + t.w * t.w); }
        const float rstd = 1.0f / sqrtf(ss * (1.0f / 64.0f) + NORM_EPS);
        const int s = tok & (SEQ - 1);
        const float sc = which ? 1.0f : QSCALE;
        bf16_t* dst = (which ? K : Q) + (size_t)tok * 512 + hh * 64;
#pragma unroll
        for (int i = 0; i < 32; ++i) {
            const float x1 = x[i] * rstd * gn[i], x2 = x[i + 32] * rstd * gn[i + 32];
            const float cs = rope[(s * 32 + i) * 2], sn = rope[(s * 32 + i) * 2 + 1];
            dst[i] = f2bf((x1 * cs - x2 * sn) * sc);
            dst[i + 32] = f2bf((x2 * cs + x1 * sn) * sc);
        }
    }
}
DEVI void ph_ksum(const Frame& F, const bf16_t* K, float* ksum) {
    const int lane = F.lane, rg = lane >> 3, c = lane & 7;
    for (int w = F.gw; w < BATCH * NH * NBLK; w += F.NGW) {
        const int blk = w & 15, hh = (w >> 4) & 7, b = w >> 7;
        const bf16_t* kp = K + ((size_t)b * SEQ + blk * 256 + rg) * 512 + hh * 64 + c * 8;
        float acc[8];
#pragma unroll
        for (int j = 0; j < 8; ++j) acc[j] = 0.f;
#pragma unroll 8
        for (int i = 0; i < 32; ++i) { const bf16x8 v = *(const bf16x8*)(kp + (size_t)i * 8 * 512);
#pragma unroll
            for (int j = 0; j < 8; ++j) acc[j] += bf2f((bf16_t)v[j]); }
#pragma unroll
        for (int j = 0; j < 8; ++j) { float t = acc[j]; t += xshfl(t, 8, lane); t += xshfl(t, 16, lane); t += xshfl(t, 32, lane); acc[j] = t; }
        if (rg == 0) { float* o = ksum + (size_t)w * 64 + c * 8; *(f32x4*)o = (f32x4){acc[0], acc[1], acc[2], acc[3]}; *(f32x4*)(o + 4) = (f32x4){acc[4], acc[5], acc[6], acc[7]}; }
    }
}

DEVI void ph_attn_simple(const Frame& F, const bf16_t* Q, const bf16_t* K, const bf16_t* V, const float* ksum, bf16_t* O) {
    const int lane = F.lane;
    for (int w = F.gw; w < BATCH * NH * SEQ; w += F.NGW) {
        const int s = w & (SEQ - 1), hh = (w >> 12) & 7, b = w >> 15;
        const int qb = s >> 8;
        const bf16_t* qp = Q + ((size_t)b * SEQ + s) * 512 + hh * 64;
        float q[64];
#pragma unroll
        for (int i = 0; i < 8; ++i) { const bf16x8 t = *((const bf16x8*)qp + i);
#pragma unroll
            for (int j = 0; j < 8; ++j) q[8 * i + j] = bf2f((bf16_t)t[j]); }
        float gsc = -INFINITY;
        if (lane < qb) { const float* km = ksum + ((size_t)(b * 8 + hh) * 16 + lane) * 64; float a = 0.f;
#pragma unroll
            for (int i = 0; i < 64; ++i) a += q[i] * km[i];
            gsc = a; }
        int blks[4]; int nsel = 0;
#pragma unroll
        for (int t = 0; t < 3; ++t) {
            float best = -INFINITY; int bi = -1;
            for (int j = 0; j < 15; ++j) { const float v = __shfl(gsc, j); const bool used = (t > 0 && j == blks[0]) || (t > 1 && j == blks[1]); if (j < qb && !used && v > best) { best = v; bi = j; } }
            blks[t] = bi; if (bi >= 0) nsel = t + 1;
        }
        blks[3] = qb;
        float sc[4][4]; float m = -INFINITY;
#pragma unroll
        for (int t = 0; t < 4; ++t) {
            const bool on = (t == 3) || (t < nsel);
            const int blk = on ? blks[t] : 0;
#pragma unroll
            for (int i = 0; i < 4; ++i) {
                const int key = blk * 256 + lane + 64 * i;
                float a = -INFINITY;
                if (on && (t < 3 || key <= s)) {
                    const bf16_t* kp = K + ((size_t)b * SEQ + key) * 512 + hh * 64; a = 0.f;
#pragma unroll
                    for (int c = 0; c < 8; ++c) { const bf16x8 kk = *((const bf16x8*)kp + c);
#pragma unroll
                        for (int j = 0; j < 8; ++j) a += q[8 * c + j] * bf2f((bf16_t)kk[j]); }
                }
                sc[t][i] = a; m = fmaxf(m, a);
            }
        }
        m = wave_max(m);
        float l = 0.f;
#pragma unroll
        for (int t = 0; t < 4; ++t)
#pragma unroll
            for (int i = 0; i < 4; ++i) { const float p = exp2f(sc[t][i] - m); sc[t][i] = p; l += p; }
        l = wave_sum(l, lane);
        float o = 0.f;
#pragma unroll
        for (int t = 0; t < 4; ++t) {
            const bool on = (t == 3) || (t < nsel);
            if (!on) continue;
            const int blk = blks[t];
#pragma unroll
            for (int i = 0; i < 4; ++i) {
                const float pv = sc[t][i];
                for (int j = 0; j < 64; ++j) {
                    const float p = __shfl(pv, j);
                    const int key = blk * 256 + j + 64 * i;
                    if (p != 0.f) o += p * bf2f(V[((size_t)b * SEQ + key) * 512 + hh * 64 + lane]);
                }
            }
        }
        O[((size_t)b * SEQ + s) * 512 + hh * 64 + lane] = f2bf(o / l);
    }
}

struct EpiS5A { float* sl; DEVI void operator()(int y, int row, int c0, int c1, float a0, float a1) const { float* p = sl + ((size_t)y * UROWS + row) * 128; p[c0] = a0; p[c1] = a1; } };
DEVI void ph_s5_scan(const Frame& F, const float* sl, const float* AL, bf16_t* ucat) {
    for (int idx = F.gt; idx < SSM_G * BATCH * 64; idx += F.NGT) {
        const int p = idx & 63, b = (idx >> 6) & 7, g = idx >> 9;
        const float ar = AL[(g * 64 + p) * 2], ai = AL[(g * 64 + p) * 2 + 1];
        float hr = 0.f, hi = 0.f;
        for (int c = 0; c < NCH; ++c) {
            const size_t row = (size_t)g * UROWS + b * NCH + c;
            ucat[row * UK + 512 + p] = f2bf(hr); ucat[row * UK + 576 + p] = f2bf(hi);
            const float sr = sl[row * 128 + p], si = sl[row * 128 + 64 + p];
            const float nr = ar * hr - ai * hi + sr, ni = ar * hi + ai * hr + si; hr = nr; hi = ni;
        }
    }
}
struct EpiS5C { const bf16_t* ucat; const float* dskip; bf16_t* z;
    DEVI void one(int g, int row, int n, float a) const {
        const int t = n >> 4, co = n & 15, b = row >> 7, c = row & 127;
        const float u = bf2f(ucat[((size_t)g * UROWS + row) * UK + n]);
        const float y = a + dskip[g * 16 + co] * u;
        z[((size_t)b * SEQ + c * CHL + t) * 512 + g * 16 + co] = f2bf(gelu_tanh(y));
    }
    DEVI void operator()(int y, int row, int c0, int c1, float a0, float a1) const { one(y, row, c0, a0); one(y, row, c1, a1); } };

struct EpiG3s { const bf16_t* sg; bf16_t* mixa;
    DEVI void operator()(int, int row, int c0, int c1, float val, float gate) const { mixa[(size_t)row * 1024 + c0] = f2bf(bf2f(sg[(size_t)row * 2048 + c0]) * val * sigmoidf_(gate)); } };
struct EpiG4s { const bf16_t* sg; const bf16_t* mixa; bf16_t* mixed;
    DEVI void one(int row, int c, float a) const { mixed[(size_t)row * 1024 + c] = f2bf(bf2f(mixa[(size_t)row * 1024 + c]) + bf2f(sg[(size_t)row * 2048 + 1024 + c]) * a); }
    DEVI void operator()(int, int row, int c0, int c1, float a0, float a1) const { one(row, c0, a0); one(row, c1, a1); } };
struct EpiG5s { const float* xin; float* xout;
    DEVI void operator()(int, int row, int c0, int c1, float a0, float a1) const { xout[(size_t)row * 1024 + c0] = xin[(size_t)row * 1024 + c0] + a0; xout[(size_t)row * 1024 + c1] = xin[(size_t)row * 1024 + c1] + a1; } };

DEVI void ph_norm_router(const Frame& F, const float* x, const float* g, const float* wg, const float* bg, const float* we, const float* be,
                         bf16_t* h2, unsigned* cnt, int* list, unsigned* rec) {
    const int lane = F.lane;
    for (int row = F.gw; row < NTOK; row += F.NGW) {
        const f32x4* xr = (const f32x4*)(x + (size_t)row * D) + lane;
        f32x4 v[4]; float s = 0.f;
#pragma unroll
        for (int j = 0; j < 4; ++j) { v[j] = xr[64 * j]; s += (v[j].x * v[j].x + v[j].y * v[j].y) + (v[j].z * v[j].z + v[j].w * v[j].w); }
        const float rstd = 1.0f / sqrtf(wave_sum(s, lane) * (1.0f / D) + NORM_EPS);
        float acc[36];
#pragma unroll
        for (int o = 0; o < 36; ++o) acc[o] = 0.f;
#pragma unroll
        for (int j = 0; j < 4; ++j) {
            const f32x4 gg = *((const f32x4*)g + lane + 64 * j);
            const float hv[4] = {v[j].x * rstd * gg.x, v[j].y * rstd * gg.y, v[j].z * rstd * gg.z, v[j].w * rstd * gg.w};
            u32x2 o; o.x = pk2(hv[0], hv[1]); o.y = pk2(hv[2], hv[3]);
            *((u32x2*)(h2 + (size_t)row * D) + lane + 64 * j) = o;
#pragma unroll
            for (int e = 0; e < 4; ++e) {
                const int k = 4 * lane + 256 * j + e;
                const f32x4 w4 = *(const f32x4*)(wg + (size_t)k * 4);
                acc[0] += hv[e] * w4.x; acc[1] += hv[e] * w4.y; acc[2] += hv[e] * w4.z; acc[3] += hv[e] * w4.w;
#pragma unroll
                for (int q = 0; q < 8; ++q) { const f32x4 w = *(const f32x4*)(we + (size_t)k * 32 + 4 * q);
                    acc[4 + 4 * q] += hv[e] * w.x; acc[5 + 4 * q] += hv[e] * w.y; acc[6 + 4 * q] += hv[e] * w.z; acc[7 + 4 * q] += hv[e] * w.w; }
            }
        }
#pragma unroll
        for (int o = 0; o < 36; ++o) acc[o] = wave_sum(acc[o], lane);
        if (lane == 0) {
            float gl[4]; int gt = 0; float gm = -INFINITY;
#pragma unroll
            for (int i = 0; i < 4; ++i) { gl[i] = acc[i] + bg[i]; if (gl[i] > gm) { gm = gl[i]; gt = i; } }
            float gs = 0.f;
#pragma unroll
            for (int i = 0; i < 4; ++i) gs += __expf(gl[i] - gm);
            const float pg = 1.0f / gs;
            float el[8]; float em = -INFINITY;
#pragma unroll
            for (int i = 0; i < 8; ++i) { float t = 0.f;
#pragma unroll
                for (int gq = 0; gq < 4; ++gq) t = (gq == gt) ? acc[4 + gq * 8 + i] + be[gq * 8 + i] : t;
                el[i] = t; em = fmaxf(em, t); }
            int i1 = 0; float v1 = -INFINITY;
#pragma unroll
            for (int i = 0; i < 8; ++i) if (el[i] > v1) { v1 = el[i]; i1 = i; }
            int i2 = 0; float v2 = -INFINITY;
#pragma unroll
            for (int i = 0; i < 8; ++i) if (i != i1 && el[i] > v2) { v2 = el[i]; i2 = i; }
            const float p1 = __expf(v1 - em), p2 = __expf(v2 - em);
            const float w0 = pg * p1 / (p1 + p2), w1 = pg * p2 / (p1 + p2);
            const int e0 = gt * 8 + i1, e1 = gt * 8 + i2;
            const unsigned pos0 = atomicAdd(cnt + e0, 1u), pos1 = atomicAdd(cnt + e1, 1u);
            list[(size_t)e0 * LIST_CAP + pos0] = row; list[(size_t)e1 * LIST_CAP + pos1] = row;
            unsigned* rp = rec + (size_t)row * 8;
            rp[0] = (unsigned)e0; rp[1] = (unsigned)e1; rp[2] = pos0; rp[3] = pos1; rp[4] = __float_as_uint(w0); rp[5] = __float_as_uint(w1);
        }
    }
}
DEVI void compute_pstart(const Frame& F, const unsigned* cnt, volatile LAS int* pstart) {
    if (F.tid == 0) { int a = 0; for (int e = 0; e < NEXP; ++e) { pstart[e] = a; a += (int)((__hip_atomic_load(cnt + e, __ATOMIC_RELAXED, __HIP_MEMORY_SCOPE_AGENT) + 255u) / 256u) * 256; } pstart[NEXP] = a; }
    __syncthreads();
}
struct RowM1 { const bf16_t* h2; const int* list; const unsigned* cnt;
    DEVI int nrows(int y) const { return (int)cnt[y]; }
    DEVI const bf16_t* operator()(int y, int r) const { return h2 + (size_t)list[(size_t)y * LIST_CAP + r] * D; } };
struct EpiM1s { bf16_t* hmid; volatile LAS int* pstart;
    DEVI void operator()(int y, int row, int c0, int c1, float gt, float up) const { hmid[((size_t)pstart[y] + row) * 512 + c0] = f2bf(gt * sigmoidf_(gt) * up); } };
struct RowM2 { const bf16_t* hmid; volatile LAS int* pstart; const unsigned* cnt;
    DEVI int nrows(int y) const { return (int)cnt[y]; }
    DEVI const bf16_t* operator()(int y, int r) const { return hmid + ((size_t)pstart[y] + r) * 512; } };
struct EpiM2s { bf16_t* ybuf; volatile LAS int* pstart;
    DEVI void operator()(int y, int row, int c0, int c1, float a0, float a1) const { bf16_t* p = ybuf + ((size_t)pstart[y] + row) * 1024; p[c0] = f2bf(a0); p[c1] = f2bf(a1); } };
template <bool LAST>
DEVI void ph_combine(const Frame& F, bf16_t* xb, float* out, const bf16_t* ybuf, const unsigned* rec, volatile LAS int* pstart, const float* gnext, bf16_t* hout) {
    const int lane = F.lane;
    for (int row0 = F.gw; row0 < NTOK; row0 += 2 * F.NGW) {
        int rw[2]; const bf16_t* y0[2]; const bf16_t* y1[2]; float w0[2], w1[2]; bool on[2];
#pragma unroll
        for (int u = 0; u < 2; ++u) { rw[u] = row0 + u * F.NGW; on[u] = rw[u] < NTOK; const int rr = on[u] ? rw[u] : row0;
            const u32x4 ra = *(const u32x4*)(rec + (size_t)rr * 8); const u32x2 rb = *(const u32x2*)(rec + (size_t)rr * 8 + 4);
            y0[u] = ybuf + ((size_t)pstart[(int)ra.x] + ra.z) * 1024; y1[u] = ybuf + ((size_t)pstart[(int)ra.y] + ra.w) * 1024;
            w0[u] = __uint_as_float(rb.x); w1[u] = __uint_as_float(rb.y); }
        u32x2 xw[2][4], ya[2][4], yb[2][4];
#pragma unroll
        for (int u = 0; u < 2; ++u)
#pragma unroll
            for (int j = 0; j < 4; ++j) { const int rr = on[u] ? rw[u] : row0;
                xw[u][j] = *((const u32x2*)(xb + (size_t)rr * D) + lane + 64 * j); ya[u][j] = *((const u32x2*)y0[u] + lane + 64 * j); yb[u][j] = *((const u32x2*)y1[u] + lane + 64 * j); }
#pragma unroll
        for (int u = 0; u < 2; ++u) {
            if (!on[u]) continue;
            const int row = rw[u];
            f32x4 v[4]; float s = 0.f;
#pragma unroll
            for (int j = 0; j < 4; ++j) {
                const u32x2 x = xw[u][j], a = ya[u][j], b = yb[u][j];
                v[j].x = __uint_as_float(x.x << 16) + w0[u] * __uint_as_float(a.x << 16) + w1[u] * __uint_as_float(b.x << 16);
                v[j].y = __uint_as_float(x.x & 0xffff0000u) + w0[u] * __uint_as_float(a.x & 0xffff0000u) + w1[u] * __uint_as_float(b.x & 0xffff0000u);
                v[j].z = __uint_as_float(x.y << 16) + w0[u] * __uint_as_float(a.y << 16) + w1[u] * __uint_as_float(b.y << 16);
                v[j].w = __uint_as_float(x.y & 0xffff0000u) + w0[u] * __uint_as_float(a.y & 0xffff0000u) + w1[u] * __uint_as_float(b.y & 0xffff0000u);
                if (LAST) *((f32x4*)(out + (size_t)row * D) + lane + 64 * j) = v[j];
                else { u32x2 o; o.x = pk2(v[j].x, v[j].y); o.y = pk2(v[j].z, v[j].w); *((u32x2*)(xb + (size_t)row * D) + lane + 64 * j) = o; }
                s += (v[j].x * v[j].x + v[j].y * v[j].y) + (v[j].z * v[j].z + v[j].w * v[j].w);
            }
            if (!LAST) {
                const float rstd = 1.0f / sqrtf(wave_sum(s, lane) * (1.0f / D) + NORM_EPS);
#pragma unroll
                for (int j = 0; j < 4; ++j) { const f32x4 gg = *((const f32x4*)gnext + lane + 64 * j);
                    u32x2 o; o.x = pk2(v[j].x * rstd * gg.x, v[j].y * rstd * gg.y); o.y = pk2(v[j].z * rstd * gg.z, v[j].w * rstd * gg.w);
                    *((u32x2*)(hout + (size_t)row * D) + lane + 64 * j) = o; }
            }
        }
    }
}

namespace pg8 {
constexpr int BM = 256, BK = 64, HALF = 128, HTB = HALF * BK * 2  , STAGE_BYTES = 8 * HTB;
__host__ __device__ __forceinline__ int lds_byte(int r, int c) { const int st = (r >> 4) * 2 + (c >> 5), rr = r & 15, cc = c & 31, ob = rr * 64 + cc * 2; return st * 1024 + (ob ^ (((ob >> 9) & 1) << 5)); }
__host__ __device__ __forceinline__ void stage_rc(int b, int& R, int& C) { const int st = b / 1024, sb = b % 1024, swz = sb ^ (((sb >> 9) & 1) << 5); R = (st >> 1) * 16 + swz / 64; C = (st & 1) * 32 + (swz % 64) / 2; }
__host__ __device__ __forceinline__ int perm32(int rho) { const int n = rho >> 4, i = rho & 15; return 8 * (i >> 2) + 4 * n + (i & 3); }

struct Unit { int pm, pn, g, ui; };
struct Gemm { const bf16_t* A; const bf16_t* Bt; int lda, ldb, K; size_t ags, bgs;
    DEVI const char* abase(const Unit& u) const { return (const char*)(A + (size_t)u.g * ags + (size_t)u.pm * BM * lda); }
    DEVI const char* bbase(const Unit& u) const { return (const char*)(Bt + (size_t)u.g * bgs + (size_t)u.pn * BM * ldb); } };
struct NoGather { static constexpr bool ON = false; DEVI unsigned rowoff(const Unit&, int) const { return 0u; } };
struct LdsGather { static constexpr bool ON = true; const LAS unsigned* tab;
    DEVI unsigned rowoff(const Unit& u, int r) const { return tab[u.ui * 256 + r]; } };

typedef float f32x2_t __attribute__((ext_vector_type(2))); typedef __bf16 bf16x2_t __attribute__((ext_vector_type(2)));
DEVI unsigned cvt_pk_bf16(float lo, float hi) { const f32x2_t v = {lo, hi}; const bf16x2_t b = __builtin_convertvector(v, bf16x2_t); return __builtin_bit_cast(unsigned, b); }

template <class Epi, class Sched, class GA, bool ALIGN_EPI>
DEVI void gemm_phase(LAS unsigned char* lds, const Gemm g, const Sched& S, const Epi& E, const GA& ga, int tid_in) {
    const int tid = tid_in, wid = __builtin_amdgcn_readfirstlane(tid >> 6), lane = tid & 63, wr = wid >> 2, wc = wid & 3, fr = lane & 15, fq = lane >> 4;
    const int K = g.K, nt = K / BK;
    unsigned voffA[2], voffB[2]; int RA[2]; unsigned CA[2];
#pragma unroll
    for (int i = 0; i < 2; ++i) { int R, C; stage_rc(tid * 16 + i * 8192, R, C); const int Rb = Epi::PERM ? ((R & ~31) + perm32(R & 31)) : R;
        voffA[i] = (unsigned)(R * g.lda + C) * 2u; voffB[i] = (unsigned)(Rb * g.ldb + C) * 2u; RA[i] = R; CA[i] = (unsigned)C * 2u; }
    const size_t kstep = (size_t)(BK * 2);
    const size_t hstepA = GA::ON ? (size_t)0 : (size_t)HALF * g.lda * 2, hstepB = (size_t)HALF * g.ldb * 2;
    const unsigned ldsw = (unsigned)wid * 1024u;
    const int aoff = lds_byte(wr * 64 + fr, fq * 8), boff = lds_byte(wc * 32 + fr, fq * 8);
#define PG8_SA(b, h) (((b) * 2 + (h)) * HTB)
#define PG8_SB(b, h) ((4 + (b) * 2 + (h)) * HTB)
#define PG8_STAGE2(bufoff, gbase, v0, v1) do { \
        __builtin_amdgcn_global_load_lds((const unsigned*)((const char*)(gbase) + (v0)), (LAS unsigned*)(lds + (bufoff) + ldsw), 16, 0, 0); \
        __builtin_amdgcn_global_load_lds((const unsigned*)((const char*)(gbase) + (v1)), (LAS unsigned*)(lds + (bufoff) + ldsw + 8192), 16, 0, 0); } while (0)
#define PG8_STAGE_B(b, h, bptr) PG8_STAGE2(PG8_SB(b, h), (bptr) + (h) * hstepB, voffB[0], voffB[1])
#define PG8_STAGE_A(b, h, aptr, NX) do { if constexpr (GA::ON) { const unsigned _o0 = (NX) ? vgn[h][0] : vgc[h][0], _o1 = (NX) ? vgn[h][1] : vgc[h][1]; PG8_STAGE2(PG8_SA(b, h), (aptr), _o0, _o1); } \
        else { PG8_STAGE2(PG8_SA(b, h), (aptr) + (h) * hstepA, voffA[0], voffA[1]); } } while (0)
#define PG8_LDA(dst, b, h) do { _Pragma("unroll") for (int m = 0; m < 4; ++m) _Pragma("unroll") for (int k = 0; k < 2; ++k) dst[m][k] = *(const LAS bf16x8*)(lds + PG8_SA(b, h) + aoff + m * 2048 + k * 1024); } while (0)
#define PG8_LDB(dst, b, h) do { _Pragma("unroll") for (int n = 0; n < 2; ++n) _Pragma("unroll") for (int k = 0; k < 2; ++k) dst[n][k] = *(const LAS bf16x8*)(lds + PG8_SB(b, h) + boff + n * 2048 + k * 1024); } while (0)
#define PG8_MMA(ai, bj, At, Bt) do { __builtin_amdgcn_s_setprio(1); _Pragma("unroll") for (int m = 0; m < 4; ++m) _Pragma("unroll") for (int n = 0; n < 2; ++n) _Pragma("unroll") for (int k = 0; k < 2; ++k) \
        acc[ai][bj][m][n] = __builtin_amdgcn_mfma_f32_16x16x32_bf16(Bt[n][k], At[m][k], acc[ai][bj][m][n], 0, 0, 0); __builtin_amdgcn_s_setprio(0); } while (0)
#define PG8_WAIT_V(n) asm volatile("s_waitcnt vmcnt(" #n ")" ::: "memory")
#define PG8_WAIT_L(n) asm volatile("s_waitcnt lgkmcnt(" #n ")" ::: "memory")
#define PG8_BAR __builtin_amdgcn_s_barrier()
#define PG8_SCHED __builtin_amdgcn_sched_barrier(0)
    Unit cur, nxt; int ui = 0;
    if (!S.next(0, cur)) return;
    f32x4 acc[2][2][4][2];
#pragma unroll
    for (int a = 0; a < 2; ++a)
#pragma unroll
        for (int b = 0; b < 2; ++b)
#pragma unroll
            for (int m = 0; m < 4; ++m)
#pragma unroll
                for (int n = 0; n < 2; ++n) acc[a][b][m][n] = (f32x4){0.f, 0.f, 0.f, 0.f};
    bf16x8 At[4][2], B0[2][2], B1[2][2];
    unsigned vgc[2][2] = {{0u, 0u}, {0u, 0u}}, vgn[2][2] = {{0u, 0u}, {0u, 0u}};
    if constexpr (GA::ON) {
#pragma unroll
        for (int h = 0; h < 2; ++h)
#pragma unroll
            for (int i = 0; i < 2; ++i) vgc[h][i] = ga.rowoff(cur, h * HALF + RA[i]) + CA[i];
    }
    const char* cA = GA::ON ? (const char*)g.A : g.abase(cur); const char* cB = g.bbase(cur);
    S.a_ready(cur);
    PG8_STAGE_B(0, 0, cB); PG8_STAGE_B(0, 1, cB); PG8_STAGE_A(0, 0, cA, false); PG8_STAGE_A(0, 1, cA, false);
    if (wr == 1) PG8_BAR;
    PG8_WAIT_V(2); PG8_BAR;
    PG8_STAGE_B(1, 0, cB + kstep); PG8_STAGE_A(1, 0, cA + kstep, false); PG8_STAGE_B(1, 1, cB + kstep);
    PG8_WAIT_V(6); PG8_BAR;
    for (;;) {
        const bool has_next = S.next(ui + 1, nxt);
        const char* nA = has_next ? (GA::ON ? (const char*)g.A : g.abase(nxt)) : cA; const char* nB = has_next ? g.bbase(nxt) : cB;
        if constexpr (GA::ON) {
#pragma unroll
            for (int h = 0; h < 2; ++h)
#pragma unroll
                for (int i = 0; i < 2; ++i) vgn[h][i] = has_next ? ga.rowoff(nxt, h * HALF + RA[i]) + CA[i] : vgc[h][i];
            asm volatile("" : "+v"(vgn[0][0]), "+v"(vgn[0][1]), "+v"(vgn[1][0]), "+v"(vgn[1][1]));
        }
        for (int t = 0; t < nt; t += 2) {
            const bool last = (t == nt - 2);
            const char* a1 = cA + (size_t)(t + 1) * kstep;
            const char* a2 = last ? nA : cA + (size_t)(t + 2) * kstep; const char* b2 = last ? nB : cB + (size_t)(t + 2) * kstep;
            const char* a3 = a2 + kstep; const char* b3 = b2 + kstep;
            if (last && has_next) S.a_ready(nxt);
            PG8_LDB(B0, 0, 0); PG8_LDB(B1, 0, 1); PG8_SCHED; PG8_LDA(At, 0, 0); PG8_STAGE_A(1, 1, a1, false);
            PG8_WAIT_V(8); PG8_WAIT_L(0); PG8_BAR; PG8_MMA(0, 0, At, B0); PG8_MMA(0, 1, At, B1); PG8_BAR; PG8_SCHED;
            PG8_LDA(At, 0, 1); PG8_STAGE_B(0, 0, b2); PG8_STAGE_B(0, 1, b2); PG8_STAGE_A(0, 0, a2, last);
            PG8_WAIT_V(8); PG8_WAIT_L(0); PG8_BAR; PG8_MMA(1, 0, At, B0); PG8_MMA(1, 1, At, B1); PG8_BAR; PG8_SCHED;
            PG8_LDB(B0, 1, 0); PG8_LDB(B1, 1, 1); PG8_SCHED; PG8_LDA(At, 1, 0); PG8_STAGE_A(0, 1, a2, last);
            PG8_WAIT_V(8); PG8_WAIT_L(0); PG8_BAR; PG8_MMA(0, 0, At, B0); PG8_MMA(0, 1, At, B1); PG8_BAR; PG8_SCHED;
            PG8_LDA(At, 1, 1); PG8_STAGE_B(1, 0, b3); PG8_STAGE_B(1, 1, b3); PG8_STAGE_A(1, 0, a3, last);
            PG8_WAIT_V(8); PG8_WAIT_L(0); PG8_BAR; PG8_MMA(1, 0, At, B0); PG8_MMA(1, 1, At, B1); PG8_BAR; PG8_SCHED;
        }
        if constexpr (ALIGN_EPI) { if (wr == 0) PG8_BAR; }
        if constexpr (!Epi::AFTER_DRAIN) { E(acc, cur, wr, wc, fr, fq); S.done(cur); }
        if (!has_next) break;
#pragma unroll
        for (int a = 0; a < 2; ++a)
#pragma unroll
            for (int b = 0; b < 2; ++b)
#pragma unroll
                for (int m = 0; m < 4; ++m)
#pragma unroll
                    for (int n = 0; n < 2; ++n) acc[a][b][m][n] = (f32x4){0.f, 0.f, 0.f, 0.f};
        cur = nxt; cA = nA; cB = nB; ++ui;
        if constexpr (GA::ON) {
#pragma unroll
            for (int h = 0; h < 2; ++h)
#pragma unroll
                for (int i = 0; i < 2; ++i) vgc[h][i] = vgn[h][i];
        }
        if constexpr (ALIGN_EPI) { if (wr == 1) PG8_BAR; }
    }
    PG8_WAIT_V(0);
    if constexpr (!ALIGN_EPI) { if (wr == 0) PG8_BAR; }
    PG8_BAR;
    if constexpr (Epi::AFTER_DRAIN) { E.fused(acc, cur, wr, wc, fr, fq, lds, wid, lane); S.done(cur); }
#undef PG8_SA
#undef PG8_SB
#undef PG8_STAGE2
#undef PG8_STAGE_A
#undef PG8_STAGE_B
#undef PG8_LDA
#undef PG8_LDB
#undef PG8_MMA
#undef PG8_WAIT_V
#undef PG8_WAIT_L
#undef PG8_BAR
#undef PG8_SCHED
}
}

namespace pg8 {
DEVI float fsig(float x) { return __builtin_amdgcn_rcpf(1.0f + __expf(-x)); }
DEVI f32x4 unpk_lo(u32x4 w, int half) {
    const unsigned a = half ? w.z : w.x, b = half ? w.w : w.y;
    return (f32x4){__uint_as_float(a << 16), __uint_as_float(a & 0xffff0000u), __uint_as_float(b << 16), __uint_as_float(b & 0xffff0000u)}; }
DEVI u32x4 pk8(f32x4 v0, f32x4 v1) { u32x4 w; w.x = cvt_pk_bf16(v0[0], v0[1]); w.y = cvt_pk_bf16(v0[2], v0[3]); w.z = cvt_pk_bf16(v1[0], v1[1]); w.w = cvt_pk_bf16(v1[2], v1[3]); return w; }

struct StaticOrder {
    int nM, nN, nwg, G, c;
    DEVI void init(int M, int N, int G_, int c_) { nM = M / BM; nN = N / BM; nwg = nM * nN; G = G_; c = c_; }
    DEVI bool next(int i, Unit& u) const {
        const long L = (long)i * G + c; if (L >= nwg) return false;
        int wgid = (int)L; { const int q = nwg / 8, r = nwg % 8, xcd = wgid % 8, off = wgid / 8; wgid = (xcd < r ? xcd * (q + 1) : r * (q + 1) + (xcd - r) * q) + off; }
        const int nig = 8 * nN, gid = wgid / nig, fm = gid * 8, gsz = (nM - fm) < 8 ? (nM - fm) : 8;
        u.pm = fm + ((wgid % nig) % gsz); u.pn = (wgid % nig) / gsz; u.g = 0; u.ui = i; return true;
    }
    DEVI void a_ready(const Unit&) const {}
    DEVI void done(const Unit&) const {}
};
struct OrderS5A { int G, c; DEVI bool next(int i, Unit& u) const { const int U = i * G + c; if (U >= SSM_G * 4) return false; u.g = U >> 2; u.pm = U & 3; u.pn = 0; u.ui = i; return true; }
    DEVI void a_ready(const Unit&) const {} DEVI void done(const Unit&) const {} };
struct OrderS5C { int G, c; DEVI bool next(int i, Unit& u) const { const int U = i * G + c; if (U >= SSM_G * 8) return false; u.g = U >> 3; u.pm = (U >> 1) & 3; u.pn = U & 1; u.ui = i; return true; }
    DEVI void a_ready(const Unit&) const {} DEVI void done(const Unit&) const {} };
struct OrderMoE { int G, v; const volatile LAS int* tstart;
    DEVI bool next(int i, Unit& u) const { const int U = i * G + v, rt = U >> 2; if (rt >= tstart[NEXP]) return false;
        int e = 0;
#pragma unroll 1
        for (int q = 1; q < NEXP; ++q) e = (rt >= tstart[q]) ? q : e;
        u.pm = rt; u.pn = U & 3; u.g = e; u.ui = i; return true; }
    DEVI void a_ready(const Unit&) const {} DEVI void done(const Unit&) const {} };

template <bool F32IN> struct EpiResBf16 { static constexpr bool PERM = true, AFTER_DRAIN = false; const float* xin32; bf16_t* xb;
    DEVI void operator()(const f32x4 (&acc)[2][2][4][2], const Unit& u, int wr, int wc, int fr, int fq) const {
        const int row0 = u.pm * BM + wr * 64 + fr, col0 = u.pn * BM + wc * 32 + 8 * fq;
#pragma unroll
        for (int ai = 0; ai < 2; ++ai)
#pragma unroll
            for (int m = 0; m < 4; ++m) { const size_t off = (size_t)(row0 + ai * HALF + m * 16) * D + col0;
#pragma unroll
                for (int bj = 0; bj < 2; ++bj) { f32x4 a0, a1;
                    if (F32IN) { a0 = *(const f32x4*)(xin32 + off + bj * HALF); a1 = *(const f32x4*)(xin32 + off + bj * HALF + 4); }
                    else { const u32x4 w = *(const u32x4*)(xb + off + bj * HALF); a0 = unpk_lo(w, 0); a1 = unpk_lo(w, 1); }
                    *(u32x4*)(xb + off + bj * HALF) = pk8(a0 + acc[ai][bj][m][0], a1 + acc[ai][bj][m][1]); }
                if (m & 1) asm volatile("" ::: "memory"); }
    } };
struct EpiMix { static constexpr bool PERM = true, AFTER_DRAIN = false; const bf16_t* sg; const bf16_t* mixa; bf16_t* mixed;
    DEVI void operator()(const f32x4 (&acc)[2][2][4][2], const Unit& u, int wr, int wc, int fr, int fq) const {
        const int row0 = u.pm * BM + wr * 64 + fr, col0 = u.pn * BM + wc * 32 + 8 * fq;
#pragma unroll
        for (int ai = 0; ai < 2; ++ai)
#pragma unroll
            for (int m = 0; m < 4; ++m) { const size_t row = (size_t)(row0 + ai * HALF + m * 16);
#pragma unroll
                for (int bj = 0; bj < 2; ++bj) { const int col = col0 + bj * HALF;
                    const u32x4 a = *(const u32x4*)(mixa + row * 1024 + col), s = *(const u32x4*)(sg + row * 2048 + 1024 + col);
                    const f32x4 o0 = unpk_lo(a, 0) + unpk_lo(s, 0) * acc[ai][bj][m][0], o1 = unpk_lo(a, 1) + unpk_lo(s, 1) * acc[ai][bj][m][1];
                    *(u32x4*)(mixed + row * 1024 + col) = pk8(o0, o1); }
                if (m & 1) asm volatile("" ::: "memory"); }
    } };
struct EpiGlu { static constexpr bool PERM = true, AFTER_DRAIN = false; const bf16_t* sg; bf16_t* mixa;
    DEVI void operator()(const f32x4 (&acc)[2][2][4][2], const Unit& u, int wr, int wc, int fr, int fq) const {
        const int row0 = u.pm * BM + wr * 64 + fr, col = u.pn * HALF + wc * 32 + 8 * fq;
#pragma unroll
        for (int ai = 0; ai < 2; ++ai)
#pragma unroll
            for (int m = 0; m < 4; ++m) { const size_t row = (size_t)(row0 + ai * HALF + m * 16);
                const u32x4 s = *(const u32x4*)(sg + row * 2048 + col);
                f32x4 o[2];
#pragma unroll
                for (int n = 0; n < 2; ++n) { const f32x4 v = acc[ai][0][m][n], gt = acc[ai][1][m][n], sv = unpk_lo(s, n);
                    o[n] = (f32x4){sv[0] * v[0] * fsig(gt[0]), sv[1] * v[1] * fsig(gt[1]), sv[2] * v[2] * fsig(gt[2]), sv[3] * v[3] * fsig(gt[3])}; }
                *(u32x4*)(mixa + row * 1024 + col) = pk8(o[0], o[1]);
                if (m & 1) asm volatile("" ::: "memory"); }
    } };
struct EpiSwiglu { static constexpr bool PERM = true, AFTER_DRAIN = false; bf16_t* hmid;
    DEVI void operator()(const f32x4 (&acc)[2][2][4][2], const Unit& u, int wr, int wc, int fr, int fq) const {
        const int row0 = u.pm * BM + wr * 64 + fr, col = u.pn * HALF + wc * 32 + 8 * fq;
#pragma unroll
        for (int ai = 0; ai < 2; ++ai)
#pragma unroll
            for (int m = 0; m < 4; ++m) { const size_t row = (size_t)(row0 + ai * HALF + m * 16);
                f32x4 o[2];
#pragma unroll
                for (int n = 0; n < 2; ++n) { const f32x4 gt = acc[ai][0][m][n], up = acc[ai][1][m][n];
                    o[n] = (f32x4){gt[0] * fsig(gt[0]) * up[0], gt[1] * fsig(gt[1]) * up[1], gt[2] * fsig(gt[2]) * up[2], gt[3] * fsig(gt[3]) * up[3]}; }
                *(u32x4*)(hmid + row * 512 + col) = pk8(o[0], o[1]); }
    } };
struct EpiStoreBf16 { static constexpr bool PERM = true, AFTER_DRAIN = false; bf16_t* out; int ldc;
    DEVI void operator()(const f32x4 (&acc)[2][2][4][2], const Unit& u, int wr, int wc, int fr, int fq) const {
        const int row0 = u.pm * BM + wr * 64 + fr, col0 = u.pn * BM + wc * 32 + 8 * fq;
#pragma unroll
        for (int ai = 0; ai < 2; ++ai)
#pragma unroll
            for (int m = 0; m < 4; ++m) { bf16_t* rp = out + (size_t)(row0 + ai * HALF + m * 16) * ldc + col0;
#pragma unroll
                for (int bj = 0; bj < 2; ++bj) *(u32x4*)(rp + bj * HALF) = pk8(acc[ai][bj][m][0], acc[ai][bj][m][1]); }
    } };
struct EpiS5Cm { static constexpr bool PERM = true, AFTER_DRAIN = false; const bf16_t* ucat; const float* dskip; bf16_t* z;
    DEVI void operator()(const f32x4 (&acc)[2][2][4][2], const Unit& u, int wr, int wc, int fr, int fq) const {
        const int g = u.g, row0 = u.pm * BM + wr * 64 + fr, col0 = u.pn * BM + wc * 32 + 8 * fq;
        const int co0 = col0 & 15;
        const f32x4 d0 = *(const f32x4*)(dskip + g * 16 + co0), d1 = *(const f32x4*)(dskip + g * 16 + co0 + 4);
#pragma unroll
        for (int ai = 0; ai < 2; ++ai)
#pragma unroll
            for (int m = 0; m < 4; ++m) { const int row = row0 + ai * HALF + m * 16, b = row >> 7, c = row & 127;
#pragma unroll
                for (int bj = 0; bj < 2; ++bj) { const int n = col0 + bj * HALF, t = n >> 4;
                    const u32x4 uu = *(const u32x4*)(ucat + ((size_t)g * UROWS + row) * UK + n);
                    const f32x4 y0 = acc[ai][bj][m][0] + d0 * unpk_lo(uu, 0), y1 = acc[ai][bj][m][1] + d1 * unpk_lo(uu, 1);
                    const f32x4 z0 = (f32x4){gelu_tanh(y0[0]), gelu_tanh(y0[1]), gelu_tanh(y0[2]), gelu_tanh(y0[3])}, z1 = (f32x4){gelu_tanh(y1[0]), gelu_tanh(y1[1]), gelu_tanh(y1[2]), gelu_tanh(y1[3])};
                    *(u32x4*)(z + ((size_t)b * SEQ + c * CHL + t) * 512 + g * 16 + co0) = pk8(z0, z1); } }
    } };
struct EpiS5Am { static constexpr bool PERM = false, AFTER_DRAIN = true; const float* AL; bf16_t* ucat;
    DEVI void fused(f32x4 (&acc)[2][2][4][2], const Unit& u, int wr, int wc, int fr, int fq, LAS unsigned char* lds, int wid, int lane) const {
        LAS float* sl = (LAS float*)lds;
#pragma unroll
        for (int ai = 0; ai < 2; ++ai)
#pragma unroll
            for (int m = 0; m < 4; ++m) { const int row = ai * HALF + wr * 64 + m * 16 + fr;
#pragma unroll
                for (int n = 0; n < 2; ++n) *(LAS f32x4*)(sl + row * 128 + wc * 32 + n * 16 + 4 * fq) = acc[ai][0][m][n]; }
        asm volatile("s_waitcnt lgkmcnt(0)" ::: "memory"); __builtin_amdgcn_s_barrier(); asm volatile("" ::: "memory");
        const int tid = wid * 64 + lane;
        if (tid < 128) { const int bb = tid >> 6, p = tid & 63, g = u.g;
            const float ar = AL[(g * 64 + p) * 2], ai_ = AL[(g * 64 + p) * 2 + 1];
            float hr = 0.f, hi = 0.f;
            for (int c = 0; c < NCH; ++c) { const int row = bb * NCH + c;
                bf16_t* up = ucat + ((size_t)g * UROWS + u.pm * BM + row) * UK + 512 + p;
                up[0] = f2bf(hr); up[64] = f2bf(hi);
                const float sr = sl[row * 128 + p], si = sl[row * 128 + 64 + p];
                const float nr = ar * hr - ai_ * hi + sr, ni = ar * hi + ai_ * hr + si; hr = nr; hi = ni; } }
        asm volatile("s_waitcnt lgkmcnt(0)" ::: "memory"); __builtin_amdgcn_s_barrier(); asm volatile("" ::: "memory");
    } };
struct EpiG1 { static constexpr bool PERM = true, AFTER_DRAIN = false; bf16_t* ucat; bf16_t* q; bf16_t* k; bf16_t* v; bf16_t* sg; const float* qg; const float* kg; const float* rope; float* qraw; float* kraw;
    DEVI void operator()(const f32x4 (&acc)[2][2][4][2], const Unit& u, int wr, int wc, int fr, int fq) const {
        const int pn = u.pn, row0 = u.pm * BM + wr * 64 + fr;
        if (pn < 2) {
#pragma unroll
            for (int ai = 0; ai < 2; ++ai)
#pragma unroll
                for (int m = 0; m < 4; ++m) { const int row = row0 + ai * HALF + m * 16, b = row >> 12, s = row & 4095;
#pragma unroll
                    for (int bj = 0; bj < 2; ++bj) { const int c = pn * BM + bj * HALF + wc * 32 + 8 * fq, g = c >> 4, ci = c & 15;
                        *(u32x4*)(ucat + ((size_t)g * UROWS + b * NCH + (s >> 5)) * UK + (s & 31) * 16 + ci) = pk8(acc[ai][bj][m][0], acc[ai][bj][m][1]); } }
        } else if (pn < 6) {
            const bool isk = pn >= 4; const int hh = (pn & 1) * 4 + wc;
#if G1_RAWQK
            { float* raw = isk ? kraw : qraw;
#pragma unroll
              for (int ai = 0; ai < 2; ++ai)
#pragma unroll
                for (int m = 0; m < 4; ++m) { const int row = row0 + ai * HALF + m * 16;
#pragma unroll
                    for (int bj = 0; bj < 2; ++bj)
#pragma unroll
                        for (int n = 0; n < 2; ++n) *(f32x4*)(raw + (size_t)row * 512 + hh * 64 + 32 * bj + 8 * fq + 4 * n) = acc[ai][bj][m][n]; }
              return; }
#endif
            const float* gn = isk ? kg : qg; bf16_t* dst = isk ? k : q; const float sc = isk ? 1.0f : QSCALE;
            f32x4 gv[2][2];
#pragma unroll
            for (int bj = 0; bj < 2; ++bj)
#pragma unroll
                for (int n = 0; n < 2; ++n) gv[bj][n] = *(const f32x4*)(gn + 32 * bj + 8 * fq + 4 * n);
#pragma unroll
            for (int ai = 0; ai < 2; ++ai)
#pragma unroll
                for (int m = 0; m < 4; ++m) { const int row = row0 + ai * HALF + m * 16, s = row & 4095;
                    float ss = 0.f;
#pragma unroll
                    for (int bj = 0; bj < 2; ++bj)
#pragma unroll
                        for (int n = 0; n < 2; ++n) { const f32x4 x = acc[ai][bj][m][n]; ss += (x[0] * x[0] + x[1] * x[1]) + (x[2] * x[2] + x[3] * x[3]); }
                    ss += xshfl(ss, 16, fq * 16 + fr); ss += xshfl(ss, 32, fq * 16 + fr);
                    const float rstd = 1.0f / sqrtf(ss * (1.0f / 64.0f) + NORM_EPS);
                    f32x4 o1[2], o2[2];
#pragma unroll
                    for (int n = 0; n < 2; ++n) { const float* rp = rope + ((size_t)s * 32 + 8 * fq + 4 * n) * 2;
                        const f32x4 r0 = *(const f32x4*)rp, r1 = *(const f32x4*)(rp + 4);
                        const f32x4 cv = (f32x4){r0[0], r0[2], r1[0], r1[2]}, sv = (f32x4){r0[1], r0[3], r1[1], r1[3]};
                        const f32x4 x1 = acc[ai][0][m][n] * rstd * gv[0][n], x2 = acc[ai][1][m][n] * rstd * gv[1][n];
                        o1[n] = (x1 * cv - x2 * sv) * sc; o2[n] = (x2 * cv + x1 * sv) * sc; }
                    const u32x4 w1 = pk8(o1[0], o1[1]), w2 = pk8(o2[0], o2[1]);
                    bf16_t* dp = dst + (size_t)row * 512 + hh * 64 + 8 * fq;
                    *(u32x4*)dp = w1; *(u32x4*)(dp + 32) = w2;
                    if (m & 1) asm volatile("" ::: "memory"); }
        } else if (pn < 8) {
#pragma unroll
            for (int ai = 0; ai < 2; ++ai)
#pragma unroll
                for (int m = 0; m < 4; ++m) { bf16_t* rp = v + (size_t)(row0 + ai * HALF + m * 16) * 512 + (pn - 6) * BM + wc * 32 + 8 * fq;
#pragma unroll
                    for (int bj = 0; bj < 2; ++bj) *(u32x4*)(rp + bj * HALF) = pk8(acc[ai][bj][m][0], acc[ai][bj][m][1]); }
        } else {
#pragma unroll
            for (int ai = 0; ai < 2; ++ai)
#pragma unroll
                for (int m = 0; m < 4; ++m) { bf16_t* rp = sg + (size_t)(row0 + ai * HALF + m * 16) * 2048 + (pn - 8) * BM + wc * 32 + 8 * fq;
#pragma unroll
                    for (int bj = 0; bj < 2; ++bj) { const f32x4 a = acc[ai][bj][m][0], b = acc[ai][bj][m][1];
                        *(u32x4*)(rp + bj * HALF) = pk8((f32x4){fsig(a[0]), fsig(a[1]), fsig(a[2]), fsig(a[3])}, (f32x4){fsig(b[0]), fsig(b[1]), fsig(b[2]), fsig(b[3])}); } }
        }
    } };
}

struct CvtItem { const float* src; bf16_t* dst; int N, K; };
DEVI void cvt_load(const CvtItem& it, float (&v)[32], int lane) {
#pragma unroll
    for (int i = 0; i < 32; ++i) v[i] = it.src[(size_t)(2 * i + (lane >> 5)) * it.N + (lane & 31)];
}
DEVI void cvt_store(const CvtItem& it, const float (&v)[32], LAS float* scr, int lane) {
#pragma unroll
    for (int i = 0; i < 32; ++i) scr[(2 * i + (lane >> 5)) * 33 + (lane & 31)] = v[i];
    asm volatile("s_waitcnt lgkmcnt(0)" ::: "memory");
    const int c = lane & 7;
#pragma unroll
    for (int j = 0; j < 4; ++j) { const int n = (lane >> 3) + 8 * j; const LAS float* s = scr + (8 * c) * 33 + n;
        u32x4 o; o.x = pk2(s[0 * 33], s[1 * 33]); o.y = pk2(s[2 * 33], s[3 * 33]); o.z = pk2(s[4 * 33], s[5 * 33]); o.w = pk2(s[6 * 33], s[7 * 33]);
        *(u32x4*)(it.dst + (size_t)n * it.K + 8 * c) = o; }
    asm volatile("s_waitcnt lgkmcnt(0)" ::: "memory");
}
constexpr int CV_IN = 16 * 128, CV_GLU = 8 * 64, CV_ATT = 8 * 32, CV_OUT = 16 * 32, CV_GU1 = 16 * 32, CV_DN1 = 8 * 32;
constexpr int CV_PER_LAYER = CV_IN + CV_GLU + CV_ATT + CV_OUT + NEXP * (CV_GU1 + CV_DN1);
DEVI CvtItem cvt_decode(int it, const float* w_in, const float* w_glu, const float* w_attn, const float* w_out, const float* w_gu, const float* w_dn,
                        bf16_t* WIN, bf16_t* WGLU, bf16_t* WATT, bf16_t* WOUT, bf16_t* WGU, bf16_t* WDN) {
    const int l = it / CV_PER_LAYER; int r = it % CV_PER_LAYER;
    const float* W; bf16_t* WT; int K, N, mode;
    if (r < CV_IN) { W = w_in + (size_t)l * D * D_IN; WT = WIN + (size_t)l * D_IN * D; K = D; N = D_IN; mode = 1; }
    else if ((r -= CV_IN) < CV_GLU) { W = w_glu + (size_t)l * 512 * 2048; WT = WGLU + (size_t)l * 2048 * 512; K = 512; N = 2048; mode = 2; }
    else if ((r -= CV_GLU) < CV_ATT) { W = w_attn + (size_t)l * 512 * 1024; WT = WATT + (size_t)l * 1024 * 512; K = 512; N = 1024; mode = 0; }
    else if ((r -= CV_ATT) < CV_OUT) { W = w_out + (size_t)l * 1024 * 1024; WT = WOUT + (size_t)l * 1024 * 1024; K = 1024; N = 1024; mode = 0; }
    else if ((r -= CV_OUT) < NEXP * CV_GU1) { const int e = r / CV_GU1; r %= CV_GU1; W = w_gu + ((size_t)l * NEXP + e) * 1024 * 1024; WT = WGU + ((size_t)l * NEXP + e) * 1024 * 1024; K = 1024; N = 1024; mode = 3; }
    else { r -= NEXP * CV_GU1; const int e = r / CV_DN1; r %= CV_DN1; W = w_dn + ((size_t)l * NEXP + e) * 512 * 1024; WT = WDN + ((size_t)l * NEXP + e) * 1024 * 512; K = 512; N = 1024; mode = 0; }
    const int nblk = N / 32, kb = r / nblk, nb = r % nblk, nd = 32 * nb;
    int ns = nd;
    if (mode == 1) { const int pn = nd >> 8, tc = nd & 255; if (pn >= 2 && pn < 6) { const int sec = pn < 4 ? 512 : 1024, hh = (pn & 1) * 4 + ((tc >> 5) & 3); ns = sec + hh * 64 + 32 * (tc >> 7); } }
    else if (mode == 2) { const int pn = nd >> 8, tc = nd & 255; ns = (tc < 128) ? 128 * pn + tc : 1024 + 128 * pn + (tc - 128); }
    else if (mode == 3) { const int pn = nd >> 8, tc = nd & 255; ns = (tc < 128) ? 128 * pn + tc : 512 + 128 * pn + (tc - 128); }
    return CvtItem{W + (size_t)(64 * kb) * N + ns, WT + (size_t)nd * K + 64 * kb, N, K};
}
constexpr int CVQ_BASE = CV_IN + CV_GLU + CV_ATT + CV_OUT;
constexpr int CVQ_PER_BARRIER = 2;
constexpr int CVQ_TOTAL = DEPTH * CV_PER_LAYER - CVQ_BASE;
constexpr int CVQ_LIM_MOE0 = CV_PER_LAYER - CVQ_BASE;
constexpr int CVQ_LIM_PROJ1 = CVQ_LIM_MOE0 + CVQ_BASE;
struct CvtQ { const float* w_in; const float* w_glu; const float* w_attn; const float* w_out; const float* w_gu; const float* w_dn;
              bf16_t* WIN_; bf16_t* WGLU_; bf16_t* WATT_; bf16_t* WOUT_; bf16_t* WGU_; bf16_t* WDN_; LAS unsigned* head; LAS unsigned char* lds; int wave, lane, c, G;
    DEVI void item(int q) const { const CvtItem c = cvt_decode(q + CVQ_BASE, w_in, w_glu, w_attn, w_out, w_gu, w_dn, WIN_, WGLU_, WATT_, WOUT_, WGU_, WDN_);
        float v[32]; cvt_load(c, v, lane); cvt_store(c, v, (LAS float*)(lds + wave * 16384), lane); }
    DEVI int take() const { unsigned j = 0u; if (lane == 0) j = __hip_atomic_fetch_add(head, 1u, __ATOMIC_RELAXED, __HIP_MEMORY_SCOPE_WORKGROUP); return c + G * __builtin_amdgcn_readfirstlane((int)j); }
    DEVI int peek() const { return c + G * __builtin_amdgcn_readfirstlane((int)__hip_atomic_load(head, __ATOMIC_RELAXED, __HIP_MEMORY_SCOPE_WORKGROUP)); }
    DEVI void run_until(volatile LAS unsigned* genw, unsigned n) const {
        bool empty = peek() >= CVQ_TOTAL; int budget = CVQ_PER_BARRIER;
        while (*genw < n) {
            if (empty || budget == 0) { __builtin_amdgcn_s_sleep(4); continue; }
            --budget;
            const int q = take();
            if (q >= CVQ_TOTAL) { empty = true; continue; }
            item(q);
        }
    }
    DEVI void catchup(int limit) const { for (;;) { if (peek() >= limit) break; const int q = take(); if (q >= CVQ_TOTAL) break; item(q); } }
};
DEVI int fresh_lane() { int l = (int)__builtin_amdgcn_mbcnt_hi(~0u, __builtin_amdgcn_mbcnt_lo(~0u, 0u)); asm volatile("" : "+v"(l)); return l; }
DEVI CvtQ make_cvtq(const Args& a, LAS unsigned char* lds, int wave, int lane) {
    unsigned char* w = a.ws;
    return CvtQ{a.in[2], a.in[11], a.in[14], a.in[15], a.in[21], a.in[22], (bf16_t*)(w + WS_WIN), (bf16_t*)(w + WS_WGLU), (bf16_t*)(w + WS_WATT), (bf16_t*)(w + WS_WOUT), (bf16_t*)(w + WS_WGU), (bf16_t*)(w + WS_WDN),
                (LAS unsigned*)(lds + LDSCTL_OFF) + 5, lds, wave, lane, (int)blockIdx.x, (int)gridDim.x};
}
DEVI void ph_convert_first(const Frame& F, const CvtQ& Q) { for (int it = F.gw; it < CVQ_BASE; it += F.NGW) Q.item(it - CVQ_BASE); }
DEVI void xcd_barrier_w(const XcdBarrier& b, unsigned n, volatile LAS unsigned* genw, const CvtQ& Q) {
    asm volatile("s_waitcnt vmcnt(0)" ::: "memory");
    __syncthreads();
    if (Q.wave == 0) {
        if (threadIdx.x == 0) {
            unsigned* bar = b.bar;
            __builtin_amdgcn_s_waitcnt(0);
            unsigned nloc = b.st[0], nx = b.st[1];
            if (nloc == 0u) { xcd_barrier_complete(bar, b.x, nloc, nx); b.st[0] = nloc; b.st[1] = nx; }
            const unsigned old = xb_add(&bar[XB_XSUB(b.x)], 1u);
            const unsigned gen = old / nloc;
            if (old + 1u == (gen + 1u) * nloc) {
                __builtin_amdgcn_fence(__ATOMIC_RELEASE, "agent");
                asm volatile("s_waitcnt vmcnt(0)" ::: "memory");
                const unsigned og = xb_add(&bar[XB_TOP], 1u);
                const unsigned tg = og / nx;
                if (og + 1u == (tg + 1u) * nx) xb_add(&bar[XB_TOPGEN], 1u);
                else XB_SPIN(xb_ld(&bar[XB_TOPGEN]) == tg, bar);
                __builtin_amdgcn_fence(__ATOMIC_ACQUIRE, "agent");
                xb_add(&bar[XB_XGEN(b.x)], 1u);
                asm volatile("s_waitcnt vmcnt(0)" ::: "memory");
            } else {
                XB_SPIN(xb_ld(&bar[XB_XGEN(b.x)]) == gen, bar);
                __builtin_amdgcn_fence(__ATOMIC_ACQUIRE, "agent");
                asm volatile("s_waitcnt vmcnt(0)" ::: "memory");
            }
            *genw = n;
        }
    } else Q.run_until(genw, n);
    __syncthreads();
}


DEVI void moe_tstart(const Frame& F, const unsigned* cnt, volatile LAS int* tstart) {
    if (F.tid == 0) { int a = 0; for (int e = 0; e < NEXP; ++e) { tstart[e] = a; a += (int)((__hip_atomic_load(cnt + e, __ATOMIC_RELAXED, __HIP_MEMORY_SCOPE_AGENT) + 255u) / 256u); } tstart[NEXP] = a; }
    __syncthreads();
}
DEVI void moe_gather_table(const Frame& F, int v, const unsigned* cnt, const int* list, volatile LAS int* tstart, LAS unsigned* tab) {
    for (int i = 0; i < 8; ++i) {
        const int U = i * F.G + v, rt = U >> 2; if (rt >= tstart[NEXP]) break;
        int e = 0;
        for (int q = 1; q < NEXP; ++q) e = (rt >= tstart[q]) ? q : e;
        const int n = (int)cnt[e];
        for (int r = F.tid; r < 256; r += NTHR) { const int idx = (rt - tstart[e]) * 256 + r; tab[i * 256 + r] = (unsigned)list[(size_t)e * LIST_CAP + (idx < n ? idx : 0)] * (unsigned)(D * 2); }
    }
    __syncthreads();
}
DEVI void ph_zero_ksum(const Frame& F, float* ksum) { for (int i = F.gt; i < BATCH * NH * NBLK * 64; i += F.NGT) ksum[i] = 0.f; }

namespace attn_body {
using bf16=__hip_bfloat16;
using bf16x8=__attribute__((ext_vector_type(8)))short;
using s16x4=__attribute__((ext_vector_type(4)))short;
using f32x16=__attribute__((ext_vector_type(16)))float;
using f32x4=__attribute__((ext_vector_type(4)))float;
using u32x4=__attribute__((ext_vector_type(4)))unsigned;
constexpr int BATCH=8,NHEAD=8,SEQ=4096,D=64,DM=NHEAD*D;
constexpr int NW=8,QBLK=32,QB=QBLK*NW,KVBLK=64,NQB=SEQ/QB;
constexpr int ATTN_PITCH=DM, ATTN_UNIT_ROWS=QB;
__device__ __forceinline__ int crow(int r,int hi){return (r&3)+8*(r>>2)+4*hi;}
#define SBAR() __builtin_amdgcn_sched_barrier(0)
__device__ __forceinline__ void cmask(f32x16&p0,f32x16&p1,int jb,int qrel,int hi){
  const float NEG=-INFINITY; int kb=64*jb+4*hi;
  #pragma unroll
  for(int r=0;r<16;++r){int kv=kb+(r&3)+8*(r>>2); if(kv>qrel)p0[r]=NEG; if(kv+32>qrel)p1[r]=NEG;}
}

constexpr int NSLOT=3, SLOTB=8192;
constexpr int LDS_K=0, LDS_V=NSLOT*SLOTB, LDS_WS=2*NSLOT*SLOTB, LDS_OST=LDS_WS+NW*64*4, LDS_BYTES=LDS_OST+NW*4096;
constexpr float C2=0.125f*1.4426950408889634f;
__device__ __forceinline__ void glds16(const void*gsrc,unsigned lds_dst){unsigned keep;
  asm volatile("s_mov_b32 %0, m0\n\ts_mov_b32 m0, %2\n\ts_nop 0\n\tglobal_load_lds_dwordx4 %1, off\n\ts_mov_b32 m0, %0":"=&s"(keep):"v"(gsrc),"s"(lds_dst):"memory");}
__device__ __forceinline__ float max3f(float a,float b,float c){float r;asm("v_max3_f32 %0, %1, %2, %3":"=v"(r):"v"(a),"v"(b),"v"(c));return r;}
__device__ __forceinline__ float max2f(float a,float b){float r;asm("v_max_f32_e32 %0, %1, %2":"=v"(r):"v"(a),"v"(b));return r;}
__device__ __forceinline__ float fadd_s(float a,float b){float r;asm("v_add_f32_e32 %0, %1, %2":"=v"(r):"v"(a),"v"(b));return r;}
__device__ __forceinline__ float fsub_s(float a,float b){float r;asm("v_sub_f32_e32 %0, %1, %2":"=v"(r):"v"(a),"v"(b));return r;}
typedef float f32x2_t __attribute__((ext_vector_type(2))); typedef __bf16 bf16x2_t __attribute__((ext_vector_type(2)));
__device__ __forceinline__ unsigned cvtpk_s(float lo,float hi){f32x2_t v={lo,hi};bf16x2_t b=__builtin_convertvector(v,bf16x2_t);return __builtin_bit_cast(unsigned,b);}
#define WAIT_BAR(N) asm volatile("s_waitcnt vmcnt(" #N ") lgkmcnt(0)\n\ts_barrier":::"memory")

__device__ __forceinline__ void qkt(f32x16&p0,f32x16&p1,const char*Kslot,const bf16x8*qr,const f32x16&negm,int r32,int hi){
  const char*kb=Kslot+hi*1024+r32*16;
  #pragma unroll
  for(int d0=0;d0<4;++d0){
    const bf16x8 b0=*reinterpret_cast<const bf16x8*>(kb+d0*2048);
    const bf16x8 b1=*reinterpret_cast<const bf16x8*>(kb+d0*2048+512);
    if(d0==0){p0=__builtin_amdgcn_mfma_f32_32x32x16_bf16(b0,qr[0],negm,0,0,0);p1=__builtin_amdgcn_mfma_f32_32x32x16_bf16(b1,qr[0],negm,0,0,0);}
    else{p0=__builtin_amdgcn_mfma_f32_32x32x16_bf16(b0,qr[d0],p0,0,0,0);p1=__builtin_amdgcn_mfma_f32_32x32x16_bf16(b1,qr[d0],p1,0,0,0);}}
}
typedef __attribute__((address_space(3))) const char* lds_cptr;
typedef short v4i16_t __attribute__((ext_vector_type(4)));
__device__ __forceinline__ void kload8(bf16x8*kf,lds_cptr kp){
  kf[0]=*(const __attribute__((address_space(3))) bf16x8*)(kp);      kf[1]=*(const __attribute__((address_space(3))) bf16x8*)(kp+512);
  kf[2]=*(const __attribute__((address_space(3))) bf16x8*)(kp+2048); kf[3]=*(const __attribute__((address_space(3))) bf16x8*)(kp+2560);
  kf[4]=*(const __attribute__((address_space(3))) bf16x8*)(kp+4096); kf[5]=*(const __attribute__((address_space(3))) bf16x8*)(kp+4608);
  kf[6]=*(const __attribute__((address_space(3))) bf16x8*)(kp+6144); kf[7]=*(const __attribute__((address_space(3))) bf16x8*)(kp+6656);
}
__device__ __forceinline__ void kload2(bf16x8*kf,lds_cptr kp,int j){ kf[2*j]=*(const __attribute__((address_space(3))) bf16x8*)(kp+j*2048); kf[2*j+1]=*(const __attribute__((address_space(3))) bf16x8*)(kp+j*2048+512); }
__device__ __forceinline__ s16x4 vtr(lds_cptr p){ return __builtin_bit_cast(s16x4,__builtin_amdgcn_ds_read_tr16_b64_v4i16((__attribute__((address_space(3))) v4i16_t*)p)); }
__device__ __forceinline__ float rowmax(const f32x16&p0,const f32x16&p1){
  float a=max3f(p0[0],p0[1],p1[0]),b=max3f(p0[2],p0[3],p1[1]);a=max3f(a,p1[2],p1[3]);
  #pragma unroll
  for(int r=4;r<16;r+=4){a=max3f(a,p0[r],p0[r+1]);b=max3f(b,p0[r+2],p0[r+3]);a=max3f(a,p1[r],p1[r+1]);b=max3f(b,p1[r+2],p1[r+3]);}
  const float m=max2f(a,b);
  auto rr=__builtin_amdgcn_permlane32_swap(__float_as_uint(m),__float_as_uint(m),false,false);
  return max2f(__uint_as_float(rr[0]),__uint_as_float(rr[1]));
}
__device__ __forceinline__ void pv(f32x16*o,int vb,bf16x8 pa0,bf16x8 pa1,bf16x8 pa2,bf16x8 pa3){
  #pragma unroll
  for(int d0=0;d0<2;++d0){s16x4 lo[4],hi[4];
    #pragma unroll
    for(int ks=0;ks<4;++ks){
      asm volatile("ds_read_b64_tr_b16 %0,%1 offset:%c2":"=&v"(lo[ks]):"v"(vb),"i"(d0*4096+ks*1024):"memory");
      asm volatile("ds_read_b64_tr_b16 %0,%1 offset:%c2":"=&v"(hi[ks]):"v"(vb),"i"(d0*4096+ks*1024+512):"memory");}
    asm volatile("s_waitcnt lgkmcnt(0)":::"memory");SBAR();
    #define PK(k) (bf16x8){lo[k][0],lo[k][1],lo[k][2],lo[k][3],hi[k][0],hi[k][1],hi[k][2],hi[k][3]}
    o[d0]=__builtin_amdgcn_mfma_f32_32x32x16_bf16(pa0,PK(0),o[d0],0,0,0);
    o[d0]=__builtin_amdgcn_mfma_f32_32x32x16_bf16(pa1,PK(1),o[d0],0,0,0);
    o[d0]=__builtin_amdgcn_mfma_f32_32x32x16_bf16(pa2,PK(2),o[d0],0,0,0);
    o[d0]=__builtin_amdgcn_mfma_f32_32x32x16_bf16(pa3,PK(3),o[d0],0,0,0);
    #undef PK
  }
}

#ifndef ATTN_STORE16
#define ATTN_STORE16(p,v) (*(u32x4*)(p)=(v))
#endif
template<int THRL> __device__ __forceinline__ void attn_unit(int b,int h,int qb,const bf16*Q,const bf16*__restrict__ K,const bf16*__restrict__ V,bf16*O,const unsigned*__restrict__ sel,char*shm,int tid_in){
  const int tid=tid_in,lane=tid&63,r32=lane&31,hi=lane>>5; const int wid=__builtin_amdgcn_readfirstlane(tid>>6);
  const long rowbase=(long)b*SEQ; const int q0=qb*QB;
  const bf16*Qw=Q+(rowbase+q0+wid*QBLK)*DM+h*D;
  const bf16*Kh=K+rowbase*DM+h*D,*Vh=V+rowbase*DM+h*D;
  const unsigned lds0=(unsigned)(uintptr_t)shm;
  float*wsf=(float*)(shm+LDS_WS)+wid*64;
  const bf16*ksrc=Kh+(long)lane*DM+wid*8;
  const bf16*vsrc=Vh+(long)(16*(wid&3)+(lane>>2))*DM+(wid>>2)*32+(lane&3)*8;
  const unsigned kdst=lds0+LDS_K+wid*1024, vdst=lds0+LDS_V+wid*1024;
  #define DMA_K(t,slot) glds16(ksrc+(long)(t)*KVBLK*DM,(unsigned)__builtin_amdgcn_readfirstlane(kdst+(slot)))
  #define DMA_V(t,slot) glds16(vsrc+(long)(t)*KVBLK*DM,(unsigned)__builtin_amdgcn_readfirstlane(vdst+(slot)))
  const int vb0=(int)(lds0+LDS_V)+((lane>>4)&1)*32+(lane&3)*8+(4*hi+((lane&15)>>2))*64;
  const char*Kbase=shm+LDS_K; bf16x8 kf[8];
  const lds_cptr shm3=(lds_cptr)shm; const lds_cptr kp0=shm3+LDS_K+hi*1024+r32*16; const lds_cptr vp0=shm3+LDS_V+((lane>>4)&1)*32+(lane&3)*8+(4*hi+((lane&15)>>2))*64;
  const int NT=(q0+QB)/KVBLK;
  DMA_K(0,0);DMA_V(0,0);DMA_K(1,SLOTB);
  bf16x8 qr[4];
  #pragma unroll
  for(int d0=0;d0<4;++d0)qr[d0]=*reinterpret_cast<const bf16x8*>(&Qw[(long)r32*DM+d0*16+hi*8]);
  const unsigned selmask=sel[((size_t)(b*NHEAD+h))*SEQ+q0+wid*QBLK+r32];
  const float NEGINF=-INFINITY;
  float mhat=0.f,l_reg=0.f;f32x16 o[2];o[0]=f32x16{};o[1]=f32x16{};f32x16 negm=f32x16{};asm volatile("":"+v"(negm));
  const int qrel=wid*QBLK+r32;
  #define CMASK(P0,P1,t) do{int jb_=(t)-(NT-4); if(jb_>=0)cmask(P0,P1,jb_,qrel,hi);}while(0)
  bool resc=false;
  #define START(P0,P1) do{ const float rm=rowmax(P0,P1); resc=false; \
    { const float dl=__builtin_fmaxf(rm,-64.f); mhat=fadd_s(mhat,dl); \
      _Pragma("unroll") for(int r=0;r<16;++r){P0[r]=fsub_s(P0[r],dl);P1[r]=fsub_s(P1[r],dl);} \
      _Pragma("unroll") for(int r=0;r<16;++r)negm[r]=-mhat; asm volatile("":"+v"(negm)); } \
    _Pragma("unroll") for(int r=0;r<16;++r)P0[r]=__builtin_amdgcn_exp2f(P0[r]); }while(0)
  #define RESC() do{ if(resc){ asm volatile("s_waitcnt lgkmcnt(0)":::"memory"); \
      _Pragma("unroll") for(int d_=0;d_<2;++d_) _Pragma("unroll") for(int r=0;r<16;++r)o[d_][r]*=wsf[crow(r,hi)]; } }while(0)
  f32x16 pA0,pA1,pB0,pB1;
  int sl_prev=0,sl_cur=0,sl_next=SLOTB;
  #define ROT() do{sl_prev=sl_cur;sl_cur=sl_next;sl_next=(sl_next==(NSLOT-1)*SLOTB)?0:sl_next+SLOTB;}while(0)
  DMA_K(2,2*SLOTB);
  WAIT_BAR(3);
  #define SETNEGM(t) do{ const bool keep_=((t)>=NT-4)||(((selmask>>((t)>>2))&1u)!=0u); const float nm_=keep_?-mhat:NEGINF; _Pragma("unroll") for(int r=0;r<16;++r)negm[r]=nm_; asm volatile("":"+v"(negm)); }while(0)
  SETNEGM(0);
  qkt(pA0,pA1,Kbase,qr,negm,r32,hi);asm volatile("s_nop 15\n\ts_nop 7":"+v"(pA0),"+v"(pA1));CMASK(pA0,pA1,0);
  START(pA0,pA1);
  _Pragma("unroll") for(int r=0;r<16;++r)pA1[r]=__builtin_amdgcn_exp2f(pA1[r]);
  WAIT_BAR(0);
  DMA_K(3,0);DMA_V(1,SLOTB);
  ROT();
  kload8(kf,kp0+sl_cur);
  WAIT_BAR(2);
  s16x4 vlo[8],vhi[8]; u32x4 pw0,pw1,pw2,pw3;
  #define PKW(P,B) cvtpk_s(P[B],P[B+1])
  #define PAF(k) __builtin_bit_cast(bf16x8,pw##k)
  #define VFR(i) (bf16x8){vlo[i][0],vlo[i][1],vlo[i][2],vlo[i][3],vhi[i][0],vhi[i][1],vhi[i][2],vhi[i][3]}
  #define PIN(x) asm volatile("":"+v"(x))
  #define MX3(a,b,c) __builtin_fmaxf(__builtin_fmaxf((a),(b)),(c))
  #define GAPA(MF,A0,A1,A2,A3,W0,W1,PW) do{ MF; sacc+=A0; sacc+=A1; sacc+=A2; sacc+=A3; PIN(sacc); W0; W1; PIN(PW); SBAR(); }while(0)
  #define EX(v) __builtin_amdgcn_exp2f(v)
  #define GAPB(MF,X,B) do{ MF; X[B]=EX(X[B]); X[B+1]=EX(X[B+1]); X[B+2]=EX(X[B+2]); X[B+3]=EX(X[B+3]); PIN(X); SBAR(); }while(0)
  #define VRD(i) do{ vlo[i]=vtr(vp_+(((i)>>2)*4096+((i)&3)*1024)); vhi[i]=vtr(vp_+(((i)>>2)*4096+((i)&3)*1024+512)); }while(0)
  #define KRD(G,j) do{ if(G){ kload2(kf,kp0+sl_next,j); SBAR(); } }while(0)
  #define STEP(C0,C1,P0,P1,t,GK,GV,GL) do{ SBAR(); SETNEGM(t); SBAR(); \
    const lds_cptr vp_=vp0+sl_prev; \
    VRD(0); SBAR(); float sacc=(P0[0]+P0[1]); \
    GAPA(C0=__builtin_amdgcn_mfma_f32_32x32x16_bf16(kf[0],qr[0],negm,0,0,0), P0[2],P0[3],P0[4],P0[5],     pw0[0]=PKW(P0,0), pw0[1]=PKW(P0,2), pw0); \
    VRD(4); SBAR(); GAPA(C1=__builtin_amdgcn_mfma_f32_32x32x16_bf16(kf[1],qr[0],negm,0,0,0), P0[6],P0[7],P0[8],P0[9],     pw0[2]=PKW(P0,4), pw0[3]=PKW(P0,6), pw0); \
    VRD(1); SBAR(); GAPA(C0=__builtin_amdgcn_mfma_f32_32x32x16_bf16(kf[2],qr[1],C0,0,0,0),   P0[10],P0[11],P0[12],P0[13], pw1[0]=PKW(P0,8), pw1[1]=PKW(P0,10), pw1); \
    VRD(5); SBAR(); GAPA(C1=__builtin_amdgcn_mfma_f32_32x32x16_bf16(kf[3],qr[1],C1,0,0,0),   P0[14],P0[15],P1[0],P1[1],   pw1[2]=PKW(P0,12),pw1[3]=PKW(P0,14), pw1); \
    VRD(2); SBAR(); GAPA(C0=__builtin_amdgcn_mfma_f32_32x32x16_bf16(kf[4],qr[2],C0,0,0,0),   P1[2],P1[3],P1[4],P1[5],     pw2[0]=PKW(P1,0), pw2[1]=PKW(P1,2), pw2); \
    VRD(6); SBAR(); GAPA(C1=__builtin_amdgcn_mfma_f32_32x32x16_bf16(kf[5],qr[2],C1,0,0,0),   P1[6],P1[7],P1[8],P1[9],     pw2[2]=PKW(P1,4), pw2[3]=PKW(P1,6), pw2); \
    VRD(3); SBAR(); GAPA(C0=__builtin_amdgcn_mfma_f32_32x32x16_bf16(kf[6],qr[3],C0,0,0,0),   P1[10],P1[11],P1[12],P1[13], pw3[0]=PKW(P1,8), pw3[1]=PKW(P1,10), pw3); \
    VRD(7); SBAR(); GAPA(C1=__builtin_amdgcn_mfma_f32_32x32x16_bf16(kf[7],qr[3],C1,0,0,0),   P1[14],P1[15],0.f,0.f,       pw3[2]=PKW(P1,12),pw3[3]=PKW(P1,14), pw3); \
    l_reg+=sacc; \
    if(GK){DMA_K((t)+3,sl_cur);} if(GV){DMA_V((t)+1,sl_next);} \
    CMASK(C0,C1,t); \
    { float a=MX3(C0[0],C0[1],C1[0]),b=MX3(C0[2],C0[3],C1[1]); a=MX3(a,C1[2],C1[3]); \
      _Pragma("unroll") for(int r=4;r<16;r+=4){a=MX3(a,C0[r],C0[r+1]);b=MX3(b,C0[r+2],C0[r+3]);a=MX3(a,C1[r],C1[r+1]);b=MX3(b,C1[r+2],C1[r+3]);} \
      float rm=__builtin_fmaxf(a,b); { auto rr=__builtin_amdgcn_permlane32_swap(__float_as_uint(rm),__float_as_uint(rm),false,false); rm=__builtin_fmaxf(__uint_as_float(rr[0]),__uint_as_float(rr[1])); } \
      resc=false; \
      if(__builtin_expect(__any(rm>(float)THRL),0)){ const float dl=__builtin_fmaxf(rm,0.f); mhat+=dl; \
        _Pragma("unroll") for(int r=0;r<16;++r){C0[r]-=dl;C1[r]-=dl;} \
        const float f=__builtin_amdgcn_exp2f(-dl); l_reg*=f; if(hi==0)wsf[r32]=f; resc=true; } } \
    SBAR(); \
    GAPB(o[0]=__builtin_amdgcn_mfma_f32_32x32x16_bf16(PAF(0),VFR(0),o[0],0,0,0), C0,0); \
    GAPB(o[1]=__builtin_amdgcn_mfma_f32_32x32x16_bf16(PAF(0),VFR(4),o[1],0,0,0), C0,4); \
    KRD(GL,0); GAPB(o[0]=__builtin_amdgcn_mfma_f32_32x32x16_bf16(PAF(1),VFR(1),o[0],0,0,0), C0,8); \
    KRD(GL,1); GAPB(o[1]=__builtin_amdgcn_mfma_f32_32x32x16_bf16(PAF(1),VFR(5),o[1],0,0,0), C0,12); \
    KRD(GL,2); GAPB(o[0]=__builtin_amdgcn_mfma_f32_32x32x16_bf16(PAF(2),VFR(2),o[0],0,0,0), C1,0); \
    KRD(GL,3); GAPB(o[1]=__builtin_amdgcn_mfma_f32_32x32x16_bf16(PAF(2),VFR(6),o[1],0,0,0), C1,4); \
    GAPB(o[0]=__builtin_amdgcn_mfma_f32_32x32x16_bf16(PAF(3),VFR(3),o[0],0,0,0), C1,8); \
    GAPB(o[1]=__builtin_amdgcn_mfma_f32_32x32x16_bf16(PAF(3),VFR(7),o[1],0,0,0), C1,12); \
    }while(0)
  int t=1;
  #undef CMASK
  #define CMASK(P0,P1,t) do{}while(0)
  for(;t+5<NT;t+=2){
    STEP(pB0,pB1,pA0,pA1,t,true,true,true);     WAIT_BAR(2); RESC(); ROT();
    STEP(pA0,pA1,pB0,pB1,t+1,true,true,true);   WAIT_BAR(2); RESC(); ROT();
  }
  #undef CMASK
  #define CMASK(P0,P1,t) do{int jb_=(t)-(NT-4); if(jb_>=0)cmask(P0,P1,jb_,qrel,hi);}while(0)
  #define ENDW(tt) do{ if((tt)+3<NT){WAIT_BAR(2);} else if((tt)+2<NT){WAIT_BAR(1);} else {WAIT_BAR(0);} }while(0)
  for(;t+1<NT;t+=2){
    STEP(pB0,pB1,pA0,pA1,t,(t+3<NT),(t+1<NT),(t+1<NT));       ENDW(t);   RESC(); ROT();
    STEP(pA0,pA1,pB0,pB1,t+1,(t+4<NT),(t+2<NT),(t+2<NT));     ENDW(t+1); RESC(); ROT();
  }
  STEP(pB0,pB1,pA0,pA1,NT-1,false,false,false); RESC();
  { float sacc=pB0[0]+pB0[1]; _Pragma("unroll") for(int r=2;r<16;++r)sacc+=pB0[r]; _Pragma("unroll") for(int r=0;r<16;++r)sacc+=pB1[r]; l_reg+=sacc;
    pw0=(u32x4){PKW(pB0,0),PKW(pB0,2),PKW(pB0,4),PKW(pB0,6)};pw1=(u32x4){PKW(pB0,8),PKW(pB0,10),PKW(pB0,12),PKW(pB0,14)};pw2=(u32x4){PKW(pB1,0),PKW(pB1,2),PKW(pB1,4),PKW(pB1,6)};pw3=(u32x4){PKW(pB1,8),PKW(pB1,10),PKW(pB1,12),PKW(pB1,14)};
    SBAR(); pv(o,vb0+sl_cur,PAF(0),PAF(1),PAF(2),PAF(3)); }
  #undef PKW
  #undef PAF
  #undef VFR
  #undef PIN
  #undef MX3
  #undef GAPA
  #undef GAPB
  #undef EX
  #undef VRD
  #undef KRD
  #undef STEP
  #undef ENDW
  {auto rr=__builtin_amdgcn_permlane32_swap(__float_as_uint(l_reg),__float_as_uint(l_reg),false,false);l_reg=__uint_as_float(rr[0])+__uint_as_float(rr[1]);}
  if(hi==0)wsf[32+r32]=l_reg;asm volatile("s_waitcnt lgkmcnt(0)":::"memory");
  float rli[16];
  #pragma unroll
  for(int r=0;r<16;++r)rli[r]=__builtin_amdgcn_rcpf(wsf[32+crow(r,hi)]);
  bf16*Ow=O+(rowbase+q0+wid*QBLK)*DM+h*D;
  { bf16*stg=(bf16*)(shm+LDS_OST)+wid*2048;
    #pragma unroll
    for(int r=0;r<16;++r){const int orow=crow(r,hi);
      #pragma unroll
      for(int d0=0;d0<2;++d0)stg[orow*64+d0*32+r32]=__float2bfloat16(o[d0][r]*rli[r]);}
    asm volatile("s_waitcnt lgkmcnt(0)":::"memory");
    #pragma unroll
    for(int i=0;i<4;++i){const int row=i*8+(lane>>3),ch=lane&7; const u32x4 v=*(const u32x4*)(stg+row*64+ch*8); ATTN_STORE16(Ow+(long)row*DM+ch*8,v);} }
  asm volatile("s_waitcnt lgkmcnt(0)\n\ts_barrier":::"memory");
  #undef DMA_K
  #undef DMA_V
  #undef CMASK
  #undef START
  #undef SETNEGM
  #undef RESC
  #undef ROT
}
constexpr int ATTN_LDS_BYTES=LDS_BYTES;
struct AttnTensors { const bf16* Q; const bf16* K; const bf16* V; bf16* O; const unsigned* sel; };
struct AttnUnit { int bh; int qb; };
struct StaticOrder {
  int vcu,grid;
  __device__ __forceinline__ explicit StaticOrder(int grid_,int block):vcu((grid_%8==0)?(block%8)*(grid_/8)+block/8:block),grid(grid_){}
  __device__ __forceinline__ bool next(int i,AttnUnit&u)const{
    if(grid==256){ if(i>=4)return false; const int s=vcu&3; u.bh=vcu>>2; u.qb=(i==0)?s:(i==1)?7-s:(i==2)?8+s:15-s; return true; }
    const int U=i*grid+vcu; if(U>=BATCH*NHEAD*NQB)return false; u.bh=U/NQB; u.qb=U%NQB; return true; }
  __device__ __forceinline__ void a_ready(const AttnUnit&)const{}
  __device__ __forceinline__ void done(const AttnUnit&)const{}
};
template<class Sched,int THRL=8> __device__ __forceinline__ void attn_phase(char*lds,const AttnTensors&T,const Sched&S,int tid_in){
  AttnUnit u;
  for(int i=0;S.next(i,u);++i){ S.a_ready(u); attn_unit<THRL>(u.bh/NHEAD,u.bh%NHEAD,u.qb,T.Q,T.K,T.V,T.O,T.sel,lds,tid_in); S.done(u); }
}
#undef SBAR
#undef WAIT_BAR
}


DEVI void ph_moba_select(const Frame& F, const bf16_t* Q, const float* ksum, unsigned* sel) {
    for (int idx = F.gt; idx < BATCH * NH * SEQ; idx += F.NGT) {
        const int s = idx & (SEQ - 1), bh = idx >> 12, b = bh >> 3, hh = bh & 7, qb = s >> 8;
        const bf16_t* qp = Q + ((size_t)b * SEQ + s) * 512 + hh * 64;
        float q[64];
#pragma unroll
        for (int i = 0; i < 8; ++i) { const bf16x8 t = *((const bf16x8*)qp + i);
#pragma unroll
            for (int j = 0; j < 8; ++j) q[8 * i + j] = bf2f((bf16_t)t[j]); }
        float gsc[15];
#pragma unroll
        for (int j = 0; j < 15; ++j) { gsc[j] = -INFINITY;
            if (j < qb) { const float* km = ksum + ((size_t)bh * 16 + j) * 64; float a = 0.f;
#pragma unroll
                for (int i = 0; i < 64; ++i) a += q[i] * km[i];
                gsc[j] = a; } }
        unsigned m = 0u;
#pragma unroll
        for (int t = 0; t < 3; ++t) { float best = -INFINITY; int bi = -1;
#pragma unroll
            for (int j = 0; j < 15; ++j) { const bool ok = (j < qb) && !((m >> j) & 1u) && (gsc[j] > best); best = ok ? gsc[j] : best; bi = ok ? j : bi; }
            if (bi >= 0) m |= 1u << bi; }
        sel[idx] = m;
    }
}


DEVI void ph_router_weights(const Frame& F, const float* wg, const float* we, bf16_t* wr) {
    for (int idx = F.gt; idx < DEPTH * 48 * 1024; idx += F.NGT) {
        const int l = idx / (48 * 1024), r = idx % (48 * 1024), o = r >> 10, kk = r & 1023;
        const float v = (o < 4) ? wg[((size_t)l * D + kk) * 4 + o] : (o < 36) ? we[((size_t)l * D + kk) * 32 + (o - 4)] : 0.f;
        const bf16_t hi = f2bf(v), lo = f2bf(v - bf2f(hi));
        wr[((size_t)l * 2 + 0) * 48 * 1024 + r] = hi; wr[((size_t)l * 2 + 1) * 48 * 1024 + r] = lo;
    }
}
DEVI void ph_norm_router_mfma(const Frame& F, const bf16_t* x, const float* g, const bf16_t* wr, const float* bg, const float* be, bf16_t* h2, unsigned* cnt, int* list, unsigned* rec) {
    const int lane = F.lane, ri = lane & 15, q = lane >> 4;
    LAS float* lg = (LAS float*)(F.lds + F.wave * 3072);
    volatile LAS unsigned* hist = (volatile LAS unsigned*)(F.lds + 8 * 3072);
    const bf16_t* whi = wr; const bf16_t* wlo = wr + 48 * 1024;
    for (int tile = blockIdx.x; tile < NTOK / 128; tile += F.G) {
        if (F.tid < 64) hist[F.tid] = 0u;
        const int row = tile * 128 + F.wave * 16 + ri;
        const bf16_t* xr = x + (size_t)row * D + 8 * q;
        float ss = 0.f;
#pragma unroll 8
        for (int kk = 0; kk < 32; ++kk) { const u32x4 xw = *(const u32x4*)(xr + 32 * kk); const f32x4 a = pg8::unpk_lo(xw, 0), b = pg8::unpk_lo(xw, 1);
            ss += (a[0] * a[0] + a[1] * a[1]) + (a[2] * a[2] + a[3] * a[3]) + (b[0] * b[0] + b[1] * b[1]) + (b[2] * b[2] + b[3] * b[3]); }
        ss += xshfl(ss, 16, lane); ss += xshfl(ss, 32, lane);
        const float rstd = 1.0f / sqrtf(ss * (1.0f / D) + NORM_EPS);
        f32x4 acc[3] = {(f32x4){0.f, 0.f, 0.f, 0.f}, (f32x4){0.f, 0.f, 0.f, 0.f}, (f32x4){0.f, 0.f, 0.f, 0.f}};
#pragma unroll 4
        for (int kk = 0; kk < 32; ++kk) {
            const int k0 = 32 * kk + 8 * q;
            const u32x4 xw = *(const u32x4*)(xr + 32 * kk); const f32x4 a = pg8::unpk_lo(xw, 0), b = pg8::unpk_lo(xw, 1);
            const f32x4 ga = *(const f32x4*)(g + k0), gb = *(const f32x4*)(g + k0 + 4);
            const f32x4 ha = a * rstd * ga, hb = b * rstd * gb;
            const u32x4 hi = pg8::pk8(ha, hb);
            const f32x4 ra = ha - pg8::unpk_lo(hi, 0), rb = hb - pg8::unpk_lo(hi, 1);
            const u32x4 lo = pg8::pk8(ra, rb);
            *(u32x4*)(h2 + (size_t)row * D + k0) = hi;
            const bf16x8 ahi = __builtin_bit_cast(bf16x8, hi), alo = __builtin_bit_cast(bf16x8, lo);
#pragma unroll
            for (int t = 0; t < 3; ++t) {
                const bf16x8 bh = *(const bf16x8*)(whi + (size_t)(16 * t + ri) * 1024 + k0), bl = *(const bf16x8*)(wlo + (size_t)(16 * t + ri) * 1024 + k0);
                acc[t] = __builtin_amdgcn_mfma_f32_16x16x32_bf16(ahi, bh, acc[t], 0, 0, 0);
                acc[t] = __builtin_amdgcn_mfma_f32_16x16x32_bf16(alo, bh, acc[t], 0, 0, 0);
                acc[t] = __builtin_amdgcn_mfma_f32_16x16x32_bf16(ahi, bl, acc[t], 0, 0, 0);
            }
        }
#pragma unroll
        for (int t = 0; t < 3; ++t)
#pragma unroll
            for (int e = 0; e < 4; ++e) lg[(4 * q + e) * 48 + 16 * t + ri] = acc[t][e];
        __syncthreads();
        int e0 = 0, e1 = 0; float w0 = 0.f, w1 = 0.f; unsigned r0 = 0u, r1 = 0u;
        if (lane < 16) {
            const LAS float* L = lg + lane * 48;
            float gl[4]; int gt = 0; float gm = -INFINITY;
#pragma unroll
            for (int i = 0; i < 4; ++i) { gl[i] = L[i] + bg[i]; if (gl[i] > gm) { gm = gl[i]; gt = i; } }
            float gs = 0.f;
#pragma unroll
            for (int i = 0; i < 4; ++i) gs += __expf(gl[i] - gm);
            const float pgv = 1.0f / gs;
            float el[8]; float em = -INFINITY;
#pragma unroll
            for (int i = 0; i < 8; ++i) { el[i] = L[4 + gt * 8 + i] + be[gt * 8 + i]; em = fmaxf(em, el[i]); }
            int i1 = 0; float v1 = -INFINITY;
#pragma unroll
            for (int i = 0; i < 8; ++i) if (el[i] > v1) { v1 = el[i]; i1 = i; }
            int i2 = 0; float v2 = -INFINITY;
#pragma unroll
            for (int i = 0; i < 8; ++i) if (i != i1 && el[i] > v2) { v2 = el[i]; i2 = i; }
            const float p1 = __expf(v1 - em), p2 = __expf(v2 - em);
            w0 = pgv * p1 / (p1 + p2); w1 = pgv * p2 / (p1 + p2);
            e0 = gt * 8 + i1; e1 = gt * 8 + i2;
            r0 = __hip_atomic_fetch_add((LAS unsigned*)hist + e0, 1u, __ATOMIC_RELAXED, __HIP_MEMORY_SCOPE_WORKGROUP); r1 = __hip_atomic_fetch_add((LAS unsigned*)hist + e1, 1u, __ATOMIC_RELAXED, __HIP_MEMORY_SCOPE_WORKGROUP);
        }
        __syncthreads();
        if (F.tid < 32) { const unsigned n = hist[F.tid]; hist[32 + F.tid] = n ? atomicAdd(cnt + F.tid, n) : 0u; }
        __syncthreads();
        if (lane < 16) {
            const int tok = tile * 128 + F.wave * 16 + lane;
            const unsigned pos0 = hist[32 + e0] + r0, pos1 = hist[32 + e1] + r1;
            list[(size_t)e0 * LIST_CAP + pos0] = tok; list[(size_t)e1 * LIST_CAP + pos1] = tok;
            unsigned* rp = rec + (size_t)tok * 8;
            rp[0] = (unsigned)e0; rp[1] = (unsigned)e1; rp[2] = pos0; rp[3] = pos1; rp[4] = __float_as_uint(w0); rp[5] = __float_as_uint(w1);
        }
        __syncthreads();
    }
}


DEVI void ph_moba_select_mfma(const Frame& F, const bf16_t* Q, const float* ksum, unsigned* sel) {
    const int lane = F.lane, r = lane & 31, h = lane >> 5;
    for (int item = F.gw; item < BATCH * NH * (SEQ / 32); item += F.NGW) {
        const int qt = item & 127, bh = item >> 7, b = bh >> 3, hh = bh & 7, s0 = qt * 32, qb = s0 >> 8;
        if (qb == 0) { if (h == 0) sel[(size_t)bh * SEQ + s0 + r] = 0u; continue; }
        f32x16 acc = {};
#pragma unroll
        for (int s = 0; s < 4; ++s) {
            const bf16x8 bq = *(const bf16x8*)(Q + ((size_t)b * SEQ + s0 + r) * 512 + hh * 64 + 16 * s + 8 * h);
            f32x4 k0 = (f32x4){0.f, 0.f, 0.f, 0.f}, k1 = k0;
            if (r < 16) { const float* kp = ksum + ((size_t)bh * 16 + r) * 64 + 16 * s + 8 * h; k0 = *(const f32x4*)kp; k1 = *(const f32x4*)(kp + 4); }
            const u32x4 hi = pg8::pk8(k0, k1), lo = pg8::pk8(k0 - pg8::unpk_lo(hi, 0), k1 - pg8::unpk_lo(hi, 1));
            acc = __builtin_amdgcn_mfma_f32_32x32x16_bf16(__builtin_bit_cast(bf16x8, hi), bq, acc, 0, 0, 0);
            acc = __builtin_amdgcn_mfma_f32_32x32x16_bf16(__builtin_bit_cast(bf16x8, lo), bq, acc, 0, 0, 0);
        }
        float sc[16];
#pragma unroll
        for (int reg = 0; reg < 8; ++reg) { const float mine = acc[reg], other = xshfl(acc[reg], 32, lane); const int base = (reg & 3) + 8 * (reg >> 2);
            sc[base] = h ? other : mine; sc[base + 4] = h ? mine : other; }
        unsigned m = 0u;
#pragma unroll
        for (int t = 0; t < 3; ++t) { float best = -INFINITY; int bi = -1;
#pragma unroll
            for (int j = 0; j < 15; ++j) { const bool ok = (j < qb) && !((m >> j) & 1u) && (sc[j] > best); best = ok ? sc[j] : best; bi = ok ? j : bi; }
            if (bi >= 0) m |= 1u << bi; }
        if (h == 0) sel[(size_t)bh * SEQ + s0 + r] = m;
    }
}

constexpr int PH_PER_LAYER = 10, N_PHASES = 1 + DEPTH * PH_PER_LAYER;
__global__ void __launch_bounds__(NTHR, 2) mk_fwd(Args a) {
    extern __shared__ __attribute__((aligned(16))) unsigned char lds_raw[];
    Frame F0;
    F0.lds = (LAS unsigned char*)lds_raw;
    F0.tid = threadIdx.x; F0.lane = F0.tid & 63; F0.wave = __builtin_amdgcn_readfirstlane(F0.tid >> 6);
    F0.G = gridDim.x; F0.gw = blockIdx.x * NWAVES + F0.wave; F0.NGW = F0.G * NWAVES; F0.gt = blockIdx.x * NTHR + F0.tid; F0.NGT = F0.G * NTHR;
    volatile LAS unsigned* LCTL = (volatile LAS unsigned*)(F0.lds + LDSCTL_OFF);
    volatile LAS int* pstart = (volatile LAS int*)(F0.lds + LDSCTL_OFF + 256);
    for (int u = F0.tid; u < 256; u += NTHR) LCTL[u] = 0u;
    __syncthreads();
    unsigned* ctl = (unsigned*)(a.ws + WS_CTL);
    XcdBarrier bar = xcd_barrier_post(ctl + CW_BAR + a.li * XCD_BAR_WORDS, LCTL);

#define x_in (a.in[0])
#define norm1_g (a.in[1])
#define w_in (a.in[2])
#define ssm_d (a.in[10])
#define w_glu (a.in[11])
#define qng (a.in[12])
#define kng (a.in[13])
#define w_attn (a.in[14])
#define w_out (a.in[15])
#define norm2_g (a.in[16])
#define wgrp (a.in[17])
#define bgrp (a.in[18])
#define wexp (a.in[19])
#define bexp (a.in[20])
#define w_gu (a.in[21])
#define w_dn (a.in[22])
#define X (a.out)
#define rope ((float*)(ws + WS_ROPE))
#define AL ((float*)(ws + WS_MISC + MISC_AL))
#define ksum ((float*)(ws + WS_MISC + MISC_KSUM))
#define SEL ((unsigned*)(ws + WS_MISC + MISC_SEL))
#define rec ((unsigned*)(ws + WS_REC))
#define list ((int*)(ws + WS_LIST))
#define TC ((bf16_t*)(ws + WS_S5TC))
#define BS ((bf16_t*)(ws + WS_S5BS))
#define H ((bf16_t*)(ws + WS_H))
#define UCAT ((bf16_t*)(ws + WS_UCAT))
#define Qb ((bf16_t*)(ws + WS_Q))
#define Kb ((bf16_t*)(ws + WS_K))
#define Vb ((bf16_t*)(ws + WS_V))
#define SG ((bf16_t*)(ws + WS_SG))
#define Z ((bf16_t*)(ws + WS_Z))
#define ATT ((bf16_t*)(ws + WS_ATT))
#define MIXA ((bf16_t*)(ws + WS_MIXA))
#define MIXED ((bf16_t*)(ws + WS_MIXED))
#define SL ((float*)(ws + WS_SL))
#define HMID ((bf16_t*)(ws + WS_HMID))
#define YBUF ((bf16_t*)(ws + WS_YBUF))
#define QRAW ((float*)(ws + WS_QRAW))
#define KRAW ((float*)(ws + WS_KRAW))
#define WIN ((bf16_t*)(ws + WS_WIN))
#define WGLU ((bf16_t*)(ws + WS_WGLU))
#define WATT ((bf16_t*)(ws + WS_WATT))
#define WOUT ((bf16_t*)(ws + WS_WOUT))
#define WGU ((bf16_t*)(ws + WS_WGU))
#define WDN ((bf16_t*)(ws + WS_WDN))
#define WR ((bf16_t*)(ws + WS_MISC + MISC_WR))
#define XB ((bf16_t*)(ws + WS_XB))
    const int lo = a.ph_lo, hi = a.ph_hi;
    int ph = 0; unsigned bgen = 0u;
#define PH_BEGIN if (ph >= lo && ph < hi) { for (int rep_ = 0; rep_ < ((((unsigned long long)REP_MASK >> ph) & 1ull) ? 2 : 1); ++rep_) { if (rep_) __syncthreads(); Frame P = F0; unsigned long long wz_ = 0ull; asm volatile("" : "+s"(wz_)); unsigned char* ws = a.ws + wz_;     { int t_ = F0.wave * 64 + (int)__builtin_amdgcn_mbcnt_hi(~0u, __builtin_amdgcn_mbcnt_lo(~0u, 0u)); asm volatile("" : "+v"(t_));     P.tid = t_; P.lane = t_ & 63; P.gt = (int)blockIdx.x * NTHR + t_; P.wave = __builtin_amdgcn_readfirstlane(t_ >> 6); P.gw = (int)blockIdx.x * NWAVES + P.wave; }
#define PH_END   } if (ph + 1 < hi) { ++bgen; xcd_barrier_w(bar, bgen, LCTL + 4, make_cvtq(a, F0.lds, F0.wave, fresh_lane())); } } ++ph;

    const int vcu = (F0.G % 8 == 0) ? ((int)blockIdx.x % 8) * (F0.G / 8) + (int)blockIdx.x / 8 : (int)blockIdx.x;
    LAS unsigned char* ring = F0.lds;
    volatile LAS int* tstart = (volatile LAS int*)(F0.lds + LDSCTL_OFF + 512);
    LAS unsigned* gtab = (LAS unsigned*)(F0.lds + GTAB_OFF);

    PH_BEGIN
        ph_rope_table(P, rope);
        for (int it4 = blockIdx.x; it4 < DEPTH * SSM_G * 4; it4 += P.G) { const int it = it4 >> 2;
            s5_tables_item(it / SSM_G, it % SSM_G, a.in[3], a.in[4], a.in[5], a.in[6], a.in[7], a.in[8], a.in[9],
                           TC + (size_t)it * 512 * 640, BS + (size_t)it * 128 * 512, AL + (size_t)it * 128, (LAS float*)P.lds, P.tid, NTHR, it4 & 3); }
        ph_rmsnorm(P, x_in, norm1_g, H);
        ph_convert_first(P, make_cvtq(a, F0.lds, P.wave, P.lane));
        ph_router_weights(P, wgrp, wexp, WR);
    PH_END

    for (int l = 0; l < DEPTH; ++l) {
#define xin ((l == 0) ? x_in : (const float*)X)
#define cnt ((unsigned*)(ws + WS_CTL) + CW_CNT + l * NEXP)
        PH_BEGIN
            pg8::Gemm g{H, WIN + (size_t)l * D_IN * D, D, D, D, 0, 0}; pg8::StaticOrder S; S.init(NTOK, D_IN, P.G, (int)blockIdx.x);
            pg8::EpiG1 E{UCAT, Qb, Kb, Vb, SG, qng + l * 64, kng + l * 64, rope, QRAW, KRAW};
            pg8::gemm_phase<pg8::EpiG1, pg8::StaticOrder, pg8::NoGather, G1_ALIGN>(ring, g, S, E, pg8::NoGather{}, P.tid);
        PH_END
        PH_BEGIN
            if (P.G == 256) { if (blockIdx.x >= 128) { Frame Q2 = P; Q2.gw = P.gw - 128 * NWAVES; Q2.NGW = 128 * NWAVES; ph_ksum(Q2, Kb, ksum); } } else ph_ksum(P, Kb, ksum);
            { pg8::Gemm g{UCAT, BS + (size_t)l * SSM_G * 128 * 512, UK, 512, 512, (size_t)UROWS * UK, (size_t)128 * 512}; pg8::OrderS5A S{P.G, (int)blockIdx.x};
              pg8::EpiS5Am E{AL + (size_t)l * SSM_G * 128, UCAT};
              pg8::gemm_phase<pg8::EpiS5Am, pg8::OrderS5A, pg8::NoGather, false>(ring, g, S, E, pg8::NoGather{}, P.tid); }
        PH_END
        PH_BEGIN
            ph_moba_select_mfma(P, Qb, ksum, SEL);
            { pg8::Gemm g{UCAT, TC + (size_t)l * SSM_G * 512 * 640, UK, UK, UK, (size_t)UROWS * UK, (size_t)512 * 640}; pg8::OrderS5C S{P.G, (int)blockIdx.x};
              pg8::EpiS5Cm E{UCAT, ssm_d + l * SSM_W, Z};
              pg8::gemm_phase<pg8::EpiS5Cm, pg8::OrderS5C, pg8::NoGather, false>(ring, g, S, E, pg8::NoGather{}, P.tid); }
        PH_END
        PH_BEGIN
            { const attn_body::AttnTensors AT{(const attn_body::bf16*)Qb, (const attn_body::bf16*)Kb, (const attn_body::bf16*)Vb, (attn_body::bf16*)ATT, SEL};
              const attn_body::StaticOrder SA((int)P.G, (int)blockIdx.x);
              attn_body::attn_phase<attn_body::StaticOrder>((char*)lds_raw, AT, SA, P.tid); }
            { pg8::Gemm g{Z, WGLU + (size_t)l * 2048 * 512, 512, 512, 512, 0, 0}; pg8::StaticOrder S; S.init(NTOK, 2048, P.G, (int)blockIdx.x);
              pg8::EpiGlu E{SG, MIXA};
              pg8::gemm_phase<pg8::EpiGlu, pg8::StaticOrder, pg8::NoGather, true>(ring, g, S, E, pg8::NoGather{}, P.tid); }
        PH_END
        PH_BEGIN
            pg8::Gemm g{ATT, WATT + (size_t)l * 1024 * 512, 512, 512, 512, 0, 0}; pg8::StaticOrder S; S.init(NTOK, 1024, P.G, (int)blockIdx.x);
            pg8::EpiMix E{SG, MIXA, MIXED};
            pg8::gemm_phase<pg8::EpiMix, pg8::StaticOrder, pg8::NoGather, true>(ring, g, S, E, pg8::NoGather{}, P.tid);
        PH_END
        PH_BEGIN
            pg8::Gemm g{MIXED, WOUT + (size_t)l * 1024 * 1024, 1024, 1024, 1024, 0, 0}; pg8::StaticOrder S; S.init(NTOK, 1024, P.G, (int)blockIdx.x);
            if (l == 0) { pg8::EpiResBf16<true> E{x_in, XB}; pg8::gemm_phase<pg8::EpiResBf16<true>, pg8::StaticOrder, pg8::NoGather, true>(ring, g, S, E, pg8::NoGather{}, P.tid); }
            else { pg8::EpiResBf16<false> E{nullptr, XB}; pg8::gemm_phase<pg8::EpiResBf16<false>, pg8::StaticOrder, pg8::NoGather, true>(ring, g, S, E, pg8::NoGather{}, P.tid); }
        PH_END
        PH_BEGIN make_cvtq(a, F0.lds, P.wave, P.lane).catchup(l == 0 ? CVQ_LIM_MOE0 : CVQ_TOTAL); __syncthreads(); ph_norm_router_mfma(P, XB, norm2_g + l * D, WR + (size_t)l * 2 * 48 * 1024, bgrp + l * 4, bexp + l * 32, H, cnt, list, rec); PH_END
        PH_BEGIN
            moe_tstart(P, cnt, tstart); moe_gather_table(P, vcu, cnt, list, tstart, gtab);
            pg8::Gemm g{H, WGU + (size_t)l * NEXP * 1024 * 1024, D, 1024, 1024, 0, (size_t)1024 * 1024}; pg8::OrderMoE S{P.G, vcu, tstart};
            pg8::EpiSwiglu E{HMID};
            pg8::gemm_phase<pg8::EpiSwiglu, pg8::OrderMoE, pg8::LdsGather, true>(ring, g, S, E, pg8::LdsGather{gtab}, P.tid);
        PH_END
        PH_BEGIN
            moe_tstart(P, cnt, tstart);
            pg8::Gemm g{HMID, WDN + (size_t)l * NEXP * 1024 * 512, 512, 512, 512, 0, (size_t)1024 * 512}; pg8::OrderMoE S{P.G, vcu, tstart};
            pg8::EpiStoreBf16 E{YBUF, 1024};
            pg8::gemm_phase<pg8::EpiStoreBf16, pg8::OrderMoE, pg8::NoGather, true>(ring, g, S, E, pg8::NoGather{}, P.tid);
        PH_END
        PH_BEGIN
            if (l + 1 < DEPTH) { make_cvtq(a, F0.lds, P.wave, P.lane).catchup(CVQ_LIM_PROJ1); __syncthreads(); }
            compute_pstart(P, cnt, pstart);
            if (l + 1 < DEPTH) ph_combine<false>(P, XB, X, YBUF, rec, pstart, norm1_g + (l + 1) * D, H);
            else ph_combine<true>(P, XB, X, YBUF, rec, pstart, nullptr, H);
        PH_END
    }
#undef PH_BEGIN
#undef PH_END
#undef x_in
#undef norm1_g
#undef w_in
#undef ssm_d
#undef w_glu
#undef qng
#undef kng
#undef w_attn
#undef w_out
#undef norm2_g
#undef wgrp
#undef bgrp
#undef wexp
#undef bexp
#undef w_gu
#undef w_dn
#undef X
#undef rope
#undef AL
#undef ksum
#undef SEL
#undef rec
#undef list
#undef TC
#undef BS
#undef H
#undef UCAT
#undef Qb
#undef Kb
#undef Vb
#undef SG
#undef Z
#undef ATT
#undef MIXA
#undef MIXED
#undef SL
#undef HMID
#undef YBUF
#undef QRAW
#undef KRAW
#undef WIN
#undef WGLU
#undef WATT
#undef WOUT
#undef WGU
#undef WDN
#undef WR
#undef XB
#undef xin
#undef cnt
}

extern "C" void kernel_launch(void* const* d_in, const int* in_sizes, int n_in, void* d_out, int out_size, void* d_ws, size_t ws_size, hipStream_t stream) {
    static int grid = 0;
    if (grid == 0) {
        if (n_in != 23 || ws_size < WS_END || out_size != NTOK * D) { fprintf(stderr, "kernel_launch: unexpected n_in %d / ws_size %zu / out_size %d; nothing launched\n", n_in, ws_size, out_size); grid = -1; return; }
        int dev = 0, cus = 0, per_cu = 0;
        if (hipGetDevice(&dev) != hipSuccess || hipDeviceGetAttribute(&cus, hipDeviceAttributeMultiprocessorCount, dev) != hipSuccess) { grid = -1; return; }
        if (hipFuncSetAttribute((const void*)mk_fwd, hipFuncAttributeMaxDynamicSharedMemorySize, LDS_BYTES) != hipSuccess) { fprintf(stderr, "kernel_launch: hipFuncSetAttribute failed\n"); grid = -1; return; }
        if (hipOccupancyMaxActiveBlocksPerMultiprocessor(&per_cu, (const void*)mk_fwd, NTHR, LDS_BYTES) != hipSuccess || per_cu < 1) { fprintf(stderr, "kernel_launch: occupancy query says %d\n", per_cu); }
        (void)hipGetLastError();
        grid = cus;
    }
    if (grid < 0) return;
    if (hipMemsetAsync((char*)d_ws + WS_CTL, 0, CTL_BYTES, stream) != hipSuccess) return;
    Args a{};
    for (int i = 0; i < 23; ++i) a.in[i] = (const float*)d_in[i];
    a.out = (float*)d_out; a.ws = (unsigned char*)d_ws;
#if MK_PER_PHASE
    for (int p = 0; p < N_PHASES; ++p) { a.ph_lo = p; a.ph_hi = p + 1; a.li = p; hipLaunchKernelGGL(mk_fwd, dim3(grid), dim3(NTHR), LDS_BYTES, stream, a); }
#else
    a.ph_lo = 0; a.ph_hi = N_PHASES; a.li = 0;
    hipLaunchKernelGGL(mk_fwd, dim3(grid), dim3(NTHR), LDS_BYTES, stream, a);
#endif
}
```

```cpp
#include <hip/hip_runtime.h>
#include <hip/hip_bf16.h>
#include <cstdint>
#include <cstdio>
#include <cmath>

#define DEVI __device__ __forceinline__
#define GAS __attribute__((address_space(1)))
#define LAS __attribute__((address_space(3)))
typedef unsigned short bf16_t;
typedef short bf16x8 __attribute__((ext_vector_type(8)));
typedef float f32x4 __attribute__((ext_vector_type(4)));
typedef float f32x16 __attribute__((ext_vector_type(16)));
typedef unsigned u32x4 __attribute__((ext_vector_type(4)));
typedef unsigned u32x2 __attribute__((ext_vector_type(2)));
typedef float cf32 __attribute__((ext_vector_type(2)));

#ifndef OPT_G1
#define OPT_G1 1
#endif
#ifndef G1_RAWQK
#define G1_RAWQK 0
#endif
#ifndef OPT_S5
#define OPT_S5 1
#endif
#ifndef OPT_G3
#define OPT_G3 1
#endif
#ifndef OPT_G4
#define OPT_G4 1
#endif
#ifndef OPT_G5
#define OPT_G5 1
#endif
#ifndef OPT_ATT
#define OPT_ATT 1
#endif
#ifndef REP_MASK
#define REP_MASK 0ull
#endif
#ifndef BAR_TWICE
#define BAR_TWICE 0
#endif
#ifndef G1_ALIGN
#define G1_ALIGN true
#endif
#ifndef OPT_RT
#define OPT_RT 1
#endif
#ifndef OPT_M1
#define OPT_M1 1
#endif
#ifndef OPT_M2
#define OPT_M2 1
#endif
#ifndef MK_PER_PHASE
#define MK_PER_PHASE 0
#endif

constexpr int D = 1024, BATCH = 8, SEQ = 4096, NTOK = BATCH * SEQ, DEPTH = 2;
constexpr int SSM_G = 32, SSM_C = 16, SSM_W = 512, SSM_P = 64;
constexpr int NH = 8, HD = 64, AW = 512, MOBA_B = 256, NBLK = SEQ / MOBA_B;
constexpr int D_IN = 4096;
constexpr int NEXP = 32, DEXP = 512;
constexpr int CHL = 32, NCH = SEQ / CHL, UK = 640, UROWS = BATCH * NCH;
constexpr int SLOT_CAP = 2 * NTOK + NEXP * 256;
constexpr int LIST_CAP = NTOK;
constexpr float NORM_EPS = 1e-6f;
constexpr float QSCALE = 0.125f * 1.4426950408889634f;
constexpr int NWAVES = 8, NTHR = 512;

constexpr size_t MiB = 1u << 20;
constexpr size_t WS_CTL = 0, CTL_BYTES = 1 * MiB;
constexpr size_t WS_ROPE = 1 * MiB;
constexpr size_t WS_MISC = 2 * MiB;
constexpr size_t WS_REC = 4 * MiB;
constexpr size_t WS_LIST = 5 * MiB;
constexpr size_t WS_S5TC = 16 * MiB;
constexpr size_t WS_S5BS = 56 * MiB;
constexpr size_t WS_WIN = 66 * MiB, WS_WGLU = 82 * MiB, WS_WATT = 86 * MiB, WS_WOUT = 88 * MiB, WS_WGU = 92 * MiB, WS_WDN = 220 * MiB;
constexpr size_t WS_H = 284 * MiB;
constexpr size_t WS_UCAT = 348 * MiB;
constexpr size_t WS_Q = 388 * MiB, WS_K = 420 * MiB, WS_V = 452 * MiB;
constexpr size_t WS_SG = 484 * MiB;
constexpr size_t WS_Z = 612 * MiB;
constexpr size_t WS_ATT = 644 * MiB;
constexpr size_t WS_MIXA = 676 * MiB, WS_MIXED = 740 * MiB;
constexpr size_t WS_SL = 804 * MiB;
constexpr size_t WS_XB = 820 * MiB;
constexpr size_t WS_END = 884 * MiB;
constexpr size_t WS_HMID = WS_UCAT;
constexpr size_t WS_YBUF = WS_SG;
constexpr size_t WS_QRAW = WS_MIXA, WS_KRAW = WS_MIXED;
constexpr size_t MISC_AL = 0;
constexpr size_t MISC_KSUM = 64 * 1024;
constexpr size_t MISC_SEL = 512 * 1024;
constexpr size_t MISC_WR = 1536 * 1024;
constexpr int CW_CNT = 64;
constexpr int CW_CVQ = 1024;
constexpr int CW_BAR = 4096;
constexpr int MAX_LAUNCHES = 64;

constexpr int RING_BYTES = 131072;
constexpr int LDSCTL_OFF = RING_BYTES;
constexpr int GTAB_OFF = RING_BYTES + 1024;
constexpr int LDS_BYTES = 160 * 1024;

DEVI float bf2f(bf16_t v) { return __uint_as_float((unsigned)v << 16); }
DEVI bf16_t f2bf(float f) { unsigned u = __float_as_uint(f); return (bf16_t)((u + 0x7fffu + ((u >> 16) & 1u)) >> 16); }
DEVI unsigned pk2(float lo, float hi) { return (unsigned)f2bf(lo) | ((unsigned)f2bf(hi) << 16); }
DEVI float sigmoidf_(float x) { return 1.f / (1.f + __expf(-x)); }
DEVI float gelu_tanh(float x) { const float u = 0.7978845608028654f * (x + 0.044715f * x * x * x); return 0.5f * x * (1.f + tanhf(u)); }
DEVI float xshfl(float v, int o, int lane) { return __int_as_float(__builtin_amdgcn_ds_bpermute((lane ^ o) << 2, __float_as_int(v))); }
DEVI float wave_sum(float v, int lane) {
#pragma unroll
    for (int o = 1; o < 64; o <<= 1) v += xshfl(v, o, lane);
    return v;
}
DEVI float wave_max(float v) {
#pragma unroll
    for (int o = 1; o < 64; o <<= 1) v = fmaxf(v, __shfl_xor(v, o));
    return v;
}

#define XB_TMO      128
#define XB_XCNT(j)  (256  + 64 * (j))
#define XB_XSUB(j)  (1280 + 64 * (j))
#define XB_XGEN(j)  (2304 + 64 * (j))
#define XB_TOP      3328
#define XB_TOPGEN   3392
#define XCD_BAR_WORDS 3456
#define XB_SPIN_CAP (1u << 18)
DEVI unsigned xb_ld(unsigned* p)              { return __hip_atomic_load(p, __ATOMIC_RELAXED, __HIP_MEMORY_SCOPE_AGENT); }
DEVI unsigned xb_add(unsigned* p, unsigned v) { return __hip_atomic_fetch_add(p, v, __ATOMIC_RELAXED, __HIP_MEMORY_SCOPE_AGENT); }
DEVI unsigned xb_xcc_id() { return (unsigned)__builtin_amdgcn_s_getreg((3 << 11) | 20) & 0xFu; }
#define XB_SPIN(cond, bar) do { unsigned _sp = 0; while (cond) { __builtin_amdgcn_s_sleep(1); \
    if ((++_sp & 255u) == 0u) { if (xb_ld(&(bar)[XB_TMO])) break; if (_sp > XB_SPIN_CAP) { atomicAdd(&(bar)[XB_TMO], 1u); break; } } } } while (0)
struct XcdBarrier { unsigned* bar; unsigned x; volatile LAS unsigned* st; };
DEVI XcdBarrier xcd_barrier_post(unsigned* bar, volatile LAS unsigned* st) {
    XcdBarrier b; b.bar = bar; b.x = xb_xcc_id(); b.st = st;
    if (threadIdx.x == 0) (void)xb_add(&bar[XB_XCNT(b.x)], 1u);
    return b;
}
DEVI void xcd_barrier_complete(unsigned* bar, unsigned x, unsigned& nloc, unsigned& nx) {
    const unsigned G = gridDim.x * gridDim.y * gridDim.z;
    unsigned sum, cnt, mine, sp = 0u;
    for (;;) {
        sum = 0u; cnt = 0u; mine = 0u;
#pragma unroll
        for (unsigned j = 0; j < 16; ++j) { const unsigned c = xb_ld(&bar[XB_XCNT(j)]); sum += c; cnt += (c > 0u) ? 1u : 0u; mine = (j == x) ? c : mine; }
        if (sum == G) break;
        __builtin_amdgcn_s_sleep(1);
        if ((++sp & 255u) == 0u) { if (xb_ld(&bar[XB_TMO])) break; if (sp > XB_SPIN_CAP) { atomicAdd(&bar[XB_TMO], 1u); break; } }
    }
    nloc = mine > 0u ? mine : 1u; nx = cnt > 0u ? cnt : 1u;
}
DEVI void xcd_barrier(const XcdBarrier& b) {
    asm volatile("s_waitcnt vmcnt(0)" ::: "memory");
    __syncthreads();
    if (threadIdx.x == 0) {
        unsigned* bar = b.bar;
        __builtin_amdgcn_s_waitcnt(0);
        unsigned nloc = b.st[0], nx = b.st[1];
        if (nloc == 0u) { xcd_barrier_complete(bar, b.x, nloc, nx); b.st[0] = nloc; b.st[1] = nx; }
        const unsigned old = xb_add(&bar[XB_XSUB(b.x)], 1u);
        const unsigned gen = old / nloc;
        if (old + 1u == (gen + 1u) * nloc) {
            __builtin_amdgcn_fence(__ATOMIC_RELEASE, "agent");
            asm volatile("s_waitcnt vmcnt(0)" ::: "memory");
            const unsigned og = xb_add(&bar[XB_TOP], 1u);
            const unsigned tg = og / nx;
            if (og + 1u == (tg + 1u) * nx) xb_add(&bar[XB_TOPGEN], 1u);
            else XB_SPIN(xb_ld(&bar[XB_TOPGEN]) == tg, bar);
            __builtin_amdgcn_fence(__ATOMIC_ACQUIRE, "agent");
            xb_add(&bar[XB_XGEN(b.x)], 1u);
            asm volatile("s_waitcnt vmcnt(0)" ::: "memory");
        } else {
            XB_SPIN(xb_ld(&bar[XB_XGEN(b.x)]) == gen, bar);
            __builtin_amdgcn_fence(__ATOMIC_ACQUIRE, "agent");
            asm volatile("s_waitcnt vmcnt(0)" ::: "memory");
        }
    }
    __syncthreads();
}

struct Args { const float* in[23]; float* out; unsigned char* ws; int ph_lo, ph_hi, li, pad; };
struct Frame { int tid, lane, wave, gw, NGW, gt, NGT, G; LAS unsigned char* lds; };

DEVI void ph_rope_table(const Frame& F, float* rope) {
    for (int idx = F.gt; idx < SEQ * 32; idx += F.NGT) {
        const int s = idx >> 5, i = idx & 31;
        const float inv = powf(10000.0f, -(float)(2 * i) / 64.0f);
        const float ang = (float)s * inv;
        float sn, cs; sincosf(ang, &sn, &cs);
        rope[2 * idx] = cs; rope[2 * idx + 1] = sn;
    }
}
DEVI void s5_tables_item(int l, int g, const float* a_re, const float* a_im, const float* log_dt, const float* b_re, const float* b_im,
                         const float* c_re, const float* c_im, bf16_t* TC, bf16_t* BS, float* AL, LAS float* lds, int tid, int nthr, int part) {
    LAS cf32* pw = (LAS cf32*)lds;
    LAS cf32* Cc = pw + 33 * 64;
    LAS cf32* Bb = Cc + 16 * 64;
    LAS cf32* fp = Bb + 64 * 16;
    LAS float* Kt = (LAS float*)(fp + 64);
    const int lg = l * SSM_G + g;
    const float dt = expf(log_dt[lg]);
    for (int i = tid; i < 33 * 64; i += nthr) {
        const int tau = i >> 6, p = i & 63;
        const float lr = a_re[lg * 64 + p], li = a_im[lg * 64 + p];
        const float mag = expf(lr * dt * (float)tau);
        float sn, cs; sincosf(li * dt * (float)tau, &sn, &cs);
        pw[i] = (cf32){mag * cs, mag * sn};
    }
    for (int i = tid; i < 16 * 64; i += nthr) Cc[i] = (cf32){c_re[(size_t)lg * 1024 + i], c_im[(size_t)lg * 1024 + i]};
    __syncthreads();
    for (int p = tid; p < 64; p += nthr) {
        const float lr = a_re[lg * 64 + p], li = a_im[lg * 64 + p];
        const cf32 ab = pw[64 + p];
        const float den = lr * lr + li * li, nre = ab.x - 1.0f;
        fp[p] = (cf32){(nre * lr + ab.y * li) / den, (ab.y * lr - nre * li) / den};
    }
    __syncthreads();
    for (int i = tid; i < 64 * 16; i += nthr) {
        const cf32 f = fp[i >> 4];
        const float br = b_re[(size_t)lg * 1024 + i], bi = b_im[(size_t)lg * 1024 + i];
        Bb[i] = (cf32){f.x * br - f.y * bi, f.x * bi + f.y * br};
    }
    __syncthreads();
    for (int i = tid; i < 8 * 256; i += nthr) {
        const int tau = 8 * part + (i >> 8), co = (i >> 4) & 15, ci = i & 15;
        float acc = 0.f;
        for (int p = 0; p < 64; ++p) {
            const cf32 c = Cc[co * 64 + p], w = pw[tau * 64 + p], b = Bb[p * 16 + ci];
            const float xr = c.x * w.x - c.y * w.y, xi = c.x * w.y + c.y * w.x;
            acc += xr * b.x - xi * b.y;
        }
        Kt[i] = acc;
    }
    __syncthreads();
    for (int i = tid; i < 512 * 512; i += nthr) {
        const int n = i >> 9, kk = i & 511, t = n >> 4, co = n & 15, tp = kk >> 4, ci = kk & 15, tau = t - tp;
        if (tau >= 0) { if ((tau >> 3) == part) TC[(size_t)n * 640 + kk] = f2bf(Kt[((tau & 7) * 16 + co) * 16 + ci]); }
        else if (((-tau - 1) >> 3) == part) TC[(size_t)n * 640 + kk] = 0;
    }
    for (int i = part * 128 * 128 + tid; i < (part + 1) * 128 * 128; i += nthr) {
        const int n = i >> 7, kc = i & 127, t = n >> 4, co = n & 15, p = kc & 63;
        const cf32 c = Cc[co * 64 + p], w = pw[(t + 1) * 64 + p];
        const float xr = c.x * w.x - c.y * w.y, xi = c.x * w.y + c.y * w.x;
        TC[(size_t)n * 640 + 512 + kc] = f2bf(kc < 64 ? xr : -xi);
    }
    for (int i = part * 32 * 512 + tid; i < (part + 1) * 32 * 512; i += nthr) {
        const int row = i >> 9, kk = i & 511, p = row & 63, tp = kk >> 4, ci = kk & 15;
        const cf32 w = pw[(31 - tp) * 64 + p], b = Bb[p * 16 + ci];
        BS[i] = f2bf(row < 64 ? (w.x * b.x - w.y * b.y) : (w.x * b.y + w.y * b.x));
    }
    if (part == 0) for (int i = tid; i < 64; i += nthr) { AL[2 * i] = pw[32 * 64 + i].x; AL[2 * i + 1] = pw[32 * 64 + i].y; }
    __syncthreads();
}

DEVI void ph_rmsnorm(const Frame& F, const float* x, const float* g, bf16_t* out) {
    for (int row = F.gw; row < NTOK; row += F.NGW) {
        const f32x4* xr = (const f32x4*)(x + (size_t)row * D) + F.lane;
        f32x4 v[4]; float s = 0.f;
#pragma unroll
        for (int j = 0; j < 4; ++j) { v[j] = xr[64 * j]; s += (v[j].x * v[j].x + v[j].y * v[j].y) + (v[j].z * v[j].z + v[j].w * v[j].w); }
        const float rstd = 1.0f / sqrtf(wave_sum(s, F.lane) * (1.0f / D) + NORM_EPS);
#pragma unroll
        for (int j = 0; j < 4; ++j) {
            const f32x4 gg = *((const f32x4*)g + F.lane + 64 * j);
            u32x2 o; o.x = pk2(v[j].x * rstd * gg.x, v[j].y * rstd * gg.y); o.y = pk2(v[j].z * rstd * gg.z, v[j].w * rstd * gg.w);
            *((u32x2*)(out + (size_t)row * D) + F.lane + 64 * j) = o;
        }
    }
}

template <int BMODE, class RowF, class Epi>
DEVI void sg_phase(const Frame& F, int ny, const RowF& rowf, const void* Bv, size_t bstride, int ldb, int K, int nct, int cstep, int off2, const Epi& epi) {
    const int lane = F.lane, r = lane & 31, h = lane >> 5;
    int base = 0;
    for (int y = 0; y < ny; ++y) {
        const int nrows = rowf.nrows(y), nrt = (nrows + 31) / 32, ntile = nrt * nct;
        const float* Bf = (const float*)Bv + (size_t)y * bstride;
        const bf16_t* Bt = (const bf16_t*)Bv + (size_t)y * bstride;
        int first = (F.gw - base % F.NGW + F.NGW) % F.NGW;
        for (int tile = first; tile < ntile; tile += F.NGW) {
            const int rt = tile / nct, ct = tile % nct, c0 = ct * cstep, c1 = c0 + off2;
            const int arow_i = rt * 32 + r;
            const bf16_t* arow = (arow_i < nrows) ? rowf(y, arow_i) : nullptr;
            f32x16 acc0 = {}, acc1 = {};
            for (int k = 0; k < K; k += 16) {
                bf16x8 a = {};
                if (arow) a = *(const bf16x8*)(arow + k + 8 * h);
                bf16x8 b0, b1;
                if (BMODE == 0) {
#pragma unroll
                    for (int j = 0; j < 8; ++j) { b0[j] = (short)f2bf(Bf[(size_t)(k + 8 * h + j) * ldb + c0 + r]); b1[j] = (short)f2bf(Bf[(size_t)(k + 8 * h + j) * ldb + c1 + r]); }
                } else {
                    b0 = *(const bf16x8*)(Bt + (size_t)(c0 + r) * ldb + k + 8 * h);
                    b1 = *(const bf16x8*)(Bt + (size_t)(c1 + r) * ldb + k + 8 * h);
                }
                acc0 = __builtin_amdgcn_mfma_f32_32x32x16_bf16(a, b0, acc0, 0, 0, 0);
                acc1 = __builtin_amdgcn_mfma_f32_32x32x16_bf16(a, b1, acc1, 0, 0, 0);
            }
#pragma unroll
            for (int reg = 0; reg < 16; ++reg) {
                const int row = rt * 32 + (reg & 3) + 8 * (reg >> 2) + 4 * h;
                if (row < nrows) epi(y, row, c0 + r, c1 + r, acc0[reg], acc1[reg]);
            }
        }
        base += ntile;
    }
}

struct RowPlain { const bf16_t* A; int lda; int n; size_t ystride;
    DEVI int nrows(int) const { return n; }
    DEVI const bf16_t* operator()(int y, int r) const { return A + (size_t)y * ystride + (size_t)r * lda; } };

struct EpiG1sPerm;
struct EpiG1s { bf16_t* ucat; float* qraw; float* kraw; bf16_t* v; bf16_t* sg;
    DEVI void one(int row, int c, float a) const {
        if (c < 512) { const int b = row >> 12, s = row & 4095, g = c >> 4, ci = c & 15;
            ucat[((size_t)g * UROWS + b * NCH + (s >> 5)) * UK + (s & 31) * 16 + ci] = f2bf(a); }
        else if (c < 1024) qraw[(size_t)row * 512 + (c - 512)] = a;
        else if (c < 1536) kraw[(size_t)row * 512 + (c - 1024)] = a;
        else if (c < 2048) v[(size_t)row * 512 + (c - 1536)] = f2bf(a);
        else sg[(size_t)row * 2048 + (c - 2048)] = f2bf(sigmoidf_(a));
    }
    DEVI void operator()(int, int row, int c0, int c1, float a0, float a1) const { one(row, c0, a0); one(row, c1, a1); } };

DEVI int g1_unperm(int cp) { const int pn = cp >> 8, tc = cp & 255; if (pn < 2 || pn >= 6) return cp; const int sec = pn < 4 ? 512 : 1024, hh = (pn & 1) * 4 + ((tc >> 5) & 3); return sec + hh * 64 + 32 * (tc >> 7) + (tc & 31); }
#ifndef G1_FIX_MASK
#define G1_FIX_MASK 0
#endif
DEVI bool g1_sel(int c) { const int sec = c < 512 ? 1 : c < 1024 ? 2 : c < 1536 ? 4 : c < 2048 ? 8 : 16; return (G1_FIX_MASK & sec) != 0; }
struct EpiG1sPerm { EpiG1s e; DEVI void operator()(int, int row, int c0, int c1, float a0, float a1) const { e.one(row, g1_unperm(c0), a0); e.one(row, g1_unperm(c1), a1); } };
struct EpiG1sFix { EpiG1s e; DEVI void operator()(int, int row, int c0, int c1, float a0, float a1) const { const int n0 = g1_unperm(c0), n1 = g1_unperm(c1); if (g1_sel(n0)) e.one(row, n0, a0); if (g1_sel(n1)) e.one(row, n1, a1); } };
DEVI void ph_qkpost(const Frame& F, const float* qraw, const float* kraw, const float* qg, const float* kg, const float* rope, bf16_t* Q, bf16_t* K) {
    for (int idx = F.gt; idx < NTOK * 16; idx += F.NGT) {
        const int which = idx & 1, hh = (idx >> 1) & 7, tok = idx >> 4;
        const float* src = (which ? kraw : qraw) + (size_t)tok * 512 + hh * 64;
        const float* gn = which ? kg : qg;
        float x[64]; float ss = 0.f;
#pragma unroll
        for (int i = 0; i < 16; ++i) { const f32x4 t = *((const f32x4*)src + i); x[4 * i] = t.x; x[4 * i + 1] = t.y; x[4 * i + 2] = t.z; x[4 * i + 3] = t.w; ss += (t.x * t.x + t.y * t.y) + (t.z * t.z + t.w * t.w); }
        const float rstd = 1.0f / sqrtf(ss * (1.0f / 64.0f) + NORM_EPS);
        const int s = tok & (SEQ - 1);
        const float sc = which ? 1.0f : QSCALE;
        bf16_t* dst = (which ? K : Q) + (size_t)tok * 512 + hh * 64;
#pragma unroll
        for (int i = 0; i < 32; ++i) {
            const float x1 = x[i] * rstd * gn[i], x2 = x[i + 32] * rstd * gn[i + 32];
            const float cs = rope[(s * 32 + i) * 2], sn = rope[(s * 32 + i) * 2 + 1];
            dst[i] = f2bf((x1 * cs - x2 * sn) * sc);
            dst[i + 32] = f2bf((x2 * cs + x1 * sn) * sc);
        }
    }
}
DEVI void ph_ksum(const Frame& F, const bf16_t* K, float* ksum) {
    const int lane = F.lane, rg = lane >> 3, c = lane & 7;
    for (int w = F.gw; w < BATCH * NH * NBLK; w += F.NGW) {
        const int blk = w & 15, hh = (w >> 4) & 7, b = w >> 7;
        const bf16_t* kp = K + ((size_t)b * SEQ + blk * 256 + rg) * 512 + hh * 64 + c * 8;
        float acc[8];
#pragma unroll
        for (int j = 0; j < 8; ++j) acc[j] = 0.f;
#pragma unroll 8
        for (int i = 0; i < 32; ++i) { const bf16x8 v = *(const bf16x8*)(kp + (size_t)i * 8 * 512);
#pragma unroll
            for (int j = 0; j < 8; ++j) acc[j] += bf2f((bf16_t)v[j]); }
#pragma unroll
        for (int j = 0; j < 8; ++j) { float t = acc[j]; t += xshfl(t, 8, lane); t += xshfl(t, 16, lane); t += xshfl(t, 32, lane); acc[j] = t; }
        if (rg == 0) { float* o = ksum + (size_t)w * 64 + c * 8; *(f32x4*)o = (f32x4){acc[0], acc[1], acc[2], acc[3]}; *(f32x4*)(o + 4) = (f32x4){acc[4], acc[5], acc[6], acc[7]}; }
    }
}

DEVI void ph_attn_simple(const Frame& F, const bf16_t* Q, const bf16_t* K, const bf16_t* V, const float* ksum, bf16_t* O) {
    const int lane = F.lane;
    for (int w = F.gw; w < BATCH * NH * SEQ; w += F.NGW) {
        const int s = w & (SEQ - 1), hh = (w >> 12) & 7, b = w >> 15;
        const int qb = s >> 8;
        const bf16_t* qp = Q + ((size_t)b * SEQ + s) * 512 + hh * 64;
        float q[64];
#pragma unroll
        for (int i = 0; i < 8; ++i) { const bf16x8 t = *((const bf16x8*)qp + i);
#pragma unroll
            for (int j = 0; j < 8; ++j) q[8 * i + j] = bf2f((bf16_t)t[j]); }
        float gsc = -INFINITY;
        if (lane < qb) { const float* km = ksum + ((size_t)(b * 8 + hh) * 16 + lane) * 64; float a = 0.f;
#pragma unroll
            for (int i = 0; i < 64; ++i) a += q[i] * km[i];
            gsc = a; }
        int blks[4]; int nsel = 0;
#pragma unroll
        for (int t = 0; t < 3; ++t) {
            float best = -INFINITY; int bi = -1;
            for (int j = 0; j < 15; ++j) { const float v = __shfl(gsc, j); const bool used = (t > 0 && j == blks[0]) || (t > 1 && j == blks[1]); if (j < qb && !used && v > best) { best = v; bi = j; } }
            blks[t] = bi; if (bi >= 0) nsel = t + 1;
        }
        blks[3] = qb;
        float sc[4][4]; float m = -INFINITY;
#pragma unroll
        for (int t = 0; t < 4; ++t) {
            const bool on = (t == 3) || (t < nsel);
            const int blk = on ? blks[t] : 0;
#pragma unroll
            for (int i = 0; i < 4; ++i) {
                const int key = blk * 256 + lane + 64 * i;
                float a = -INFINITY;
                if (on && (t < 3 || key <= s)) {
                    const bf16_t* kp = K + ((size_t)b * SEQ + key) * 512 + hh * 64; a = 0.f;
#pragma unroll
                    for (int c = 0; c < 8; ++c) { const bf16x8 kk = *((const bf16x8*)kp + c);
#pragma unroll
                        for (int j = 0; j < 8; ++j) a += q[8 * c + j] * bf2f((bf16_t)kk[j]); }
                }
                sc[t][i] = a; m = fmaxf(m, a);
            }
        }
        m = wave_max(m);
        float l = 0.f;
#pragma unroll
        for (int t = 0; t < 4; ++t)
#pragma unroll
            for (int i = 0; i < 4; ++i) { const float p = exp2f(sc[t][i] - m); sc[t][i] = p; l += p; }
        l = wave_sum(l, lane);
        float o = 0.f;
#pragma unroll
        for (int t = 0; t < 4; ++t) {
            const bool on = (t == 3) || (t < nsel);
            if (!on) continue;
            const int blk = blks[t];
#pragma unroll
            for (int i = 0; i < 4; ++i) {
                const float pv = sc[t][i];
                for (int j = 0; j < 64; ++j) {
                    const float p = __shfl(pv, j);
                    const int key = blk * 256 + j + 64 * i;
                    if (p != 0.f) o += p * bf2f(V[((size_t)b * SEQ + key) * 512 + hh * 64 + lane]);
                }
            }
        }
        O[((size_t)b * SEQ + s) * 512 + hh * 64 + lane] = f2bf(o / l);
    }
}

struct EpiS5A { float* sl; DEVI void operator()(int y, int row, int c0, int c1, float a0, float a1) const { float* p = sl + ((size_t)y * UROWS + row) * 128; p[c0] = a0; p[c1] = a1; } };
DEVI void ph_s5_scan(const Frame& F, const float* sl, const float* AL, bf16_t* ucat) {
    for (int idx = F.gt; idx < SSM_G * BATCH * 64; idx += F.NGT) {
        const int p = idx & 63, b = (idx >> 6) & 7, g = idx >> 9;
        const float ar = AL[(g * 64 + p) * 2], ai = AL[(g * 64 + p) * 2 + 1];
        float hr = 0.f, hi = 0.f;
        for (int c = 0; c < NCH; ++c) {
            const size_t row = (size_t)g * UROWS + b * NCH + c;
            ucat[row * UK + 512 + p] = f2bf(hr); ucat[row * UK + 576 + p] = f2bf(hi);
            const float sr = sl[row * 128 + p], si = sl[row * 128 + 64 + p];
            const float nr = ar * hr - ai * hi + sr, ni = ar * hi + ai * hr + si; hr = nr; hi = ni;
        }
    }
}
struct EpiS5C { const bf16_t* ucat; const float* dskip; bf16_t* z;
    DEVI void one(int g, int row, int n, float a) const {
        const int t = n >> 4, co = n & 15, b = row >> 7, c = row & 127;
        const float u = bf2f(ucat[((size_t)g * UROWS + row) * UK + n]);
        const float y = a + dskip[g * 16 + co] * u;
        z[((size_t)b * SEQ + c * CHL + t) * 512 + g * 16 + co] = f2bf(gelu_tanh(y));
    }
    DEVI void operator()(int y, int row, int c0, int c1, float a0, float a1) const { one(y, row, c0, a0); one(y, row, c1, a1); } };

struct EpiG3s { const bf16_t* sg; bf16_t* mixa;
    DEVI void operator()(int, int row, int c0, int c1, float val, float gate) const { mixa[(size_t)row * 1024 + c0] = f2bf(bf2f(sg[(size_t)row * 2048 + c0]) * val * sigmoidf_(gate)); } };
struct EpiG4s { const bf16_t* sg; const bf16_t* mixa; bf16_t* mixed;
    DEVI void one(int row, int c, float a) const { mixed[(size_t)row * 1024 + c] = f2bf(bf2f(mixa[(size_t)row * 1024 + c]) + bf2f(sg[(size_t)row * 2048 + 1024 + c]) * a); }
    DEVI void operator()(int, int row, int c0, int c1, float a0, float a1) const { one(row, c0, a0); one(row, c1, a1); } };
struct EpiG5s { const float* xin; float* xout;
    DEVI void operator()(int, int row, int c0, int c1, float a0, float a1) const { xout[(size_t)row * 1024 + c0] = xin[(size_t)row * 1024 + c0] + a0; xout[(size_t)row * 1024 + c1] = xin[(size_t)row * 1024 + c1] + a1; } };

DEVI void ph_norm_router(const Frame& F, const float* x, const float* g, const float* wg, const float* bg, const float* we, const float* be,
                         bf16_t* h2, unsigned* cnt, int* list, unsigned* rec) {
    const int lane = F.lane;
    for (int row = F.gw; row < NTOK; row += F.NGW) {
        const f32x4* xr = (const f32x4*)(x + (size_t)row * D) + lane;
        f32x4 v[4]; float s = 0.f;
#pragma unroll
        for (int j = 0; j < 4; ++j) { v[j] = xr[64 * j]; s += (v[j].x * v[j].x + v[j].y * v[j].y) + (v[j].z * v[j].z + v[j].w * v[j].w); }
        const float rstd = 1.0f / sqrtf(wave_sum(s, lane) * (1.0f / D) + NORM_EPS);
        float acc[36];
#pragma unroll
        for (int o = 0; o < 36; ++o) acc[o] = 0.f;
#pragma unroll
        for (int j = 0; j < 4; ++j) {
            const f32x4 gg = *((const f32x4*)g + lane + 64 * j);
            const float hv[4] = {v[j].x * rstd * gg.x, v[j].y * rstd * gg.y, v[j].z * rstd * gg.z, v[j].w * rstd * gg.w};
            u32x2 o; o.x = pk2(hv[0], hv[1]); o.y = pk2(hv[2], hv[3]);
            *((u32x2*)(h2 + (size_t)row * D) + lane + 64 * j) = o;
#pragma unroll
            for (int e = 0; e < 4; ++e) {
                const int k = 4 * lane + 256 * j + e;
                const f32x4 w4 = *(const f32x4*)(wg + (size_t)k * 4);
                acc[0] += hv[e] * w4.x; acc[1] += hv[e] * w4.y; acc[2] += hv[e] * w4.z; acc[3] += hv[e] * w4.w;
#pragma unroll
                for (int q = 0; q < 8; ++q) { const f32x4 w = *(const f32x4*)(we + (size_t)k * 32 + 4 * q);
                    acc[4 + 4 * q] += hv[e] * w.x; acc[5 + 4 * q] += hv[e] * w.y; acc[6 + 4 * q] += hv[e] * w.z; acc[7 + 4 * q] += hv[e] * w.w; }
            }
        }
#pragma unroll
        for (int o = 0; o < 36; ++o) acc[o] = wave_sum(acc[o], lane);
        if (lane == 0) {
            float gl[4]; int gt = 0; float gm = -INFINITY;
#pragma unroll
            for (int i = 0; i < 4; ++i) { gl[i] = acc[i] + bg[i]; if (gl[i] > gm) { gm = gl[i]; gt = i; } }
            float gs = 0.f;
#pragma unroll
            for (int i = 0; i < 4; ++i) gs += __expf(gl[i] - gm);
            const float pg = 1.0f / gs;
            float el[8]; float em = -INFINITY;
#pragma unroll
            for (int i = 0; i < 8; ++i) { float t = 0.f;
#pragma unroll
                for (int gq = 0; gq < 4; ++gq) t = (gq == gt) ? acc[4 + gq * 8 + i] + be[gq * 8 + i] : t;
                el[i] = t; em = fmaxf(em, t); }
            int i1 = 0; float v1 = -INFINITY;
#pragma unroll
            for (int i = 0; i < 8; ++i) if (el[i] > v1) { v1 = el[i]; i1 = i; }
            int i2 = 0; float v2 = -INFINITY;
#pragma unroll
            for (int i = 0; i < 8; ++i) if (i != i1 && el[i] > v2) { v2 = el[i]; i2 = i; }
            const float p1 = __expf(v1 - em), p2 = __expf(v2 - em);
            const float w0 = pg * p1 / (p1 + p2), w1 = pg * p2 / (p1 + p2);
            const int e0 = gt * 8 + i1, e1 = gt * 8 + i2;
            const unsigned pos0 = atomicAdd(cnt + e0, 1u), pos1 = atomicAdd(cnt + e1, 1u);
            list[(size_t)e0 * LIST_CAP + pos0] = row; list[(size_t)e1 * LIST_CAP + pos1] = row;
            unsigned* rp = rec + (size_t)row * 8;
            rp[0] = (unsigned)e0; rp[1] = (unsigned)e1; rp[2] = pos0; rp[3] = pos1; rp[4] = __float_as_uint(w0); rp[5] = __float_as_uint(w1);
        }
    }
}
DEVI void compute_pstart(const Frame& F, const unsigned* cnt, volatile LAS int* pstart) {
    if (F.tid == 0) { int a = 0; for (int e = 0; e < NEXP; ++e) { pstart[e] = a; a += (int)((__hip_atomic_load(cnt + e, __ATOMIC_RELAXED, __HIP_MEMORY_SCOPE_AGENT) + 255u) / 256u) * 256; } pstart[NEXP] = a; }
    __syncthreads();
}
struct RowM1 { const bf16_t* h2; const int* list; const unsigned* cnt;
    DEVI int nrows(int y) const { return (int)cnt[y]; }
    DEVI const bf16_t* operator()(int y, int r) const { return h2 + (size_t)list[(size_t)y * LIST_CAP + r] * D; } };
struct EpiM1s { bf16_t* hmid; volatile LAS int* pstart;
    DEVI void operator()(int y, int row, int c0, int c1, float gt, float up) const { hmid[((size_t)pstart[y] + row) * 512 + c0] = f2bf(gt * sigmoidf_(gt) * up); } };
struct RowM2 { const bf16_t* hmid; volatile LAS int* pstart; const unsigned* cnt;
    DEVI int nrows(int y) const { return (int)cnt[y]; }
    DEVI const bf16_t* operator()(int y, int r) const { return hmid + ((size_t)pstart[y] + r) * 512; } };
struct EpiM2s { bf16_t* ybuf; volatile LAS int* pstart;
    DEVI void operator()(int y, int row, int c0, int c1, float a0, float a1) const { bf16_t* p = ybuf + ((size_t)pstart[y] + row) * 1024; p[c0] = f2bf(a0); p[c1] = f2bf(a1); } };
template <bool LAST>
DEVI void ph_combine(const Frame& F, bf16_t* xb, float* out, const bf16_t* ybuf, const unsigned* rec, volatile LAS int* pstart, const float* gnext, bf16_t* hout) {
    const int lane = F.lane;
    for (int row0 = F.gw; row0 < NTOK; row0 += 2 * F.NGW) {
        int rw[2]; const bf16_t* y0[2]; const bf16_t* y1[2]; float w0[2], w1[2]; bool on[2];
#pragma unroll
        for (int u = 0; u < 2; ++u) { rw[u] = row0 + u * F.NGW; on[u] = rw[u] < NTOK; const int rr = on[u] ? rw[u] : row0;
            const u32x4 ra = *(const u32x4*)(rec + (size_t)rr * 8); const u32x2 rb = *(const u32x2*)(rec + (size_t)rr * 8 + 4);
            y0[u] = ybuf + ((size_t)pstart[(int)ra.x] + ra.z) * 1024; y1[u] = ybuf + ((size_t)pstart[(int)ra.y] + ra.w) * 1024;
            w0[u] = __uint_as_float(rb.x); w1[u] = __uint_as_float(rb.y); }
        u32x2 xw[2][4], ya[2][4], yb[2][4];
#pragma unroll
        for (int u = 0; u < 2; ++u)
#pragma unroll
            for (int j = 0; j < 4; ++j) { const int rr = on[u] ? rw[u] : row0;
                xw[u][j] = *((const u32x2*)(xb + (size_t)rr * D) + lane + 64 * j); ya[u][j] = *((const u32x2*)y0[u] + lane + 64 * j); yb[u][j] = *((const u32x2*)y1[u] + lane + 64 * j); }
#pragma unroll
        for (int u = 0; u < 2; ++u) {
            if (!on[u]) continue;
            const int row = rw[u];
            f32x4 v[4]; float s = 0.f;
#pragma unroll
            for (int j = 0; j < 4; ++j) {
                const u32x2 x = xw[u][j], a = ya[u][j], b = yb[u][j];
                v[j].x = __uint_as_float(x.x << 16) + w0[u] * __uint_as_float(a.x << 16) + w1[u] * __uint_as_float(b.x << 16);
                v[j].y = __uint_as_float(x.x & 0xffff0000u) + w0[u] * __uint_as_float(a.x & 0xffff0000u) + w1[u] * __uint_as_float(b.x & 0xffff0000u);
                v[j].z = __uint_as_float(x.y << 16) + w0[u] * __uint_as_float(a.y << 16) + w1[u] * __uint_as_float(b.y << 16);
                v[j].w = __uint_as_float(x.y & 0xffff0000u) + w0[u] * __uint_as_float(a.y & 0xffff0000u) + w1[u] * __uint_as_float(b.y & 0xffff0000u);
                if (LAST) *((f32x4*)(out + (size_t)row * D) + lane + 64 * j) = v[j];
                else { u32x2 o; o.x = pk2(v[j].x, v[j].y); o.y = pk2(v[j].z, v[j].w); *((u32x2*)(xb + (size_t)row * D) + lane + 64 * j) = o; }
                s += (v[j].x * v[j].x + v[j].y * v[j].y) + (v[j].z * v[j].z + v[j].w * v[j].w);
            }
            if (!LAST) {
                const float rstd = 1.0f / sqrtf(wave_sum(s, lane) * (1.0f / D) + NORM_EPS);
#pragma unroll
                for (int j = 0; j < 4; ++j) { const f32x4 gg = *((const f32x4*)gnext + lane + 64 * j);
                    u32x2 o; o.x = pk2(v[j].x * rstd * gg.x, v[j].y * rstd * gg.y); o.y = pk2(v[j].z * rstd * gg.z, v[j].w * rstd * gg.w);
                    *((u32x2*)(hout + (size_t)row * D) + lane + 64 * j) = o; }
            }
        }
    }
}

namespace pg8 {
constexpr int BM = 256, BK = 64, HALF = 128, HTB = HALF * BK * 2  , STAGE_BYTES = 8 * HTB;
__host__ __device__ __forceinline__ int lds_byte(int r, int c) { const int st = (r >> 4) * 2 + (c >> 5), rr = r & 15, cc = c & 31, ob = rr * 64 + cc * 2; return st * 1024 + (ob ^ (((ob >> 9) & 1) << 5)); }
__host__ __device__ __forceinline__ void stage_rc(int b, int& R, int& C) { const int st = b / 1024, sb = b % 1024, swz = sb ^ (((sb >> 9) & 1) << 5); R = (st >> 1) * 16 + swz / 64; C = (st & 1) * 32 + (swz % 64) / 2; }
__host__ __device__ __forceinline__ int perm32(int rho) { const int n = rho >> 4, i = rho & 15; return 8 * (i >> 2) + 4 * n + (i & 3); }

struct Unit { int pm, pn, g, ui; };
struct Gemm { const bf16_t* A; const bf16_t* Bt; int lda, ldb, K; size_t ags, bgs;
    DEVI const char* abase(const Unit& u) const { return (const char*)(A + (size_t)u.g * ags + (size_t)u.pm * BM * lda); }
    DEVI const char* bbase(const Unit& u) const { return (const char*)(Bt + (size_t)u.g * bgs + (size_t)u.pn * BM * ldb); } };
struct NoGather { static constexpr bool ON = false; DEVI unsigned rowoff(const Unit&, int) const { return 0u; } };
struct LdsGather { static constexpr bool ON = true; const LAS unsigned* tab;
    DEVI unsigned rowoff(const Unit& u, int r) const { return tab[u.ui * 256 + r]; } };

typedef float f32x2_t __attribute__((ext_vector_type(2))); typedef __bf16 bf16x2_t __attribute__((ext_vector_type(2)));
DEVI unsigned cvt_pk_bf16(float lo, float hi) { const f32x2_t v = {lo, hi}; const bf16x2_t b = __builtin_convertvector(v, bf16x2_t); return __builtin_bit_cast(unsigned, b); }

template <class Epi, class Sched, class GA, bool ALIGN_EPI>
DEVI void gemm_phase(LAS unsigned char* lds, const Gemm g, const Sched& S, const Epi& E, const GA& ga, int tid_in) {
    const int tid = tid_in, wid = __builtin_amdgcn_readfirstlane(tid >> 6), lane = tid & 63, wr = wid >> 2, wc = wid & 3, fr = lane & 15, fq = lane >> 4;
    const int K = g.K, nt = K / BK;
    unsigned voffA[2], voffB[2]; int RA[2]; unsigned CA[2];
#pragma unroll
    for (int i = 0; i < 2; ++i) { int R, C; stage_rc(tid * 16 + i * 8192, R, C); const int Rb = Epi::PERM ? ((R & ~31) + perm32(R & 31)) : R;
        voffA[i] = (unsigned)(R * g.lda + C) * 2u; voffB[i] = (unsigned)(Rb * g.ldb + C) * 2u; RA[i] = R; CA[i] = (unsigned)C * 2u; }
    const size_t kstep = (size_t)(BK * 2);
    const size_t hstepA = GA::ON ? (size_t)0 : (size_t)HALF * g.lda * 2, hstepB = (size_t)HALF * g.ldb * 2;
    const unsigned ldsw = (unsigned)wid * 1024u;
    const int aoff = lds_byte(wr * 64 + fr, fq * 8), boff = lds_byte(wc * 32 + fr, fq * 8);
#define PG8_SA(b, h) (((b) * 2 + (h)) * HTB)
#define PG8_SB(b, h) ((4 + (b) * 2 + (h)) * HTB)
#define PG8_STAGE2(bufoff, gbase, v0, v1) do { \
        __builtin_amdgcn_global_load_lds((const unsigned*)((const char*)(gbase) + (v0)), (LAS unsigned*)(lds + (bufoff) + ldsw), 16, 0, 0); \
        __builtin_amdgcn_global_load_lds((const unsigned*)((const char*)(gbase) + (v1)), (LAS unsigned*)(lds + (bufoff) + ldsw + 8192), 16, 0, 0); } while (0)
#define PG8_STAGE_B(b, h, bptr) PG8_STAGE2(PG8_SB(b, h), (bptr) + (h) * hstepB, voffB[0], voffB[1])
#define PG8_STAGE_A(b, h, aptr, NX) do { if constexpr (GA::ON) { const unsigned _o0 = (NX) ? vgn[h][0] : vgc[h][0], _o1 = (NX) ? vgn[h][1] : vgc[h][1]; PG8_STAGE2(PG8_SA(b, h), (aptr), _o0, _o1); } \
        else { PG8_STAGE2(PG8_SA(b, h), (aptr) + (h) * hstepA, voffA[0], voffA[1]); } } while (0)
#define PG8_LDA(dst, b, h) do { _Pragma("unroll") for (int m = 0; m < 4; ++m) _Pragma("unroll") for (int k = 0; k < 2; ++k) dst[m][k] = *(const LAS bf16x8*)(lds + PG8_SA(b, h) + aoff + m * 2048 + k * 1024); } while (0)
#define PG8_LDB(dst, b, h) do { _Pragma("unroll") for (int n = 0; n < 2; ++n) _Pragma("unroll") for (int k = 0; k < 2; ++k) dst[n][k] = *(const LAS bf16x8*)(lds + PG8_SB(b, h) + boff + n * 2048 + k * 1024); } while (0)
#define PG8_MMA(ai, bj, At, Bt) do { __builtin_amdgcn_s_setprio(1); _Pragma("unroll") for (int m = 0; m < 4; ++m) _Pragma("unroll") for (int n = 0; n < 2; ++n) _Pragma("unroll") for (int k = 0; k < 2; ++k) \
        acc[ai][bj][m][n] = __builtin_amdgcn_mfma_f32_16x16x32_bf16(Bt[n][k], At[m][k], acc[ai][bj][m][n], 0, 0, 0); __builtin_amdgcn_s_setprio(0); } while (0)
#define PG8_WAIT_V(n) asm volatile("s_waitcnt vmcnt(" #n ")" ::: "memory")
#define PG8_WAIT_L(n) asm volatile("s_waitcnt lgkmcnt(" #n ")" ::: "memory")
#define PG8_BAR __builtin_amdgcn_s_barrier()
#define PG8_SCHED __builtin_amdgcn_sched_barrier(0)
    Unit cur, nxt; int ui = 0;
    if (!S.next(0, cur)) return;
    f32x4 acc[2][2][4][2];
#pragma unroll
    for (int a = 0; a < 2; ++a)
#pragma unroll
        for (int b = 0; b < 2; ++b)
#pragma unroll
            for (int m = 0; m < 4; ++m)
#pragma unroll
                for (int n = 0; n < 2; ++n) acc[a][b][m][n] = (f32x4){0.f, 0.f, 0.f, 0.f};
    bf16x8 At[4][2], B0[2][2], B1[2][2];
    unsigned vgc[2][2] = {{0u, 0u}, {0u, 0u}}, vgn[2][2] = {{0u, 0u}, {0u, 0u}};
    if constexpr (GA::ON) {
#pragma unroll
        for (int h = 0; h < 2; ++h)
#pragma unroll
            for (int i = 0; i < 2; ++i) vgc[h][i] = ga.rowoff(cur, h * HALF + RA[i]) + CA[i];
    }
    const char* cA = GA::ON ? (const char*)g.A : g.abase(cur); const char* cB = g.bbase(cur);
    S.a_ready(cur);
    PG8_STAGE_B(0, 0, cB); PG8_STAGE_B(0, 1, cB); PG8_STAGE_A(0, 0, cA, false); PG8_STAGE_A(0, 1, cA, false);
    if (wr == 1) PG8_BAR;
    PG8_WAIT_V(2); PG8_BAR;
    PG8_STAGE_B(1, 0, cB + kstep); PG8_STAGE_A(1, 0, cA + kstep, false); PG8_STAGE_B(1, 1, cB + kstep);
    PG8_WAIT_V(6); PG8_BAR;
    for (;;) {
        const bool has_next = S.next(ui + 1, nxt);
        const char* nA = has_next ? (GA::ON ? (const char*)g.A : g.abase(nxt)) : cA; const char* nB = has_next ? g.bbase(nxt) : cB;
        if constexpr (GA::ON) {
#pragma unroll
            for (int h = 0; h < 2; ++h)
#pragma unroll
                for (int i = 0; i < 2; ++i) vgn[h][i] = has_next ? ga.rowoff(nxt, h * HALF + RA[i]) + CA[i] : vgc[h][i];
            asm volatile("" : "+v"(vgn[0][0]), "+v"(vgn[0][1]), "+v"(vgn[1][0]), "+v"(vgn[1][1]));
        }
        for (int t = 0; t < nt; t += 2) {
            const bool last = (t == nt - 2);
            const char* a1 = cA + (size_t)(t + 1) * kstep;
            const char* a2 = last ? nA : cA + (size_t)(t + 2) * kstep; const char* b2 = last ? nB : cB + (size_t)(t + 2) * kstep;
            const char* a3 = a2 + kstep; const char* b3 = b2 + kstep;
            if (last && has_next) S.a_ready(nxt);
            PG8_LDB(B0, 0, 0); PG8_LDB(B1, 0, 1); PG8_SCHED; PG8_LDA(At, 0, 0); PG8_STAGE_A(1, 1, a1, false);
            PG8_WAIT_V(8); PG8_WAIT_L(0); PG8_BAR; PG8_MMA(0, 0, At, B0); PG8_MMA(0, 1, At, B1); PG8_BAR; PG8_SCHED;
            PG8_LDA(At, 0, 1); PG8_STAGE_B(0, 0, b2); PG8_STAGE_B(0, 1, b2); PG8_STAGE_A(0, 0, a2, last);
            PG8_WAIT_V(8); PG8_WAIT_L(0); PG8_BAR; PG8_MMA(1, 0, At, B0); PG8_MMA(1, 1, At, B1); PG8_BAR; PG8_SCHED;
            PG8_LDB(B0, 1, 0); PG8_LDB(B1, 1, 1); PG8_SCHED; PG8_LDA(At, 1, 0); PG8_STAGE_A(0, 1, a2, last);
            PG8_WAIT_V(8); PG8_WAIT_L(0); PG8_BAR; PG8_MMA(0, 0, At, B0); PG8_MMA(0, 1, At, B1); PG8_BAR; PG8_SCHED;
            PG8_LDA(At, 1, 1); PG8_STAGE_B(1, 0, b3); PG8_STAGE_B(1, 1, b3); PG8_STAGE_A(1, 0, a3, last);
            PG8_WAIT_V(8); PG8_WAIT_L(0); PG8_BAR; PG8_MMA(1, 0, At, B0); PG8_MMA(1, 1, At, B1); PG8_BAR; PG8_SCHED;
        }
        if constexpr (ALIGN_EPI) { if (wr == 0) PG8_BAR; }
        if constexpr (!Epi::AFTER_DRAIN) { E(acc, cur, wr, wc, fr, fq); S.done(cur); }
        if (!has_next) break;
#pragma unroll
        for (int a = 0; a < 2; ++a)
#pragma unroll
            for (int b = 0; b < 2; ++b)
#pragma unroll
                for (int m = 0; m < 4; ++m)
#pragma unroll
                    for (int n = 0; n < 2; ++n) acc[a][b][m][n] = (f32x4){0.f, 0.f, 0.f, 0.f};
        cur = nxt; cA = nA; cB = nB; ++ui;
        if constexpr (GA::ON) {
#pragma unroll
            for (int h = 0; h < 2; ++h)
#pragma unroll
                for (int i = 0; i < 2; ++i) vgc[h][i] = vgn[h][i];
        }
        if constexpr (ALIGN_EPI) { if (wr == 1) PG8_BAR; }
    }
    PG8_WAIT_V(0);
    if constexpr (!ALIGN_EPI) { if (wr == 0) PG8_BAR; }
    PG8_BAR;
    if constexpr (Epi::AFTER_DRAIN) { E.fused(acc, cur, wr, wc, fr, fq, lds, wid, lane); S.done(cur); }
#undef PG8_SA
#undef PG8_SB
#undef PG8_STAGE2
#undef PG8_STAGE_A
#undef PG8_STAGE_B
#undef PG8_LDA
#undef PG8_LDB
#undef PG8_MMA
#undef PG8_WAIT_V
#undef PG8_WAIT_L
#undef PG8_BAR
#undef PG8_SCHED
}
}

namespace pg8 {
DEVI float fsig(float x) { return __builtin_amdgcn_rcpf(1.0f + __expf(-x)); }
DEVI f32x4 unpk_lo(u32x4 w, int half) {
    const unsigned a = half ? w.z : w.x, b = half ? w.w : w.y;
    return (f32x4){__uint_as_float(a << 16), __uint_as_float(a & 0xffff0000u), __uint_as_float(b << 16), __uint_as_float(b & 0xffff0000u)}; }
DEVI u32x4 pk8(f32x4 v0, f32x4 v1) { u32x4 w; w.x = cvt_pk_bf16(v0[0], v0[1]); w.y = cvt_pk_bf16(v0[2], v0[3]); w.z = cvt_pk_bf16(v1[0], v1[1]); w.w = cvt_pk_bf16(v1[2], v1[3]); return w; }

struct StaticOrder {
    int nM, nN, nwg, G, c;
    DEVI void init(int M, int N, int G_, int c_) { nM = M / BM; nN = N / BM; nwg = nM * nN; G = G_; c = c_; }
    DEVI bool next(int i, Unit& u) const {
        const long L = (long)i * G + c; if (L >= nwg) return false;
        int wgid = (int)L; { const int q = nwg / 8, r = nwg % 8, xcd = wgid % 8, off = wgid / 8; wgid = (xcd < r ? xcd * (q + 1) : r * (q + 1) + (xcd - r) * q) + off; }
        const int nig = 8 * nN, gid = wgid / nig, fm = gid * 8, gsz = (nM - fm) < 8 ? (nM - fm) : 8;
        u.pm = fm + ((wgid % nig) % gsz); u.pn = (wgid % nig) / gsz; u.g = 0; u.ui = i; return true;
    }
    DEVI void a_ready(const Unit&) const {}
    DEVI void done(const Unit&) const {}
};
struct OrderS5A { int G, c; DEVI bool next(int i, Unit& u) const { const int U = i * G + c; if (U >= SSM_G * 4) return false; u.g = U >> 2; u.pm = U & 3; u.pn = 0; u.ui = i; return true; }
    DEVI void a_ready(const Unit&) const {} DEVI void done(const Unit&) const {} };
struct OrderS5C { int G, c; DEVI bool next(int i, Unit& u) const { const int U = i * G + c; if (U >= SSM_G * 8) return false; u.g = U >> 3; u.pm = (U >> 1) & 3; u.pn = U & 1; u.ui = i; return true; }
    DEVI void a_ready(const Unit&) const {} DEVI void done(const Unit&) const {} };
struct OrderMoE { int G, v; const volatile LAS int* tstart;
    DEVI bool next(int i, Unit& u) const { const int U = i * G + v, rt = U >> 2; if (rt >= tstart[NEXP]) return false;
        int e = 0;
#pragma unroll 1
        for (int q = 1; q < NEXP; ++q) e = (rt >= tstart[q]) ? q : e;
        u.pm = rt; u.pn = U & 3; u.g = e; u.ui = i; return true; }
    DEVI void a_ready(const Unit&) const {} DEVI void done(const Unit&) const {} };

template <bool F32IN> struct EpiResBf16 { static constexpr bool PERM = true, AFTER_DRAIN = false; const float* xin32; bf16_t* xb;
    DEVI void operator()(const f32x4 (&acc)[2][2][4][2], const Unit& u, int wr, int wc, int fr, int fq) const {
        const int row0 = u.pm * BM + wr * 64 + fr, col0 = u.pn * BM + wc * 32 + 8 * fq;
#pragma unroll
        for (int ai = 0; ai < 2; ++ai)
#pragma unroll
            for (int m = 0; m < 4; ++m) { const size_t off = (size_t)(row0 + ai * HALF + m * 16) * D + col0;
#pragma unroll
                for (int bj = 0; bj < 2; ++bj) { f32x4 a0, a1;
                    if (F32IN) { a0 = *(const f32x4*)(xin32 + off + bj * HALF); a1 = *(const f32x4*)(xin32 + off + bj * HALF + 4); }
                    else { const u32x4 w = *(const u32x4*)(xb + off + bj * HALF); a0 = unpk_lo(w, 0); a1 = unpk_lo(w, 1); }
                    *(u32x4*)(xb + off + bj * HALF) = pk8(a0 + acc[ai][bj][m][0], a1 + acc[ai][bj][m][1]); }
                if (m & 1) asm volatile("" ::: "memory"); }
    } };
struct EpiMix { static constexpr bool PERM = true, AFTER_DRAIN = false; const bf16_t* sg; const bf16_t* mixa; bf16_t* mixed;
    DEVI void operator()(const f32x4 (&acc)[2][2][4][2], const Unit& u, int wr, int wc, int fr, int fq) const {
        const int row0 = u.pm * BM + wr * 64 + fr, col0 = u.pn * BM + wc * 32 + 8 * fq;
#pragma unroll
        for (int ai = 0; ai < 2; ++ai)
#pragma unroll
            for (int m = 0; m < 4; ++m) { const size_t row = (size_t)(row0 + ai * HALF + m * 16);
#pragma unroll
                for (int bj = 0; bj < 2; ++bj) { const int col = col0 + bj * HALF;
                    const u32x4 a = *(const u32x4*)(mixa + row * 1024 + col), s = *(const u32x4*)(sg + row * 2048 + 1024 + col);
                    const f32x4 o0 = unpk_lo(a, 0) + unpk_lo(s, 0) * acc[ai][bj][m][0], o1 = unpk_lo(a, 1) + unpk_lo(s, 1) * acc[ai][bj][m][1];
                    *(u32x4*)(mixed + row * 1024 + col) = pk8(o0, o1); }
                if (m & 1) asm volatile("" ::: "memory"); }
    } };
struct EpiGlu { static constexpr bool PERM = true, AFTER_DRAIN = false; const bf16_t* sg; bf16_t* mixa;
    DEVI void operator()(const f32x4 (&acc)[2][2][4][2], const Unit& u, int wr, int wc, int fr, int fq) const {
        const int row0 = u.pm * BM + wr * 64 + fr, col = u.pn * HALF + wc * 32 + 8 * fq;
#pragma unroll
        for (int ai = 0; ai < 2; ++ai)
#pragma unroll
            for (int m = 0; m < 4; ++m) { const size_t row = (size_t)(row0 + ai * HALF + m * 16);
                const u32x4 s = *(const u32x4*)(sg + row * 2048 + col);
                f32x4 o[2];
#pragma unroll
                for (int n = 0; n < 2; ++n) { const f32x4 v = acc[ai][0][m][n], gt = acc[ai][1][m][n], sv = unpk_lo(s, n);
                    o[n] = (f32x4){sv[0] * v[0] * fsig(gt[0]), sv[1] * v[1] * fsig(gt[1]), sv[2] * v[2] * fsig(gt[2]), sv[3] * v[3] * fsig(gt[3])}; }
                *(u32x4*)(mixa + row * 1024 + col) = pk8(o[0], o[1]);
                if (m & 1) asm volatile("" ::: "memory"); }
    } };
struct EpiSwiglu { static constexpr bool PERM = true, AFTER_DRAIN = false; bf16_t* hmid;
    DEVI void operator()(const f32x4 (&acc)[2][2][4][2], const Unit& u, int wr, int wc, int fr, int fq) const {
        const int row0 = u.pm * BM + wr * 64 + fr, col = u.pn * HALF + wc * 32 + 8 * fq;
#pragma unroll
        for (int ai = 0; ai < 2; ++ai)
#pragma unroll
            for (int m = 0; m < 4; ++m) { const size_t row = (size_t)(row0 + ai * HALF + m * 16);
                f32x4 o[2];
#pragma unroll
                for (int n = 0; n < 2; ++n) { const f32x4 gt = acc[ai][0][m][n], up = acc[ai][1][m][n];
                    o[n] = (f32x4){gt[0] * fsig(gt[0]) * up[0], gt[1] * fsig(gt[1]) * up[1], gt[2] * fsig(gt[2]) * up[2], gt[3] * fsig(gt[3]) * up[3]}; }
                *(u32x4*)(hmid + row * 512 + col) = pk8(o[0], o[1]); }
    } };
struct EpiStoreBf16 { static constexpr bool PERM = true, AFTER_DRAIN = false; bf16_t* out; int ldc;
    DEVI void operator()(const f32x4 (&acc)[2][2][4][2], const Unit& u, int wr, int wc, int fr, int fq) const {
        const int row0 = u.pm * BM + wr * 64 + fr, col0 = u.pn * BM + wc * 32 + 8 * fq;
#pragma unroll
        for (int ai = 0; ai < 2; ++ai)
#pragma unroll
            for (int m = 0; m < 4; ++m) { bf16_t* rp = out + (size_t)(row0 + ai * HALF + m * 16) * ldc + col0;
#pragma unroll
                for (int bj = 0; bj < 2; ++bj) *(u32x4*)(rp + bj * HALF) = pk8(acc[ai][bj][m][0], acc[ai][bj][m][1]); }
    } };
struct EpiS5Cm { static constexpr bool PERM = true, AFTER_DRAIN = false; const bf16_t* ucat; const float* dskip; bf16_t* z;
    DEVI void operator()(const f32x4 (&acc)[2][2][4][2], const Unit& u, int wr, int wc, int fr, int fq) const {
        const int g = u.g, row0 = u.pm * BM + wr * 64 + fr, col0 = u.pn * BM + wc * 32 + 8 * fq;
        const int co0 = col0 & 15;
        const f32x4 d0 = *(const f32x4*)(dskip + g * 16 + co0), d1 = *(const f32x4*)(dskip + g * 16 + co0 + 4);
#pragma unroll
        for (int ai = 0; ai < 2; ++ai)
#pragma unroll
            for (int m = 0; m < 4; ++m) { const int row = row0 + ai * HALF + m * 16, b = row >> 7, c = row & 127;
#pragma unroll
                for (int bj = 0; bj < 2; ++bj) { const int n = col0 + bj * HALF, t = n >> 4;
                    const u32x4 uu = *(const u32x4*)(ucat + ((size_t)g * UROWS + row) * UK + n);
                    const f32x4 y0 = acc[ai][bj][m][0] + d0 * unpk_lo(uu, 0), y1 = acc[ai][bj][m][1] + d1 * unpk_lo(uu, 1);
                    const f32x4 z0 = (f32x4){gelu_tanh(y0[0]), gelu_tanh(y0[1]), gelu_tanh(y0[2]), gelu_tanh(y0[3])}, z1 = (f32x4){gelu_tanh(y1[0]), gelu_tanh(y1[1]), gelu_tanh(y1[2]), gelu_tanh(y1[3])};
                    *(u32x4*)(z + ((size_t)b * SEQ + c * CHL + t) * 512 + g * 16 + co0) = pk8(z0, z1); } }
    } };
struct EpiS5Am { static constexpr bool PERM = false, AFTER_DRAIN = true; const float* AL; bf16_t* ucat;
    DEVI void fused(f32x4 (&acc)[2][2][4][2], const Unit& u, int wr, int wc, int fr, int fq, LAS unsigned char* lds, int wid, int lane) const {
        LAS float* sl = (LAS float*)lds;
#pragma unroll
        for (int ai = 0; ai < 2; ++ai)
#pragma unroll
            for (int m = 0; m < 4; ++m) { const int row = ai * HALF + wr * 64 + m * 16 + fr;
#pragma unroll
                for (int n = 0; n < 2; ++n) *(LAS f32x4*)(sl + row * 128 + wc * 32 + n * 16 + 4 * fq) = acc[ai][0][m][n]; }
        asm volatile("s_waitcnt lgkmcnt(0)" ::: "memory"); __builtin_amdgcn_s_barrier(); asm volatile("" ::: "memory");
        const int tid = wid * 64 + lane;
        if (tid < 128) { const int bb = tid >> 6, p = tid & 63, g = u.g;
            const float ar = AL[(g * 64 + p) * 2], ai_ = AL[(g * 64 + p) * 2 + 1];
            float hr = 0.f, hi = 0.f;
            for (int c = 0; c < NCH; ++c) { const int row = bb * NCH + c;
                bf16_t* up = ucat + ((size_t)g * UROWS + u.pm * BM + row) * UK + 512 + p;
                up[0] = f2bf(hr); up[64] = f2bf(hi);
                const float sr = sl[row * 128 + p], si = sl[row * 128 + 64 + p];
                const float nr = ar * hr - ai_ * hi + sr, ni = ar * hi + ai_ * hr + si; hr = nr; hi = ni; } }
        asm volatile("s_waitcnt lgkmcnt(0)" ::: "memory"); __builtin_amdgcn_s_barrier(); asm volatile("" ::: "memory");
    } };
struct EpiG1 { static constexpr bool PERM = true, AFTER_DRAIN = false; bf16_t* ucat; bf16_t* q; bf16_t* k; bf16_t* v; bf16_t* sg; const float* qg; const float* kg; const float* rope; float* qraw; float* kraw;
    DEVI void operator()(const f32x4 (&acc)[2][2][4][2], const Unit& u, int wr, int wc, int fr, int fq) const {
        const int pn = u.pn, row0 = u.pm * BM + wr * 64 + fr;
        if (pn < 2) {
#pragma unroll
            for (int ai = 0; ai < 2; ++ai)
#pragma unroll
                for (int m = 0; m < 4; ++m) { const int row = row0 + ai * HALF + m * 16, b = row >> 12, s = row & 4095;
#pragma unroll
                    for (int bj = 0; bj < 2; ++bj) { const int c = pn * BM + bj * HALF + wc * 32 + 8 * fq, g = c >> 4, ci = c & 15;
                        *(u32x4*)(ucat + ((size_t)g * UROWS + b * NCH + (s >> 5)) * UK + (s & 31) * 16 + ci) = pk8(acc[ai][bj][m][0], acc[ai][bj][m][1]); } }
        } else if (pn < 6) {
            const bool isk = pn >= 4; const int hh = (pn & 1) * 4 + wc;
#if G1_RAWQK
            { float* raw = isk ? kraw : qraw;
#pragma unroll
              for (int ai = 0; ai < 2; ++ai)
#pragma unroll
                for (int m = 0; m < 4; ++m) { const int row = row0 + ai * HALF + m * 16;
#pragma unroll
                    for (int bj = 0; bj < 2; ++bj)
#pragma unroll
                        for (int n = 0; n < 2; ++n) *(f32x4*)(raw + (size_t)row * 512 + hh * 64 + 32 * bj + 8 * fq + 4 * n) = acc[ai][bj][m][n]; }
              return; }
#endif
            const float* gn = isk ? kg : qg; bf16_t* dst = isk ? k : q; const float sc = isk ? 1.0f : QSCALE;
            f32x4 gv[2][2];
#pragma unroll
            for (int bj = 0; bj < 2; ++bj)
#pragma unroll
                for (int n = 0; n < 2; ++n) gv[bj][n] = *(const f32x4*)(gn + 32 * bj + 8 * fq + 4 * n);
#pragma unroll
            for (int ai = 0; ai < 2; ++ai)
#pragma unroll
                for (int m = 0; m < 4; ++m) { const int row = row0 + ai * HALF + m * 16, s = row & 4095;
                    float ss = 0.f;
#pragma unroll
                    for (int bj = 0; bj < 2; ++bj)
#pragma unroll
                        for (int n = 0; n < 2; ++n) { const f32x4 x = acc[ai][bj][m][n]; ss += (x[0] * x[0] + x[1] * x[1]) + (x[2] * x[2] + x[3] * x[3]); }
                    ss += xshfl(ss, 16, fq * 16 + fr); ss += xshfl(ss, 32, fq * 16 + fr);
                    const float rstd = 1.0f / sqrtf(ss * (1.0f / 64.0f) + NORM_EPS);
                    f32x4 o1[2], o2[2];
#pragma unroll
                    for (int n = 0; n < 2; ++n) { const float* rp = rope + ((size_t)s * 32 + 8 * fq + 4 * n) * 2;
                        const f32x4 r0 = *(const f32x4*)rp, r1 = *(const f32x4*)(rp + 4);
                        const f32x4 cv = (f32x4){r0[0], r0[2], r1[0], r1[2]}, sv = (f32x4){r0[1], r0[3], r1[1], r1[3]};
                        const f32x4 x1 = acc[ai][0][m][n] * rstd * gv[0][n], x2 = acc[ai][1][m][n] * rstd * gv[1][n];
                        o1[n] = (x1 * cv - x2 * sv) * sc; o2[n] = (x2 * cv + x1 * sv) * sc; }
                    const u32x4 w1 = pk8(o1[0], o1[1]), w2 = pk8(o2[0], o2[1]);
                    bf16_t* dp = dst + (size_t)row * 512 + hh * 64 + 8 * fq;
                    *(u32x4*)dp = w1; *(u32x4*)(dp + 32) = w2;
                    if (m & 1) asm volatile("" ::: "memory"); }
        } else if (pn < 8) {
#pragma unroll
            for (int ai = 0; ai < 2; ++ai)
#pragma unroll
                for (int m = 0; m < 4; ++m) { bf16_t* rp = v + (size_t)(row0 + ai * HALF + m * 16) * 512 + (pn - 6) * BM + wc * 32 + 8 * fq;
#pragma unroll
                    for (int bj = 0; bj < 2; ++bj) *(u32x4*)(rp + bj * HALF) = pk8(acc[ai][bj][m][0], acc[ai][bj][m][1]); }
        } else {
#pragma unroll
            for (int ai = 0; ai < 2; ++ai)
#pragma unroll
                for (int m = 0; m < 4; ++m) { bf16_t* rp = sg + (size_t)(row0 + ai * HALF + m * 16) * 2048 + (pn - 8) * BM + wc * 32 + 8 * fq;
#pragma unroll
                    for (int bj = 0; bj < 2; ++bj) { const f32x4 a = acc[ai][bj][m][0], b = acc[ai][bj][m][1];
                        *(u32x4*)(rp + bj * HALF) = pk8((f32x4){fsig(a[0]), fsig(a[1]), fsig(a[2]), fsig(a[3])}, (f32x4){fsig(b[0]), fsig(b[1]), fsig(b[2]), fsig(b[3])}); } }
        }
    } };
}

struct CvtItem { const float* src; bf16_t* dst; int N, K; };
DEVI void cvt_load(const CvtItem& it, float (&v)[32], int lane) {
#pragma unroll
    for (int i = 0; i < 32; ++i) v[i] = it.src[(size_t)(2 * i + (lane >> 5)) * it.N + (lane & 31)];
}
DEVI void cvt_store(const CvtItem& it, const float (&v)[32], LAS float* scr, int lane) {
#pragma unroll
    for (int i = 0; i < 32; ++i) scr[(2 * i + (lane >> 5)) * 33 + (lane & 31)] = v[i];
    asm volatile("s_waitcnt lgkmcnt(0)" ::: "memory");
    const int c = lane & 7;
#pragma unroll
    for (int j = 0; j < 4; ++j) { const int n = (lane >> 3) + 8 * j; const LAS float* s = scr + (8 * c) * 33 + n;
        u32x4 o; o.x = pk2(s[0 * 33], s[1 * 33]); o.y = pk2(s[2 * 33], s[3 * 33]); o.z = pk2(s[4 * 33], s[5 * 33]); o.w = pk2(s[6 * 33], s[7 * 33]);
        *(u32x4*)(it.dst + (size_t)n * it.K + 8 * c) = o; }
    asm volatile("s_waitcnt lgkmcnt(0)" ::: "memory");
}
constexpr int CV_IN = 16 * 128, CV_GLU = 8 * 64, CV_ATT = 8 * 32, CV_OUT = 16 * 32, CV_GU1 = 16 * 32, CV_DN1 = 8 * 32;
constexpr int CV_PER_LAYER = CV_IN + CV_GLU + CV_ATT + CV_OUT + NEXP * (CV_GU1 + CV_DN1);
DEVI CvtItem cvt_decode(int it, const float* w_in, const float* w_glu, const float* w_attn, const float* w_out, const float* w_gu, const float* w_dn,
                        bf16_t* WIN, bf16_t* WGLU, bf16_t* WATT, bf16_t* WOUT, bf16_t* WGU, bf16_t* WDN) {
    const int l = it / CV_PER_LAYER; int r = it % CV_PER_LAYER;
    const float* W; bf16_t* WT; int K, N, mode;
    if (r < CV_IN) { W = w_in + (size_t)l * D * D_IN; WT = WIN + (size_t)l * D_IN * D; K = D; N = D_IN; mode = 1; }
    else if ((r -= CV_IN) < CV_GLU) { W = w_glu + (size_t)l * 512 * 2048; WT = WGLU + (size_t)l * 2048 * 512; K = 512; N = 2048; mode = 2; }
    else if ((r -= CV_GLU) < CV_ATT) { W = w_attn + (size_t)l * 512 * 1024; WT = WATT + (size_t)l * 1024 * 512; K = 512; N = 1024; mode = 0; }
    else if ((r -= CV_ATT) < CV_OUT) { W = w_out + (size_t)l * 1024 * 1024; WT = WOUT + (size_t)l * 1024 * 1024; K = 1024; N = 1024; mode = 0; }
    else if ((r -= CV_OUT) < NEXP * CV_GU1) { const int e = r / CV_GU1; r %= CV_GU1; W = w_gu + ((size_t)l * NEXP + e) * 1024 * 1024; WT = WGU + ((size_t)l * NEXP + e) * 1024 * 1024; K = 1024; N = 1024; mode = 3; }
    else { r -= NEXP * CV_GU1; const int e = r / CV_DN1; r %= CV_DN1; W = w_dn + ((size_t)l * NEXP + e) * 512 * 1024; WT = WDN + ((size_t)l * NEXP + e) * 1024 * 512; K = 512; N = 1024; mode = 0; }
    const int nblk = N / 32, kb = r / nblk, nb = r % nblk, nd = 32 * nb;
    int ns = nd;
    if (mode == 1) { const int pn = nd >> 8, tc = nd & 255; if (pn >= 2 && pn < 6) { const int sec = pn < 4 ? 512 : 1024, hh = (pn & 1) * 4 + ((tc >> 5) & 3); ns = sec + hh * 64 + 32 * (tc >> 7); } }
    else if (mode == 2) { const int pn = nd >> 8, tc = nd & 255; ns = (tc < 128) ? 128 * pn + tc : 1024 + 128 * pn + (tc - 128); }
    else if (mode == 3) { const int pn = nd >> 8, tc = nd & 255; ns = (tc < 128) ? 128 * pn + tc : 512 + 128 * pn + (tc - 128); }
    return CvtItem{W + (size_t)(64 * kb) * N + ns, WT + (size_t)nd * K + 64 * kb, N, K};
}
constexpr int CVQ_BASE = CV_IN + CV_GLU + CV_ATT + CV_OUT;
constexpr int CVQ_PER_BARRIER = 2;
constexpr int CVQ_TOTAL = DEPTH * CV_PER_LAYER - CVQ_BASE;
constexpr int CVQ_LIM_MOE0 = CV_PER_LAYER - CVQ_BASE;
constexpr int CVQ_LIM_PROJ1 = CVQ_LIM_MOE0 + CVQ_BASE;
struct CvtQ { const float* w_in; const float* w_glu; const float* w_attn; const float* w_out; const float* w_gu; const float* w_dn;
              bf16_t* WIN_; bf16_t* WGLU_; bf16_t* WATT_; bf16_t* WOUT_; bf16_t* WGU_; bf16_t* WDN_; LAS unsigned* head; LAS unsigned char* lds; int wave, lane, c, G;
    DEVI void item(int q) const { const CvtItem c = cvt_decode(q + CVQ_BASE, w_in, w_glu, w_attn, w_out, w_gu, w_dn, WIN_, WGLU_, WATT_, WOUT_, WGU_, WDN_);
        float v[32]; cvt_load(c, v, lane); cvt_store(c, v, (LAS float*)(lds + wave * 16384), lane); }
    DEVI int take() const { unsigned j = 0u; if (lane == 0) j = __hip_atomic_fetch_add(head, 1u, __ATOMIC_RELAXED, __HIP_MEMORY_SCOPE_WORKGROUP); return c + G * __builtin_amdgcn_readfirstlane((int)j); }
    DEVI int peek() const { return c + G * __builtin_amdgcn_readfirstlane((int)__hip_atomic_load(head, __ATOMIC_RELAXED, __HIP_MEMORY_SCOPE_WORKGROUP)); }
    DEVI void run_until(volatile LAS unsigned* genw, unsigned n) const {
        bool empty = peek() >= CVQ_TOTAL; int budget = CVQ_PER_BARRIER;
        while (*genw < n) {
            if (empty || budget == 0) { __builtin_amdgcn_s_sleep(4); continue; }
            --budget;
            const int q = take();
            if (q >= CVQ_TOTAL) { empty = true; continue; }
            item(q);
        }
    }
    DEVI void catchup(int limit) const { for (;;) { if (peek() >= limit) break; const int q = take(); if (q >= CVQ_TOTAL) break; item(q); } }
};
DEVI int fresh_lane() { int l = (int)__builtin_amdgcn_mbcnt_hi(~0u, __builtin_amdgcn_mbcnt_lo(~0u, 0u)); asm volatile("" : "+v"(l)); return l; }
DEVI CvtQ make_cvtq(const Args& a, LAS unsigned char* lds, int wave, int lane) {
    unsigned char* w = a.ws;
    return CvtQ{a.in[2], a.in[11], a.in[14], a.in[15], a.in[21], a.in[22], (bf16_t*)(w + WS_WIN), (bf16_t*)(w + WS_WGLU), (bf16_t*)(w + WS_WATT), (bf16_t*)(w + WS_WOUT), (bf16_t*)(w + WS_WGU), (bf16_t*)(w + WS_WDN),
                (LAS unsigned*)(lds + LDSCTL_OFF) + 5, lds, wave, lane, (int)blockIdx.x, (int)gridDim.x};
}
DEVI void ph_convert_first(const Frame& F, const CvtQ& Q) { for (int it = F.gw; it < CVQ_BASE; it += F.NGW) Q.item(it - CVQ_BASE); }
DEVI void xcd_barrier_w(const XcdBarrier& b, unsigned n, volatile LAS unsigned* genw, const CvtQ& Q) {
    asm volatile("s_waitcnt vmcnt(0)" ::: "memory");
    __syncthreads();
    if (Q.wave == 0) {
        if (threadIdx.x == 0) {
            unsigned* bar = b.bar;
            __builtin_amdgcn_s_waitcnt(0);
            unsigned nloc = b.st[0], nx = b.st[1];
            if (nloc == 0u) { xcd_barrier_complete(bar, b.x, nloc, nx); b.st[0] = nloc; b.st[1] = nx; }
            const unsigned old = xb_add(&bar[XB_XSUB(b.x)], 1u);
            const unsigned gen = old / nloc;
            if (old + 1u == (gen + 1u) * nloc) {
                __builtin_amdgcn_fence(__ATOMIC_RELEASE, "agent");
                asm volatile("s_waitcnt vmcnt(0)" ::: "memory");
                const unsigned og = xb_add(&bar[XB_TOP], 1u);
                const unsigned tg = og / nx;
                if (og + 1u == (tg + 1u) * nx) xb_add(&bar[XB_TOPGEN], 1u);
                else XB_SPIN(xb_ld(&bar[XB_TOPGEN]) == tg, bar);
                __builtin_amdgcn_fence(__ATOMIC_ACQUIRE, "agent");
                xb_add(&bar[XB_XGEN(b.x)], 1u);
                asm volatile("s_waitcnt vmcnt(0)" ::: "memory");
            } else {
                XB_SPIN(xb_ld(&bar[XB_XGEN(b.x)]) == gen, bar);
                __builtin_amdgcn_fence(__ATOMIC_ACQUIRE, "agent");
                asm volatile("s_waitcnt vmcnt(0)" ::: "memory");
            }
            *genw = n;
        }
    } else Q.run_until(genw, n);
    __syncthreads();
}


DEVI void moe_tstart(const Frame& F, const unsigned* cnt, volatile LAS int* tstart) {
    if (F.tid == 0) { int a = 0; for (int e = 0; e < NEXP; ++e) { tstart[e] = a; a += (int)((__hip_atomic_load(cnt + e, __ATOMIC_RELAXED, __HIP_MEMORY_SCOPE_AGENT) + 255u) / 256u); } tstart[NEXP] = a; }
    __syncthreads();
}
DEVI void moe_gather_table(const Frame& F, int v, const unsigned* cnt, const int* list, volatile LAS int* tstart, LAS unsigned* tab) {
    for (int i = 0; i < 8; ++i) {
        const int U = i * F.G + v, rt = U >> 2; if (rt >= tstart[NEXP]) break;
        int e = 0;
        for (int q = 1; q < NEXP; ++q) e = (rt >= tstart[q]) ? q : e;
        const int n = (int)cnt[e];
        for (int r = F.tid; r < 256; r += NTHR) { const int idx = (rt - tstart[e]) * 256 + r; tab[i * 256 + r] = (unsigned)list[(size_t)e * LIST_CAP + (idx < n ? idx : 0)] * (unsigned)(D * 2); }
    }
    __syncthreads();
}
DEVI void ph_zero_ksum(const Frame& F, float* ksum) { for (int i = F.gt; i < BATCH * NH * NBLK * 64; i += F.NGT) ksum[i] = 0.f; }

namespace attn_body {
using bf16=__hip_bfloat16;
using bf16x8=__attribute__((ext_vector_type(8)))short;
using s16x4=__attribute__((ext_vector_type(4)))short;
using f32x16=__attribute__((ext_vector_type(16)))float;
using f32x4=__attribute__((ext_vector_type(4)))float;
using u32x4=__attribute__((ext_vector_type(4)))unsigned;
constexpr int BATCH=8,NHEAD=8,SEQ=4096,D=64,DM=NHEAD*D;
constexpr int NW=8,QBLK=32,QB=QBLK*NW,KVBLK=64,NQB=SEQ/QB;
constexpr int ATTN_PITCH=DM, ATTN_UNIT_ROWS=QB;
__device__ __forceinline__ int crow(int r,int hi){return (r&3)+8*(r>>2)+4*hi;}
#define SBAR() __builtin_amdgcn_sched_barrier(0)
__device__ __forceinline__ void cmask(f32x16&p0,f32x16&p1,int jb,int qrel,int hi){
  const float NEG=-INFINITY; int kb=64*jb+4*hi;
  #pragma unroll
  for(int r=0;r<16;++r){int kv=kb+(r&3)+8*(r>>2); if(kv>qrel)p0[r]=NEG; if(kv+32>qrel)p1[r]=NEG;}
}

constexpr int NSLOT=3, SLOTB=8192;
constexpr int LDS_K=0, LDS_V=NSLOT*SLOTB, LDS_WS=2*NSLOT*SLOTB, LDS_OST=LDS_WS+NW*64*4, LDS_BYTES=LDS_OST+NW*4096;
constexpr float C2=0.125f*1.4426950408889634f;
__device__ __forceinline__ void glds16(const void*gsrc,unsigned lds_dst){unsigned keep;
  asm volatile("s_mov_b32 %0, m0\n\ts_mov_b32 m0, %2\n\ts_nop 0\n\tglobal_load_lds_dwordx4 %1, off\n\ts_mov_b32 m0, %0":"=&s"(keep):"v"(gsrc),"s"(lds_dst):"memory");}
__device__ __forceinline__ float max3f(float a,float b,float c){float r;asm("v_max3_f32 %0, %1, %2, %3":"=v"(r):"v"(a),"v"(b),"v"(c));return r;}
__device__ __forceinline__ float max2f(float a,float b){float r;asm("v_max_f32_e32 %0, %1, %2":"=v"(r):"v"(a),"v"(b));return r;}
__device__ __forceinline__ float fadd_s(float a,float b){float r;asm("v_add_f32_e32 %0, %1, %2":"=v"(r):"v"(a),"v"(b));return r;}
__device__ __forceinline__ float fsub_s(float a,float b){float r;asm("v_sub_f32_e32 %0, %1, %2":"=v"(r):"v"(a),"v"(b));return r;}
typedef float f32x2_t __attribute__((ext_vector_type(2))); typedef __bf16 bf16x2_t __attribute__((ext_vector_type(2)));
__device__ __forceinline__ unsigned cvtpk_s(float lo,float hi){f32x2_t v={lo,hi};bf16x2_t b=__builtin_convertvector(v,bf16x2_t);return __builtin_bit_cast(unsigned,b);}
#define WAIT_BAR(N) asm volatile("s_waitcnt vmcnt(" #N ") lgkmcnt(0)\n\ts_barrier":::"memory")

__device__ __forceinline__ void qkt(f32x16&p0,f32x16&p1,const char*Kslot,const bf16x8*qr,const f32x16&negm,int r32,int hi){
  const char*kb=Kslot+hi*1024+r32*16;
  #pragma unroll
  for(int d0=0;d0<4;++d0){
    const bf16x8 b0=*reinterpret_cast<const bf16x8*>(kb+d0*2048);
    const bf16x8 b1=*reinterpret_cast<const bf16x8*>(kb+d0*2048+512);
    if(d0==0){p0=__builtin_amdgcn_mfma_f32_32x32x16_bf16(b0,qr[0],negm,0,0,0);p1=__builtin_amdgcn_mfma_f32_32x32x16_bf16(b1,qr[0],negm,0,0,0);}
    else{p0=__builtin_amdgcn_mfma_f32_32x32x16_bf16(b0,qr[d0],p0,0,0,0);p1=__builtin_amdgcn_mfma_f32_32x32x16_bf16(b1,qr[d0],p1,0,0,0);}}
}
typedef __attribute__((address_space(3))) const char* lds_cptr;
typedef short v4i16_t __attribute__((ext_vector_type(4)));
__device__ __forceinline__ void kload8(bf16x8*kf,lds_cptr kp){
  kf[0]=*(const __attribute__((address_space(3))) bf16x8*)(kp);      kf[1]=*(const __attribute__((address_space(3))) bf16x8*)(kp+512);
  kf[2]=*(const __attribute__((address_space(3))) bf16x8*)(kp+2048); kf[3]=*(const __attribute__((address_space(3))) bf16x8*)(kp+2560);
  kf[4]=*(const __attribute__((address_space(3))) bf16x8*)(kp+4096); kf[5]=*(const __attribute__((address_space(3))) bf16x8*)(kp+4608);
  kf[6]=*(const __attribute__((address_space(3))) bf16x8*)(kp+6144); kf[7]=*(const __attribute__((address_space(3))) bf16x8*)(kp+6656);
}
__device__ __forceinline__ void kload2(bf16x8*kf,lds_cptr kp,int j){ kf[2*j]=*(const __attribute__((address_space(3))) bf16x8*)(kp+j*2048); kf[2*j+1]=*(const __attribute__((address_space(3))) bf16x8*)(kp+j*2048+512); }
__device__ __forceinline__ s16x4 vtr(lds_cptr p){ return __builtin_bit_cast(s16x4,__builtin_amdgcn_ds_read_tr16_b64_v4i16((__attribute__((address_space(3))) v4i16_t*)p)); }
__device__ __forceinline__ float rowmax(const f32x16&p0,const f32x16&p1){
  float a=max3f(p0[0],p0[1],p1[0]),b=max3f(p0[2],p0[3],p1[1]);a=max3f(a,p1[2],p1[3]);
  #pragma unroll
  for(int r=4;r<16;r+=4){a=max3f(a,p0[r],p0[r+1]);b=max3f(b,p0[r+2],p0[r+3]);a=max3f(a,p1[r],p1[r+1]);b=max3f(b,p1[r+2],p1[r+3]);}
  const float m=max2f(a,b);
  auto rr=__builtin_amdgcn_permlane32_swap(__float_as_uint(m),__float_as_uint(m),false,false);
  return max2f(__uint_as_float(rr[0]),__uint_as_float(rr[1]));
}
__device__ __forceinline__ void pv(f32x16*o,int vb,bf16x8 pa0,bf16x8 pa1,bf16x8 pa2,bf16x8 pa3){
  #pragma unroll
  for(int d0=0;d0<2;++d0){s16x4 lo[4],hi[4];
    #pragma unroll
    for(int ks=0;ks<4;++ks){
      asm volatile("ds_read_b64_tr_b16 %0,%1 offset:%c2":"=&v"(lo[ks]):"v"(vb),"i"(d0*4096+ks*1024):"memory");
      asm volatile("ds_read_b64_tr_b16 %0,%1 offset:%c2":"=&v"(hi[ks]):"v"(vb),"i"(d0*4096+ks*1024+512):"memory");}
    asm volatile("s_waitcnt lgkmcnt(0)":::"memory");SBAR();
    #define PK(k) (bf16x8){lo[k][0],lo[k][1],lo[k][2],lo[k][3],hi[k][0],hi[k][1],hi[k][2],hi[k][3]}
    o[d0]=__builtin_amdgcn_mfma_f32_32x32x16_bf16(pa0,PK(0),o[d0],0,0,0);
    o[d0]=__builtin_amdgcn_mfma_f32_32x32x16_bf16(pa1,PK(1),o[d0],0,0,0);
    o[d0]=__builtin_amdgcn_mfma_f32_32x32x16_bf16(pa2,PK(2),o[d0],0,0,0);
    o[d0]=__builtin_amdgcn_mfma_f32_32x32x16_bf16(pa3,PK(3),o[d0],0,0,0);
    #undef PK
  }
}

#ifndef ATTN_STORE16
#define ATTN_STORE16(p,v) (*(u32x4*)(p)=(v))
#endif
template<int THRL> __device__ __forceinline__ void attn_unit(int b,int h,int qb,const bf16*Q,const bf16*__restrict__ K,const bf16*__restrict__ V,bf16*O,const unsigned*__restrict__ sel,char*shm,int tid_in){
  const int tid=tid_in,lane=tid&63,r32=lane&31,hi=lane>>5; const int wid=__builtin_amdgcn_readfirstlane(tid>>6);
  const long rowbase=(long)b*SEQ; const int q0=qb*QB;
  const bf16*Qw=Q+(rowbase+q0+wid*QBLK)*DM+h*D;
  const bf16*Kh=K+rowbase*DM+h*D,*Vh=V+rowbase*DM+h*D;
  const unsigned lds0=(unsigned)(uintptr_t)shm;
  float*wsf=(float*)(shm+LDS_WS)+wid*64;
  const bf16*ksrc=Kh+(long)lane*DM+wid*8;
  const bf16*vsrc=Vh+(long)(16*(wid&3)+(lane>>2))*DM+(wid>>2)*32+(lane&3)*8;
  const unsigned kdst=lds0+LDS_K+wid*1024, vdst=lds0+LDS_V+wid*1024;
  #define DMA_K(t,slot) glds16(ksrc+(long)(t)*KVBLK*DM,(unsigned)__builtin_amdgcn_readfirstlane(kdst+(slot)))
  #define DMA_V(t,slot) glds16(vsrc+(long)(t)*KVBLK*DM,(unsigned)__builtin_amdgcn_readfirstlane(vdst+(slot)))
  const int vb0=(int)(lds0+LDS_V)+((lane>>4)&1)*32+(lane&3)*8+(4*hi+((lane&15)>>2))*64;
  const char*Kbase=shm+LDS_K; bf16x8 kf[8];
  const lds_cptr shm3=(lds_cptr)shm; const lds_cptr kp0=shm3+LDS_K+hi*1024+r32*16; const lds_cptr vp0=shm3+LDS_V+((lane>>4)&1)*32+(lane&3)*8+(4*hi+((lane&15)>>2))*64;
  const int NT=(q0+QB)/KVBLK;
  DMA_K(0,0);DMA_V(0,0);DMA_K(1,SLOTB);
  bf16x8 qr[4];
  #pragma unroll
  for(int d0=0;d0<4;++d0)qr[d0]=*reinterpret_cast<const bf16x8*>(&Qw[(long)r32*DM+d0*16+hi*8]);
  const unsigned selmask=sel[((size_t)(b*NHEAD+h))*SEQ+q0+wid*QBLK+r32];
  const float NEGINF=-INFINITY;
  float mhat=0.f,l_reg=0.f;f32x16 o[2];o[0]=f32x16{};o[1]=f32x16{};f32x16 negm=f32x16{};asm volatile("":"+v"(negm));
  const int qrel=wid*QBLK+r32;
  #define CMASK(P0,P1,t) do{int jb_=(t)-(NT-4); if(jb_>=0)cmask(P0,P1,jb_,qrel,hi);}while(0)
  bool resc=false;
  #define START(P0,P1) do{ const float rm=rowmax(P0,P1); resc=false; \
    { const float dl=__builtin_fmaxf(rm,-64.f); mhat=fadd_s(mhat,dl); \
      _Pragma("unroll") for(int r=0;r<16;++r){P0[r]=fsub_s(P0[r],dl);P1[r]=fsub_s(P1[r],dl);} \
      _Pragma("unroll") for(int r=0;r<16;++r)negm[r]=-mhat; asm volatile("":"+v"(negm)); } \
    _Pragma("unroll") for(int r=0;r<16;++r)P0[r]=__builtin_amdgcn_exp2f(P0[r]); }while(0)
  #define RESC() do{ if(resc){ asm volatile("s_waitcnt lgkmcnt(0)":::"memory"); \
      _Pragma("unroll") for(int d_=0;d_<2;++d_) _Pragma("unroll") for(int r=0;r<16;++r)o[d_][r]*=wsf[crow(r,hi)]; } }while(0)
  f32x16 pA0,pA1,pB0,pB1;
  int sl_prev=0,sl_cur=0,sl_next=SLOTB;
  #define ROT() do{sl_prev=sl_cur;sl_cur=sl_next;sl_next=(sl_next==(NSLOT-1)*SLOTB)?0:sl_next+SLOTB;}while(0)
  DMA_K(2,2*SLOTB);
  WAIT_BAR(3);
  #define SETNEGM(t) do{ const bool keep_=((t)>=NT-4)||(((selmask>>((t)>>2))&1u)!=0u); const float nm_=keep_?-mhat:NEGINF; _Pragma("unroll") for(int r=0;r<16;++r)negm[r]=nm_; asm volatile("":"+v"(negm)); }while(0)
  SETNEGM(0);
  qkt(pA0,pA1,Kbase,qr,negm,r32,hi);asm volatile("s_nop 15\n\ts_nop 7":"+v"(pA0),"+v"(pA1));CMASK(pA0,pA1,0);
  START(pA0,pA1);
  _Pragma("unroll") for(int r=0;r<16;++r)pA1[r]=__builtin_amdgcn_exp2f(pA1[r]);
  WAIT_BAR(0);
  DMA_K(3,0);DMA_V(1,SLOTB);
  ROT();
  kload8(kf,kp0+sl_cur);
  WAIT_BAR(2);
  s16x4 vlo[8],vhi[8]; u32x4 pw0,pw1,pw2,pw3;
  #define PKW(P,B) cvtpk_s(P[B],P[B+1])
  #define PAF(k) __builtin_bit_cast(bf16x8,pw##k)
  #define VFR(i) (bf16x8){vlo[i][0],vlo[i][1],vlo[i][2],vlo[i][3],vhi[i][0],vhi[i][1],vhi[i][2],vhi[i][3]}
  #define PIN(x) asm volatile("":"+v"(x))
  #define MX3(a,b,c) __builtin_fmaxf(__builtin_fmaxf((a),(b)),(c))
  #define GAPA(MF,A0,A1,A2,A3,W0,W1,PW) do{ MF; sacc+=A0; sacc+=A1; sacc+=A2; sacc+=A3; PIN(sacc); W0; W1; PIN(PW); SBAR(); }while(0)
  #define EX(v) __builtin_amdgcn_exp2f(v)
  #define GAPB(MF,X,B) do{ MF; X[B]=EX(X[B]); X[B+1]=EX(X[B+1]); X[B+2]=EX(X[B+2]); X[B+3]=EX(X[B+3]); PIN(X); SBAR(); }while(0)
  #define VRD(i) do{ vlo[i]=vtr(vp_+(((i)>>2)*4096+((i)&3)*1024)); vhi[i]=vtr(vp_+(((i)>>2)*4096+((i)&3)*1024+512)); }while(0)
  #define KRD(G,j) do{ if(G){ kload2(kf,kp0+sl_next,j); SBAR(); } }while(0)
  #define STEP(C0,C1,P0,P1,t,GK,GV,GL) do{ SBAR(); SETNEGM(t); SBAR(); \
    const lds_cptr vp_=vp0+sl_prev; \
    VRD(0); SBAR(); float sacc=(P0[0]+P0[1]); \
    GAPA(C0=__builtin_amdgcn_mfma_f32_32x32x16_bf16(kf[0],qr[0],negm,0,0,0), P0[2],P0[3],P0[4],P0[5],     pw0[0]=PKW(P0,0), pw0[1]=PKW(P0,2), pw0); \
    VRD(4); SBAR(); GAPA(C1=__builtin_amdgcn_mfma_f32_32x32x16_bf16(kf[1],qr[0],negm,0,0,0), P0[6],P0[7],P0[8],P0[9],     pw0[2]=PKW(P0,4), pw0[3]=PKW(P0,6), pw0); \
    VRD(1); SBAR(); GAPA(C0=__builtin_amdgcn_mfma_f32_32x32x16_bf16(kf[2],qr[1],C0,0,0,0),   P0[10],P0[11],P0[12],P0[13], pw1[0]=PKW(P0,8), pw1[1]=PKW(P0,10), pw1); \
    VRD(5); SBAR(); GAPA(C1=__builtin_amdgcn_mfma_f32_32x32x16_bf16(kf[3],qr[1],C1,0,0,0),   P0[14],P0[15],P1[0],P1[1],   pw1[2]=PKW(P0,12),pw1[3]=PKW(P0,14), pw1); \
    VRD(2); SBAR(); GAPA(C0=__builtin_amdgcn_mfma_f32_32x32x16_bf16(kf[4],qr[2],C0,0,0,0),   P1[2],P1[3],P1[4],P1[5],     pw2[0]=PKW(P1,0), pw2[1]=PKW(P1,2), pw2); \
    VRD(6); SBAR(); GAPA(C1=__builtin_amdgcn_mfma_f32_32x32x16_bf16(kf[5],qr[2],C1,0,0,0),   P1[6],P1[7],P1[8],P1[9],     pw2[2]=PKW(P1,4), pw2[3]=PKW(P1,6), pw2); \
    VRD(3); SBAR(); GAPA(C0=__builtin_amdgcn_mfma_f32_32x32x16_bf16(kf[6],qr[3],C0,0,0,0),   P1[10],P1[11],P1[12],P1[13], pw3[0]=PKW(P1,8), pw3[1]=PKW(P1,10), pw3); \
    VRD(7); SBAR(); GAPA(C1=__builtin_amdgcn_mfma_f32_32x32x16_bf16(kf[7],qr[3],C1,0,0,0),   P1[14],P1[15],0.f,0.f,       pw3[2]=PKW(P1,12),pw3[3]=PKW(P1,14), pw3); \
    l_reg+=sacc; \
    if(GK){DMA_K((t)+3,sl_cur);} if(GV){DMA_V((t)+1,sl_next);} \
    CMASK(C0,C1,t); \
    { float a=MX3(C0[0],C0[1],C1[0]),b=MX3(C0[2],C0[3],C1[1]); a=MX3(a,C1[2],C1[3]); \
      _Pragma("unroll") for(int r=4;r<16;r+=4){a=MX3(a,C0[r],C0[r+1]);b=MX3(b,C0[r+2],C0[r+3]);a=MX3(a,C1[r],C1[r+1]);b=MX3(b,C1[r+2],C1[r+3]);} \
      float rm=__builtin_fmaxf(a,b); { auto rr=__builtin_amdgcn_permlane32_swap(__float_as_uint(rm),__float_as_uint(rm),false,false); rm=__builtin_fmaxf(__uint_as_float(rr[0]),__uint_as_float(rr[1])); } \
      resc=false; \
      if(__builtin_expect(__any(rm>(float)THRL),0)){ const float dl=__builtin_fmaxf(rm,0.f); mhat+=dl; \
        _Pragma("unroll") for(int r=0;r<16;++r){C0[r]-=dl;C1[r]-=dl;} \
        const float f=__builtin_amdgcn_exp2f(-dl); l_reg*=f; if(hi==0)wsf[r32]=f; resc=true; } } \
    SBAR(); \
    GAPB(o[0]=__builtin_amdgcn_mfma_f32_32x32x16_bf16(PAF(0),VFR(0),o[0],0,0,0), C0,0); \
    GAPB(o[1]=__builtin_amdgcn_mfma_f32_32x32x16_bf16(PAF(0),VFR(4),o[1],0,0,0), C0,4); \
    KRD(GL,0); GAPB(o[0]=__builtin_amdgcn_mfma_f32_32x32x16_bf16(PAF(1),VFR(1),o[0],0,0,0), C0,8); \
    KRD(GL,1); GAPB(o[1]=__builtin_amdgcn_mfma_f32_32x32x16_bf16(PAF(1),VFR(5),o[1],0,0,0), C0,12); \
    KRD(GL,2); GAPB(o[0]=__builtin_amdgcn_mfma_f32_32x32x16_bf16(PAF(2),VFR(2),o[0],0,0,0), C1,0); \
    KRD(GL,3); GAPB(o[1]=__builtin_amdgcn_mfma_f32_32x32x16_bf16(PAF(2),VFR(6),o[1],0,0,0), C1,4); \
    GAPB(o[0]=__builtin_amdgcn_mfma_f32_32x32x16_bf16(PAF(3),VFR(3),o[0],0,0,0), C1,8); \
    GAPB(o[1]=__builtin_amdgcn_mfma_f32_32x32x16_bf16(PAF(3),VFR(7),o[1],0,0,0), C1,12); \
    }while(0)
  int t=1;
  #undef CMASK
  #define CMASK(P0,P1,t) do{}while(0)
  for(;t+5<NT;t+=2){
    STEP(pB0,pB1,pA0,pA1,t,true,true,true);     WAIT_BAR(2); RESC(); ROT();
    STEP(pA0,pA1,pB0,pB1,t+1,true,true,true);   WAIT_BAR(2); RESC(); ROT();
  }
  #undef CMASK
  #define CMASK(P0,P1,t) do{int jb_=(t)-(NT-4); if(jb_>=0)cmask(P0,P1,jb_,qrel,hi);}while(0)
  #define ENDW(tt) do{ if((tt)+3<NT){WAIT_BAR(2);} else if((tt)+2<NT){WAIT_BAR(1);} else {WAIT_BAR(0);} }while(0)
  for(;t+1<NT;t+=2){
    STEP(pB0,pB1,pA0,pA1,t,(t+3<NT),(t+1<NT),(t+1<NT));       ENDW(t);   RESC(); ROT();
    STEP(pA0,pA1,pB0,pB1,t+1,(t+4<NT),(t+2<NT),(t+2<NT));     ENDW(t+1); RESC(); ROT();
  }
  STEP(pB0,pB1,pA0,pA1,NT-1,false,false,false); RESC();
  { float sacc=pB0[0]+pB0[1]; _Pragma("unroll") for(int r=2;r<16;++r)sacc+=pB0[r]; _Pragma("unroll") for(int r=0;r<16;++r)sacc+=pB1[r]; l_reg+=sacc;
    pw0=(u32x4){PKW(pB0,0),PKW(pB0,2),PKW(pB0,4),PKW(pB0,6)};pw1=(u32x4){PKW(pB0,8),PKW(pB0,10),PKW(pB0,12),PKW(pB0,14)};pw2=(u32x4){PKW(pB1,0),PKW(pB1,2),PKW(pB1,4),PKW(pB1,6)};pw3=(u32x4){PKW(pB1,8),PKW(pB1,10),PKW(pB1,12),PKW(pB1,14)};
    SBAR(); pv(o,vb0+sl_cur,PAF(0),PAF(1),PAF(2),PAF(3)); }
  #undef PKW
  #undef PAF
  #undef VFR
  #undef PIN
  #undef MX3
  #undef GAPA
  #undef GAPB
  #undef EX
  #undef VRD
  #undef KRD
  #undef STEP
  #undef ENDW
  {auto rr=__builtin_amdgcn_permlane32_swap(__float_as_uint(l_reg),__float_as_uint(l_reg),false,false);l_reg=__uint_as_float(rr[0])+__uint_as_float(rr[1]);}
  if(hi==0)wsf[32+r32]=l_reg;asm volatile("s_waitcnt lgkmcnt(0)":::"memory");
  float rli[16];
  #pragma unroll
  for(int r=0;r<16;++r)rli[r]=__builtin_amdgcn_rcpf(wsf[32+crow(r,hi)]);
  bf16*Ow=O+(rowbase+q0+wid*QBLK)*DM+h*D;
  { bf16*stg=(bf16*)(shm+LDS_OST)+wid*2048;
    #pragma unroll
    for(int r=0;r<16;++r){const int orow=crow(r,hi);
      #pragma unroll
      for(int d0=0;d0<2;++d0)stg[orow*64+d0*32+r32]=__float2bfloat16(o[d0][r]*rli[r]);}
    asm volatile("s_waitcnt lgkmcnt(0)":::"memory");
    #pragma unroll
    for(int i=0;i<4;++i){const int row=i*8+(lane>>3),ch=lane&7; const u32x4 v=*(const u32x4*)(stg+row*64+ch*8); ATTN_STORE16(Ow+(long)row*DM+ch*8,v);} }
  asm volatile("s_waitcnt lgkmcnt(0)\n\ts_barrier":::"memory");
  #undef DMA_K
  #undef DMA_V
  #undef CMASK
  #undef START
  #undef SETNEGM
  #undef RESC
  #undef ROT
}
constexpr int ATTN_LDS_BYTES=LDS_BYTES;
struct AttnTensors { const bf16* Q; const bf16* K; const bf16* V; bf16* O; const unsigned* sel; };
struct AttnUnit { int bh; int qb; };
struct StaticOrder {
  int vcu,grid;
  __device__ __forceinline__ explicit StaticOrder(int grid_,int block):vcu((grid_%8==0)?(block%8)*(grid_/8)+block/8:block),grid(grid_){}
  __device__ __forceinline__ bool next(int i,AttnUnit&u)const{
    if(grid==256){ if(i>=4)return false; const int s=vcu&3; u.bh=vcu>>2; u.qb=(i==0)?s:(i==1)?7-s:(i==2)?8+s:15-s; return true; }
    const int U=i*grid+vcu; if(U>=BATCH*NHEAD*NQB)return false; u.bh=U/NQB; u.qb=U%NQB; return true; }
  __device__ __forceinline__ void a_ready(const AttnUnit&)const{}
  __device__ __forceinline__ void done(const AttnUnit&)const{}
};
template<class Sched,int THRL=8> __device__ __forceinline__ void attn_phase(char*lds,const AttnTensors&T,const Sched&S,int tid_in){
  AttnUnit u;
  for(int i=0;S.next(i,u);++i){ S.a_ready(u); attn_unit<THRL>(u.bh/NHEAD,u.bh%NHEAD,u.qb,T.Q,T.K,T.V,T.O,T.sel,lds,tid_in); S.done(u); }
}
#undef SBAR
#undef WAIT_BAR
}


DEVI void ph_moba_select(const Frame& F, const bf16_t* Q, const float* ksum, unsigned* sel) {
    for (int idx = F.gt; idx < BATCH * NH * SEQ; idx += F.NGT) {
        const int s = idx & (SEQ - 1), bh = idx >> 12, b = bh >> 3, hh = bh & 7, qb = s >> 8;
        const bf16_t* qp = Q + ((size_t)b * SEQ + s) * 512 + hh * 64;
        float q[64];
#pragma unroll
        for (int i = 0; i < 8; ++i) { const bf16x8 t = *((const bf16x8*)qp + i);
#pragma unroll
            for (int j = 0; j < 8; ++j) q[8 * i + j] = bf2f((bf16_t)t[j]); }
        float gsc[15];
#pragma unroll
        for (int j = 0; j < 15; ++j) { gsc[j] = -INFINITY;
            if (j < qb) { const float* km = ksum + ((size_t)bh * 16 + j) * 64; float a = 0.f;
#pragma unroll
                for (int i = 0; i < 64; ++i) a += q[i] * km[i];
                gsc[j] = a; } }
        unsigned m = 0u;
#pragma unroll
        for (int t = 0; t < 3; ++t) { float best = -INFINITY; int bi = -1;
#pragma unroll
            for (int j = 0; j < 15; ++j) { const bool ok = (j < qb) && !((m >> j) & 1u) && (gsc[j] > best); best = ok ? gsc[j] : best; bi = ok ? j : bi; }
            if (bi >= 0) m |= 1u << bi; }
        sel[idx] = m;
    }
}


DEVI void ph_router_weights(const Frame& F, const float* wg, const float* we, bf16_t* wr) {
    for (int idx = F.gt; idx < DEPTH * 48 * 1024; idx += F.NGT) {
        const int l = idx / (48 * 1024), r = idx % (48 * 1024), o = r >> 10, kk = r & 1023;
        const float v = (o < 4) ? wg[((size_t)l * D + kk) * 4 + o] : (o < 36) ? we[((size_t)l * D + kk) * 32 + (o - 4)] : 0.f;
        const bf16_t hi = f2bf(v), lo = f2bf(v - bf2f(hi));
        wr[((size_t)l * 2 + 0) * 48 * 1024 + r] = hi; wr[((size_t)l * 2 + 1) * 48 * 1024 + r] = lo;
    }
}
DEVI void ph_norm_router_mfma(const Frame& F, const bf16_t* x, const float* g, const bf16_t* wr, const float* bg, const float* be, bf16_t* h2, unsigned* cnt, int* list, unsigned* rec) {
    const int lane = F.lane, ri = lane & 15, q = lane >> 4;
    LAS float* lg = (LAS float*)(F.lds + F.wave * 3072);
    volatile LAS unsigned* hist = (volatile LAS unsigned*)(F.lds + 8 * 3072);
    const bf16_t* whi = wr; const bf16_t* wlo = wr + 48 * 1024;
    for (int tile = blockIdx.x; tile < NTOK / 128; tile += F.G) {
        if (F.tid < 64) hist[F.tid] = 0u;
        const int row = tile * 128 + F.wave * 16 + ri;
        const bf16_t* xr = x + (size_t)row * D + 8 * q;
        float ss = 0.f;
#pragma unroll 8
        for (int kk = 0; kk < 32; ++kk) { const u32x4 xw = *(const u32x4*)(xr + 32 * kk); const f32x4 a = pg8::unpk_lo(xw, 0), b = pg8::unpk_lo(xw, 1);
            ss += (a[0] * a[0] + a[1] * a[1]) + (a[2] * a[2] + a[3] * a[3]) + (b[0] * b[0] + b[1] * b[1]) + (b[2] * b[2] + b[3] * b[3]); }
        ss += xshfl(ss, 16, lane); ss += xshfl(ss, 32, lane);
        const float rstd = 1.0f / sqrtf(ss * (1.0f / D) + NORM_EPS);
        f32x4 acc[3] = {(f32x4){0.f, 0.f, 0.f, 0.f}, (f32x4){0.f, 0.f, 0.f, 0.f}, (f32x4){0.f, 0.f, 0.f, 0.f}};
#pragma unroll 2
        for (int kk = 0; kk < 32; ++kk) {
            const int k0 = 32 * kk + 8 * q;
            const u32x4 xw = *(const u32x4*)(xr + 32 * kk); const f32x4 a = pg8::unpk_lo(xw, 0), b = pg8::unpk_lo(xw, 1);
            const f32x4 ga = *(const f32x4*)(g + k0), gb = *(const f32x4*)(g + k0 + 4);
            const f32x4 ha = a * rstd * ga, hb = b * rstd * gb;
            const u32x4 hi = pg8::pk8(ha, hb);
            const f32x4 ra = ha - pg8::unpk_lo(hi, 0), rb = hb - pg8::unpk_lo(hi, 1);
            const u32x4 lo = pg8::pk8(ra, rb);
            *(u32x4*)(h2 + (size_t)row * D + k0) = hi;
            const bf16x8 ahi = __builtin_bit_cast(bf16x8, hi), alo = __builtin_bit_cast(bf16x8, lo);
#pragma unroll
            for (int t = 0; t < 3; ++t) {
                const bf16x8 bh = *(const bf16x8*)(whi + (size_t)(16 * t + ri) * 1024 + k0), bl = *(const bf16x8*)(wlo + (size_t)(16 * t + ri) * 1024 + k0);
                acc[t] = __builtin_amdgcn_mfma_f32_16x16x32_bf16(ahi, bh, acc[t], 0, 0, 0);
                acc[t] = __builtin_amdgcn_mfma_f32_16x16x32_bf16(alo, bh, acc[t], 0, 0, 0);
                acc[t] = __builtin_amdgcn_mfma_f32_16x16x32_bf16(ahi, bl, acc[t], 0, 0, 0);
            }
        }
#pragma unroll
        for (int t = 0; t < 3; ++t)
#pragma unroll
            for (int e = 0; e < 4; ++e) lg[(4 * q + e) * 48 + 16 * t + ri] = acc[t][e];
        __syncthreads();
        int e0 = 0, e1 = 0; float w0 = 0.f, w1 = 0.f; unsigned r0 = 0u, r1 = 0u;
        if (lane < 16) {
            const LAS float* L = lg + lane * 48;
            float gl[4]; int gt = 0; float gm = -INFINITY;
#pragma unroll
            for (int i = 0; i < 4; ++i) { gl[i] = L[i] + bg[i]; if (gl[i] > gm) { gm = gl[i]; gt = i; } }
            float gs = 0.f;
#pragma unroll
            for (int i = 0; i < 4; ++i) gs += __expf(gl[i] - gm);
            const float pgv = 1.0f / gs;
            float el[8]; float em = -INFINITY;
#pragma unroll
            for (int i = 0; i < 8; ++i) { el[i] = L[4 + gt * 8 + i] + be[gt * 8 + i]; em = fmaxf(em, el[i]); }
            int i1 = 0; float v1 = -INFINITY;
#pragma unroll
            for (int i = 0; i < 8; ++i) if (el[i] > v1) { v1 = el[i]; i1 = i; }
            int i2 = 0; float v2 = -INFINITY;
#pragma unroll
            for (int i = 0; i < 8; ++i) if (i != i1 && el[i] > v2) { v2 = el[i]; i2 = i; }
            const float p1 = __expf(v1 - em), p2 = __expf(v2 - em);
            w0 = pgv * p1 / (p1 + p2); w1 = pgv * p2 / (p1 + p2);
            e0 = gt * 8 + i1; e1 = gt * 8 + i2;
            r0 = __hip_atomic_fetch_add((LAS unsigned*)hist + e0, 1u, __ATOMIC_RELAXED, __HIP_MEMORY_SCOPE_WORKGROUP); r1 = __hip_atomic_fetch_add((LAS unsigned*)hist + e1, 1u, __ATOMIC_RELAXED, __HIP_MEMORY_SCOPE_WORKGROUP);
        }
        __syncthreads();
        if (F.tid < 32) { const unsigned n = hist[F.tid]; hist[32 + F.tid] = n ? atomicAdd(cnt + F.tid, n) : 0u; }
        __syncthreads();
        if (lane < 16) {
            const int tok = tile * 128 + F.wave * 16 + lane;
            const unsigned pos0 = hist[32 + e0] + r0, pos1 = hist[32 + e1] + r1;
            list[(size_t)e0 * LIST_CAP + pos0] = tok; list[(size_t)e1 * LIST_CAP + pos1] = tok;
            unsigned* rp = rec + (size_t)tok * 8;
            rp[0] = (unsigned)e0; rp[1] = (unsigned)e1; rp[2] = pos0; rp[3] = pos1; rp[4] = __float_as_uint(w0); rp[5] = __float_as_uint(w1);
        }
        __syncthreads();
    }
}


DEVI void ph_moba_select_mfma(const Frame& F, const bf16_t* Q, const float* ksum, unsigned* sel) {
    const int lane = F.lane, r = lane & 31, h = lane >> 5;
    for (int item = F.gw; item < BATCH * NH * (SEQ / 32); item += F.NGW) {
        const int qt = item & 127, bh = item >> 7, b = bh >> 3, hh = bh & 7, s0 = qt * 32, qb = s0 >> 8;
        if (qb == 0) { if (h == 0) sel[(size_t)bh * SEQ + s0 + r] = 0u; continue; }
        f32x16 acc = {};
#pragma unroll
        for (int s = 0; s < 4; ++s) {
            const bf16x8 bq = *(const bf16x8*)(Q + ((size_t)b * SEQ + s0 + r) * 512 + hh * 64 + 16 * s + 8 * h);
            f32x4 k0 = (f32x4){0.f, 0.f, 0.f, 0.f}, k1 = k0;
            if (r < 16) { const float* kp = ksum + ((size_t)bh * 16 + r) * 64 + 16 * s + 8 * h; k0 = *(const f32x4*)kp; k1 = *(const f32x4*)(kp + 4); }
            const u32x4 hi = pg8::pk8(k0, k1), lo = pg8::pk8(k0 - pg8::unpk_lo(hi, 0), k1 - pg8::unpk_lo(hi, 1));
            acc = __builtin_amdgcn_mfma_f32_32x32x16_bf16(__builtin_bit_cast(bf16x8, hi), bq, acc, 0, 0, 0);
            acc = __builtin_amdgcn_mfma_f32_32x32x16_bf16(__builtin_bit_cast(bf16x8, lo), bq, acc, 0, 0, 0);
        }
        float sc[16];
#pragma unroll
        for (int reg = 0; reg < 8; ++reg) { const float mine = acc[reg], other = xshfl(acc[reg], 32, lane); const int base = (reg & 3) + 8 * (reg >> 2);
            sc[base] = h ? other : mine; sc[base + 4] = h ? mine : other; }
        unsigned m = 0u;
#pragma unroll
        for (int t = 0; t < 3; ++t) { float best = -INFINITY; int bi = -1;
#pragma unroll
            for (int j = 0; j < 15; ++j) { const bool ok = (j < qb) && !((m >> j) & 1u) && (sc[j] > best); best = ok ? sc[j] : best; bi = ok ? j : bi; }
            if (bi >= 0) m |= 1u << bi; }
        if (h == 0) sel[(size_t)bh * SEQ + s0 + r] = m;
    }
}

constexpr int PH_PER_LAYER = 10, N_PHASES = 1 + DEPTH * PH_PER_LAYER;
__global__ void __launch_bounds__(NTHR, 2) mk_fwd(Args a) {
    extern __shared__ __attribute__((aligned(16))) unsigned char lds_raw[];
    Frame F0;
    F0.lds = (LAS unsigned char*)lds_raw;
    F0.tid = threadIdx.x; F0.lane = F0.tid & 63; F0.wave = __builtin_amdgcn_readfirstlane(F0.tid >> 6);
    F0.G = gridDim.x; F0.gw = blockIdx.x * NWAVES + F0.wave; F0.NGW = F0.G * NWAVES; F0.gt = blockIdx.x * NTHR + F0.tid; F0.NGT = F0.G * NTHR;
    volatile LAS unsigned* LCTL = (volatile LAS unsigned*)(F0.lds + LDSCTL_OFF);
    volatile LAS int* pstart = (volatile LAS int*)(F0.lds + LDSCTL_OFF + 256);
    for (int u = F0.tid; u < 256; u += NTHR) LCTL[u] = 0u;
    __syncthreads();
    unsigned* ctl = (unsigned*)(a.ws + WS_CTL);
    XcdBarrier bar = xcd_barrier_post(ctl + CW_BAR + a.li * XCD_BAR_WORDS, LCTL);

#define x_in (a.in[0])
#define norm1_g (a.in[1])
#define w_in (a.in[2])
#define ssm_d (a.in[10])
#define w_glu (a.in[11])
#define qng (a.in[12])
#define kng (a.in[13])
#define w_attn (a.in[14])
#define w_out (a.in[15])
#define norm2_g (a.in[16])
#define wgrp (a.in[17])
#define bgrp (a.in[18])
#define wexp (a.in[19])
#define bexp (a.in[20])
#define w_gu (a.in[21])
#define w_dn (a.in[22])
#define X (a.out)
#define rope ((float*)(ws + WS_ROPE))
#define AL ((float*)(ws + WS_MISC + MISC_AL))
#define ksum ((float*)(ws + WS_MISC + MISC_KSUM))
#define SEL ((unsigned*)(ws + WS_MISC + MISC_SEL))
#define rec ((unsigned*)(ws + WS_REC))
#define list ((int*)(ws + WS_LIST))
#define TC ((bf16_t*)(ws + WS_S5TC))
#define BS ((bf16_t*)(ws + WS_S5BS))
#define H ((bf16_t*)(ws + WS_H))
#define UCAT ((bf16_t*)(ws + WS_UCAT))
#define Qb ((bf16_t*)(ws + WS_Q))
#define Kb ((bf16_t*)(ws + WS_K))
#define Vb ((bf16_t*)(ws + WS_V))
#define SG ((bf16_t*)(ws + WS_SG))
#define Z ((bf16_t*)(ws + WS_Z))
#define ATT ((bf16_t*)(ws + WS_ATT))
#define MIXA ((bf16_t*)(ws + WS_MIXA))
#define MIXED ((bf16_t*)(ws + WS_MIXED))
#define SL ((float*)(ws + WS_SL))
#define HMID ((bf16_t*)(ws + WS_HMID))
#define YBUF ((bf16_t*)(ws + WS_YBUF))
#define QRAW ((float*)(ws + WS_QRAW))
#define KRAW ((float*)(ws + WS_KRAW))
#define WIN ((bf16_t*)(ws + WS_WIN))
#define WGLU ((bf16_t*)(ws + WS_WGLU))
#define WATT ((bf16_t*)(ws + WS_WATT))
#define WOUT ((bf16_t*)(ws + WS_WOUT))
#define WGU ((bf16_t*)(ws + WS_WGU))
#define WDN ((bf16_t*)(ws + WS_WDN))
#define WR ((bf16_t*)(ws + WS_MISC + MISC_WR))
#define XB ((bf16_t*)(ws + WS_XB))
    const int lo = a.ph_lo, hi = a.ph_hi;
    int ph = 0; unsigned bgen = 0u;
#define PH_BEGIN if (ph >= lo && ph < hi) { for (int rep_ = 0; rep_ < ((((unsigned long long)REP_MASK >> ph) & 1ull) ? 2 : 1); ++rep_) { if (rep_) __syncthreads(); Frame P = F0; unsigned long long wz_ = 0ull; asm volatile("" : "+s"(wz_)); unsigned char* ws = a.ws + wz_;     { int t_ = F0.wave * 64 + (int)__builtin_amdgcn_mbcnt_hi(~0u, __builtin_amdgcn_mbcnt_lo(~0u, 0u)); asm volatile("" : "+v"(t_));     P.tid = t_; P.lane = t_ & 63; P.gt = (int)blockIdx.x * NTHR + t_; P.wave = __builtin_amdgcn_readfirstlane(t_ >> 6); P.gw = (int)blockIdx.x * NWAVES + P.wave; }
#define PH_END   } if (ph + 1 < hi) { ++bgen; xcd_barrier_w(bar, bgen, LCTL + 4, make_cvtq(a, F0.lds, F0.wave, fresh_lane())); } } ++ph;

    const int vcu = (F0.G % 8 == 0) ? ((int)blockIdx.x % 8) * (F0.G / 8) + (int)blockIdx.x / 8 : (int)blockIdx.x;
    LAS unsigned char* ring = F0.lds;
    volatile LAS int* tstart = (volatile LAS int*)(F0.lds + LDSCTL_OFF + 512);
    LAS unsigned* gtab = (LAS unsigned*)(F0.lds + GTAB_OFF);

    PH_BEGIN
        ph_rope_table(P, rope);
        for (int it4 = blockIdx.x; it4 < DEPTH * SSM_G * 4; it4 += P.G) { const int it = it4 >> 2;
            s5_tables_item(it / SSM_G, it % SSM_G, a.in[3], a.in[4], a.in[5], a.in[6], a.in[7], a.in[8], a.in[9],
                           TC + (size_t)it * 512 * 640, BS + (size_t)it * 128 * 512, AL + (size_t)it * 128, (LAS float*)P.lds, P.tid, NTHR, it4 & 3); }
        ph_rmsnorm(P, x_in, norm1_g, H);
        ph_convert_first(P, make_cvtq(a, F0.lds, P.wave, P.lane));
        ph_router_weights(P, wgrp, wexp, WR);
    PH_END

    for (int l = 0; l < DEPTH; ++l) {
#define xin ((l == 0) ? x_in : (const float*)X)
#define cnt ((unsigned*)(ws + WS_CTL) + CW_CNT + l * NEXP)
        PH_BEGIN
            pg8::Gemm g{H, WIN + (size_t)l * D_IN * D, D, D, D, 0, 0}; pg8::StaticOrder S; S.init(NTOK, D_IN, P.G, (int)blockIdx.x);
            pg8::EpiG1 E{UCAT, Qb, Kb, Vb, SG, qng + l * 64, kng + l * 64, rope, QRAW, KRAW};
            pg8::gemm_phase<pg8::EpiG1, pg8::StaticOrder, pg8::NoGather, G1_ALIGN>(ring, g, S, E, pg8::NoGather{}, P.tid);
        PH_END
        PH_BEGIN
            if (P.G == 256) { if (blockIdx.x >= 128) { Frame Q2 = P; Q2.gw = P.gw - 128 * NWAVES; Q2.NGW = 128 * NWAVES; ph_ksum(Q2, Kb, ksum); } } else ph_ksum(P, Kb, ksum);
            { pg8::Gemm g{UCAT, BS + (size_t)l * SSM_G * 128 * 512, UK, 512, 512, (size_t)UROWS * UK, (size_t)128 * 512}; pg8::OrderS5A S{P.G, (int)blockIdx.x};
              pg8::EpiS5Am E{AL + (size_t)l * SSM_G * 128, UCAT};
              pg8::gemm_phase<pg8::EpiS5Am, pg8::OrderS5A, pg8::NoGather, false>(ring, g, S, E, pg8::NoGather{}, P.tid); }
        PH_END
        PH_BEGIN
            ph_moba_select_mfma(P, Qb, ksum, SEL);
            { pg8::Gemm g{UCAT, TC + (size_t)l * SSM_G * 512 * 640, UK, UK, UK, (size_t)UROWS * UK, (size_t)512 * 640}; pg8::OrderS5C S{P.G, (int)blockIdx.x};
              pg8::EpiS5Cm E{UCAT, ssm_d + l * SSM_W, Z};
              pg8::gemm_phase<pg8::EpiS5Cm, pg8::OrderS5C, pg8::NoGather, false>(ring, g, S, E, pg8::NoGather{}, P.tid); }
        PH_END
        PH_BEGIN
            { const attn_body::AttnTensors AT{(const attn_body::bf16*)Qb, (const attn_body::bf16*)Kb, (const attn_body::bf16*)Vb, (attn_body::bf16*)ATT, SEL};
              const attn_body::StaticOrder SA((int)P.G, (int)blockIdx.x);
              attn_body::attn_phase<attn_body::StaticOrder>((char*)lds_raw, AT, SA, P.tid); }
            { pg8::Gemm g{Z, WGLU + (size_t)l * 2048 * 512, 512, 512, 512, 0, 0}; pg8::StaticOrder S; S.init(NTOK, 2048, P.G, (int)blockIdx.x);
              pg8::EpiGlu E{SG, MIXA};
              pg8::gemm_phase<pg8::EpiGlu, pg8::StaticOrder, pg8::NoGather, true>(ring, g, S, E, pg8::NoGather{}, P.tid); }
        PH_END
        PH_BEGIN
            pg8::Gemm g{ATT, WATT + (size_t)l * 1024 * 512, 512, 512, 512, 0, 0}; pg8::StaticOrder S; S.init(NTOK, 1024, P.G, (int)blockIdx.x);
            pg8::EpiMix E{SG, MIXA, MIXED};
            pg8::gemm_phase<pg8::EpiMix, pg8::StaticOrder, pg8::NoGather, true>(ring, g, S, E, pg8::NoGather{}, P.tid);
        PH_END
        PH_BEGIN
            pg8::Gemm g{MIXED, WOUT + (size_t)l * 1024 * 1024, 1024, 1024, 1024, 0, 0}; pg8::StaticOrder S; S.init(NTOK, 1024, P.G, (int)blockIdx.x);
            if (l == 0) { pg8::EpiResBf16<true> E{x_in, XB}; pg8::gemm_phase<pg8::EpiResBf16<true>, pg8::StaticOrder, pg8::NoGather, true>(ring, g, S, E, pg8::NoGather{}, P.tid); }
            else { pg8::EpiResBf16<false> E{nullptr, XB}; pg8::gemm_phase<pg8::EpiResBf16<false>, pg8::StaticOrder, pg8::NoGather, true>(ring, g, S, E, pg8::NoGather{}, P.tid); }
        PH_END
        PH_BEGIN make_cvtq(a, F0.lds, P.wave, P.lane).catchup(l == 0 ? CVQ_LIM_MOE0 : CVQ_TOTAL); __syncthreads(); ph_norm_router_mfma(P, XB, norm2_g + l * D, WR + (size_t)l * 2 * 48 * 1024, bgrp + l * 4, bexp + l * 32, H, cnt, list, rec); PH_END
        PH_BEGIN
            moe_tstart(P, cnt, tstart); moe_gather_table(P, vcu, cnt, list, tstart, gtab);
            pg8::Gemm g{H, WGU + (size_t)l * NEXP * 1024 * 1024, D, 1024, 1024, 0, (size_t)1024 * 1024}; pg8::OrderMoE S{P.G, vcu, tstart};
            pg8::EpiSwiglu E{HMID};
            pg8::gemm_phase<pg8::EpiSwiglu, pg8::OrderMoE, pg8::LdsGather, true>(ring, g, S, E, pg8::LdsGather{gtab}, P.tid);
        PH_END
        PH_BEGIN
            moe_tstart(P, cnt, tstart);
            pg8::Gemm g{HMID, WDN + (size_t)l * NEXP * 1024 * 512, 512, 512, 512, 0, (size_t)1024 * 512}; pg8::OrderMoE S{P.G, vcu, tstart};
            pg8::EpiStoreBf16 E{YBUF, 1024};
            pg8::gemm_phase<pg8::EpiStoreBf16, pg8::OrderMoE, pg8::NoGather, true>(ring, g, S, E, pg8::NoGather{}, P.tid);
        PH_END
        PH_BEGIN
            if (l + 1 < DEPTH) { make_cvtq(a, F0.lds, P.wave, P.lane).catchup(CVQ_LIM_PROJ1); __syncthreads(); }
            compute_pstart(P, cnt, pstart);
            if (l + 1 < DEPTH) ph_combine<false>(P, XB, X, YBUF, rec, pstart, norm1_g + (l + 1) * D, H);
            else ph_combine<true>(P, XB, X, YBUF, rec, pstart, nullptr, H);
        PH_END
    }
#undef PH_BEGIN
#undef PH_END
#undef x_in
#undef norm1_g
#undef w_in
#undef ssm_d
#undef w_glu
#undef qng
#undef kng
#undef w_attn
#undef w_out
#undef norm2_g
#undef wgrp
#undef bgrp
#undef wexp
#undef bexp
#undef w_gu
#undef w_dn
#undef X
#undef rope
#undef AL
#undef ksum
#undef SEL
#undef rec
#undef list
#undef TC
#undef BS
#undef H
#undef UCAT
#undef Qb
#undef Kb
#undef Vb
#undef SG
#undef Z
#undef ATT
#undef MIXA
#undef MIXED
#undef SL
#undef HMID
#undef YBUF
#undef QRAW
#undef KRAW
#undef WIN
#undef WGLU
#undef WATT
#undef WOUT
#undef WGU
#undef WDN
#undef WR
#undef XB
#undef xin
#undef cnt
}

extern "C" void kernel_launch(void* const* d_in, const int* in_sizes, int n_in, void* d_out, int out_size, void* d_ws, size_t ws_size, hipStream_t stream) {
    static int grid = 0;
    if (grid == 0) {
        if (n_in != 23 || ws_size < WS_END || out_size != NTOK * D) { fprintf(stderr, "kernel_launch: unexpected n_in %d / ws_size %zu / out_size %d; nothing launched\n", n_in, ws_size, out_size); grid = -1; return; }
        int dev = 0, cus = 0, per_cu = 0;
        if (hipGetDevice(&dev) != hipSuccess || hipDeviceGetAttribute(&cus, hipDeviceAttributeMultiprocessorCount, dev) != hipSuccess) { grid = -1; return; }
        if (hipFuncSetAttribute((const void*)mk_fwd, hipFuncAttributeMaxDynamicSharedMemorySize, LDS_BYTES) != hipSuccess) { fprintf(stderr, "kernel_launch: hipFuncSetAttribute failed\n"); grid = -1; return; }
        if (hipOccupancyMaxActiveBlocksPerMultiprocessor(&per_cu, (const void*)mk_fwd, NTHR, LDS_BYTES) != hipSuccess || per_cu < 1) { fprintf(stderr, "kernel_launch: occupancy query says %d\n", per_cu); }
        (void)hipGetLastError();
        grid = cus;
    }
    if (grid < 0) return;
    if (hipMemsetAsync((char*)d_ws + WS_CTL, 0, CTL_BYTES, stream) != hipSuccess) return;
    Args a{};
    for (int i = 0; i < 23; ++i) a.in[i] = (const float*)d_in[i];
    a.out = (float*)d_out; a.ws = (unsigned char*)d_ws;
#if MK_PER_PHASE
    for (int p = 0; p < N_PHASES; ++p) { a.ph_lo = p; a.ph_hi = p + 1; a.li = p; hipLaunchKernelGGL(mk_fwd, dim3(grid), dim3(NTHR), LDS_BYTES, stream, a); }
#else
    a.ph_lo = 0; a.ph_hi = N_PHASES; a.li = 0;
    hipLaunchKernelGGL(mk_fwd, dim3(grid), dim3(NTHR), LDS_BYTES, stream, a);
#endif
}
```

```cpp
#include <hip/hip_runtime.h>
#include <hip/hip_bf16.h>
#include <cstdint>
#include <cstdio>
#include <cmath>

#define DEVI __device__ __forceinline__
#define GAS __attribute__((address_space(1)))
#define LAS __attribute__((address_space(3)))
typedef unsigned short bf16_t;
typedef short bf16x8 __attribute__((ext_vector_type(8)));
typedef float f32x4 __attribute__((ext_vector_type(4)));
typedef float f32x16 __attribute__((ext_vector_type(16)));
typedef unsigned u32x4 __attribute__((ext_vector_type(4)));
typedef unsigned u32x2 __attribute__((ext_vector_type(2)));
typedef float cf32 __attribute__((ext_vector_type(2)));

#ifndef OPT_G1
#define OPT_G1 1
#endif
#ifndef G1_RAWQK
#define G1_RAWQK 0
#endif
#ifndef OPT_S5
#define OPT_S5 1
#endif
#ifndef OPT_G3
#define OPT_G3 1
#endif
#ifndef OPT_G4
#define OPT_G4 1
#endif
#ifndef OPT_G5
#define OPT_G5 1
#endif
#ifndef OPT_ATT
#define OPT_ATT 1
#endif
#ifndef REP_MASK
#define REP_MASK 0ull
#endif
#ifndef BAR_TWICE
#define BAR_TWICE 0
#endif
#ifndef G1_ALIGN
#define G1_ALIGN true
#endif
#ifndef OPT_RT
#define OPT_RT 1
#endif
#ifndef OPT_M1
#define OPT_M1 1
#endif
#ifndef OPT_M2
#define OPT_M2 1
#endif
#ifndef MK_PER_PHASE
#define MK_PER_PHASE 0
#endif

constexpr int D = 1024, BATCH = 8, SEQ = 4096, NTOK = BATCH * SEQ, DEPTH = 2;
constexpr int SSM_G = 32, SSM_C = 16, SSM_W = 512, SSM_P = 64;
constexpr int NH = 8, HD = 64, AW = 512, MOBA_B = 256, NBLK = SEQ / MOBA_B;
constexpr int D_IN = 4096;
constexpr int NEXP = 32, DEXP = 512;
constexpr int CHL = 32, NCH = SEQ / CHL, UK = 640, UROWS = BATCH * NCH;
constexpr int SLOT_CAP = 2 * NTOK + NEXP * 256;
constexpr int LIST_CAP = NTOK;
constexpr float NORM_EPS = 1e-6f;
constexpr float QSCALE = 0.125f * 1.4426950408889634f;
constexpr int NWAVES = 8, NTHR = 512;

constexpr size_t MiB = 1u << 20;
constexpr size_t WS_CTL = 0, CTL_BYTES = 1 * MiB;
constexpr size_t WS_ROPE = 1 * MiB;
constexpr size_t WS_MISC = 2 * MiB;
constexpr size_t WS_REC = 4 * MiB;
constexpr size_t WS_LIST = 5 * MiB;
constexpr size_t WS_S5TC = 16 * MiB;
constexpr size_t WS_S5BS = 56 * MiB;
constexpr size_t WS_WIN = 66 * MiB, WS_WGLU = 82 * MiB, WS_WATT = 86 * MiB, WS_WOUT = 88 * MiB, WS_WGU = 92 * MiB, WS_WDN = 220 * MiB;
constexpr size_t WS_H = 284 * MiB;
constexpr size_t WS_UCAT = 348 * MiB;
constexpr size_t WS_Q = 388 * MiB, WS_K = 420 * MiB, WS_V = 452 * MiB;
constexpr size_t WS_SG = 484 * MiB;
constexpr size_t WS_Z = 612 * MiB;
constexpr size_t WS_ATT = 644 * MiB;
constexpr size_t WS_MIXA = 676 * MiB, WS_MIXED = 740 * MiB;
constexpr size_t WS_SL = 804 * MiB;
constexpr size_t WS_XB = 820 * MiB;
constexpr size_t WS_END = 884 * MiB;
constexpr size_t WS_HMID = WS_UCAT;
constexpr size_t WS_YBUF = WS_SG;
constexpr size_t WS_QRAW = WS_MIXA, WS_KRAW = WS_MIXED;
constexpr size_t MISC_AL = 0;
constexpr size_t MISC_KSUM = 64 * 1024;
constexpr size_t MISC_SEL = 512 * 1024;
constexpr size_t MISC_WR = 1536 * 1024;
constexpr int CW_CNT = 64;
constexpr int CW_CVQ = 1024;
constexpr int CW_BAR = 4096;
constexpr int MAX_LAUNCHES = 64;

constexpr int RING_BYTES = 131072;
constexpr int LDSCTL_OFF = RING_BYTES;
constexpr int GTAB_OFF = RING_BYTES + 1024;
constexpr int LDS_BYTES = 160 * 1024;

DEVI float bf2f(bf16_t v) { return __uint_as_float((unsigned)v << 16); }
DEVI bf16_t f2bf(float f) { unsigned u = __float_as_uint(f); return (bf16_t)((u + 0x7fffu + ((u >> 16) & 1u)) >> 16); }
DEVI unsigned pk2(float lo, float hi) { return (unsigned)f2bf(lo) | ((unsigned)f2bf(hi) << 16); }
DEVI float sigmoidf_(float x) { return 1.f / (1.f + __expf(-x)); }
DEVI float gelu_tanh(float x) { const float u = 0.7978845608028654f * (x + 0.044715f * x * x * x); return 0.5f * x * (1.f + tanhf(u)); }
DEVI float xshfl(float v, int o, int lane) { return __int_as_float(__builtin_amdgcn_ds_bpermute((lane ^ o) << 2, __float_as_int(v))); }
DEVI float wave_sum(float v, int lane) {
#pragma unroll
    for (int o = 1; o < 64; o <<= 1) v += xshfl(v, o, lane);
    return v;
}
DEVI float wave_max(float v) {
#pragma unroll
    for (int o = 1; o < 64; o <<= 1) v = fmaxf(v, __shfl_xor(v, o));
    return v;
}

#define XB_TMO      128
#define XB_XCNT(j)  (256  + 64 * (j))
#define XB_XSUB(j)  (1280 + 64 * (j))
#define XB_XGEN(j)  (2304 + 64 * (j))
#define XB_TOP      3328
#define XB_TOPGEN   3392
#define XCD_BAR_WORDS 3456
#define XB_SPIN_CAP (1u << 18)
DEVI unsigned xb_ld(unsigned* p)              { return __hip_atomic_load(p, __ATOMIC_RELAXED, __HIP_MEMORY_SCOPE_AGENT); }
DEVI unsigned xb_add(unsigned* p, unsigned v) { return __hip_atomic_fetch_add(p, v, __ATOMIC_RELAXED, __HIP_MEMORY_SCOPE_AGENT); }
DEVI unsigned xb_xcc_id() { return (unsigned)__builtin_amdgcn_s_getreg((3 << 11) | 20) & 0xFu; }
#define XB_SPIN(cond, bar) do { unsigned _sp = 0; while (cond) { __builtin_amdgcn_s_sleep(1); \
    if ((++_sp & 255u) == 0u) { if (xb_ld(&(bar)[XB_TMO])) break; if (_sp > XB_SPIN_CAP) { atomicAdd(&(bar)[XB_TMO], 1u); break; } } } } while (0)
struct XcdBarrier { unsigned* bar; unsigned x; volatile LAS unsigned* st; };
DEVI XcdBarrier xcd_barrier_post(unsigned* bar, volatile LAS unsigned* st) {
    XcdBarrier b; b.bar = bar; b.x = xb_xcc_id(); b.st = st;
    if (threadIdx.x == 0) (void)xb_add(&bar[XB_XCNT(b.x)], 1u);
    return b;
}
DEVI void xcd_barrier_complete(unsigned* bar, unsigned x, unsigned& nloc, unsigned& nx) {
    const unsigned G = gridDim.x * gridDim.y * gridDim.z;
    unsigned sum, cnt, mine, sp = 0u;
    for (;;) {
        sum = 0u; cnt = 0u; mine = 0u;
#pragma unroll
        for (unsigned j = 0; j < 16; ++j) { const unsigned c = xb_ld(&bar[XB_XCNT(j)]); sum += c; cnt += (c > 0u) ? 1u : 0u; mine = (j == x) ? c : mine; }
        if (sum == G) break;
        __builtin_amdgcn_s_sleep(1);
        if ((++sp & 255u) == 0u) { if (xb_ld(&bar[XB_TMO])) break; if (sp > XB_SPIN_CAP) { atomicAdd(&bar[XB_TMO], 1u); break; } }
    }
    nloc = mine > 0u ? mine : 1u; nx = cnt > 0u ? cnt : 1u;
}
DEVI void xcd_barrier(const XcdBarrier& b) {
    asm volatile("s_waitcnt vmcnt(0)" ::: "memory");
    __syncthreads();
    if (threadIdx.x == 0) {
        unsigned* bar = b.bar;
        __builtin_amdgcn_s_waitcnt(0);
        unsigned nloc = b.st[0], nx = b.st[1];
        if (nloc == 0u) { xcd_barrier_complete(bar, b.x, nloc, nx); b.st[0] = nloc; b.st[1] = nx; }
        const unsigned old = xb_add(&bar[XB_XSUB(b.x)], 1u);
        const unsigned gen = old / nloc;
        if (old + 1u == (gen + 1u) * nloc) {
            __builtin_amdgcn_fence(__ATOMIC_RELEASE, "agent");
            asm volatile("s_waitcnt vmcnt(0)" ::: "memory");
            const unsigned og = xb_add(&bar[XB_TOP], 1u);
            const unsigned tg = og / nx;
            if (og + 1u == (tg + 1u) * nx) xb_add(&bar[XB_TOPGEN], 1u);
            else XB_SPIN(xb_ld(&bar[XB_TOPGEN]) == tg, bar);
            __builtin_amdgcn_fence(__ATOMIC_ACQUIRE, "agent");
            xb_add(&bar[XB_XGEN(b.x)], 1u);
            asm volatile("s_waitcnt vmcnt(0)" ::: "memory");
        } else {
            XB_SPIN(xb_ld(&bar[XB_XGEN(b.x)]) == gen, bar);
            __builtin_amdgcn_fence(__ATOMIC_ACQUIRE, "agent");
            asm volatile("s_waitcnt vmcnt(0)" ::: "memory");
        }
    }
    __syncthreads();
}

struct Args { const float* in[23]; float* out; unsigned char* ws; int ph_lo, ph_hi, li, pad; };
struct Frame { int tid, lane, wave, gw, NGW, gt, NGT, G; LAS unsigned char* lds; };

DEVI void ph_rope_table(const Frame& F, float* rope) {
    for (int idx = F.gt; idx < SEQ * 32; idx += F.NGT) {
        const int s = idx >> 5, i = idx & 31;
        const float inv = powf(10000.0f, -(float)(2 * i) / 64.0f);
        const float ang = (float)s * inv;
        float sn, cs; sincosf(ang, &sn, &cs);
        rope[2 * idx] = cs; rope[2 * idx + 1] = sn;
    }
}
DEVI void s5_tables_item(int l, int g, const float* a_re, const float* a_im, const float* log_dt, const float* b_re, const float* b_im,
                         const float* c_re, const float* c_im, bf16_t* TC, bf16_t* BS, float* AL, LAS float* lds, int tid, int nthr, int part) {
    LAS cf32* pw = (LAS cf32*)lds;
    LAS cf32* Cc = pw + 33 * 64;
    LAS cf32* Bb = Cc + 16 * 64;
    LAS cf32* fp = Bb + 64 * 16;
    LAS float* Kt = (LAS float*)(fp + 64);
    const int lg = l * SSM_G + g;
    const float dt = expf(log_dt[lg]);
    for (int i = tid; i < 33 * 64; i += nthr) {
        const int tau = i >> 6, p = i & 63;
        const float lr = a_re[lg * 64 + p], li = a_im[lg * 64 + p];
        const float mag = expf(lr * dt * (float)tau);
        float sn, cs; sincosf(li * dt * (float)tau, &sn, &cs);
        pw[i] = (cf32){mag * cs, mag * sn};
    }
    for (int i = tid; i < 16 * 64; i += nthr) Cc[i] = (cf32){c_re[(size_t)lg * 1024 + i], c_im[(size_t)lg * 1024 + i]};
    __syncthreads();
    for (int p = tid; p < 64; p += nthr) {
        const float lr = a_re[lg * 64 + p], li = a_im[lg * 64 + p];
        const cf32 ab = pw[64 + p];
        const float den = lr * lr + li * li, nre = ab.x - 1.0f;
        fp[p] = (cf32){(nre * lr + ab.y * li) / den, (ab.y * lr - nre * li) / den};
    }
    __syncthreads();
    for (int i = tid; i < 64 * 16; i += nthr) {
        const cf32 f = fp[i >> 4];
        const float br = b_re[(size_t)lg * 1024 + i], bi = b_im[(size_t)lg * 1024 + i];
        Bb[i] = (cf32){f.x * br - f.y * bi, f.x * bi + f.y * br};
    }
    __syncthreads();
    for (int i = tid; i < 8 * 256; i += nthr) {
        const int tau = 8 * part + (i >> 8), co = (i >> 4) & 15, ci = i & 15;
        float acc = 0.f;
        for (int p = 0; p < 64; ++p) {
            const cf32 c = Cc[co * 64 + p], w = pw[tau * 64 + p], b = Bb[p * 16 + ci];
            const float xr = c.x * w.x - c.y * w.y, xi = c.x * w.y + c.y * w.x;
            acc += xr * b.x - xi * b.y;
        }
        Kt[i] = acc;
    }
    __syncthreads();
    for (int i = tid; i < 512 * 512; i += nthr) {
        const int n = i >> 9, kk = i & 511, t = n >> 4, co = n & 15, tp = kk >> 4, ci = kk & 15, tau = t - tp;
        if (tau >= 0) { if ((tau >> 3) == part) TC[(size_t)n * 640 + kk] = f2bf(Kt[((tau & 7) * 16 + co) * 16 + ci]); }
        else if (((-tau - 1) >> 3) == part) TC[(size_t)n * 640 + kk] = 0;
    }
    for (int i = part * 128 * 128 + tid; i < (part + 1) * 128 * 128; i += nthr) {
        const int n = i >> 7, kc = i & 127, t = n >> 4, co = n & 15, p = kc & 63;
        const cf32 c = Cc[co * 64 + p], w = pw[(t + 1) * 64 + p];
        const float xr = c.x * w.x - c.y * w.y, xi = c.x * w.y + c.y * w.x;
        TC[(size_t)n * 640 + 512 + kc] = f2bf(kc < 64 ? xr : -xi);
    }
    for (int i = part * 32 * 512 + tid; i < (part + 1) * 32 * 512; i += nthr) {
        const int row = i >> 9, kk = i & 511, p = row & 63, tp = kk >> 4, ci = kk & 15;
        const cf32 w = pw[(31 - tp) * 64 + p], b = Bb[p * 16 + ci];
        BS[i] = f2bf(row < 64 ? (w.x * b.x - w.y * b.y) : (w.x * b.y + w.y * b.x));
    }
    if (part == 0) for (int i = tid; i < 64; i += nthr) { AL[2 * i] = pw[32 * 64 + i].x; AL[2 * i + 1] = pw[32 * 64 + i].y; }
    __syncthreads();
}

DEVI void ph_rmsnorm(const Frame& F, const float* x, const float* g, bf16_t* out) {
    for (int row = F.gw; row < NTOK; row += F.NGW) {
        const f32x4* xr = (const f32x4*)(x + (size_t)row * D) + F.lane;
        f32x4 v[4]; float s = 0.f;
#pragma unroll
        for (int j = 0; j < 4; ++j) { v[j] = xr[64 * j]; s += (v[j].x * v[j].x + v[j].y * v[j].y) + (v[j].z * v[j].z + v[j].w * v[j].w); }
        const float rstd = 1.0f / sqrtf(wave_sum(s, F.lane) * (1.0f / D) + NORM_EPS);
#pragma unroll
        for (int j = 0; j < 4; ++j) {
            const f32x4 gg = *((const f32x4*)g + F.lane + 64 * j);
            u32x2 o; o.x = pk2(v[j].x * rstd * gg.x, v[j].y * rstd * gg.y); o.y = pk2(v[j].z * rstd * gg.z, v[j].w * rstd * gg.w);
            *((u32x2*)(out + (size_t)row * D) + F.lane + 64 * j) = o;
        }
    }
}

template <int BMODE, class RowF, class Epi>
DEVI void sg_phase(const Frame& F, int ny, const RowF& rowf, const void* Bv, size_t bstride, int ldb, int K, int nct, int cstep, int off2, const Epi& epi) {
    const int lane = F.lane, r = lane & 31, h = lane >> 5;
    int base = 0;
    for (int y = 0; y < ny; ++y) {
        const int nrows = rowf.nrows(y), nrt = (nrows + 31) / 32, ntile = nrt * nct;
        const float* Bf = (const float*)Bv + (size_t)y * bstride;
        const bf16_t* Bt = (const bf16_t*)Bv + (size_t)y * bstride;
        int first = (F.gw - base % F.NGW + F.NGW) % F.NGW;
        for (int tile = first; tile < ntile; tile += F.NGW) {
            const int rt = tile / nct, ct = tile % nct, c0 = ct * cstep, c1 = c0 + off2;
            const int arow_i = rt * 32 + r;
            const bf16_t* arow = (arow_i < nrows) ? rowf(y, arow_i) : nullptr;
            f32x16 acc0 = {}, acc1 = {};
            for (int k = 0; k < K; k += 16) {
                bf16x8 a = {};
                if (arow) a = *(const bf16x8*)(arow + k + 8 * h);
                bf16x8 b0, b1;
                if (BMODE == 0) {
#pragma unroll
                    for (int j = 0; j < 8; ++j) { b0[j] = (short)f2bf(Bf[(size_t)(k + 8 * h + j) * ldb + c0 + r]); b1[j] = (short)f2bf(Bf[(size_t)(k + 8 * h + j) * ldb + c1 + r]); }
                } else {
                    b0 = *(const bf16x8*)(Bt + (size_t)(c0 + r) * ldb + k + 8 * h);
                    b1 = *(const bf16x8*)(Bt + (size_t)(c1 + r) * ldb + k + 8 * h);
                }
                acc0 = __builtin_amdgcn_mfma_f32_32x32x16_bf16(a, b0, acc0, 0, 0, 0);
                acc1 = __builtin_amdgcn_mfma_f32_32x32x16_bf16(a, b1, acc1, 0, 0, 0);
            }
#pragma unroll
            for (int reg = 0; reg < 16; ++reg) {
                const int row = rt * 32 + (reg & 3) + 8 * (reg >> 2) + 4 * h;
                if (row < nrows) epi(y, row, c0 + r, c1 + r, acc0[reg], acc1[reg]);
            }
        }
        base += ntile;
    }
}

struct RowPlain { const bf16_t* A; int lda; int n; size_t ystride;
    DEVI int nrows(int) const { return n; }
    DEVI const bf16_t* operator()(int y, int r) const { return A + (size_t)y * ystride + (size_t)r * lda; } };

struct EpiG1sPerm;
struct EpiG1s { bf16_t* ucat; float* qraw; float* kraw; bf16_t* v; bf16_t* sg;
    DEVI void one(int row, int c, float a) const {
        if (c < 512) { const int b = row >> 12, s = row & 4095, g = c >> 4, ci = c & 15;
            ucat[((size_t)g * UROWS + b * NCH + (s >> 5)) * UK + (s & 31) * 16 + ci] = f2bf(a); }
        else if (c < 1024) qraw[(size_t)row * 512 + (c - 512)] = a;
        else if (c < 1536) kraw[(size_t)row * 512 + (c - 1024)] = a;
        else if (c < 2048) v[(size_t)row * 512 + (c - 1536)] = f2bf(a);
        else sg[(size_t)row * 2048 + (c - 2048)] = f2bf(sigmoidf_(a));
    }
    DEVI void operator()(int, int row, int c0, int c1, float a0, float a1) const { one(row, c0, a0); one(row, c1, a1); } };

DEVI int g1_unperm(int cp) { const int pn = cp >> 8, tc = cp & 255; if (pn < 2 || pn >= 6) return cp; const int sec = pn < 4 ? 512 : 1024, hh = (pn & 1) * 4 + ((tc >> 5) & 3); return sec + hh * 64 + 32 * (tc >> 7) + (tc & 31); }
#ifndef G1_FIX_MASK
#define G1_FIX_MASK 0
#endif
DEVI bool g1_sel(int c) { const int sec = c < 512 ? 1 : c < 1024 ? 2 : c < 1536 ? 4 : c < 2048 ? 8 : 16; return (G1_FIX_MASK & sec) != 0; }
struct EpiG1sPerm { EpiG1s e; DEVI void operator()(int, int row, int c0, int c1, float a0, float a1) const { e.one(row, g1_unperm(c0), a0); e.one(row, g1_unperm(c1), a1); } };
struct EpiG1sFix { EpiG1s e; DEVI void operator()(int, int row, int c0, int c1, float a0, float a1) const { const int n0 = g1_unperm(c0), n1 = g1_unperm(c1); if (g1_sel(n0)) e.one(row, n0, a0); if (g1_sel(n1)) e.one(row, n1, a1); } };
DEVI void ph_qkpost(const Frame& F, const float* qraw, const float* kraw, const float* qg, const float* kg, const float* rope, bf16_t* Q, bf16_t* K) {
    for (int idx = F.gt; idx < NTOK * 16; idx += F.NGT) {
        const int which = idx & 1, hh = (idx >> 1) & 7, tok = idx >> 4;
        const float* src = (which ? kraw : qraw) + (size_t)tok * 512 + hh * 64;
        const float* gn = which ? kg : qg;
        float x[64]; float ss = 0.f;
#pragma unroll
        for (int i = 0; i < 16; ++i) { const f32x4 t = *((const f32x4*)src + i); x[4 * i] = t.x; x[4 * i + 1] = t.y; x[4 * i + 2] = t.z; x[4 * i + 3] = t.w; ss += (t.x * t.x + t.y * t.y) + (t.z * t.z + t.w * t.w); }
        const float rstd = 1.0f / sqrtf(ss * (1.0f / 64.0f) + NORM_EPS);
        const int s = tok & (SEQ - 1);
        const float sc = which ? 1.0f : QSCALE;
        bf16_t* dst = (which ? K : Q) + (size_t)tok * 512 + hh * 64;
#pragma unroll
        for (int i = 0; i < 32; ++i) {
            const float x1 = x[i] * rstd * gn[i], x2 = x[i + 32] * rstd * gn[i + 32];
            const float cs = rope[(s * 32 + i) * 2], sn = rope[(s * 32 + i) * 2 + 1];
            dst[i] = f2bf((x1 * cs - x2 * sn) * sc);
            dst[i + 32] = f2bf((x2 * cs + x1 * sn) * sc);
        }
    }
}
DEVI void ph_ksum(const Frame& F, const bf16_t* K, float* ksum) {
    const int lane = F.lane, rg = lane >> 3, c = lane & 7;
    for (int w = F.gw; w < BATCH * NH * NBLK; w += F.NGW) {
        const int blk = w & 15, hh = (w >> 4) & 7, b = w >> 7;
        const bf16_t* kp = K + ((size_t)b * SEQ + blk * 256 + rg) * 512 + hh * 64 + c * 8;
        float acc[8];
#pragma unroll
        for (int j = 0; j < 8; ++j) acc[j] = 0.f;
#pragma unroll 8
        for (int i = 0; i < 32; ++i) { const bf16x8 v = *(const bf16x8*)(kp + (size_t)i * 8 * 512);
#pragma unroll
            for (int j = 0; j < 8; ++j) acc[j] += bf2f((bf16_t)v[j]); }
#pragma unroll
        for (int j = 0; j < 8; ++j) { float t = acc[j]; t += xshfl(t, 8, lane); t += xshfl(t, 16, lane); t += xshfl(t, 32, lane); acc[j] = t; }
        if (rg == 0) { float* o = ksum + (size_t)w * 64 + c * 8; *(f32x4*)o = (f32x4){acc[0], acc[1], acc[2], acc[3]}; *(f32x4*)(o + 4) = (f32x4){acc[4], acc[5], acc[6], acc[7]}; }
    }
}

DEVI void ph_attn_simple(const Frame& F, const bf16_t* Q, const bf16_t* K, const bf16_t* V, const float* ksum, bf16_t* O) {
    const int lane = F.lane;
    for (int w = F.gw; w < BATCH * NH * SEQ; w += F.NGW) {
        const int s = w & (SEQ - 1), hh = (w >> 12) & 7, b = w >> 15;
        const int qb = s >> 8;
        const bf16_t* qp = Q + ((size_t)b * SEQ + s) * 512 + hh * 64;
        float q[64];
#pragma unroll
        for (int i = 0; i < 8; ++i) { const bf16x8 t = *((const bf16x8*)qp + i);
#pragma unroll
            for (int j = 0; j < 8; ++j) q[8 * i + j] = bf2f((bf16_t)t[j]); }
        float gsc = -INFINITY;
        if (lane < qb) { const float* km = ksum + ((size_t)(b * 8 + hh) * 16 + lane) * 64; float a = 0.f;
#pragma unroll
            for (int i = 0; i < 64; ++i) a += q[i] * km[i];
            gsc = a; }
        int blks[4]; int nsel = 0;
#pragma unroll
        for (int t = 0; t < 3; ++t) {
            float best = -INFINITY; int bi = -1;
            for (int j = 0; j < 15; ++j) { const float v = __shfl(gsc, j); const bool used = (t > 0 && j == blks[0]) || (t > 1 && j == blks[1]); if (j < qb && !used && v > best) { best = v; bi = j; } }
            blks[t] = bi; if (bi >= 0) nsel = t + 1;
        }
        blks[3] = qb;
        float sc[4][4]; float m = -INFINITY;
#pragma unroll
        for (int t = 0; t < 4; ++t) {
            const bool on = (t == 3) || (t < nsel);
            const int blk = on ? blks[t] : 0;
#pragma unroll
            for (int i = 0; i < 4; ++i) {
                const int key = blk * 256 + lane + 64 * i;
                float a = -INFINITY;
                if (on && (t < 3 || key <= s)) {
                    const bf16_t* kp = K + ((size_t)b * SEQ + key) * 512 + hh * 64; a = 0.f;
#pragma unroll
                    for (int c = 0; c < 8; ++c) { const bf16x8 kk = *((const bf16x8*)kp + c);
#pragma unroll
                        for (int j = 0; j < 8; ++j) a += q[8 * c + j] * bf2f((bf16_t)kk[j]); }
                }
                sc[t][i] = a; m = fmaxf(m, a);
            }
        }
        m = wave_max(m);
        float l = 0.f;
#pragma unroll
        for (int t = 0; t < 4; ++t)
#pragma unroll
            for (int i = 0; i < 4; ++i) { const float p = exp2f(sc[t][i] - m); sc[t][i] = p; l += p; }
        l = wave_sum(l, lane);
        float o = 0.f;
#pragma unroll
        for (int t = 0; t < 4; ++t) {
            const bool on = (t == 3) || (t < nsel);
            if (!on) continue;
            const int blk = blks[t];
#pragma unroll
            for (int i = 0; i < 4; ++i) {
                const float pv = sc[t][i];
                for (int j = 0; j < 64; ++j) {
                    const float p = __shfl(pv, j);
                    const int key = blk * 256 + j + 64 * i;
                    if (p != 0.f) o += p * bf2f(V[((size_t)b * SEQ + key) * 512 + hh * 64 + lane]);
                }
            }
        }
        O[((size_t)b * SEQ + s) * 512 + hh * 64 + lane] = f2bf(o / l);
    }
}

struct EpiS5A { float* sl; DEVI void operator()(int y, int row, int c0, int c1, float a0, float a1) const { float* p = sl + ((size_t)y * UROWS + row) * 128; p[c0] = a0; p[c1] = a1; } };
DEVI void ph_s5_scan(const Frame& F, const float* sl, const float* AL, bf16_t* ucat) {
    for (int idx = F.gt; idx < SSM_G * BATCH * 64; idx += F.NGT) {
        const int p = idx & 63, b = (idx >> 6) & 7, g = idx >> 9;
        const float ar = AL[(g * 64 + p) * 2], ai = AL[(g * 64 + p) * 2 + 1];
        float hr = 0.f, hi = 0.f;
        for (int c = 0; c < NCH; ++c) {
            const size_t row = (size_t)g * UROWS + b * NCH + c;
            ucat[row * UK + 512 + p] = f2bf(hr); ucat[row * UK + 576 + p] = f2bf(hi);
            const float sr = sl[row * 128 + p], si = sl[row * 128 + 64 + p];
            const float nr = ar * hr - ai * hi + sr, ni = ar * hi + ai * hr + si; hr = nr; hi = ni;
        }
    }
}
struct EpiS5C { const bf16_t* ucat; const float* dskip; bf16_t* z;
    DEVI void one(int g, int row, int n, float a) const {
        const int t = n >> 4, co = n & 15, b = row >> 7, c = row & 127;
        const float u = bf2f(ucat[((size_t)g * UROWS + row) * UK + n]);
        const float y = a + dskip[g * 16 + co] * u;
        z[((size_t)b * SEQ + c * CHL + t) * 512 + g * 16 + co] = f2bf(gelu_tanh(y));
    }
    DEVI void operator()(int y, int row, int c0, int c1, float a0, float a1) const { one(y, row, c0, a0); one(y, row, c1, a1); } };

struct EpiG3s { const bf16_t* sg; bf16_t* mixa;
    DEVI void operator()(int, int row, int c0, int c1, float val, float gate) const { mixa[(size_t)row * 1024 + c0] = f2bf(bf2f(sg[(size_t)row * 2048 + c0]) * val * sigmoidf_(gate)); } };
struct EpiG4s { const bf16_t* sg; const bf16_t* mixa; bf16_t* mixed;
    DEVI void one(int row, int c, float a) const { mixed[(size_t)row * 1024 + c] = f2bf(bf2f(mixa[(size_t)row * 1024 + c]) + bf2f(sg[(size_t)row * 2048 + 1024 + c]) * a); }
    DEVI void operator()(int, int row, int c0, int c1, float a0, float a1) const { one(row, c0, a0); one(row, c1, a1); } };
struct EpiG5s { const float* xin; float* xout;
    DEVI void operator()(int, int row, int c0, int c1, float a0, float a1) const { xout[(size_t)row * 1024 + c0] = xin[(size_t)row * 1024 + c0] + a0; xout[(size_t)row * 1024 + c1] = xin[(size_t)row * 1024 + c1] + a1; } };

DEVI void ph_norm_router(const Frame& F, const float* x, const float* g, const float* wg, const float* bg, const float* we, const float* be,
                         bf16_t* h2, unsigned* cnt, int* list, unsigned* rec) {
    const int lane = F.lane;
    for (int row = F.gw; row < NTOK; row += F.NGW) {
        const f32x4* xr = (const f32x4*)(x + (size_t)row * D) + lane;
        f32x4 v[4]; float s = 0.f;
#pragma unroll
        for (int j = 0; j < 4; ++j) { v[j] = xr[64 * j]; s += (v[j].x * v[j].x + v[j].y * v[j].y) + (v[j].z * v[j].z + v[j].w * v[j].w); }
        const float rstd = 1.0f / sqrtf(wave_sum(s, lane) * (1.0f / D) + NORM_EPS);
        float acc[36];
#pragma unroll
        for (int o = 0; o < 36; ++o) acc[o] = 0.f;
#pragma unroll
        for (int j = 0; j < 4; ++j) {
            const f32x4 gg = *((const f32x4*)g + lane + 64 * j);
            const float hv[4] = {v[j].x * rstd * gg.x, v[j].y * rstd * gg.y, v[j].z * rstd * gg.z, v[j].w * rstd * gg.w};
            u32x2 o; o.x = pk2(hv[0], hv[1]); o.y = pk2(hv[2], hv[3]);
            *((u32x2*)(h2 + (size_t)row * D) + lane + 64 * j) = o;
#pragma unroll
            for (int e = 0; e < 4; ++e) {
                const int k = 4 * lane + 256 * j + e;
                const f32x4 w4 = *(const f32x4*)(wg + (size_t)k * 4);
                acc[0] += hv[e] * w4.x; acc[1] += hv[e] * w4.y; acc[2] += hv[e] * w4.z; acc[3] += hv[e] * w4.w;
#pragma unroll
                for (int q = 0; q < 8; ++q) { const f32x4 w = *(const f32x4*)(we + (size_t)k * 32 + 4 * q);
                    acc[4 + 4 * q] += hv[e] * w.x; acc[5 + 4 * q] += hv[e] * w.y; acc[6 + 4 * q] += hv[e] * w.z; acc[7 + 4 * q] += hv[e] * w.w; }
            }
        }
#pragma unroll
        for (int o = 0; o < 36; ++o) acc[o] = wave_sum(acc[o], lane);
        if (lane == 0) {
            float gl[4]; int gt = 0; float gm = -INFINITY;
#pragma unroll
            for (int i = 0; i < 4; ++i) { gl[i] = acc[i] + bg[i]; if (gl[i] > gm) { gm = gl[i]; gt = i; } }
            float gs = 0.f;
#pragma unroll
            for (int i = 0; i < 4; ++i) gs += __expf(gl[i] - gm);
            const float pg = 1.0f / gs;
            float el[8]; float em = -INFINITY;
#pragma unroll
            for (int i = 0; i < 8; ++i) { float t = 0.f;
#pragma unroll
                for (int gq = 0; gq < 4; ++gq) t = (gq == gt) ? acc[4 + gq * 8 + i] + be[gq * 8 + i] : t;
                el[i] = t; em = fmaxf(em, t); }
            int i1 = 0; float v1 = -INFINITY;
#pragma unroll
            for (int i = 0; i < 8; ++i) if (el[i] > v1) { v1 = el[i]; i1 = i; }
            int i2 = 0; float v2 = -INFINITY;
#pragma unroll
            for (int i = 0; i < 8; ++i) if (i != i1 && el[i] > v2) { v2 = el[i]; i2 = i; }
            const float p1 = __expf(v1 - em), p2 = __expf(v2 - em);
            const float w0 = pg * p1 / (p1 + p2), w1 = pg * p2 / (p1 + p2);
            const int e0 = gt * 8 + i1, e1 = gt * 8 + i2;
            const unsigned pos0 = atomicAdd(cnt + e0, 1u), pos1 = atomicAdd(cnt + e1, 1u);
            list[(size_t)e0 * LIST_CAP + pos0] = row; list[(size_t)e1 * LIST_CAP + pos1] = row;
            unsigned* rp = rec + (size_t)row * 8;
            rp[0] = (unsigned)e0; rp[1] = (unsigned)e1; rp[2] = pos0; rp[3] = pos1; rp[4] = __float_as_uint(w0); rp[5] = __float_as_uint(w1);
        }
    }
}
DEVI void expert_prefix(const Frame& F, const unsigned* cnt, volatile LAS int* out, int mul) {
    if (F.wave == 0) { const int lane = F.lane;
        int c = (lane < NEXP) ? (int)((__hip_atomic_load(cnt + (lane & 31), __ATOMIC_RELAXED, __HIP_MEMORY_SCOPE_AGENT) + 255u) / 256u) : 0;
        int s = c;
#pragma unroll
        for (int d = 1; d < 32; d <<= 1) { const int t = __builtin_amdgcn_ds_bpermute(((lane - d) & 63) << 2, s); if (lane >= d) s += t; }
        if (lane < NEXP) out[lane] = (s - c) * mul;
        if (lane == NEXP - 1) out[NEXP] = s * mul; }
    __syncthreads();
}
DEVI void compute_pstart(const Frame& F, const unsigned* cnt, volatile LAS int* pstart) { expert_prefix(F, cnt, pstart, 256); }
struct RowM1 { const bf16_t* h2; const int* list; const unsigned* cnt;
    DEVI int nrows(int y) const { return (int)cnt[y]; }
    DEVI const bf16_t* operator()(int y, int r) const { return h2 + (size_t)list[(size_t)y * LIST_CAP + r] * D; } };
struct EpiM1s { bf16_t* hmid; volatile LAS int* pstart;
    DEVI void operator()(int y, int row, int c0, int c1, float gt, float up) const { hmid[((size_t)pstart[y] + row) * 512 + c0] = f2bf(gt * sigmoidf_(gt) * up); } };
struct RowM2 { const bf16_t* hmid; volatile LAS int* pstart; const unsigned* cnt;
    DEVI int nrows(int y) const { return (int)cnt[y]; }
    DEVI const bf16_t* operator()(int y, int r) const { return hmid + ((size_t)pstart[y] + r) * 512; } };
struct EpiM2s { bf16_t* ybuf; volatile LAS int* pstart;
    DEVI void operator()(int y, int row, int c0, int c1, float a0, float a1) const { bf16_t* p = ybuf + ((size_t)pstart[y] + row) * 1024; p[c0] = f2bf(a0); p[c1] = f2bf(a1); } };
template <bool LAST>
DEVI void ph_combine(const Frame& F, bf16_t* xb, float* out, const bf16_t* ybuf, const unsigned* rec, volatile LAS int* pstart, const float* gnext, bf16_t* hout) {
    const int lane = F.lane;
    for (int row0 = F.gw; row0 < NTOK; row0 += 2 * F.NGW) {
        int rw[2]; const bf16_t* y0[2]; const bf16_t* y1[2]; float w0[2], w1[2]; bool on[2];
#pragma unroll
        for (int u = 0; u < 2; ++u) { rw[u] = row0 + u * F.NGW; on[u] = rw[u] < NTOK; const int rr = on[u] ? rw[u] : row0;
            const u32x4 ra = *(const u32x4*)(rec + (size_t)rr * 8); const u32x2 rb = *(const u32x2*)(rec + (size_t)rr * 8 + 4);
            y0[u] = ybuf + ((size_t)pstart[(int)ra.x] + ra.z) * 1024; y1[u] = ybuf + ((size_t)pstart[(int)ra.y] + ra.w) * 1024;
            w0[u] = __uint_as_float(rb.x); w1[u] = __uint_as_float(rb.y); }
        u32x2 xw[2][4], ya[2][4], yb[2][4];
#pragma unroll
        for (int u = 0; u < 2; ++u)
#pragma unroll
            for (int j = 0; j < 4; ++j) { const int rr = on[u] ? rw[u] : row0;
                xw[u][j] = *((const u32x2*)(xb + (size_t)rr * D) + lane + 64 * j); ya[u][j] = *((const u32x2*)y0[u] + lane + 64 * j); yb[u][j] = *((const u32x2*)y1[u] + lane + 64 * j); }
#pragma unroll
        for (int u = 0; u < 2; ++u) {
            if (!on[u]) continue;
            const int row = rw[u];
            f32x4 v[4]; float s = 0.f;
#pragma unroll
            for (int j = 0; j < 4; ++j) {
                const u32x2 x = xw[u][j], a = ya[u][j], b = yb[u][j];
                v[j].x = __uint_as_float(x.x << 16) + w0[u] * __uint_as_float(a.x << 16) + w1[u] * __uint_as_float(b.x << 16);
                v[j].y = __uint_as_float(x.x & 0xffff0000u) + w0[u] * __uint_as_float(a.x & 0xffff0000u) + w1[u] * __uint_as_float(b.x & 0xffff0000u);
                v[j].z = __uint_as_float(x.y << 16) + w0[u] * __uint_as_float(a.y << 16) + w1[u] * __uint_as_float(b.y << 16);
                v[j].w = __uint_as_float(x.y & 0xffff0000u) + w0[u] * __uint_as_float(a.y & 0xffff0000u) + w1[u] * __uint_as_float(b.y & 0xffff0000u);
                if (LAST) *((f32x4*)(out + (size_t)row * D) + lane + 64 * j) = v[j];
                else { u32x2 o; o.x = pk2(v[j].x, v[j].y); o.y = pk2(v[j].z, v[j].w); *((u32x2*)(xb + (size_t)row * D) + lane + 64 * j) = o; }
                s += (v[j].x * v[j].x + v[j].y * v[j].y) + (v[j].z * v[j].z + v[j].w * v[j].w);
            }
            if (!LAST) {
                const float rstd = 1.0f / sqrtf(wave_sum(s, lane) * (1.0f / D) + NORM_EPS);
#pragma unroll
                for (int j = 0; j < 4; ++j) { const f32x4 gg = *((const f32x4*)gnext + lane + 64 * j);
                    u32x2 o; o.x = pk2(v[j].x * rstd * gg.x, v[j].y * rstd * gg.y); o.y = pk2(v[j].z * rstd * gg.z, v[j].w * rstd * gg.w);
                    *((u32x2*)(hout + (size_t)row * D) + lane + 64 * j) = o; }
            }
        }
    }
}

namespace pg8 {
constexpr int BM = 256, BK = 64, HALF = 128, HTB = HALF * BK * 2  , STAGE_BYTES = 8 * HTB;
__host__ __device__ __forceinline__ int lds_byte(int r, int c) { const int st = (r >> 4) * 2 + (c >> 5), rr = r & 15, cc = c & 31, ob = rr * 64 + cc * 2; return st * 1024 + (ob ^ (((ob >> 9) & 1) << 5)); }
__host__ __device__ __forceinline__ void stage_rc(int b, int& R, int& C) { const int st = b / 1024, sb = b % 1024, swz = sb ^ (((sb >> 9) & 1) << 5); R = (st >> 1) * 16 + swz / 64; C = (st & 1) * 32 + (swz % 64) / 2; }
__host__ __device__ __forceinline__ int perm32(int rho) { const int n = rho >> 4, i = rho & 15; return 8 * (i >> 2) + 4 * n + (i & 3); }

struct Unit { int pm, pn, g, ui; };
struct Gemm { const bf16_t* A; const bf16_t* Bt; int lda, ldb, K; size_t ags, bgs;
    DEVI const char* abase(const Unit& u) const { return (const char*)(A + (size_t)u.g * ags + (size_t)u.pm * BM * lda); }
    DEVI const char* bbase(const Unit& u) const { return (const char*)(Bt + (size_t)u.g * bgs + (size_t)u.pn * BM * ldb); } };
struct NoGather { static constexpr bool ON = false; DEVI unsigned rowoff(const Unit&, int) const { return 0u; } };
struct LdsGather { static constexpr bool ON = true; const LAS unsigned* tab;
    DEVI unsigned rowoff(const Unit& u, int r) const { return tab[u.ui * 256 + r]; } };

typedef float f32x2_t __attribute__((ext_vector_type(2))); typedef __bf16 bf16x2_t __attribute__((ext_vector_type(2)));
DEVI unsigned cvt_pk_bf16(float lo, float hi) { const f32x2_t v = {lo, hi}; const bf16x2_t b = __builtin_convertvector(v, bf16x2_t); return __builtin_bit_cast(unsigned, b); }

template <class Epi, class Sched, class GA, bool ALIGN_EPI>
DEVI void gemm_phase(LAS unsigned char* lds, const Gemm g, const Sched& S, const Epi& E, const GA& ga, int tid_in) {
    const int tid = tid_in, wid = __builtin_amdgcn_readfirstlane(tid >> 6), lane = tid & 63, wr = wid >> 2, wc = wid & 3, fr = lane & 15, fq = lane >> 4;
    const int K = g.K, nt = K / BK;
    unsigned voffA[2], voffB[2]; int RA[2]; unsigned CA[2];
#pragma unroll
    for (int i = 0; i < 2; ++i) { int R, C; stage_rc(tid * 16 + i * 8192, R, C); const int Rb = Epi::PERM ? ((R & ~31) + perm32(R & 31)) : R;
        voffA[i] = (unsigned)(R * g.lda + C) * 2u; voffB[i] = (unsigned)(Rb * g.ldb + C) * 2u; RA[i] = R; CA[i] = (unsigned)C * 2u; }
    const size_t kstep = (size_t)(BK * 2);
    const size_t hstepA = GA::ON ? (size_t)0 : (size_t)HALF * g.lda * 2, hstepB = (size_t)HALF * g.ldb * 2;
    const unsigned ldsw = (unsigned)wid * 1024u;
    const int aoff = lds_byte(wr * 64 + fr, fq * 8), boff = lds_byte(wc * 32 + fr, fq * 8);
#define PG8_SA(b, h) (((b) * 2 + (h)) * HTB)
#define PG8_SB(b, h) ((4 + (b) * 2 + (h)) * HTB)
#define PG8_STAGE2(bufoff, gbase, v0, v1) do { \
        __builtin_amdgcn_global_load_lds((const unsigned*)((const char*)(gbase) + (v0)), (LAS unsigned*)(lds + (bufoff) + ldsw), 16, 0, 0); \
        __builtin_amdgcn_global_load_lds((const unsigned*)((const char*)(gbase) + (v1)), (LAS unsigned*)(lds + (bufoff) + ldsw + 8192), 16, 0, 0); } while (0)
#define PG8_STAGE_B(b, h, bptr) PG8_STAGE2(PG8_SB(b, h), (bptr) + (h) * hstepB, voffB[0], voffB[1])
#define PG8_STAGE_A(b, h, aptr, NX) do { if constexpr (GA::ON) { const unsigned _o0 = (NX) ? vgn[h][0] : vgc[h][0], _o1 = (NX) ? vgn[h][1] : vgc[h][1]; PG8_STAGE2(PG8_SA(b, h), (aptr), _o0, _o1); } \
        else { PG8_STAGE2(PG8_SA(b, h), (aptr) + (h) * hstepA, voffA[0], voffA[1]); } } while (0)
#define PG8_LDA(dst, b, h) do { _Pragma("unroll") for (int m = 0; m < 4; ++m) _Pragma("unroll") for (int k = 0; k < 2; ++k) dst[m][k] = *(const LAS bf16x8*)(lds + PG8_SA(b, h) + aoff + m * 2048 + k * 1024); } while (0)
#define PG8_LDB(dst, b, h) do { _Pragma("unroll") for (int n = 0; n < 2; ++n) _Pragma("unroll") for (int k = 0; k < 2; ++k) dst[n][k] = *(const LAS bf16x8*)(lds + PG8_SB(b, h) + boff + n * 2048 + k * 1024); } while (0)
#define PG8_MMA(ai, bj, At, Bt) do { __builtin_amdgcn_s_setprio(1); _Pragma("unroll") for (int m = 0; m < 4; ++m) _Pragma("unroll") for (int n = 0; n < 2; ++n) _Pragma("unroll") for (int k = 0; k < 2; ++k) \
        acc[ai][bj][m][n] = __builtin_amdgcn_mfma_f32_16x16x32_bf16(Bt[n][k], At[m][k], acc[ai][bj][m][n], 0, 0, 0); __builtin_amdgcn_s_setprio(0); } while (0)
#define PG8_WAIT_V(n) asm volatile("s_waitcnt vmcnt(" #n ")" ::: "memory")
#define PG8_WAIT_L(n) asm volatile("s_waitcnt lgkmcnt(" #n ")" ::: "memory")
#define PG8_BAR __builtin_amdgcn_s_barrier()
#define PG8_SCHED __builtin_amdgcn_sched_barrier(0)
    Unit cur, nxt; int ui = 0;
    if (!S.next(0, cur)) return;
    f32x4 acc[2][2][4][2];
#pragma unroll
    for (int a = 0; a < 2; ++a)
#pragma unroll
        for (int b = 0; b < 2; ++b)
#pragma unroll
            for (int m = 0; m < 4; ++m)
#pragma unroll
                for (int n = 0; n < 2; ++n) acc[a][b][m][n] = (f32x4){0.f, 0.f, 0.f, 0.f};
    bf16x8 At[4][2], B0[2][2], B1[2][2];
    unsigned vgc[2][2] = {{0u, 0u}, {0u, 0u}}, vgn[2][2] = {{0u, 0u}, {0u, 0u}};
    if constexpr (GA::ON) {
#pragma unroll
        for (int h = 0; h < 2; ++h)
#pragma unroll
            for (int i = 0; i < 2; ++i) vgc[h][i] = ga.rowoff(cur, h * HALF + RA[i]) + CA[i];
    }
    const char* cA = GA::ON ? (const char*)g.A : g.abase(cur); const char* cB = g.bbase(cur);
    S.a_ready(cur);
    PG8_STAGE_B(0, 0, cB); PG8_STAGE_B(0, 1, cB); PG8_STAGE_A(0, 0, cA, false); PG8_STAGE_A(0, 1, cA, false);
    if (wr == 1) PG8_BAR;
    PG8_WAIT_V(2); PG8_BAR;
    PG8_STAGE_B(1, 0, cB + kstep); PG8_STAGE_A(1, 0, cA + kstep, false); PG8_STAGE_B(1, 1, cB + kstep);
    PG8_WAIT_V(6); PG8_BAR;
    for (;;) {
        const bool has_next = S.next(ui + 1, nxt);
        const char* nA = has_next ? (GA::ON ? (const char*)g.A : g.abase(nxt)) : cA; const char* nB = has_next ? g.bbase(nxt) : cB;
        if constexpr (GA::ON) {
#pragma unroll
            for (int h = 0; h < 2; ++h)
#pragma unroll
                for (int i = 0; i < 2; ++i) vgn[h][i] = has_next ? ga.rowoff(nxt, h * HALF + RA[i]) + CA[i] : vgc[h][i];
            asm volatile("" : "+v"(vgn[0][0]), "+v"(vgn[0][1]), "+v"(vgn[1][0]), "+v"(vgn[1][1]));
        }
        for (int t = 0; t < nt; t += 2) {
            const bool last = (t == nt - 2);
            const char* a1 = cA + (size_t)(t + 1) * kstep;
            const char* a2 = last ? nA : cA + (size_t)(t + 2) * kstep; const char* b2 = last ? nB : cB + (size_t)(t + 2) * kstep;
            const char* a3 = a2 + kstep; const char* b3 = b2 + kstep;
            if (last && has_next) S.a_ready(nxt);
            PG8_LDB(B0, 0, 0); PG8_LDB(B1, 0, 1); PG8_SCHED; PG8_LDA(At, 0, 0); PG8_STAGE_A(1, 1, a1, false);
            PG8_WAIT_V(8); PG8_WAIT_L(0); PG8_BAR; PG8_MMA(0, 0, At, B0); PG8_MMA(0, 1, At, B1); PG8_BAR; PG8_SCHED;
            PG8_LDA(At, 0, 1); PG8_STAGE_B(0, 0, b2); PG8_STAGE_B(0, 1, b2); PG8_STAGE_A(0, 0, a2, last);
            PG8_WAIT_V(8); PG8_WAIT_L(0); PG8_BAR; PG8_MMA(1, 0, At, B0); PG8_MMA(1, 1, At, B1); PG8_BAR; PG8_SCHED;
            PG8_LDB(B0, 1, 0); PG8_LDB(B1, 1, 1); PG8_SCHED; PG8_LDA(At, 1, 0); PG8_STAGE_A(0, 1, a2, last);
            PG8_WAIT_V(8); PG8_WAIT_L(0); PG8_BAR; PG8_MMA(0, 0, At, B0); PG8_MMA(0, 1, At, B1); PG8_BAR; PG8_SCHED;
            PG8_LDA(At, 1, 1); PG8_STAGE_B(1, 0, b3); PG8_STAGE_B(1, 1, b3); PG8_STAGE_A(1, 0, a3, last);
            PG8_WAIT_V(8); PG8_WAIT_L(0); PG8_BAR; PG8_MMA(1, 0, At, B0); PG8_MMA(1, 1, At, B1); PG8_BAR; PG8_SCHED;
        }
        if constexpr (ALIGN_EPI) { if (wr == 0) PG8_BAR; }
        if constexpr (!Epi::AFTER_DRAIN) { E(acc, cur, wr, wc, fr, fq); S.done(cur); }
        if (!has_next) break;
#pragma unroll
        for (int a = 0; a < 2; ++a)
#pragma unroll
            for (int b = 0; b < 2; ++b)
#pragma unroll
                for (int m = 0; m < 4; ++m)
#pragma unroll
                    for (int n = 0; n < 2; ++n) acc[a][b][m][n] = (f32x4){0.f, 0.f, 0.f, 0.f};
        cur = nxt; cA = nA; cB = nB; ++ui;
        if constexpr (GA::ON) {
#pragma unroll
            for (int h = 0; h < 2; ++h)
#pragma unroll
                for (int i = 0; i < 2; ++i) vgc[h][i] = vgn[h][i];
        }
        if constexpr (ALIGN_EPI) { if (wr == 1) PG8_BAR; }
    }
    PG8_WAIT_V(0);
    if constexpr (!ALIGN_EPI) { if (wr == 0) PG8_BAR; }
    PG8_BAR;
    if constexpr (Epi::AFTER_DRAIN) { E.fused(acc, cur, wr, wc, fr, fq, lds, wid, lane); S.done(cur); }
#undef PG8_SA
#undef PG8_SB
#undef PG8_STAGE2
#undef PG8_STAGE_A
#undef PG8_STAGE_B
#undef PG8_LDA
#undef PG8_LDB
#undef PG8_MMA
#undef PG8_WAIT_V
#undef PG8_WAIT_L
#undef PG8_BAR
#undef PG8_SCHED
}
}

namespace pg8 {
DEVI float fsig(float x) { return __builtin_amdgcn_rcpf(1.0f + __expf(-x)); }
DEVI f32x4 unpk_lo(u32x4 w, int half) {
    const unsigned a = half ? w.z : w.x, b = half ? w.w : w.y;
    return (f32x4){__uint_as_float(a << 16), __uint_as_float(a & 0xffff0000u), __uint_as_float(b << 16), __uint_as_float(b & 0xffff0000u)}; }
DEVI u32x4 pk8(f32x4 v0, f32x4 v1) { u32x4 w; w.x = cvt_pk_bf16(v0[0], v0[1]); w.y = cvt_pk_bf16(v0[2], v0[3]); w.z = cvt_pk_bf16(v1[0], v1[1]); w.w = cvt_pk_bf16(v1[2], v1[3]); return w; }

struct StaticOrder {
    int nM, nN, nwg, G, c;
    DEVI void init(int M, int N, int G_, int c_) { nM = M / BM; nN = N / BM; nwg = nM * nN; G = G_; c = c_; }
    DEVI bool next(int i, Unit& u) const {
        const long L = (long)i * G + c; if (L >= nwg) return false;
        int wgid = (int)L; { const int q = nwg / 8, r = nwg % 8, xcd = wgid % 8, off = wgid / 8; wgid = (xcd < r ? xcd * (q + 1) : r * (q + 1) + (xcd - r) * q) + off; }
        const int nig = 8 * nN, gid = wgid / nig, fm = gid * 8, gsz = (nM - fm) < 8 ? (nM - fm) : 8;
        u.pm = fm + ((wgid % nig) % gsz); u.pn = (wgid % nig) / gsz; u.g = 0; u.ui = i; return true;
    }
    DEVI void a_ready(const Unit&) const {}
    DEVI void done(const Unit&) const {}
};
struct OrderS5A { int G, c; DEVI bool next(int i, Unit& u) const { const int U = i * G + c; if (U >= SSM_G * 4) return false; u.g = U >> 2; u.pm = U & 3; u.pn = 0; u.ui = i; return true; }
    DEVI void a_ready(const Unit&) const {} DEVI void done(const Unit&) const {} };
struct OrderS5C { int G, c; DEVI bool next(int i, Unit& u) const { const int U = i * G + c; if (U >= SSM_G * 8) return false; u.g = U >> 3; u.pm = (U >> 1) & 3; u.pn = U & 1; u.ui = i; return true; }
    DEVI void a_ready(const Unit&) const {} DEVI void done(const Unit&) const {} };
struct OrderMoE { int G, v; const volatile LAS int* tstart;
    DEVI bool next(int i, Unit& u) const { const int U = i * G + v, rt = U >> 2; if (rt >= tstart[NEXP]) return false;
        int e = 0;
#pragma unroll 1
        for (int q = 1; q < NEXP; ++q) e = (rt >= tstart[q]) ? q : e;
        u.pm = rt; u.pn = U & 3; u.g = e; u.ui = i; return true; }
    DEVI void a_ready(const Unit&) const {} DEVI void done(const Unit&) const {} };

template <bool F32IN> struct EpiResBf16 { static constexpr bool PERM = true, AFTER_DRAIN = false; const float* xin32; bf16_t* xb;
    DEVI void operator()(const f32x4 (&acc)[2][2][4][2], const Unit& u, int wr, int wc, int fr, int fq) const {
        const int row0 = u.pm * BM + wr * 64 + fr, col0 = u.pn * BM + wc * 32 + 8 * fq;
#pragma unroll
        for (int ai = 0; ai < 2; ++ai)
#pragma unroll
            for (int m = 0; m < 4; ++m) { const size_t off = (size_t)(row0 + ai * HALF + m * 16) * D + col0;
#pragma unroll
                for (int bj = 0; bj < 2; ++bj) { f32x4 a0, a1;
                    if (F32IN) { a0 = *(const f32x4*)(xin32 + off + bj * HALF); a1 = *(const f32x4*)(xin32 + off + bj * HALF + 4); }
                    else { const u32x4 w = *(const u32x4*)(xb + off + bj * HALF); a0 = unpk_lo(w, 0); a1 = unpk_lo(w, 1); }
                    *(u32x4*)(xb + off + bj * HALF) = pk8(a0 + acc[ai][bj][m][0], a1 + acc[ai][bj][m][1]); }
                if (m & 1) asm volatile("" ::: "memory"); }
    } };
struct EpiMix { static constexpr bool PERM = true, AFTER_DRAIN = false; const bf16_t* sg; const bf16_t* mixa; bf16_t* mixed;
    DEVI void operator()(const f32x4 (&acc)[2][2][4][2], const Unit& u, int wr, int wc, int fr, int fq) const {
        const int row0 = u.pm * BM + wr * 64 + fr, col0 = u.pn * BM + wc * 32 + 8 * fq;
#pragma unroll
        for (int ai = 0; ai < 2; ++ai)
#pragma unroll
            for (int m = 0; m < 4; ++m) { const size_t row = (size_t)(row0 + ai * HALF + m * 16);
#pragma unroll
                for (int bj = 0; bj < 2; ++bj) { const int col = col0 + bj * HALF;
                    const u32x4 a = *(const u32x4*)(mixa + row * 1024 + col), s = *(const u32x4*)(sg + row * 2048 + 1024 + col);
                    const f32x4 o0 = unpk_lo(a, 0) + unpk_lo(s, 0) * acc[ai][bj][m][0], o1 = unpk_lo(a, 1) + unpk_lo(s, 1) * acc[ai][bj][m][1];
                    *(u32x4*)(mixed + row * 1024 + col) = pk8(o0, o1); }
                if (m & 1) asm volatile("" ::: "memory"); }
    } };
struct EpiGlu { static constexpr bool PERM = true, AFTER_DRAIN = false; const bf16_t* sg; bf16_t* mixa;
    DEVI void operator()(const f32x4 (&acc)[2][2][4][2], const Unit& u, int wr, int wc, int fr, int fq) const {
        const int row0 = u.pm * BM + wr * 64 + fr, col = u.pn * HALF + wc * 32 + 8 * fq;
#pragma unroll
        for (int ai = 0; ai < 2; ++ai)
#pragma unroll
            for (int m = 0; m < 4; ++m) { const size_t row = (size_t)(row0 + ai * HALF + m * 16);
                const u32x4 s = *(const u32x4*)(sg + row * 2048 + col);
                f32x4 o[2];
#pragma unroll
                for (int n = 0; n < 2; ++n) { const f32x4 v = acc[ai][0][m][n], gt = acc[ai][1][m][n], sv = unpk_lo(s, n);
                    o[n] = (f32x4){sv[0] * v[0] * fsig(gt[0]), sv[1] * v[1] * fsig(gt[1]), sv[2] * v[2] * fsig(gt[2]), sv[3] * v[3] * fsig(gt[3])}; }
                *(u32x4*)(mixa + row * 1024 + col) = pk8(o[0], o[1]);
                if (m & 1) asm volatile("" ::: "memory"); }
    } };
struct EpiSwiglu { static constexpr bool PERM = true, AFTER_DRAIN = false; bf16_t* hmid;
    DEVI void operator()(const f32x4 (&acc)[2][2][4][2], const Unit& u, int wr, int wc, int fr, int fq) const {
        const int row0 = u.pm * BM + wr * 64 + fr, col = u.pn * HALF + wc * 32 + 8 * fq;
#pragma unroll
        for (int ai = 0; ai < 2; ++ai)
#pragma unroll
            for (int m = 0; m < 4; ++m) { const size_t row = (size_t)(row0 + ai * HALF + m * 16);
                f32x4 o[2];
#pragma unroll
                for (int n = 0; n < 2; ++n) { const f32x4 gt = acc[ai][0][m][n], up = acc[ai][1][m][n];
                    o[n] = (f32x4){gt[0] * fsig(gt[0]) * up[0], gt[1] * fsig(gt[1]) * up[1], gt[2] * fsig(gt[2]) * up[2], gt[3] * fsig(gt[3]) * up[3]}; }
                *(u32x4*)(hmid + row * 512 + col) = pk8(o[0], o[1]); }
    } };
struct EpiStoreBf16 { static constexpr bool PERM = true, AFTER_DRAIN = false; bf16_t* out; int ldc;
    DEVI void operator()(const f32x4 (&acc)[2][2][4][2], const Unit& u, int wr, int wc, int fr, int fq) const {
        const int row0 = u.pm * BM + wr * 64 + fr, col0 = u.pn * BM + wc * 32 + 8 * fq;
#pragma unroll
        for (int ai = 0; ai < 2; ++ai)
#pragma unroll
            for (int m = 0; m < 4; ++m) { bf16_t* rp = out + (size_t)(row0 + ai * HALF + m * 16) * ldc + col0;
#pragma unroll
                for (int bj = 0; bj < 2; ++bj) *(u32x4*)(rp + bj * HALF) = pk8(acc[ai][bj][m][0], acc[ai][bj][m][1]); }
    } };
struct EpiS5Cm { static constexpr bool PERM = true, AFTER_DRAIN = false; const bf16_t* ucat; const float* dskip; bf16_t* z;
    DEVI void operator()(const f32x4 (&acc)[2][2][4][2], const Unit& u, int wr, int wc, int fr, int fq) const {
        const int g = u.g, row0 = u.pm * BM + wr * 64 + fr, col0 = u.pn * BM + wc * 32 + 8 * fq;
        const int co0 = col0 & 15;
        const f32x4 d0 = *(const f32x4*)(dskip + g * 16 + co0), d1 = *(const f32x4*)(dskip + g * 16 + co0 + 4);
#pragma unroll
        for (int ai = 0; ai < 2; ++ai)
#pragma unroll
            for (int m = 0; m < 4; ++m) { const int row = row0 + ai * HALF + m * 16, b = row >> 7, c = row & 127;
#pragma unroll
                for (int bj = 0; bj < 2; ++bj) { const int n = col0 + bj * HALF, t = n >> 4;
                    const u32x4 uu = *(const u32x4*)(ucat + ((size_t)g * UROWS + row) * UK + n);
                    const f32x4 y0 = acc[ai][bj][m][0] + d0 * unpk_lo(uu, 0), y1 = acc[ai][bj][m][1] + d1 * unpk_lo(uu, 1);
                    const f32x4 z0 = (f32x4){gelu_tanh(y0[0]), gelu_tanh(y0[1]), gelu_tanh(y0[2]), gelu_tanh(y0[3])}, z1 = (f32x4){gelu_tanh(y1[0]), gelu_tanh(y1[1]), gelu_tanh(y1[2]), gelu_tanh(y1[3])};
                    *(u32x4*)(z + ((size_t)b * SEQ + c * CHL + t) * 512 + g * 16 + co0) = pk8(z0, z1); } }
    } };
struct EpiS5Am { static constexpr bool PERM = false, AFTER_DRAIN = true; const float* AL; bf16_t* ucat;
    DEVI void fused(f32x4 (&acc)[2][2][4][2], const Unit& u, int wr, int wc, int fr, int fq, LAS unsigned char* lds, int wid, int lane) const {
        LAS float* sl = (LAS float*)lds;
#pragma unroll
        for (int ai = 0; ai < 2; ++ai)
#pragma unroll
            for (int m = 0; m < 4; ++m) { const int row = ai * HALF + wr * 64 + m * 16 + fr;
#pragma unroll
                for (int n = 0; n < 2; ++n) *(LAS f32x4*)(sl + row * 128 + wc * 32 + n * 16 + 4 * fq) = acc[ai][0][m][n]; }
        asm volatile("s_waitcnt lgkmcnt(0)" ::: "memory"); __builtin_amdgcn_s_barrier(); asm volatile("" ::: "memory");
        const int tid = wid * 64 + lane;
        if (tid < 128) { const int bb = tid >> 6, p = tid & 63, g = u.g;
            const float ar = AL[(g * 64 + p) * 2], ai_ = AL[(g * 64 + p) * 2 + 1];
            float hr = 0.f, hi = 0.f;
            for (int c = 0; c < NCH; ++c) { const int row = bb * NCH + c;
                bf16_t* up = ucat + ((size_t)g * UROWS + u.pm * BM + row) * UK + 512 + p;
                up[0] = f2bf(hr); up[64] = f2bf(hi);
                const float sr = sl[row * 128 + p], si = sl[row * 128 + 64 + p];
                const float nr = ar * hr - ai_ * hi + sr, ni = ar * hi + ai_ * hr + si; hr = nr; hi = ni; } }
        asm volatile("s_waitcnt lgkmcnt(0)" ::: "memory"); __builtin_amdgcn_s_barrier(); asm volatile("" ::: "memory");
    } };
struct EpiG1 { static constexpr bool PERM = true, AFTER_DRAIN = false; bf16_t* ucat; bf16_t* q; bf16_t* k; bf16_t* v; bf16_t* sg; const float* qg; const float* kg; const float* rope; float* qraw; float* kraw;
    DEVI void operator()(const f32x4 (&acc)[2][2][4][2], const Unit& u, int wr, int wc, int fr, int fq) const {
        const int pn = u.pn, row0 = u.pm * BM + wr * 64 + fr;
        if (pn < 2) {
#pragma unroll
            for (int ai = 0; ai < 2; ++ai)
#pragma unroll
                for (int m = 0; m < 4; ++m) { const int row = row0 + ai * HALF + m * 16, b = row >> 12, s = row & 4095;
#pragma unroll
                    for (int bj = 0; bj < 2; ++bj) { const int c = pn * BM + bj * HALF + wc * 32 + 8 * fq, g = c >> 4, ci = c & 15;
                        *(u32x4*)(ucat + ((size_t)g * UROWS + b * NCH + (s >> 5)) * UK + (s & 31) * 16 + ci) = pk8(acc[ai][bj][m][0], acc[ai][bj][m][1]); } }
        } else if (pn < 6) {
            const bool isk = pn >= 4; const int hh = (pn & 1) * 4 + wc;
#if G1_RAWQK
            { float* raw = isk ? kraw : qraw;
#pragma unroll
              for (int ai = 0; ai < 2; ++ai)
#pragma unroll
                for (int m = 0; m < 4; ++m) { const int row = row0 + ai * HALF + m * 16;
#pragma unroll
                    for (int bj = 0; bj < 2; ++bj)
#pragma unroll
                        for (int n = 0; n < 2; ++n) *(f32x4*)(raw + (size_t)row * 512 + hh * 64 + 32 * bj + 8 * fq + 4 * n) = acc[ai][bj][m][n]; }
              return; }
#endif
            const float* gn = isk ? kg : qg; bf16_t* dst = isk ? k : q; const float sc = isk ? 1.0f : QSCALE;
            f32x4 gv[2][2];
#pragma unroll
            for (int bj = 0; bj < 2; ++bj)
#pragma unroll
                for (int n = 0; n < 2; ++n) gv[bj][n] = *(const f32x4*)(gn + 32 * bj + 8 * fq + 4 * n);
#pragma unroll
            for (int ai = 0; ai < 2; ++ai)
#pragma unroll
                for (int m = 0; m < 4; ++m) { const int row = row0 + ai * HALF + m * 16, s = row & 4095;
                    float ss = 0.f;
#pragma unroll
                    for (int bj = 0; bj < 2; ++bj)
#pragma unroll
                        for (int n = 0; n < 2; ++n) { const f32x4 x = acc[ai][bj][m][n]; ss += (x[0] * x[0] + x[1] * x[1]) + (x[2] * x[2] + x[3] * x[3]); }
                    ss += xshfl(ss, 16, fq * 16 + fr); ss += xshfl(ss, 32, fq * 16 + fr);
                    const float rstd = 1.0f / sqrtf(ss * (1.0f / 64.0f) + NORM_EPS);
                    f32x4 o1[2], o2[2];
#pragma unroll
                    for (int n = 0; n < 2; ++n) { const float* rp = rope + ((size_t)s * 32 + 8 * fq + 4 * n) * 2;
                        const f32x4 r0 = *(const f32x4*)rp, r1 = *(const f32x4*)(rp + 4);
                        const f32x4 cv = (f32x4){r0[0], r0[2], r1[0], r1[2]}, sv = (f32x4){r0[1], r0[3], r1[1], r1[3]};
                        const f32x4 x1 = acc[ai][0][m][n] * rstd * gv[0][n], x2 = acc[ai][1][m][n] * rstd * gv[1][n];
                        o1[n] = (x1 * cv - x2 * sv) * sc; o2[n] = (x2 * cv + x1 * sv) * sc; }
                    const u32x4 w1 = pk8(o1[0], o1[1]), w2 = pk8(o2[0], o2[1]);
                    bf16_t* dp = dst + (size_t)row * 512 + hh * 64 + 8 * fq;
                    *(u32x4*)dp = w1; *(u32x4*)(dp + 32) = w2;
                    if (m & 1) asm volatile("" ::: "memory"); }
        } else if (pn < 8) {
#pragma unroll
            for (int ai = 0; ai < 2; ++ai)
#pragma unroll
                for (int m = 0; m < 4; ++m) { bf16_t* rp = v + (size_t)(row0 + ai * HALF + m * 16) * 512 + (pn - 6) * BM + wc * 32 + 8 * fq;
#pragma unroll
                    for (int bj = 0; bj < 2; ++bj) *(u32x4*)(rp + bj * HALF) = pk8(acc[ai][bj][m][0], acc[ai][bj][m][1]); }
        } else {
#pragma unroll
            for (int ai = 0; ai < 2; ++ai)
#pragma unroll
                for (int m = 0; m < 4; ++m) { bf16_t* rp = sg + (size_t)(row0 + ai * HALF + m * 16) * 2048 + (pn - 8) * BM + wc * 32 + 8 * fq;
#pragma unroll
                    for (int bj = 0; bj < 2; ++bj) { const f32x4 a = acc[ai][bj][m][0], b = acc[ai][bj][m][1];
                        *(u32x4*)(rp + bj * HALF) = pk8((f32x4){fsig(a[0]), fsig(a[1]), fsig(a[2]), fsig(a[3])}, (f32x4){fsig(b[0]), fsig(b[1]), fsig(b[2]), fsig(b[3])}); } }
        }
    } };
}

struct CvtItem { const float* src; bf16_t* dst; int N, K; };
DEVI void cvt_load(const CvtItem& it, float (&v)[32], int lane) {
#pragma unroll
    for (int i = 0; i < 32; ++i) v[i] = it.src[(size_t)(2 * i + (lane >> 5)) * it.N + (lane & 31)];
}
DEVI void cvt_store(const CvtItem& it, const float (&v)[32], LAS float* scr, int lane) {
#pragma unroll
    for (int i = 0; i < 32; ++i) scr[(2 * i + (lane >> 5)) * 33 + (lane & 31)] = v[i];
    asm volatile("s_waitcnt lgkmcnt(0)" ::: "memory");
    const int c = lane & 7;
#pragma unroll
    for (int j = 0; j < 4; ++j) { const int n = (lane >> 3) + 8 * j; const LAS float* s = scr + (8 * c) * 33 + n;
        u32x4 o; o.x = pk2(s[0 * 33], s[1 * 33]); o.y = pk2(s[2 * 33], s[3 * 33]); o.z = pk2(s[4 * 33], s[5 * 33]); o.w = pk2(s[6 * 33], s[7 * 33]);
        *(u32x4*)(it.dst + (size_t)n * it.K + 8 * c) = o; }
    asm volatile("s_waitcnt lgkmcnt(0)" ::: "memory");
}
constexpr int CV_IN = 16 * 128, CV_GLU = 8 * 64, CV_ATT = 8 * 32, CV_OUT = 16 * 32, CV_GU1 = 16 * 32, CV_DN1 = 8 * 32;
constexpr int CV_PER_LAYER = CV_IN + CV_GLU + CV_ATT + CV_OUT + NEXP * (CV_GU1 + CV_DN1);
DEVI CvtItem cvt_decode(int it, const float* w_in, const float* w_glu, const float* w_attn, const float* w_out, const float* w_gu, const float* w_dn,
                        bf16_t* WIN, bf16_t* WGLU, bf16_t* WATT, bf16_t* WOUT, bf16_t* WGU, bf16_t* WDN) {
    const int l = it / CV_PER_LAYER; int r = it % CV_PER_LAYER;
    const float* W; bf16_t* WT; int K, N, mode;
    if (r < CV_IN) { W = w_in + (size_t)l * D * D_IN; WT = WIN + (size_t)l * D_IN * D; K = D; N = D_IN; mode = 1; }
    else if ((r -= CV_IN) < CV_GLU) { W = w_glu + (size_t)l * 512 * 2048; WT = WGLU + (size_t)l * 2048 * 512; K = 512; N = 2048; mode = 2; }
    else if ((r -= CV_GLU) < CV_ATT) { W = w_attn + (size_t)l * 512 * 1024; WT = WATT + (size_t)l * 1024 * 512; K = 512; N = 1024; mode = 0; }
    else if ((r -= CV_ATT) < CV_OUT) { W = w_out + (size_t)l * 1024 * 1024; WT = WOUT + (size_t)l * 1024 * 1024; K = 1024; N = 1024; mode = 0; }
    else if ((r -= CV_OUT) < NEXP * CV_GU1) { const int e = r / CV_GU1; r %= CV_GU1; W = w_gu + ((size_t)l * NEXP + e) * 1024 * 1024; WT = WGU + ((size_t)l * NEXP + e) * 1024 * 1024; K = 1024; N = 1024; mode = 3; }
    else { r -= NEXP * CV_GU1; const int e = r / CV_DN1; r %= CV_DN1; W = w_dn + ((size_t)l * NEXP + e) * 512 * 1024; WT = WDN + ((size_t)l * NEXP + e) * 1024 * 512; K = 512; N = 1024; mode = 0; }
    const int nblk = N / 32, kb = r / nblk, nb = r % nblk, nd = 32 * nb;
    int ns = nd;
    if (mode == 1) { const int pn = nd >> 8, tc = nd & 255; if (pn >= 2 && pn < 6) { const int sec = pn < 4 ? 512 : 1024, hh = (pn & 1) * 4 + ((tc >> 5) & 3); ns = sec + hh * 64 + 32 * (tc >> 7); } }
    else if (mode == 2) { const int pn = nd >> 8, tc = nd & 255; ns = (tc < 128) ? 128 * pn + tc : 1024 + 128 * pn + (tc - 128); }
    else if (mode == 3) { const int pn = nd >> 8, tc = nd & 255; ns = (tc < 128) ? 128 * pn + tc : 512 + 128 * pn + (tc - 128); }
    return CvtItem{W + (size_t)(64 * kb) * N + ns, WT + (size_t)nd * K + 64 * kb, N, K};
}
constexpr int CVQ_BASE = CV_IN + CV_GLU + CV_ATT + CV_OUT;
constexpr int CVQ_PER_BARRIER = 2;
constexpr int CVQ_TOTAL = DEPTH * CV_PER_LAYER - CVQ_BASE;
constexpr int CVQ_LIM_MOE0 = CV_PER_LAYER - CVQ_BASE;
constexpr int CVQ_LIM_PROJ1 = CVQ_LIM_MOE0 + CVQ_BASE;
struct CvtQ { const float* w_in; const float* w_glu; const float* w_attn; const float* w_out; const float* w_gu; const float* w_dn;
              bf16_t* WIN_; bf16_t* WGLU_; bf16_t* WATT_; bf16_t* WOUT_; bf16_t* WGU_; bf16_t* WDN_; LAS unsigned* head; LAS unsigned char* lds; int wave, lane, c, G;
    DEVI void item(int q) const { const CvtItem c = cvt_decode(q + CVQ_BASE, w_in, w_glu, w_attn, w_out, w_gu, w_dn, WIN_, WGLU_, WATT_, WOUT_, WGU_, WDN_);
        float v[32]; cvt_load(c, v, lane); cvt_store(c, v, (LAS float*)(lds + wave * 16384), lane); }
    DEVI int take() const { unsigned j = 0u; if (lane == 0) j = __hip_atomic_fetch_add(head, 1u, __ATOMIC_RELAXED, __HIP_MEMORY_SCOPE_WORKGROUP); return c + G * __builtin_amdgcn_readfirstlane((int)j); }
    DEVI int peek() const { return c + G * __builtin_amdgcn_readfirstlane((int)__hip_atomic_load(head, __ATOMIC_RELAXED, __HIP_MEMORY_SCOPE_WORKGROUP)); }
    DEVI void run_until(volatile LAS unsigned* genw, unsigned n) const {
        bool empty = peek() >= CVQ_TOTAL; int budget = CVQ_PER_BARRIER;
        while (*genw < n) {
            if (empty || budget == 0) { __builtin_amdgcn_s_sleep(4); continue; }
            --budget;
            const int q = take();
            if (q >= CVQ_TOTAL) { empty = true; continue; }
            item(q);
        }
    }
    DEVI void catchup(int limit) const { for (;;) { if (peek() >= limit) break; const int q = take(); if (q >= CVQ_TOTAL) break; item(q); } }
};
DEVI int fresh_lane() { int l = (int)__builtin_amdgcn_mbcnt_hi(~0u, __builtin_amdgcn_mbcnt_lo(~0u, 0u)); asm volatile("" : "+v"(l)); return l; }
DEVI CvtQ make_cvtq(const Args& a, LAS unsigned char* lds, int wave, int lane) {
    unsigned char* w = a.ws;
    return CvtQ{a.in[2], a.in[11], a.in[14], a.in[15], a.in[21], a.in[22], (bf16_t*)(w + WS_WIN), (bf16_t*)(w + WS_WGLU), (bf16_t*)(w + WS_WATT), (bf16_t*)(w + WS_WOUT), (bf16_t*)(w + WS_WGU), (bf16_t*)(w + WS_WDN),
                (LAS unsigned*)(lds + LDSCTL_OFF) + 5, lds, wave, lane, (int)blockIdx.x, (int)gridDim.x};
}
DEVI void ph_convert_first(const Frame& F, const CvtQ& Q) { for (int it = F.gw; it < CVQ_BASE; it += F.NGW) Q.item(it - CVQ_BASE); }
DEVI void xcd_barrier_w(const XcdBarrier& b, unsigned n, volatile LAS unsigned* genw, const CvtQ& Q) {
    asm volatile("s_waitcnt vmcnt(0)" ::: "memory");
    __syncthreads();
    if (Q.wave == 0) {
        if (threadIdx.x == 0) {
            unsigned* bar = b.bar;
            __builtin_amdgcn_s_waitcnt(0);
            unsigned nloc = b.st[0], nx = b.st[1];
            if (nloc == 0u) { xcd_barrier_complete(bar, b.x, nloc, nx); b.st[0] = nloc; b.st[1] = nx; }
            const unsigned old = xb_add(&bar[XB_XSUB(b.x)], 1u);
            const unsigned gen = old / nloc;
            if (old + 1u == (gen + 1u) * nloc) {
                __builtin_amdgcn_fence(__ATOMIC_RELEASE, "agent");
                asm volatile("s_waitcnt vmcnt(0)" ::: "memory");
                const unsigned og = xb_add(&bar[XB_TOP], 1u);
                const unsigned tg = og / nx;
                if (og + 1u == (tg + 1u) * nx) xb_add(&bar[XB_TOPGEN], 1u);
                else XB_SPIN(xb_ld(&bar[XB_TOPGEN]) == tg, bar);
                __builtin_amdgcn_fence(__ATOMIC_ACQUIRE, "agent");
                xb_add(&bar[XB_XGEN(b.x)], 1u);
                asm volatile("s_waitcnt vmcnt(0)" ::: "memory");
            } else {
                XB_SPIN(xb_ld(&bar[XB_XGEN(b.x)]) == gen, bar);
                __builtin_amdgcn_fence(__ATOMIC_ACQUIRE, "agent");
                asm volatile("s_waitcnt vmcnt(0)" ::: "memory");
            }
            *genw = n;
        }
    } else Q.run_until(genw, n);
    __syncthreads();
}


DEVI void moe_tstart(const Frame& F, const unsigned* cnt, volatile LAS int* tstart) { expert_prefix(F, cnt, tstart, 1); }
DEVI void moe_gather_table(const Frame& F, int v, const unsigned* cnt, const int* list, volatile LAS int* tstart, LAS unsigned* tab) {
    for (int j = F.tid; j < 8 * 256; j += NTHR) {
        const int i = j >> 8, r = j & 255, U = i * F.G + v, rt = U >> 2; if (rt >= tstart[NEXP]) continue;
        int e = 0;
        for (int q = 1; q < NEXP; ++q) e = (rt >= tstart[q]) ? q : e;
        const int n = (int)cnt[e], idx = (rt - tstart[e]) * 256 + r;
        tab[j] = (unsigned)list[(size_t)e * LIST_CAP + (idx < n ? idx : 0)] * (unsigned)(D * 2);
    }
    __syncthreads();
}
DEVI void ph_zero_ksum(const Frame& F, float* ksum) { for (int i = F.gt; i < BATCH * NH * NBLK * 64; i += F.NGT) ksum[i] = 0.f; }

namespace attn_body {
using bf16=__hip_bfloat16;
using bf16x8=__attribute__((ext_vector_type(8)))short;
using s16x4=__attribute__((ext_vector_type(4)))short;
using f32x16=__attribute__((ext_vector_type(16)))float;
using f32x4=__attribute__((ext_vector_type(4)))float;
using u32x4=__attribute__((ext_vector_type(4)))unsigned;
constexpr int BATCH=8,NHEAD=8,SEQ=4096,D=64,DM=NHEAD*D;
constexpr int NW=8,QBLK=32,QB=QBLK*NW,KVBLK=64,NQB=SEQ/QB;
constexpr int ATTN_PITCH=DM, ATTN_UNIT_ROWS=QB;
__device__ __forceinline__ int crow(int r,int hi){return (r&3)+8*(r>>2)+4*hi;}
#define SBAR() __builtin_amdgcn_sched_barrier(0)
__device__ __forceinline__ void cmask(f32x16&p0,f32x16&p1,int jb,int qrel,int hi){
  const float NEG=-INFINITY; int kb=64*jb+4*hi;
  #pragma unroll
  for(int r=0;r<16;++r){int kv=kb+(r&3)+8*(r>>2); if(kv>qrel)p0[r]=NEG; if(kv+32>qrel)p1[r]=NEG;}
}

constexpr int NSLOT=3, SLOTB=8192;
constexpr int LDS_K=0, LDS_V=NSLOT*SLOTB, LDS_WS=2*NSLOT*SLOTB, LDS_OST=LDS_WS+NW*64*4, LDS_BYTES=LDS_OST+NW*4096;
constexpr float C2=0.125f*1.4426950408889634f;
__device__ __forceinline__ void glds16(const void*gsrc,unsigned lds_dst){unsigned keep;
  asm volatile("s_mov_b32 %0, m0\n\ts_mov_b32 m0, %2\n\ts_nop 0\n\tglobal_load_lds_dwordx4 %1, off\n\ts_mov_b32 m0, %0":"=&s"(keep):"v"(gsrc),"s"(lds_dst):"memory");}
__device__ __forceinline__ float max3f(float a,float b,float c){float r;asm("v_max3_f32 %0, %1, %2, %3":"=v"(r):"v"(a),"v"(b),"v"(c));return r;}
__device__ __forceinline__ float max2f(float a,float b){float r;asm("v_max_f32_e32 %0, %1, %2":"=v"(r):"v"(a),"v"(b));return r;}
__device__ __forceinline__ float fadd_s(float a,float b){float r;asm("v_add_f32_e32 %0, %1, %2":"=v"(r):"v"(a),"v"(b));return r;}
__device__ __forceinline__ float fsub_s(float a,float b){float r;asm("v_sub_f32_e32 %0, %1, %2":"=v"(r):"v"(a),"v"(b));return r;}
typedef float f32x2_t __attribute__((ext_vector_type(2))); typedef __bf16 bf16x2_t __attribute__((ext_vector_type(2)));
__device__ __forceinline__ unsigned cvtpk_s(float lo,float hi){f32x2_t v={lo,hi};bf16x2_t b=__builtin_convertvector(v,bf16x2_t);return __builtin_bit_cast(unsigned,b);}
#define WAIT_BAR(N) asm volatile("s_waitcnt vmcnt(" #N ") lgkmcnt(0)\n\ts_barrier":::"memory")

__device__ __forceinline__ void qkt(f32x16&p0,f32x16&p1,const char*Kslot,const bf16x8*qr,const f32x16&negm,int r32,int hi){
  const char*kb=Kslot+hi*1024+r32*16;
  #pragma unroll
  for(int d0=0;d0<4;++d0){
    const bf16x8 b0=*reinterpret_cast<const bf16x8*>(kb+d0*2048);
    const bf16x8 b1=*reinterpret_cast<const bf16x8*>(kb+d0*2048+512);
    if(d0==0){p0=__builtin_amdgcn_mfma_f32_32x32x16_bf16(b0,qr[0],negm,0,0,0);p1=__builtin_amdgcn_mfma_f32_32x32x16_bf16(b1,qr[0],negm,0,0,0);}
    else{p0=__builtin_amdgcn_mfma_f32_32x32x16_bf16(b0,qr[d0],p0,0,0,0);p1=__builtin_amdgcn_mfma_f32_32x32x16_bf16(b1,qr[d0],p1,0,0,0);}}
}
typedef __attribute__((address_space(3))) const char* lds_cptr;
typedef short v4i16_t __attribute__((ext_vector_type(4)));
__device__ __forceinline__ void kload8(bf16x8*kf,lds_cptr kp){
  kf[0]=*(const __attribute__((address_space(3))) bf16x8*)(kp);      kf[1]=*(const __attribute__((address_space(3))) bf16x8*)(kp+512);
  kf[2]=*(const __attribute__((address_space(3))) bf16x8*)(kp+2048); kf[3]=*(const __attribute__((address_space(3))) bf16x8*)(kp+2560);
  kf[4]=*(const __attribute__((address_space(3))) bf16x8*)(kp+4096); kf[5]=*(const __attribute__((address_space(3))) bf16x8*)(kp+4608);
  kf[6]=*(const __attribute__((address_space(3))) bf16x8*)(kp+6144); kf[7]=*(const __attribute__((address_space(3))) bf16x8*)(kp+6656);
}
__device__ __forceinline__ void kload2(bf16x8*kf,lds_cptr kp,int j){ kf[2*j]=*(const __attribute__((address_space(3))) bf16x8*)(kp+j*2048); kf[2*j+1]=*(const __attribute__((address_space(3))) bf16x8*)(kp+j*2048+512); }
__device__ __forceinline__ s16x4 vtr(lds_cptr p){ return __builtin_bit_cast(s16x4,__builtin_amdgcn_ds_read_tr16_b64_v4i16((__attribute__((address_space(3))) v4i16_t*)p)); }
__device__ __forceinline__ float rowmax(const f32x16&p0,const f32x16&p1){
  float a=max3f(p0[0],p0[1],p1[0]),b=max3f(p0[2],p0[3],p1[1]);a=max3f(a,p1[2],p1[3]);
  #pragma unroll
  for(int r=4;r<16;r+=4){a=max3f(a,p0[r],p0[r+1]);b=max3f(b,p0[r+2],p0[r+3]);a=max3f(a,p1[r],p1[r+1]);b=max3f(b,p1[r+2],p1[r+3]);}
  const float m=max2f(a,b);
  auto rr=__builtin_amdgcn_permlane32_swap(__float_as_uint(m),__float_as_uint(m),false,false);
  return max2f(__uint_as_float(rr[0]),__uint_as_float(rr[1]));
}
__device__ __forceinline__ void pv(f32x16*o,int vb,bf16x8 pa0,bf16x8 pa1,bf16x8 pa2,bf16x8 pa3){
  #pragma unroll
  for(int d0=0;d0<2;++d0){s16x4 lo[4],hi[4];
    #pragma unroll
    for(int ks=0;ks<4;++ks){
      asm volatile("ds_read_b64_tr_b16 %0,%1 offset:%c2":"=&v"(lo[ks]):"v"(vb),"i"(d0*4096+ks*1024):"memory");
      asm volatile("ds_read_b64_tr_b16 %0,%1 offset:%c2":"=&v"(hi[ks]):"v"(vb),"i"(d0*4096+ks*1024+512):"memory");}
    asm volatile("s_waitcnt lgkmcnt(0)":::"memory");SBAR();
    #define PK(k) (bf16x8){lo[k][0],lo[k][1],lo[k][2],lo[k][3],hi[k][0],hi[k][1],hi[k][2],hi[k][3]}
    o[d0]=__builtin_amdgcn_mfma_f32_32x32x16_bf16(pa0,PK(0),o[d0],0,0,0);
    o[d0]=__builtin_amdgcn_mfma_f32_32x32x16_bf16(pa1,PK(1),o[d0],0,0,0);
    o[d0]=__builtin_amdgcn_mfma_f32_32x32x16_bf16(pa2,PK(2),o[d0],0,0,0);
    o[d0]=__builtin_amdgcn_mfma_f32_32x32x16_bf16(pa3,PK(3),o[d0],0,0,0);
    #undef PK
  }
}

#ifndef ATTN_STORE16
#define ATTN_STORE16(p,v) (*(u32x4*)(p)=(v))
#endif
template<int THRL> __device__ __forceinline__ void attn_unit(int b,int h,int qb,const bf16*Q,const bf16*__restrict__ K,const bf16*__restrict__ V,bf16*O,const unsigned*__restrict__ sel,char*shm,int tid_in){
  const int tid=tid_in,lane=tid&63,r32=lane&31,hi=lane>>5; const int wid=__builtin_amdgcn_readfirstlane(tid>>6);
  const long rowbase=(long)b*SEQ; const int q0=qb*QB;
  const bf16*Qw=Q+(rowbase+q0+wid*QBLK)*DM+h*D;
  const bf16*Kh=K+rowbase*DM+h*D,*Vh=V+rowbase*DM+h*D;
  const unsigned lds0=(unsigned)(uintptr_t)shm;
  float*wsf=(float*)(shm+LDS_WS)+wid*64;
  const bf16*ksrc=Kh+(long)lane*DM+wid*8;
  const bf16*vsrc=Vh+(long)(16*(wid&3)+(lane>>2))*DM+(wid>>2)*32+(lane&3)*8;
  const unsigned kdst=lds0+LDS_K+wid*1024, vdst=lds0+LDS_V+wid*1024;
  #define DMA_K(t,slot) glds16(ksrc+(long)(t)*KVBLK*DM,(unsigned)__builtin_amdgcn_readfirstlane(kdst+(slot)))
  #define DMA_V(t,slot) glds16(vsrc+(long)(t)*KVBLK*DM,(unsigned)__builtin_amdgcn_readfirstlane(vdst+(slot)))
  const int vb0=(int)(lds0+LDS_V)+((lane>>4)&1)*32+(lane&3)*8+(4*hi+((lane&15)>>2))*64;
  const char*Kbase=shm+LDS_K; bf16x8 kf[8];
  const lds_cptr shm3=(lds_cptr)shm; const lds_cptr kp0=shm3+LDS_K+hi*1024+r32*16; const lds_cptr vp0=shm3+LDS_V+((lane>>4)&1)*32+(lane&3)*8+(4*hi+((lane&15)>>2))*64;
  const int NT=(q0+QB)/KVBLK;
  DMA_K(0,0);DMA_V(0,0);DMA_K(1,SLOTB);
  bf16x8 qr[4];
  #pragma unroll
  for(int d0=0;d0<4;++d0)qr[d0]=*reinterpret_cast<const bf16x8*>(&Qw[(long)r32*DM+d0*16+hi*8]);
  const unsigned selmask=sel[((size_t)(b*NHEAD+h))*SEQ+q0+wid*QBLK+r32];
  const float NEGINF=-INFINITY;
  float mhat=0.f,l_reg=0.f;f32x16 o[2];o[0]=f32x16{};o[1]=f32x16{};f32x16 negm=f32x16{};asm volatile("":"+v"(negm));
  const int qrel=wid*QBLK+r32;
  #define CMASK(P0,P1,t) do{int jb_=(t)-(NT-4); if(jb_>=0)cmask(P0,P1,jb_,qrel,hi);}while(0)
  bool resc=false;
  #define START(P0,P1) do{ const float rm=rowmax(P0,P1); resc=false; \
    { const float dl=__builtin_fmaxf(rm,-64.f); mhat=fadd_s(mhat,dl); \
      _Pragma("unroll") for(int r=0;r<16;++r){P0[r]=fsub_s(P0[r],dl);P1[r]=fsub_s(P1[r],dl);} \
      _Pragma("unroll") for(int r=0;r<16;++r)negm[r]=-mhat; asm volatile("":"+v"(negm)); } \
    _Pragma("unroll") for(int r=0;r<16;++r)P0[r]=__builtin_amdgcn_exp2f(P0[r]); }while(0)
  #define RESC() do{ if(resc){ asm volatile("s_waitcnt lgkmcnt(0)":::"memory"); \
      _Pragma("unroll") for(int d_=0;d_<2;++d_) _Pragma("unroll") for(int r=0;r<16;++r)o[d_][r]*=wsf[crow(r,hi)]; } }while(0)
  f32x16 pA0,pA1,pB0,pB1;
  int sl_prev=0,sl_cur=0,sl_next=SLOTB;
  #define ROT() do{sl_prev=sl_cur;sl_cur=sl_next;sl_next=(sl_next==(NSLOT-1)*SLOTB)?0:sl_next+SLOTB;}while(0)
  DMA_K(2,2*SLOTB);
  WAIT_BAR(3);
  #define SETNEGM(t) do{ const bool keep_=((t)>=NT-4)||(((selmask>>((t)>>2))&1u)!=0u); const float nm_=keep_?-mhat:NEGINF; _Pragma("unroll") for(int r=0;r<16;++r)negm[r]=nm_; asm volatile("":"+v"(negm)); }while(0)
  SETNEGM(0);
  qkt(pA0,pA1,Kbase,qr,negm,r32,hi);asm volatile("s_nop 15\n\ts_nop 7":"+v"(pA0),"+v"(pA1));CMASK(pA0,pA1,0);
  START(pA0,pA1);
  _Pragma("unroll") for(int r=0;r<16;++r)pA1[r]=__builtin_amdgcn_exp2f(pA1[r]);
  WAIT_BAR(0);
  DMA_K(3,0);DMA_V(1,SLOTB);
  ROT();
  kload8(kf,kp0+sl_cur);
  WAIT_BAR(2);
  s16x4 vlo[8],vhi[8]; u32x4 pw0,pw1,pw2,pw3;
  #define PKW(P,B) cvtpk_s(P[B],P[B+1])
  #define PAF(k) __builtin_bit_cast(bf16x8,pw##k)
  #define VFR(i) (bf16x8){vlo[i][0],vlo[i][1],vlo[i][2],vlo[i][3],vhi[i][0],vhi[i][1],vhi[i][2],vhi[i][3]}
  #define PIN(x) asm volatile("":"+v"(x))
  #define MX3(a,b,c) __builtin_fmaxf(__builtin_fmaxf((a),(b)),(c))
  #define GAPA(MF,A0,A1,A2,A3,W0,W1,PW) do{ MF; sacc+=A0; sacc+=A1; sacc+=A2; sacc+=A3; PIN(sacc); W0; W1; PIN(PW); SBAR(); }while(0)
  #define EX(v) __builtin_amdgcn_exp2f(v)
  #define GAPB(MF,X,B) do{ MF; X[B]=EX(X[B]); X[B+1]=EX(X[B+1]); X[B+2]=EX(X[B+2]); X[B+3]=EX(X[B+3]); PIN(X); SBAR(); }while(0)
  #define VRD(i) do{ vlo[i]=vtr(vp_+(((i)>>2)*4096+((i)&3)*1024)); vhi[i]=vtr(vp_+(((i)>>2)*4096+((i)&3)*1024+512)); }while(0)
  #define KRD(G,j) do{ if(G){ kload2(kf,kp0+sl_next,j); SBAR(); } }while(0)
  #define STEP(C0,C1,P0,P1,t,GK,GV,GL) do{ SBAR(); SETNEGM(t); SBAR(); \
    const lds_cptr vp_=vp0+sl_prev; \
    VRD(0); SBAR(); float sacc=(P0[0]+P0[1]); \
    GAPA(C0=__builtin_amdgcn_mfma_f32_32x32x16_bf16(kf[0],qr[0],negm,0,0,0), P0[2],P0[3],P0[4],P0[5],     pw0[0]=PKW(P0,0), pw0[1]=PKW(P0,2), pw0); \
    VRD(4); SBAR(); GAPA(C1=__builtin_amdgcn_mfma_f32_32x32x16_bf16(kf[1],qr[0],negm,0,0,0), P0[6],P0[7],P0[8],P0[9],     pw0[2]=PKW(P0,4), pw0[3]=PKW(P0,6), pw0); \
    VRD(1); SBAR(); GAPA(C0=__builtin_amdgcn_mfma_f32_32x32x16_bf16(kf[2],qr[1],C0,0,0,0),   P0[10],P0[11],P0[12],P0[13], pw1[0]=PKW(P0,8), pw1[1]=PKW(P0,10), pw1); \
    VRD(5); SBAR(); GAPA(C1=__builtin_amdgcn_mfma_f32_32x32x16_bf16(kf[3],qr[1],C1,0,0,0),   P0[14],P0[15],P1[0],P1[1],   pw1[2]=PKW(P0,12),pw1[3]=PKW(P0,14), pw1); \
    VRD(2); SBAR(); GAPA(C0=__builtin_amdgcn_mfma_f32_32x32x16_bf16(kf[4],qr[2],C0,0,0,0),   P1[2],P1[3],P1[4],P1[5],     pw2[0]=PKW(P1,0), pw2[1]=PKW(P1,2), pw2); \
    VRD(6); SBAR(); GAPA(C1=__builtin_amdgcn_mfma_f32_32x32x16_bf16(kf[5],qr[2],C1,0,0,0),   P1[6],P1[7],P1[8],P1[9],     pw2[2]=PKW(P1,4), pw2[3]=PKW(P1,6), pw2); \
    VRD(3); SBAR(); GAPA(C0=__builtin_amdgcn_mfma_f32_32x32x16_bf16(kf[6],qr[3],C0,0,0,0),   P1[10],P1[11],P1[12],P1[13], pw3[0]=PKW(P1,8), pw3[1]=PKW(P1,10), pw3); \
    VRD(7); SBAR(); GAPA(C1=__builtin_amdgcn_mfma_f32_32x32x16_bf16(kf[7],qr[3],C1,0,0,0),   P1[14],P1[15],0.f,0.f,       pw3[2]=PKW(P1,12),pw3[3]=PKW(P1,14), pw3); \
    l_reg+=sacc; \
    if(GK){DMA_K((t)+3,sl_cur);} if(GV){DMA_V((t)+1,sl_next);} \
    CMASK(C0,C1,t); \
    { float a=MX3(C0[0],C0[1],C1[0]),b=MX3(C0[2],C0[3],C1[1]); a=MX3(a,C1[2],C1[3]); \
      _Pragma("unroll") for(int r=4;r<16;r+=4){a=MX3(a,C0[r],C0[r+1]);b=MX3(b,C0[r+2],C0[r+3]);a=MX3(a,C1[r],C1[r+1]);b=MX3(b,C1[r+2],C1[r+3]);} \
      float rm=__builtin_fmaxf(a,b); { auto rr=__builtin_amdgcn_permlane32_swap(__float_as_uint(rm),__float_as_uint(rm),false,false); rm=__builtin_fmaxf(__uint_as_float(rr[0]),__uint_as_float(rr[1])); } \
      resc=false; \
      if(__builtin_expect(__any(rm>(float)THRL),0)){ const float dl=__builtin_fmaxf(rm,0.f); mhat+=dl; \
        _Pragma("unroll") for(int r=0;r<16;++r){C0[r]-=dl;C1[r]-=dl;} \
        const float f=__builtin_amdgcn_exp2f(-dl); l_reg*=f; if(hi==0)wsf[r32]=f; resc=true; } } \
    SBAR(); \
    GAPB(o[0]=__builtin_amdgcn_mfma_f32_32x32x16_bf16(PAF(0),VFR(0),o[0],0,0,0), C0,0); \
    GAPB(o[1]=__builtin_amdgcn_mfma_f32_32x32x16_bf16(PAF(0),VFR(4),o[1],0,0,0), C0,4); \
    KRD(GL,0); GAPB(o[0]=__builtin_amdgcn_mfma_f32_32x32x16_bf16(PAF(1),VFR(1),o[0],0,0,0), C0,8); \
    KRD(GL,1); GAPB(o[1]=__builtin_amdgcn_mfma_f32_32x32x16_bf16(PAF(1),VFR(5),o[1],0,0,0), C0,12); \
    KRD(GL,2); GAPB(o[0]=__builtin_amdgcn_mfma_f32_32x32x16_bf16(PAF(2),VFR(2),o[0],0,0,0), C1,0); \
    KRD(GL,3); GAPB(o[1]=__builtin_amdgcn_mfma_f32_32x32x16_bf16(PAF(2),VFR(6),o[1],0,0,0), C1,4); \
    GAPB(o[0]=__builtin_amdgcn_mfma_f32_32x32x16_bf16(PAF(3),VFR(3),o[0],0,0,0), C1,8); \
    GAPB(o[1]=__builtin_amdgcn_mfma_f32_32x32x16_bf16(PAF(3),VFR(7),o[1],0,0,0), C1,12); \
    }while(0)
  int t=1;
  #undef CMASK
  #define CMASK(P0,P1,t) do{}while(0)
  for(;t+5<NT;t+=2){
    STEP(pB0,pB1,pA0,pA1,t,true,true,true);     WAIT_BAR(2); RESC(); ROT();
    STEP(pA0,pA1,pB0,pB1,t+1,true,true,true);   WAIT_BAR(2); RESC(); ROT();
  }
  #undef CMASK
  #define CMASK(P0,P1,t) do{int jb_=(t)-(NT-4); if(jb_>=0)cmask(P0,P1,jb_,qrel,hi);}while(0)
  #define ENDW(tt) do{ if((tt)+3<NT){WAIT_BAR(2);} else if((tt)+2<NT){WAIT_BAR(1);} else {WAIT_BAR(0);} }while(0)
  for(;t+1<NT;t+=2){
    STEP(pB0,pB1,pA0,pA1,t,(t+3<NT),(t+1<NT),(t+1<NT));       ENDW(t);   RESC(); ROT();
    STEP(pA0,pA1,pB0,pB1,t+1,(t+4<NT),(t+2<NT),(t+2<NT));     ENDW(t+1); RESC(); ROT();
  }
  STEP(pB0,pB1,pA0,pA1,NT-1,false,false,false); RESC();
  { float sacc=pB0[0]+pB0[1]; _Pragma("unroll") for(int r=2;r<16;++r)sacc+=pB0[r]; _Pragma("unroll") for(int r=0;r<16;++r)sacc+=pB1[r]; l_reg+=sacc;
    pw0=(u32x4){PKW(pB0,0),PKW(pB0,2),PKW(pB0,4),PKW(pB0,6)};pw1=(u32x4){PKW(pB0,8),PKW(pB0,10),PKW(pB0,12),PKW(pB0,14)};pw2=(u32x4){PKW(pB1,0),PKW(pB1,2),PKW(pB1,4),PKW(pB1,6)};pw3=(u32x4){PKW(pB1,8),PKW(pB1,10),PKW(pB1,12),PKW(pB1,14)};
    SBAR(); pv(o,vb0+sl_cur,PAF(0),PAF(1),PAF(2),PAF(3)); }
  #undef PKW
  #undef PAF
  #undef VFR
  #undef PIN
  #undef MX3
  #undef GAPA
  #undef GAPB
  #undef EX
  #undef VRD
  #undef KRD
  #undef STEP
  #undef ENDW
  {auto rr=__builtin_amdgcn_permlane32_swap(__float_as_uint(l_reg),__float_as_uint(l_reg),false,false);l_reg=__uint_as_float(rr[0])+__uint_as_float(rr[1]);}
  if(hi==0)wsf[32+r32]=l_reg;asm volatile("s_waitcnt lgkmcnt(0)":::"memory");
  float rli[16];
  #pragma unroll
  for(int r=0;r<16;++r)rli[r]=__builtin_amdgcn_rcpf(wsf[32+crow(r,hi)]);
  bf16*Ow=O+(rowbase+q0+wid*QBLK)*DM+h*D;
  { bf16*stg=(bf16*)(shm+LDS_OST)+wid*2048;
    #pragma unroll
    for(int r=0;r<16;++r){const int orow=crow(r,hi);
      #pragma unroll
      for(int d0=0;d0<2;++d0)stg[orow*64+d0*32+r32]=__float2bfloat16(o[d0][r]*rli[r]);}
    asm volatile("s_waitcnt lgkmcnt(0)":::"memory");
    #pragma unroll
    for(int i=0;i<4;++i){const int row=i*8+(lane>>3),ch=lane&7; const u32x4 v=*(const u32x4*)(stg+row*64+ch*8); ATTN_STORE16(Ow+(long)row*DM+ch*8,v);} }
  asm volatile("s_waitcnt lgkmcnt(0)\n\ts_barrier":::"memory");
  #undef DMA_K
  #undef DMA_V
  #undef CMASK
  #undef START
  #undef SETNEGM
  #undef RESC
  #undef ROT
}
constexpr int ATTN_LDS_BYTES=LDS_BYTES;
struct AttnTensors { const bf16* Q; const bf16* K; const bf16* V; bf16* O; const unsigned* sel; };
struct AttnUnit { int bh; int qb; };
struct StaticOrder {
  int vcu,grid;
  __device__ __forceinline__ explicit StaticOrder(int grid_,int block):vcu((grid_%8==0)?(block%8)*(grid_/8)+block/8:block),grid(grid_){}
  __device__ __forceinline__ bool next(int i,AttnUnit&u)const{
    if(grid==256){ if(i>=4)return false; const int s=vcu&3; u.bh=vcu>>2; u.qb=(i==0)?s:(i==1)?7-s:(i==2)?8+s:15-s; return true; }
    const int U=i*grid+vcu; if(U>=BATCH*NHEAD*NQB)return false; u.bh=U/NQB; u.qb=U%NQB; return true; }
  __device__ __forceinline__ void a_ready(const AttnUnit&)const{}
  __device__ __forceinline__ void done(const AttnUnit&)const{}
};
template<class Sched,int THRL=8> __device__ __forceinline__ void attn_phase(char*lds,const AttnTensors&T,const Sched&S,int tid_in){
  AttnUnit u;
  for(int i=0;S.next(i,u);++i){ S.a_ready(u); attn_unit<THRL>(u.bh/NHEAD,u.bh%NHEAD,u.qb,T.Q,T.K,T.V,T.O,T.sel,lds,tid_in); S.done(u); }
}
#undef SBAR
#undef WAIT_BAR
}


DEVI void ph_moba_select(const Frame& F, const bf16_t* Q, const float* ksum, unsigned* sel) {
    for (int idx = F.gt; idx < BATCH * NH * SEQ; idx += F.NGT) {
        const int s = idx & (SEQ - 1), bh = idx >> 12, b = bh >> 3, hh = bh & 7, qb = s >> 8;
        const bf16_t* qp = Q + ((size_t)b * SEQ + s) * 512 + hh * 64;
        float q[64];
#pragma unroll
        for (int i = 0; i < 8; ++i) { const bf16x8 t = *((const bf16x8*)qp + i);
#pragma unroll
            for (int j = 0; j < 8; ++j) q[8 * i + j] = bf2f((bf16_t)t[j]); }
        float gsc[15];
#pragma unroll
        for (int j = 0; j < 15; ++j) { gsc[j] = -INFINITY;
            if (j < qb) { const float* km = ksum + ((size_t)bh * 16 + j) * 64; float a = 0.f;
#pragma unroll
                for (int i = 0; i < 64; ++i) a += q[i] * km[i];
                gsc[j] = a; } }
        unsigned m = 0u;
#pragma unroll
        for (int t = 0; t < 3; ++t) { float best = -INFINITY; int bi = -1;
#pragma unroll
            for (int j = 0; j < 15; ++j) { const bool ok = (j < qb) && !((m >> j) & 1u) && (gsc[j] > best); best = ok ? gsc[j] : best; bi = ok ? j : bi; }
            if (bi >= 0) m |= 1u << bi; }
        sel[idx] = m;
    }
}


DEVI void ph_router_weights(const Frame& F, const float* wg, const float* we, bf16_t* wr) {
    for (int idx = F.gt; idx < DEPTH * 48 * 1024; idx += F.NGT) {
        const int l = idx / (48 * 1024), r = idx % (48 * 1024), o = r >> 10, kk = r & 1023;
        const float v = (o < 4) ? wg[((size_t)l * D + kk) * 4 + o] : (o < 36) ? we[((size_t)l * D + kk) * 32 + (o - 4)] : 0.f;
        const bf16_t hi = f2bf(v), lo = f2bf(v - bf2f(hi));
        wr[((size_t)l * 2 + 0) * 48 * 1024 + r] = hi; wr[((size_t)l * 2 + 1) * 48 * 1024 + r] = lo;
    }
}
DEVI void ph_norm_router_mfma(const Frame& F, const bf16_t* x, const float* g, const bf16_t* wr, const float* bg, const float* be, bf16_t* h2, unsigned* cnt, int* list, unsigned* rec) {
    const int lane = F.lane, ri = lane & 15, q = lane >> 4;
    LAS float* lg = (LAS float*)(F.lds + F.wave * 3072);
    volatile LAS unsigned* hist = (volatile LAS unsigned*)(F.lds + 8 * 3072);
    const bf16_t* whi = wr; const bf16_t* wlo = wr + 48 * 1024;
    for (int tile = blockIdx.x; tile < NTOK / 128; tile += F.G) {
        if (F.tid < 64) hist[F.tid] = 0u;
        const int row = tile * 128 + F.wave * 16 + ri;
        const bf16_t* xr = x + (size_t)row * D + 8 * q;
        float ss = 0.f;
#pragma unroll 8
        for (int kk = 0; kk < 32; ++kk) { const u32x4 xw = *(const u32x4*)(xr + 32 * kk); const f32x4 a = pg8::unpk_lo(xw, 0), b = pg8::unpk_lo(xw, 1);
            ss += (a[0] * a[0] + a[1] * a[1]) + (a[2] * a[2] + a[3] * a[3]) + (b[0] * b[0] + b[1] * b[1]) + (b[2] * b[2] + b[3] * b[3]); }
        ss += xshfl(ss, 16, lane); ss += xshfl(ss, 32, lane);
        const float rstd = 1.0f / sqrtf(ss * (1.0f / D) + NORM_EPS);
        f32x4 acc[3] = {(f32x4){0.f, 0.f, 0.f, 0.f}, (f32x4){0.f, 0.f, 0.f, 0.f}, (f32x4){0.f, 0.f, 0.f, 0.f}};
#pragma unroll 2
        for (int kk = 0; kk < 32; ++kk) {
            const int k0 = 32 * kk + 8 * q;
            const u32x4 xw = *(const u32x4*)(xr + 32 * kk); const f32x4 a = pg8::unpk_lo(xw, 0), b = pg8::unpk_lo(xw, 1);
            const f32x4 ga = *(const f32x4*)(g + k0), gb = *(const f32x4*)(g + k0 + 4);
            const f32x4 ha = a * rstd * ga, hb = b * rstd * gb;
            const u32x4 hi = pg8::pk8(ha, hb);
            const f32x4 ra = ha - pg8::unpk_lo(hi, 0), rb = hb - pg8::unpk_lo(hi, 1);
            const u32x4 lo = pg8::pk8(ra, rb);
            *(u32x4*)(h2 + (size_t)row * D + k0) = hi;
            const bf16x8 ahi = __builtin_bit_cast(bf16x8, hi), alo = __builtin_bit_cast(bf16x8, lo);
#pragma unroll
            for (int t = 0; t < 3; ++t) {
                const bf16x8 bh = *(const bf16x8*)(whi + (size_t)(16 * t + ri) * 1024 + k0), bl = *(const bf16x8*)(wlo + (size_t)(16 * t + ri) * 1024 + k0);
                acc[t] = __builtin_amdgcn_mfma_f32_16x16x32_bf16(ahi, bh, acc[t], 0, 0, 0);
                acc[t] = __builtin_amdgcn_mfma_f32_16x16x32_bf16(alo, bh, acc[t], 0, 0, 0);
                acc[t] = __builtin_amdgcn_mfma_f32_16x16x32_bf16(ahi, bl, acc[t], 0, 0, 0);
            }
        }
#pragma unroll
        for (int t = 0; t < 3; ++t)
#pragma unroll
            for (int e = 0; e < 4; ++e) lg[(4 * q + e) * 48 + 16 * t + ri] = acc[t][e];
        __syncthreads();
        int e0 = 0, e1 = 0; float w0 = 0.f, w1 = 0.f; unsigned r0 = 0u, r1 = 0u;
        if (lane < 16) {
            const LAS float* L = lg + lane * 48;
            float gl[4]; int gt = 0; float gm = -INFINITY;
#pragma unroll
            for (int i = 0; i < 4; ++i) { gl[i] = L[i] + bg[i]; if (gl[i] > gm) { gm = gl[i]; gt = i; } }
            float gs = 0.f;
#pragma unroll
            for (int i = 0; i < 4; ++i) gs += __expf(gl[i] - gm);
            const float pgv = 1.0f / gs;
            float el[8]; float em = -INFINITY;
#pragma unroll
            for (int i = 0; i < 8; ++i) { el[i] = L[4 + gt * 8 + i] + be[gt * 8 + i]; em = fmaxf(em, el[i]); }
            int i1 = 0; float v1 = -INFINITY;
#pragma unroll
            for (int i = 0; i < 8; ++i) if (el[i] > v1) { v1 = el[i]; i1 = i; }
            int i2 = 0; float v2 = -INFINITY;
#pragma unroll
            for (int i = 0; i < 8; ++i) if (i != i1 && el[i] > v2) { v2 = el[i]; i2 = i; }
            const float p1 = __expf(v1 - em), p2 = __expf(v2 - em);
            w0 = pgv * p1 / (p1 + p2); w1 = pgv * p2 / (p1 + p2);
            e0 = gt * 8 + i1; e1 = gt * 8 + i2;
            r0 = __hip_atomic_fetch_add((LAS unsigned*)hist + e0, 1u, __ATOMIC_RELAXED, __HIP_MEMORY_SCOPE_WORKGROUP); r1 = __hip_atomic_fetch_add((LAS unsigned*)hist + e1, 1u, __ATOMIC_RELAXED, __HIP_MEMORY_SCOPE_WORKGROUP);
        }
        __syncthreads();
        if (F.tid < 32) { const unsigned n = hist[F.tid]; hist[32 + F.tid] = n ? atomicAdd(cnt + F.tid, n) : 0u; }
        __syncthreads();
        if (lane < 16) {
            const int tok = tile * 128 + F.wave * 16 + lane;
            const unsigned pos0 = hist[32 + e0] + r0, pos1 = hist[32 + e1] + r1;
            list[(size_t)e0 * LIST_CAP + pos0] = tok; list[(size_t)e1 * LIST_CAP + pos1] = tok;
            unsigned* rp = rec + (size_t)tok * 8;
            rp[0] = (unsigned)e0; rp[1] = (unsigned)e1; rp[2] = pos0; rp[3] = pos1; rp[4] = __float_as_uint(w0); rp[5] = __float_as_uint(w1);
        }
        __syncthreads();
    }
}


DEVI void ph_moba_select_mfma(const Frame& F, const bf16_t* Q, const float* ksum, unsigned* sel) {
    const int lane = F.lane, r = lane & 31, h = lane >> 5;
    for (int item = F.gw; item < BATCH * NH * (SEQ / 32); item += F.NGW) {
        const int qt = item & 127, bh = item >> 7, b = bh >> 3, hh = bh & 7, s0 = qt * 32, qb = s0 >> 8;
        if (qb == 0) { if (h == 0) sel[(size_t)bh * SEQ + s0 + r] = 0u; continue; }
        f32x16 acc = {};
#pragma unroll
        for (int s = 0; s < 4; ++s) {
            const bf16x8 bq = *(const bf16x8*)(Q + ((size_t)b * SEQ + s0 + r) * 512 + hh * 64 + 16 * s + 8 * h);
            f32x4 k0 = (f32x4){0.f, 0.f, 0.f, 0.f}, k1 = k0;
            if (r < 16) { const float* kp = ksum + ((size_t)bh * 16 + r) * 64 + 16 * s + 8 * h; k0 = *(const f32x4*)kp; k1 = *(const f32x4*)(kp + 4); }
            const u32x4 hi = pg8::pk8(k0, k1), lo = pg8::pk8(k0 - pg8::unpk_lo(hi, 0), k1 - pg8::unpk_lo(hi, 1));
            acc = __builtin_amdgcn_mfma_f32_32x32x16_bf16(__builtin_bit_cast(bf16x8, hi), bq, acc, 0, 0, 0);
            acc = __builtin_amdgcn_mfma_f32_32x32x16_bf16(__builtin_bit_cast(bf16x8, lo), bq, acc, 0, 0, 0);
        }
        float sc[16];
#pragma unroll
        for (int reg = 0; reg < 8; ++reg) { const float mine = acc[reg], other = xshfl(acc[reg], 32, lane); const int base = (reg & 3) + 8 * (reg >> 2);
            sc[base] = h ? other : mine; sc[base + 4] = h ? mine : other; }
        unsigned m = 0u;
#pragma unroll
        for (int t = 0; t < 3; ++t) { float best = -INFINITY; int bi = -1;
#pragma unroll
            for (int j = 0; j < 15; ++j) { const bool ok = (j < qb) && !((m >> j) & 1u) && (sc[j] > best); best = ok ? sc[j] : best; bi = ok ? j : bi; }
            if (bi >= 0) m |= 1u << bi; }
        if (h == 0) sel[(size_t)bh * SEQ + s0 + r] = m;
    }
}

constexpr int PH_PER_LAYER = 10, N_PHASES = 1 + DEPTH * PH_PER_LAYER;
__global__ void __launch_bounds__(NTHR, 2) mk_fwd(Args a) {
    extern __shared__ __attribute__((aligned(16))) unsigned char lds_raw[];
    Frame F0;
    F0.lds = (LAS unsigned char*)lds_raw;
    F0.tid = threadIdx.x; F0.lane = F0.tid & 63; F0.wave = __builtin_amdgcn_readfirstlane(F0.tid >> 6);
    F0.G = gridDim.x; F0.gw = blockIdx.x * NWAVES + F0.wave; F0.NGW = F0.G * NWAVES; F0.gt = blockIdx.x * NTHR + F0.tid; F0.NGT = F0.G * NTHR;
    volatile LAS unsigned* LCTL = (volatile LAS unsigned*)(F0.lds + LDSCTL_OFF);
    volatile LAS int* pstart = (volatile LAS int*)(F0.lds + LDSCTL_OFF + 256);
    for (int u = F0.tid; u < 256; u += NTHR) LCTL[u] = 0u;
    __syncthreads();
    unsigned* ctl = (unsigned*)(a.ws + WS_CTL);
    XcdBarrier bar = xcd_barrier_post(ctl + CW_BAR + a.li * XCD_BAR_WORDS, LCTL);

#define x_in (a.in[0])
#define norm1_g (a.in[1])
#define w_in (a.in[2])
#define ssm_d (a.in[10])
#define w_glu (a.in[11])
#define qng (a.in[12])
#define kng (a.in[13])
#define w_attn (a.in[14])
#define w_out (a.in[15])
#define norm2_g (a.in[16])
#define wgrp (a.in[17])
#define bgrp (a.in[18])
#define wexp (a.in[19])
#define bexp (a.in[20])
#define w_gu (a.in[21])
#define w_dn (a.in[22])
#define X (a.out)
#define rope ((float*)(ws + WS_ROPE))
#define AL ((float*)(ws + WS_MISC + MISC_AL))
#define ksum ((float*)(ws + WS_MISC + MISC_KSUM))
#define SEL ((unsigned*)(ws + WS_MISC + MISC_SEL))
#define rec ((unsigned*)(ws + WS_REC))
#define list ((int*)(ws + WS_LIST))
#define TC ((bf16_t*)(ws + WS_S5TC))
#define BS ((bf16_t*)(ws + WS_S5BS))
#define H ((bf16_t*)(ws + WS_H))
#define UCAT ((bf16_t*)(ws + WS_UCAT))
#define Qb ((bf16_t*)(ws + WS_Q))
#define Kb ((bf16_t*)(ws + WS_K))
#define Vb ((bf16_t*)(ws + WS_V))
#define SG ((bf16_t*)(ws + WS_SG))
#define Z ((bf16_t*)(ws + WS_Z))
#define ATT ((bf16_t*)(ws + WS_ATT))
#define MIXA ((bf16_t*)(ws + WS_MIXA))
#define MIXED ((bf16_t*)(ws + WS_MIXED))
#define SL ((float*)(ws + WS_SL))
#define HMID ((bf16_t*)(ws + WS_HMID))
#define YBUF ((bf16_t*)(ws + WS_YBUF))
#define QRAW ((float*)(ws + WS_QRAW))
#define KRAW ((float*)(ws + WS_KRAW))
#define WIN ((bf16_t*)(ws + WS_WIN))
#define WGLU ((bf16_t*)(ws + WS_WGLU))
#define WATT ((bf16_t*)(ws + WS_WATT))
#define WOUT ((bf16_t*)(ws + WS_WOUT))
#define WGU ((bf16_t*)(ws + WS_WGU))
#define WDN ((bf16_t*)(ws + WS_WDN))
#define WR ((bf16_t*)(ws + WS_MISC + MISC_WR))
#define XB ((bf16_t*)(ws + WS_XB))
    const int lo = a.ph_lo, hi = a.ph_hi;
    int ph = 0; unsigned bgen = 0u;
#define PH_BEGIN if (ph >= lo && ph < hi) { for (int rep_ = 0; rep_ < ((((unsigned long long)REP_MASK >> ph) & 1ull) ? 2 : 1); ++rep_) { if (rep_) __syncthreads(); Frame P = F0; unsigned long long wz_ = 0ull; asm volatile("" : "+s"(wz_)); unsigned char* ws = a.ws + wz_;     { int t_ = F0.wave * 64 + (int)__builtin_amdgcn_mbcnt_hi(~0u, __builtin_amdgcn_mbcnt_lo(~0u, 0u)); asm volatile("" : "+v"(t_));     P.tid = t_; P.lane = t_ & 63; P.gt = (int)blockIdx.x * NTHR + t_; P.wave = __builtin_amdgcn_readfirstlane(t_ >> 6); P.gw = (int)blockIdx.x * NWAVES + P.wave; }
#define PH_END   } if (ph + 1 < hi) { ++bgen; xcd_barrier_w(bar, bgen, LCTL + 4, make_cvtq(a, F0.lds, F0.wave, fresh_lane())); } } ++ph;

    const int vcu = (F0.G % 8 == 0) ? ((int)blockIdx.x % 8) * (F0.G / 8) + (int)blockIdx.x / 8 : (int)blockIdx.x;
    LAS unsigned char* ring = F0.lds;
    volatile LAS int* tstart = (volatile LAS int*)(F0.lds + LDSCTL_OFF + 512);
    LAS unsigned* gtab = (LAS unsigned*)(F0.lds + GTAB_OFF);

    PH_BEGIN
        ph_rope_table(P, rope);
        for (int it4 = blockIdx.x; it4 < DEPTH * SSM_G * 4; it4 += P.G) { const int it = it4 >> 2;
            s5_tables_item(it / SSM_G, it % SSM_G, a.in[3], a.in[4], a.in[5], a.in[6], a.in[7], a.in[8], a.in[9],
                           TC + (size_t)it * 512 * 640, BS + (size_t)it * 128 * 512, AL + (size_t)it * 128, (LAS float*)P.lds, P.tid, NTHR, it4 & 3); }
        ph_rmsnorm(P, x_in, norm1_g, H);
        ph_convert_first(P, make_cvtq(a, F0.lds, P.wave, P.lane));
        ph_router_weights(P, wgrp, wexp, WR);
    PH_END

    for (int l = 0; l < DEPTH; ++l) {
#define xin ((l == 0) ? x_in : (const float*)X)
#define cnt ((unsigned*)(ws + WS_CTL) + CW_CNT + l * NEXP)
        PH_BEGIN
            pg8::Gemm g{H, WIN + (size_t)l * D_IN * D, D, D, D, 0, 0}; pg8::StaticOrder S; S.init(NTOK, D_IN, P.G, (int)blockIdx.x);
            pg8::EpiG1 E{UCAT, Qb, Kb, Vb, SG, qng + l * 64, kng + l * 64, rope, QRAW, KRAW};
            pg8::gemm_phase<pg8::EpiG1, pg8::StaticOrder, pg8::NoGather, G1_ALIGN>(ring, g, S, E, pg8::NoGather{}, P.tid);
        PH_END
        PH_BEGIN
            if (P.G == 256) { if (blockIdx.x >= 128) { Frame Q2 = P; Q2.gw = P.gw - 128 * NWAVES; Q2.NGW = 128 * NWAVES; ph_ksum(Q2, Kb, ksum); } } else ph_ksum(P, Kb, ksum);
            { pg8::Gemm g{UCAT, BS + (size_t)l * SSM_G * 128 * 512, UK, 512, 512, (size_t)UROWS * UK, (size_t)128 * 512}; pg8::OrderS5A S{P.G, (int)blockIdx.x};
              pg8::EpiS5Am E{AL + (size_t)l * SSM_G * 128, UCAT};
              pg8::gemm_phase<pg8::EpiS5Am, pg8::OrderS5A, pg8::NoGather, false>(ring, g, S, E, pg8::NoGather{}, P.tid); }
        PH_END
        PH_BEGIN
            ph_moba_select_mfma(P, Qb, ksum, SEL);
            { pg8::Gemm g{UCAT, TC + (size_t)l * SSM_G * 512 * 640, UK, UK, UK, (size_t)UROWS * UK, (size_t)512 * 640}; pg8::OrderS5C S{P.G, (int)blockIdx.x};
              pg8::EpiS5Cm E{UCAT, ssm_d + l * SSM_W, Z};
              pg8::gemm_phase<pg8::EpiS5Cm, pg8::OrderS5C, pg8::NoGather, false>(ring, g, S, E, pg8::NoGather{}, P.tid); }
        PH_END
        PH_BEGIN
            { const attn_body::AttnTensors AT{(const attn_body::bf16*)Qb, (const attn_body::bf16*)Kb, (const attn_body::bf16*)Vb, (attn_body::bf16*)ATT, SEL};
              const attn_body::StaticOrder SA((int)P.G, (int)blockIdx.x);
              attn_body::attn_phase<attn_body::StaticOrder>((char*)lds_raw, AT, SA, P.tid); }
            { pg8::Gemm g{Z, WGLU + (size_t)l * 2048 * 512, 512, 512, 512, 0, 0}; pg8::StaticOrder S; S.init(NTOK, 2048, P.G, (int)blockIdx.x);
              pg8::EpiGlu E{SG, MIXA};
              pg8::gemm_phase<pg8::EpiGlu, pg8::StaticOrder, pg8::NoGather, true>(ring, g, S, E, pg8::NoGather{}, P.tid); }
        PH_END
        PH_BEGIN
            pg8::Gemm g{ATT, WATT + (size_t)l * 1024 * 512, 512, 512, 512, 0, 0}; pg8::StaticOrder S; S.init(NTOK, 1024, P.G, (int)blockIdx.x);
            pg8::EpiMix E{SG, MIXA, MIXED};
            pg8::gemm_phase<pg8::EpiMix, pg8::StaticOrder, pg8::NoGather, true>(ring, g, S, E, pg8::NoGather{}, P.tid);
        PH_END
        PH_BEGIN
            pg8::Gemm g{MIXED, WOUT + (size_t)l * 1024 * 1024, 1024, 1024, 1024, 0, 0}; pg8::StaticOrder S; S.init(NTOK, 1024, P.G, (int)blockIdx.x);
            if (l == 0) { pg8::EpiResBf16<true> E{x_in, XB}; pg8::gemm_phase<pg8::EpiResBf16<true>, pg8::StaticOrder, pg8::NoGather, true>(ring, g, S, E, pg8::NoGather{}, P.tid); }
            else { pg8::EpiResBf16<false> E{nullptr, XB}; pg8::gemm_phase<pg8::EpiResBf16<false>, pg8::StaticOrder, pg8::NoGather, true>(ring, g, S, E, pg8::NoGather{}, P.tid); }
        PH_END
        PH_BEGIN make_cvtq(a, F0.lds, P.wave, P.lane).catchup(l == 0 ? CVQ_LIM_MOE0 : CVQ_TOTAL); __syncthreads(); ph_norm_router_mfma(P, XB, norm2_g + l * D, WR + (size_t)l * 2 * 48 * 1024, bgrp + l * 4, bexp + l * 32, H, cnt, list, rec); PH_END
        PH_BEGIN
            moe_tstart(P, cnt, tstart); moe_gather_table(P, vcu, cnt, list, tstart, gtab);
            pg8::Gemm g{H, WGU + (size_t)l * NEXP * 1024 * 1024, D, 1024, 1024, 0, (size_t)1024 * 1024}; pg8::OrderMoE S{P.G, vcu, tstart};
            pg8::EpiSwiglu E{HMID};
            pg8::gemm_phase<pg8::EpiSwiglu, pg8::OrderMoE, pg8::LdsGather, true>(ring, g, S, E, pg8::LdsGather{gtab}, P.tid);
        PH_END
        PH_BEGIN
            moe_tstart(P, cnt, tstart);
            pg8::Gemm g{HMID, WDN + (size_t)l * NEXP * 1024 * 512, 512, 512, 512, 0, (size_t)1024 * 512}; pg8::OrderMoE S{P.G, vcu, tstart};
            pg8::EpiStoreBf16 E{YBUF, 1024};
            pg8::gemm_phase<pg8::EpiStoreBf16, pg8::OrderMoE, pg8::NoGather, true>(ring, g, S, E, pg8::NoGather{}, P.tid);
        PH_END
        PH_BEGIN
            if (l + 1 < DEPTH) { make_cvtq(a, F0.lds, P.wave, P.lane).catchup(CVQ_LIM_PROJ1); __syncthreads(); }
            compute_pstart(P, cnt, pstart);
            if (l + 1 < DEPTH) ph_combine<false>(P, XB, X, YBUF, rec, pstart, norm1_g + (l + 1) * D, H);
            else ph_combine<true>(P, XB, X, YBUF, rec, pstart, nullptr, H);
        PH_END
    }
#undef PH_BEGIN
#undef PH_END
#undef x_in
#undef norm1_g
#undef w_in
#undef ssm_d
#undef w_glu
#undef qng
#undef kng
#undef w_attn
#undef w_out
#undef norm2_g
#undef wgrp
#undef bgrp
#undef wexp
#undef bexp
#undef w_gu
#undef w_dn
#undef X
#undef rope
#undef AL
#undef ksum
#undef SEL
#undef rec
#undef list
#undef TC
#undef BS
#undef H
#undef UCAT
#undef Qb
#undef Kb
#undef Vb
#undef SG
#undef Z
#undef ATT
#undef MIXA
#undef MIXED
#undef SL
#undef HMID
#undef YBUF
#undef QRAW
#undef KRAW
#undef WIN
#undef WGLU
#undef WATT
#undef WOUT
#undef WGU
#undef WDN
#undef WR
#undef XB
#undef xin
#undef cnt
}

extern "C" void kernel_launch(void* const* d_in, const int* in_sizes, int n_in, void* d_out, int out_size, void* d_ws, size_t ws_size, hipStream_t stream) {
    static int grid = 0;
    if (grid == 0) {
        if (n_in != 23 || ws_size < WS_END || out_size != NTOK * D) { fprintf(stderr, "kernel_launch: unexpected n_in %d / ws_size %zu / out_size %d; nothing launched\n", n_in, ws_size, out_size); grid = -1; return; }
        int dev = 0, cus = 0, per_cu = 0;
        if (hipGetDevice(&dev) != hipSuccess || hipDeviceGetAttribute(&cus, hipDeviceAttributeMultiprocessorCount, dev) != hipSuccess) { grid = -1; return; }
        if (hipFuncSetAttribute((const void*)mk_fwd, hipFuncAttributeMaxDynamicSharedMemorySize, LDS_BYTES) != hipSuccess) { fprintf(stderr, "kernel_launch: hipFuncSetAttribute failed\n"); grid = -1; return; }
        if (hipOccupancyMaxActiveBlocksPerMultiprocessor(&per_cu, (const void*)mk_fwd, NTHR, LDS_BYTES) != hipSuccess || per_cu < 1) { fprintf(stderr, "kernel_launch: occupancy query says %d\n", per_cu); }
        (void)hipGetLastError();
        grid = cus;
    }
    if (grid < 0) return;
    if (hipMemsetAsync((char*)d_ws + WS_CTL, 0, CTL_BYTES, stream) != hipSuccess) return;
    Args a{};
    for (int i = 0; i < 23; ++i) a.in[i] = (const float*)d_in[i];
    a.out = (float*)d_out; a.ws = (unsigned char*)d_ws;
#if MK_PER_PHASE
    for (int p = 0; p < N_PHASES; ++p) { a.ph_lo = p; a.ph_hi = p + 1; a.li = p; hipLaunchKernelGGL(mk_fwd, dim3(grid), dim3(NTHR), LDS_BYTES, stream, a); }
#else
    a.ph_lo = 0; a.ph_hi = N_PHASES; a.li = 0;
    hipLaunchKernelGGL(mk_fwd, dim3(grid), dim3(NTHR), LDS_BYTES, stream, a);
#endif
}
```

```cpp
#include <hip/hip_runtime.h>
#include <hip/hip_bf16.h>
#include <cstdint>
#include <cstdio>
#include <cmath>

#define DEVI __device__ __forceinline__
#define GAS __attribute__((address_space(1)))
#define LAS __attribute__((address_space(3)))
typedef unsigned short bf16_t;
typedef short bf16x8 __attribute__((ext_vector_type(8)));
typedef float f32x4 __attribute__((ext_vector_type(4)));
typedef float f32x16 __attribute__((ext_vector_type(16)));
typedef unsigned u32x4 __attribute__((ext_vector_type(4)));
typedef unsigned u32x2 __attribute__((ext_vector_type(2)));
typedef float cf32 __attribute__((ext_vector_type(2)));

#ifndef OPT_G1
#define OPT_G1 1
#endif
#ifndef G1_RAWQK
#define G1_RAWQK 0
#endif
#ifndef OPT_S5
#define OPT_S5 1
#endif
#ifndef OPT_G3
#define OPT_G3 1
#endif
#ifndef OPT_G4
#define OPT_G4 1
#endif
#ifndef OPT_G5
#define OPT_G5 1
#endif
#ifndef OPT_ATT
#define OPT_ATT 1
#endif
#ifndef REP_MASK
#define REP_MASK 0ull
#endif
#ifndef BAR_TWICE
#define BAR_TWICE 0
#endif
#ifndef G1_ALIGN
#define G1_ALIGN true
#endif
#ifndef OPT_RT
#define OPT_RT 1
#endif
#ifndef OPT_M1
#define OPT_M1 1
#endif
#ifndef OPT_M2
#define OPT_M2 1
#endif
#ifndef MK_PER_PHASE
#define MK_PER_PHASE 0
#endif

constexpr int D = 1024, BATCH = 8, SEQ = 4096, NTOK = BATCH * SEQ, DEPTH = 2;
constexpr int SSM_G = 32, SSM_C = 16, SSM_W = 512, SSM_P = 64;
constexpr int NH = 8, HD = 64, AW = 512, MOBA_B = 256, NBLK = SEQ / MOBA_B;
constexpr int D_IN = 4096;
constexpr int NEXP = 32, DEXP = 512;
constexpr int CHL = 32, NCH = SEQ / CHL, UK = 640, UROWS = BATCH * NCH;
constexpr int SLOT_CAP = 2 * NTOK + NEXP * 256;
constexpr int LIST_CAP = NTOK;
constexpr float NORM_EPS = 1e-6f;
constexpr float QSCALE = 0.125f * 1.4426950408889634f;
constexpr int NWAVES = 8, NTHR = 512;

constexpr size_t MiB = 1u << 20;
constexpr size_t WS_CTL = 0, CTL_BYTES = 1 * MiB;
constexpr size_t WS_ROPE = 1 * MiB;
constexpr size_t WS_MISC = 2 * MiB;
constexpr size_t WS_REC = 4 * MiB;
constexpr size_t WS_LIST = 5 * MiB;
constexpr size_t WS_S5TC = 16 * MiB;
constexpr size_t WS_S5BS = 56 * MiB;
constexpr size_t WS_WIN = 66 * MiB, WS_WGLU = 82 * MiB, WS_WATT = 86 * MiB, WS_WOUT = 88 * MiB, WS_WGU = 92 * MiB, WS_WDN = 220 * MiB;
constexpr size_t WS_H = 284 * MiB;
constexpr size_t WS_UCAT = 348 * MiB;
constexpr size_t WS_Q = 388 * MiB, WS_K = 420 * MiB, WS_V = 452 * MiB;
constexpr size_t WS_SG = 484 * MiB;
constexpr size_t WS_Z = 612 * MiB;
constexpr size_t WS_ATT = 644 * MiB;
constexpr size_t WS_MIXA = 676 * MiB, WS_MIXED = 740 * MiB;
constexpr size_t WS_SL = 804 * MiB;
constexpr size_t WS_XB = 820 * MiB;
constexpr size_t WS_END = 884 * MiB;
constexpr size_t WS_HMID = WS_UCAT;
constexpr size_t WS_YBUF = WS_SG;
constexpr size_t WS_QRAW = WS_MIXA, WS_KRAW = WS_MIXED;
constexpr size_t MISC_AL = 0;
constexpr size_t MISC_KSUM = 64 * 1024;
constexpr size_t MISC_SEL = 512 * 1024;
constexpr size_t MISC_WR = 1536 * 1024;
constexpr int CW_CNT = 64;
constexpr int CW_CVQ = 1024;
constexpr int CW_BAR = 4096;
constexpr int MAX_LAUNCHES = 64;

constexpr int RING_BYTES = 131072;
constexpr int LDSCTL_OFF = RING_BYTES;
constexpr int GTAB_OFF = RING_BYTES + 1024;
constexpr int LDS_BYTES = 160 * 1024;

DEVI float bf2f(bf16_t v) { return __uint_as_float((unsigned)v << 16); }
DEVI bf16_t f2bf(float f) { unsigned u = __float_as_uint(f); return (bf16_t)((u + 0x7fffu + ((u >> 16) & 1u)) >> 16); }
DEVI unsigned pk2(float lo, float hi) { return (unsigned)f2bf(lo) | ((unsigned)f2bf(hi) << 16); }
DEVI float sigmoidf_(float x) { return 1.f / (1.f + __expf(-x)); }
DEVI float gelu_tanh(float x) { const float u = 0.7978845608028654f * (x + 0.044715f * x * x * x); return 0.5f * x * (1.f + tanhf(u)); }
DEVI float xshfl(float v, int o, int lane) { return __int_as_float(__builtin_amdgcn_ds_bpermute((lane ^ o) << 2, __float_as_int(v))); }
DEVI float wave_sum(float v, int lane) {
#pragma unroll
    for (int o = 1; o < 64; o <<= 1) v += xshfl(v, o, lane);
    return v;
}
DEVI float wave_max(float v) {
#pragma unroll
    for (int o = 1; o < 64; o <<= 1) v = fmaxf(v, __shfl_xor(v, o));
    return v;
}

#define XB_TMO      128
#define XB_XCNT(j)  (256  + 64 * (j))
#define XB_XSUB(j)  (1280 + 64 * (j))
#define XB_XGEN(j)  (2304 + 64 * (j))
#define XB_TOP      3328
#define XB_TOPGEN   3392
#define XCD_BAR_WORDS 3456
#define XB_SPIN_CAP (1u << 18)
DEVI unsigned xb_ld(unsigned* p)              { return __hip_atomic_load(p, __ATOMIC_RELAXED, __HIP_MEMORY_SCOPE_AGENT); }
DEVI unsigned xb_add(unsigned* p, unsigned v) { return __hip_atomic_fetch_add(p, v, __ATOMIC_RELAXED, __HIP_MEMORY_SCOPE_AGENT); }
DEVI unsigned xb_xcc_id() { return (unsigned)__builtin_amdgcn_s_getreg((3 << 11) | 20) & 0xFu; }
#define XB_SPIN(cond, bar) do { unsigned _sp = 0; while (cond) { __builtin_amdgcn_s_sleep(1); \
    if ((++_sp & 255u) == 0u) { if (xb_ld(&(bar)[XB_TMO])) break; if (_sp > XB_SPIN_CAP) { atomicAdd(&(bar)[XB_TMO], 1u); break; } } } } while (0)
struct XcdBarrier { unsigned* bar; unsigned x; volatile LAS unsigned* st; };
DEVI XcdBarrier xcd_barrier_post(unsigned* bar, volatile LAS unsigned* st) {
    XcdBarrier b; b.bar = bar; b.x = xb_xcc_id(); b.st = st;
    if (threadIdx.x == 0) (void)xb_add(&bar[XB_XCNT(b.x)], 1u);
    return b;
}
DEVI void xcd_barrier_complete(unsigned* bar, unsigned x, unsigned& nloc, unsigned& nx) {
    const unsigned G = gridDim.x * gridDim.y * gridDim.z;
    unsigned sum, cnt, mine, sp = 0u;
    for (;;) {
        sum = 0u; cnt = 0u; mine = 0u;
#pragma unroll
        for (unsigned j = 0; j < 16; ++j) { const unsigned c = xb_ld(&bar[XB_XCNT(j)]); sum += c; cnt += (c > 0u) ? 1u : 0u; mine = (j == x) ? c : mine; }
        if (sum == G) break;
        __builtin_amdgcn_s_sleep(1);
        if ((++sp & 255u) == 0u) { if (xb_ld(&bar[XB_TMO])) break; if (sp > XB_SPIN_CAP) { atomicAdd(&bar[XB_TMO], 1u); break; } }
    }
    nloc = mine > 0u ? mine : 1u; nx = cnt > 0u ? cnt : 1u;
}
DEVI void xcd_barrier(const XcdBarrier& b) {
    asm volatile("s_waitcnt vmcnt(0)" ::: "memory");
    __syncthreads();
    if (threadIdx.x == 0) {
        unsigned* bar = b.bar;
        __builtin_amdgcn_s_waitcnt(0);
        unsigned nloc = b.st[0], nx = b.st[1];
        if (nloc == 0u) { xcd_barrier_complete(bar, b.x, nloc, nx); b.st[0] = nloc; b.st[1] = nx; }
        const unsigned old = xb_add(&bar[XB_XSUB(b.x)], 1u);
        const unsigned gen = old / nloc;
        if (old + 1u == (gen + 1u) * nloc) {
            __builtin_amdgcn_fence(__ATOMIC_RELEASE, "agent");
            asm volatile("s_waitcnt vmcnt(0)" ::: "memory");
            const unsigned og = xb_add(&bar[XB_TOP], 1u);
            const unsigned tg = og / nx;
            if (og + 1u == (tg + 1u) * nx) xb_add(&bar[XB_TOPGEN], 1u);
            else XB_SPIN(xb_ld(&bar[XB_TOPGEN]) == tg, bar);
            __builtin_amdgcn_fence(__ATOMIC_ACQUIRE, "agent");
            xb_add(&bar[XB_XGEN(b.x)], 1u);
            asm volatile("s_waitcnt vmcnt(0)" ::: "memory");
        } else {
            XB_SPIN(xb_ld(&bar[XB_XGEN(b.x)]) == gen, bar);
            __builtin_amdgcn_fence(__ATOMIC_ACQUIRE, "agent");
            asm volatile("s_waitcnt vmcnt(0)" ::: "memory");
        }
    }
    __syncthreads();
}

struct Args { const float* in[23]; float* out; unsigned char* ws; int ph_lo, ph_hi, li, pad; };
struct Frame { int tid, lane, wave, gw, NGW, gt, NGT, G; LAS unsigned char* lds; };

DEVI void ph_rope_table(const Frame& F, float* rope) {
    for (int idx = F.gt; idx < SEQ * 32; idx += F.NGT) {
        const int s = idx >> 5, i = idx & 31;
        const float inv = powf(10000.0f, -(float)(2 * i) / 64.0f);
        const float ang = (float)s * inv;
        float sn, cs; sincosf(ang, &sn, &cs);
        rope[2 * idx] = cs; rope[2 * idx + 1] = sn;
    }
}
DEVI void s5_tables_item(int l, int g, const float* a_re, const float* a_im, const float* log_dt, const float* b_re, const float* b_im,
                         const float* c_re, const float* c_im, bf16_t* TC, bf16_t* BS, float* AL, LAS float* lds, int tid, int nthr, int part) {
    LAS cf32* pw = (LAS cf32*)lds;
    LAS cf32* Cc = pw + 33 * 64;
    LAS cf32* Bb = Cc + 16 * 64;
    LAS cf32* fp = Bb + 64 * 16;
    LAS float* Kt = (LAS float*)(fp + 64);
    const int lg = l * SSM_G + g;
    const float dt = expf(log_dt[lg]);
    for (int i = tid; i < 33 * 64; i += nthr) {
        const int tau = i >> 6, p = i & 63;
        const float lr = a_re[lg * 64 + p], li = a_im[lg * 64 + p];
        const float mag = expf(lr * dt * (float)tau);
        float sn, cs; sincosf(li * dt * (float)tau, &sn, &cs);
        pw[i] = (cf32){mag * cs, mag * sn};
    }
    for (int i = tid; i < 16 * 64; i += nthr) Cc[i] = (cf32){c_re[(size_t)lg * 1024 + i], c_im[(size_t)lg * 1024 + i]};
    __syncthreads();
    for (int p = tid; p < 64; p += nthr) {
        const float lr = a_re[lg * 64 + p], li = a_im[lg * 64 + p];
        const cf32 ab = pw[64 + p];
        const float den = lr * lr + li * li, nre = ab.x - 1.0f;
        fp[p] = (cf32){(nre * lr + ab.y * li) / den, (ab.y * lr - nre * li) / den};
    }
    __syncthreads();
    for (int i = tid; i < 64 * 16; i += nthr) {
        const cf32 f = fp[i >> 4];
        const float br = b_re[(size_t)lg * 1024 + i], bi = b_im[(size_t)lg * 1024 + i];
        Bb[i] = (cf32){f.x * br - f.y * bi, f.x * bi + f.y * br};
    }
    __syncthreads();
    for (int i = tid; i < 8 * 256; i += nthr) {
        const int tau = 8 * part + (i >> 8), co = (i >> 4) & 15, ci = i & 15;
        float acc = 0.f;
        for (int p = 0; p < 64; ++p) {
            const cf32 c = Cc[co * 64 + p], w = pw[tau * 64 + p], b = Bb[p * 16 + ci];
            const float xr = c.x * w.x - c.y * w.y, xi = c.x * w.y + c.y * w.x;
            acc += xr * b.x - xi * b.y;
        }
        Kt[i] = acc;
    }
    __syncthreads();
    for (int i = tid; i < 512 * 512; i += nthr) {
        const int n = i >> 9, kk = i & 511, t = n >> 4, co = n & 15, tp = kk >> 4, ci = kk & 15, tau = t - tp;
        if (tau >= 0) { if ((tau >> 3) == part) TC[(size_t)n * 640 + kk] = f2bf(Kt[((tau & 7) * 16 + co) * 16 + ci]); }
        else if (((-tau - 1) >> 3) == part) TC[(size_t)n * 640 + kk] = 0;
    }
    for (int i = part * 128 * 128 + tid; i < (part + 1) * 128 * 128; i += nthr) {
        const int n = i >> 7, kc = i & 127, t = n >> 4, co = n & 15, p = kc & 63;
        const cf32 c = Cc[co * 64 + p], w = pw[(t + 1) * 64 + p];
        const float xr = c.x * w.x - c.y * w.y, xi = c.x * w.y + c.y * w.x;
        TC[(size_t)n * 640 + 512 + kc] = f2bf(kc < 64 ? xr : -xi);
    }
    for (int i = part * 32 * 512 + tid; i < (part + 1) * 32 * 512; i += nthr) {
        const int row = i >> 9, kk = i & 511, p = row & 63, tp = kk >> 4, ci = kk & 15;
        const cf32 w = pw[(31 - tp) * 64 + p], b = Bb[p * 16 + ci];
        BS[i] = f2bf(row < 64 ? (w.x * b.x - w.y * b.y) : (w.x * b.y + w.y * b.x));
    }
    if (part == 0) for (int i = tid; i < 64; i += nthr) { AL[2 * i] = pw[32 * 64 + i].x; AL[2 * i + 1] = pw[32 * 64 + i].y; }
    __syncthreads();
}

DEVI void ph_rmsnorm(const Frame& F, const float* x, const float* g, bf16_t* out) {
    constexpr int R = 2;
    for (int row0 = F.gw; row0 < NTOK; row0 += R * F.NGW) {
        f32x4 v[R][4];
#pragma unroll
        for (int u = 0; u < R; ++u) { const int row = (row0 + u * F.NGW < NTOK) ? row0 + u * F.NGW : row0; const f32x4* xr = (const f32x4*)(x + (size_t)row * D) + F.lane;
#pragma unroll
            for (int j = 0; j < 4; ++j) v[u][j] = xr[64 * j]; }
#pragma unroll
        for (int u = 0; u < R; ++u) { const int row = row0 + u * F.NGW; if (row >= NTOK) continue;
            float s = 0.f;
#pragma unroll
            for (int j = 0; j < 4; ++j) s += (v[u][j].x * v[u][j].x + v[u][j].y * v[u][j].y) + (v[u][j].z * v[u][j].z + v[u][j].w * v[u][j].w);
            const float rstd = 1.0f / sqrtf(wave_sum(s, F.lane) * (1.0f / D) + NORM_EPS);
#pragma unroll
            for (int j = 0; j < 4; ++j) { const f32x4 gg = *((const f32x4*)g + F.lane + 64 * j);
                u32x2 o; o.x = pk2(v[u][j].x * rstd * gg.x, v[u][j].y * rstd * gg.y); o.y = pk2(v[u][j].z * rstd * gg.z, v[u][j].w * rstd * gg.w);
                *((u32x2*)(out + (size_t)row * D) + F.lane + 64 * j) = o; } }
    }
}

template <int BMODE, class RowF, class Epi>
DEVI void sg_phase(const Frame& F, int ny, const RowF& rowf, const void* Bv, size_t bstride, int ldb, int K, int nct, int cstep, int off2, const Epi& epi) {
    const int lane = F.lane, r = lane & 31, h = lane >> 5;
    int base = 0;
    for (int y = 0; y < ny; ++y) {
        const int nrows = rowf.nrows(y), nrt = (nrows + 31) / 32, ntile = nrt * nct;
        const float* Bf = (const float*)Bv + (size_t)y * bstride;
        const bf16_t* Bt = (const bf16_t*)Bv + (size_t)y * bstride;
        int first = (F.gw - base % F.NGW + F.NGW) % F.NGW;
        for (int tile = first; tile < ntile; tile += F.NGW) {
            const int rt = tile / nct, ct = tile % nct, c0 = ct * cstep, c1 = c0 + off2;
            const int arow_i = rt * 32 + r;
            const bf16_t* arow = (arow_i < nrows) ? rowf(y, arow_i) : nullptr;
            f32x16 acc0 = {}, acc1 = {};
            for (int k = 0; k < K; k += 16) {
                bf16x8 a = {};
                if (arow) a = *(const bf16x8*)(arow + k + 8 * h);
                bf16x8 b0, b1;
                if (BMODE == 0) {
#pragma unroll
                    for (int j = 0; j < 8; ++j) { b0[j] = (short)f2bf(Bf[(size_t)(k + 8 * h + j) * ldb + c0 + r]); b1[j] = (short)f2bf(Bf[(size_t)(k + 8 * h + j) * ldb + c1 + r]); }
                } else {
                    b0 = *(const bf16x8*)(Bt + (size_t)(c0 + r) * ldb + k + 8 * h);
                    b1 = *(const bf16x8*)(Bt + (size_t)(c1 + r) * ldb + k + 8 * h);
                }
                acc0 = __builtin_amdgcn_mfma_f32_32x32x16_bf16(a, b0, acc0, 0, 0, 0);
                acc1 = __builtin_amdgcn_mfma_f32_32x32x16_bf16(a, b1, acc1, 0, 0, 0);
            }
#pragma unroll
            for (int reg = 0; reg < 16; ++reg) {
                const int row = rt * 32 + (reg & 3) + 8 * (reg >> 2) + 4 * h;
                if (row < nrows) epi(y, row, c0 + r, c1 + r, acc0[reg], acc1[reg]);
            }
        }
        base += ntile;
    }
}

struct RowPlain { const bf16_t* A; int lda; int n; size_t ystride;
    DEVI int nrows(int) const { return n; }
    DEVI const bf16_t* operator()(int y, int r) const { return A + (size_t)y * ystride + (size_t)r * lda; } };

struct EpiG1sPerm;
struct EpiG1s { bf16_t* ucat; float* qraw; float* kraw; bf16_t* v; bf16_t* sg;
    DEVI void one(int row, int c, float a) const {
        if (c < 512) { const int b = row >> 12, s = row & 4095, g = c >> 4, ci = c & 15;
            ucat[((size_t)g * UROWS + b * NCH + (s >> 5)) * UK + (s & 31) * 16 + ci] = f2bf(a); }
        else if (c < 1024) qraw[(size_t)row * 512 + (c - 512)] = a;
        else if (c < 1536) kraw[(size_t)row * 512 + (c - 1024)] = a;
        else if (c < 2048) v[(size_t)row * 512 + (c - 1536)] = f2bf(a);
        else sg[(size_t)row * 2048 + (c - 2048)] = f2bf(sigmoidf_(a));
    }
    DEVI void operator()(int, int row, int c0, int c1, float a0, float a1) const { one(row, c0, a0); one(row, c1, a1); } };

DEVI int g1_unperm(int cp) { const int pn = cp >> 8, tc = cp & 255; if (pn < 2 || pn >= 6) return cp; const int sec = pn < 4 ? 512 : 1024, hh = (pn & 1) * 4 + ((tc >> 5) & 3); return sec + hh * 64 + 32 * (tc >> 7) + (tc & 31); }
#ifndef G1_FIX_MASK
#define G1_FIX_MASK 0
#endif
DEVI bool g1_sel(int c) { const int sec = c < 512 ? 1 : c < 1024 ? 2 : c < 1536 ? 4 : c < 2048 ? 8 : 16; return (G1_FIX_MASK & sec) != 0; }
struct EpiG1sPerm { EpiG1s e; DEVI void operator()(int, int row, int c0, int c1, float a0, float a1) const { e.one(row, g1_unperm(c0), a0); e.one(row, g1_unperm(c1), a1); } };
struct EpiG1sFix { EpiG1s e; DEVI void operator()(int, int row, int c0, int c1, float a0, float a1) const { const int n0 = g1_unperm(c0), n1 = g1_unperm(c1); if (g1_sel(n0)) e.one(row, n0, a0); if (g1_sel(n1)) e.one(row, n1, a1); } };
DEVI void ph_qkpost(const Frame& F, const float* qraw, const float* kraw, const float* qg, const float* kg, const float* rope, bf16_t* Q, bf16_t* K) {
    for (int idx = F.gt; idx < NTOK * 16; idx += F.NGT) {
        const int which = idx & 1, hh = (idx >> 1) & 7, tok = idx >> 4;
        const float* src = (which ? kraw : qraw) + (size_t)tok * 512 + hh * 64;
        const float* gn = which ? kg : qg;
        float x[64]; float ss = 0.f;
#pragma unroll
        for (int i = 0; i < 16; ++i) { const f32x4 t = *((const f32x4*)src + i); x[4 * i] = t.x; x[4 * i + 1] = t.y; x[4 * i + 2] = t.z; x[4 * i + 3] = t.w; ss += (t.x * t.x + t.y * t.y) + (t.z * t.z + t.w * t.w); }
        const float rstd = 1.0f / sqrtf(ss * (1.0f / 64.0f) + NORM_EPS);
        const int s = tok & (SEQ - 1);
        const float sc = which ? 1.0f : QSCALE;
        bf16_t* dst = (which ? K : Q) + (size_t)tok * 512 + hh * 64;
#pragma unroll
        for (int i = 0; i < 32; ++i) {
            const float x1 = x[i] * rstd * gn[i], x2 = x[i + 32] * rstd * gn[i + 32];
            const float cs = rope[(s * 32 + i) * 2], sn = rope[(s * 32 + i) * 2 + 1];
            dst[i] = f2bf((x1 * cs - x2 * sn) * sc);
            dst[i + 32] = f2bf((x2 * cs + x1 * sn) * sc);
        }
    }
}
DEVI void ph_ksum(const Frame& F, const bf16_t* K, float* ksum) {
    const int lane = F.lane, rg = lane >> 3, c = lane & 7;
    for (int w = F.gw; w < BATCH * NH * NBLK; w += F.NGW) {
        const int blk = w & 15, hh = (w >> 4) & 7, b = w >> 7;
        const bf16_t* kp = K + ((size_t)b * SEQ + blk * 256 + rg) * 512 + hh * 64 + c * 8;
        float acc[8];
#pragma unroll
        for (int j = 0; j < 8; ++j) acc[j] = 0.f;
#pragma unroll 8
        for (int i = 0; i < 32; ++i) { const bf16x8 v = *(const bf16x8*)(kp + (size_t)i * 8 * 512);
#pragma unroll
            for (int j = 0; j < 8; ++j) acc[j] += bf2f((bf16_t)v[j]); }
#pragma unroll
        for (int j = 0; j < 8; ++j) { float t = acc[j]; t += xshfl(t, 8, lane); t += xshfl(t, 16, lane); t += xshfl(t, 32, lane); acc[j] = t; }
        if (rg == 0) { float* o = ksum + (size_t)w * 64 + c * 8; *(f32x4*)o = (f32x4){acc[0], acc[1], acc[2], acc[3]}; *(f32x4*)(o + 4) = (f32x4){acc[4], acc[5], acc[6], acc[7]}; }
    }
}

DEVI void ph_attn_simple(const Frame& F, const bf16_t* Q, const bf16_t* K, const bf16_t* V, const float* ksum, bf16_t* O) {
    const int lane = F.lane;
    for (int w = F.gw; w < BATCH * NH * SEQ; w += F.NGW) {
        const int s = w & (SEQ - 1), hh = (w >> 12) & 7, b = w >> 15;
        const int qb = s >> 8;
        const bf16_t* qp = Q + ((size_t)b * SEQ + s) * 512 + hh * 64;
        float q[64];
#pragma unroll
        for (int i = 0; i < 8; ++i) { const bf16x8 t = *((const bf16x8*)qp + i);
#pragma unroll
            for (int j = 0; j < 8; ++j) q[8 * i + j] = bf2f((bf16_t)t[j]); }
        float gsc = -INFINITY;
        if (lane < qb) { const float* km = ksum + ((size_t)(b * 8 + hh) * 16 + lane) * 64; float a = 0.f;
#pragma unroll
            for (int i = 0; i < 64; ++i) a += q[i] * km[i];
            gsc = a; }
        int blks[4]; int nsel = 0;
#pragma unroll
        for (int t = 0; t < 3; ++t) {
            float best = -INFINITY; int bi = -1;
            for (int j = 0; j < 15; ++j) { const float v = __shfl(gsc, j); const bool used = (t > 0 && j == blks[0]) || (t > 1 && j == blks[1]); if (j < qb && !used && v > best) { best = v; bi = j; } }
            blks[t] = bi; if (bi >= 0) nsel = t + 1;
        }
        blks[3] = qb;
        float sc[4][4]; float m = -INFINITY;
#pragma unroll
        for (int t = 0; t < 4; ++t) {
            const bool on = (t == 3) || (t < nsel);
            const int blk = on ? blks[t] : 0;
#pragma unroll
            for (int i = 0; i < 4; ++i) {
                const int key = blk * 256 + lane + 64 * i;
                float a = -INFINITY;
                if (on && (t < 3 || key <= s)) {
                    const bf16_t* kp = K + ((size_t)b * SEQ + key) * 512 + hh * 64; a = 0.f;
#pragma unroll
                    for (int c = 0; c < 8; ++c) { const bf16x8 kk = *((const bf16x8*)kp + c);
#pragma unroll
                        for (int j = 0; j < 8; ++j) a += q[8 * c + j] * bf2f((bf16_t)kk[j]); }
                }
                sc[t][i] = a; m = fmaxf(m, a);
            }
        }
        m = wave_max(m);
        float l = 0.f;
#pragma unroll
        for (int t = 0; t < 4; ++t)
#pragma unroll
            for (int i = 0; i < 4; ++i) { const float p = exp2f(sc[t][i] - m); sc[t][i] = p; l += p; }
        l = wave_sum(l, lane);
        float o = 0.f;
#pragma unroll
        for (int t = 0; t < 4; ++t) {
            const bool on = (t == 3) || (t < nsel);
            if (!on) continue;
            const int blk = blks[t];
#pragma unroll
            for (int i = 0; i < 4; ++i) {
                const float pv = sc[t][i];
                for (int j = 0; j < 64; ++j) {
                    const float p = __shfl(pv, j);
                    const int key = blk * 256 + j + 64 * i;
                    if (p != 0.f) o += p * bf2f(V[((size_t)b * SEQ + key) * 512 + hh * 64 + lane]);
                }
            }
        }
        O[((size_t)b * SEQ + s) * 512 + hh * 64 + lane] = f2bf(o / l);
    }
}

struct EpiS5A { float* sl; DEVI void operator()(int y, int row, int c0, int c1, float a0, float a1) const { float* p = sl + ((size_t)y * UROWS + row) * 128; p[c0] = a0; p[c1] = a1; } };
DEVI void ph_s5_scan(const Frame& F, const float* sl, const float* AL, bf16_t* ucat) {
    for (int idx = F.gt; idx < SSM_G * BATCH * 64; idx += F.NGT) {
        const int p = idx & 63, b = (idx >> 6) & 7, g = idx >> 9;
        const float ar = AL[(g * 64 + p) * 2], ai = AL[(g * 64 + p) * 2 + 1];
        float hr = 0.f, hi = 0.f;
        for (int c = 0; c < NCH; ++c) {
            const size_t row = (size_t)g * UROWS + b * NCH + c;
            ucat[row * UK + 512 + p] = f2bf(hr); ucat[row * UK + 576 + p] = f2bf(hi);
            const float sr = sl[row * 128 + p], si = sl[row * 128 + 64 + p];
            const float nr = ar * hr - ai * hi + sr, ni = ar * hi + ai * hr + si; hr = nr; hi = ni;
        }
    }
}
struct EpiS5C { const bf16_t* ucat; const float* dskip; bf16_t* z;
    DEVI void one(int g, int row, int n, float a) const {
        const int t = n >> 4, co = n & 15, b = row >> 7, c = row & 127;
        const float u = bf2f(ucat[((size_t)g * UROWS + row) * UK + n]);
        const float y = a + dskip[g * 16 + co] * u;
        z[((size_t)b * SEQ + c * CHL + t) * 512 + g * 16 + co] = f2bf(gelu_tanh(y));
    }
    DEVI void operator()(int y, int row, int c0, int c1, float a0, float a1) const { one(y, row, c0, a0); one(y, row, c1, a1); } };

struct EpiG3s { const bf16_t* sg; bf16_t* mixa;
    DEVI void operator()(int, int row, int c0, int c1, float val, float gate) const { mixa[(size_t)row * 1024 + c0] = f2bf(bf2f(sg[(size_t)row * 2048 + c0]) * val * sigmoidf_(gate)); } };
struct EpiG4s { const bf16_t* sg; const bf16_t* mixa; bf16_t* mixed;
    DEVI void one(int row, int c, float a) const { mixed[(size_t)row * 1024 + c] = f2bf(bf2f(mixa[(size_t)row * 1024 + c]) + bf2f(sg[(size_t)row * 2048 + 1024 + c]) * a); }
    DEVI void operator()(int, int row, int c0, int c1, float a0, float a1) const { one(row, c0, a0); one(row, c1, a1); } };
struct EpiG5s { const float* xin; float* xout;
    DEVI void operator()(int, int row, int c0, int c1, float a0, float a1) const { xout[(size_t)row * 1024 + c0] = xin[(size_t)row * 1024 + c0] + a0; xout[(size_t)row * 1024 + c1] = xin[(size_t)row * 1024 + c1] + a1; } };

DEVI void ph_norm_router(const Frame& F, const float* x, const float* g, const float* wg, const float* bg, const float* we, const float* be,
                         bf16_t* h2, unsigned* cnt, int* list, unsigned* rec) {
    const int lane = F.lane;
    for (int row = F.gw; row < NTOK; row += F.NGW) {
        const f32x4* xr = (const f32x4*)(x + (size_t)row * D) + lane;
        f32x4 v[4]; float s = 0.f;
#pragma unroll
        for (int j = 0; j < 4; ++j) { v[j] = xr[64 * j]; s += (v[j].x * v[j].x + v[j].y * v[j].y) + (v[j].z * v[j].z + v[j].w * v[j].w); }
        const float rstd = 1.0f / sqrtf(wave_sum(s, lane) * (1.0f / D) + NORM_EPS);
        float acc[36];
#pragma unroll
        for (int o = 0; o < 36; ++o) acc[o] = 0.f;
#pragma unroll
        for (int j = 0; j < 4; ++j) {
            const f32x4 gg = *((const f32x4*)g + lane + 64 * j);
            const float hv[4] = {v[j].x * rstd * gg.x, v[j].y * rstd * gg.y, v[j].z * rstd * gg.z, v[j].w * rstd * gg.w};
            u32x2 o; o.x = pk2(hv[0], hv[1]); o.y = pk2(hv[2], hv[3]);
            *((u32x2*)(h2 + (size_t)row * D) + lane + 64 * j) = o;
#pragma unroll
            for (int e = 0; e < 4; ++e) {
                const int k = 4 * lane + 256 * j + e;
                const f32x4 w4 = *(const f32x4*)(wg + (size_t)k * 4);
                acc[0] += hv[e] * w4.x; acc[1] += hv[e] * w4.y; acc[2] += hv[e] * w4.z; acc[3] += hv[e] * w4.w;
#pragma unroll
                for (int q = 0; q < 8; ++q) { const f32x4 w = *(const f32x4*)(we + (size_t)k * 32 + 4 * q);
                    acc[4 + 4 * q] += hv[e] * w.x; acc[5 + 4 * q] += hv[e] * w.y; acc[6 + 4 * q] += hv[e] * w.z; acc[7 + 4 * q] += hv[e] * w.w; }
            }
        }
#pragma unroll
        for (int o = 0; o < 36; ++o) acc[o] = wave_sum(acc[o], lane);
        if (lane == 0) {
            float gl[4]; int gt = 0; float gm = -INFINITY;
#pragma unroll
            for (int i = 0; i < 4; ++i) { gl[i] = acc[i] + bg[i]; if (gl[i] > gm) { gm = gl[i]; gt = i; } }
            float gs = 0.f;
#pragma unroll
            for (int i = 0; i < 4; ++i) gs += __expf(gl[i] - gm);
            const float pg = 1.0f / gs;
            float el[8]; float em = -INFINITY;
#pragma unroll
            for (int i = 0; i < 8; ++i) { float t = 0.f;
#pragma unroll
                for (int gq = 0; gq < 4; ++gq) t = (gq == gt) ? acc[4 + gq * 8 + i] + be[gq * 8 + i] : t;
                el[i] = t; em = fmaxf(em, t); }
            int i1 = 0; float v1 = -INFINITY;
#pragma unroll
            for (int i = 0; i < 8; ++i) if (el[i] > v1) { v1 = el[i]; i1 = i; }
            int i2 = 0; float v2 = -INFINITY;
#pragma unroll
            for (int i = 0; i < 8; ++i) if (i != i1 && el[i] > v2) { v2 = el[i]; i2 = i; }
            const float p1 = __expf(v1 - em), p2 = __expf(v2 - em);
            const float w0 = pg * p1 / (p1 + p2), w1 = pg * p2 / (p1 + p2);
            const int e0 = gt * 8 + i1, e1 = gt * 8 + i2;
            const unsigned pos0 = atomicAdd(cnt + e0, 1u), pos1 = atomicAdd(cnt + e1, 1u);
            list[(size_t)e0 * LIST_CAP + pos0] = row; list[(size_t)e1 * LIST_CAP + pos1] = row;
            unsigned* rp = rec + (size_t)row * 8;
            rp[0] = (unsigned)e0; rp[1] = (unsigned)e1; rp[2] = pos0; rp[3] = pos1; rp[4] = __float_as_uint(w0); rp[5] = __float_as_uint(w1);
        }
    }
}
DEVI void expert_prefix(const Frame& F, const unsigned* cnt, volatile LAS int* out, int mul) {
    if (F.wave == 0) { const int lane = F.lane;
        int c = (lane < NEXP) ? (int)((__hip_atomic_load(cnt + (lane & 31), __ATOMIC_RELAXED, __HIP_MEMORY_SCOPE_AGENT) + 255u) / 256u) : 0;
        int s = c;
#pragma unroll
        for (int d = 1; d < 32; d <<= 1) { const int t = __builtin_amdgcn_ds_bpermute(((lane - d) & 63) << 2, s); if (lane >= d) s += t; }
        if (lane < NEXP) out[lane] = (s - c) * mul;
        if (lane == NEXP - 1) out[NEXP] = s * mul; }
    __syncthreads();
}
DEVI void compute_pstart(const Frame& F, const unsigned* cnt, volatile LAS int* pstart) { expert_prefix(F, cnt, pstart, 256); }
struct RowM1 { const bf16_t* h2; const int* list; const unsigned* cnt;
    DEVI int nrows(int y) const { return (int)cnt[y]; }
    DEVI const bf16_t* operator()(int y, int r) const { return h2 + (size_t)list[(size_t)y * LIST_CAP + r] * D; } };
struct EpiM1s { bf16_t* hmid; volatile LAS int* pstart;
    DEVI void operator()(int y, int row, int c0, int c1, float gt, float up) const { hmid[((size_t)pstart[y] + row) * 512 + c0] = f2bf(gt * sigmoidf_(gt) * up); } };
struct RowM2 { const bf16_t* hmid; volatile LAS int* pstart; const unsigned* cnt;
    DEVI int nrows(int y) const { return (int)cnt[y]; }
    DEVI const bf16_t* operator()(int y, int r) const { return hmid + ((size_t)pstart[y] + r) * 512; } };
struct EpiM2s { bf16_t* ybuf; volatile LAS int* pstart;
    DEVI void operator()(int y, int row, int c0, int c1, float a0, float a1) const { bf16_t* p = ybuf + ((size_t)pstart[y] + row) * 1024; p[c0] = f2bf(a0); p[c1] = f2bf(a1); } };
template <bool LAST>
DEVI void ph_combine(const Frame& F, bf16_t* xb, float* out, const bf16_t* ybuf, const unsigned* rec, volatile LAS int* pstart, const float* gnext, bf16_t* hout) {
    const int lane = F.lane;
    u32x4 ra[2]; u32x2 rb[2];
#pragma unroll
    for (int u = 0; u < 2; ++u) { const int rr = (F.gw + u * F.NGW < NTOK) ? F.gw + u * F.NGW : 0; ra[u] = *(const u32x4*)(rec + (size_t)rr * 8); rb[u] = *(const u32x2*)(rec + (size_t)rr * 8 + 4); }
    for (int row0 = F.gw; row0 < NTOK; row0 += 2 * F.NGW) {
        int rw[2]; const bf16_t* y0[2]; const bf16_t* y1[2]; float w0[2], w1[2]; bool on[2];
#pragma unroll
        for (int u = 0; u < 2; ++u) { rw[u] = row0 + u * F.NGW; on[u] = rw[u] < NTOK;
            y0[u] = ybuf + ((size_t)pstart[(int)ra[u].x] + ra[u].z) * 1024; y1[u] = ybuf + ((size_t)pstart[(int)ra[u].y] + ra[u].w) * 1024;
            w0[u] = __uint_as_float(rb[u].x); w1[u] = __uint_as_float(rb[u].y); }
        u32x2 xw[2][4], ya[2][4], yb[2][4];
#pragma unroll
        for (int u = 0; u < 2; ++u)
#pragma unroll
            for (int j = 0; j < 4; ++j) { const int rr = on[u] ? rw[u] : row0;
                xw[u][j] = *((const u32x2*)(xb + (size_t)rr * D) + lane + 64 * j); ya[u][j] = *((const u32x2*)y0[u] + lane + 64 * j); yb[u][j] = *((const u32x2*)y1[u] + lane + 64 * j); }
#pragma unroll
        for (int u = 0; u < 2; ++u) { const int nr = row0 + (2 + u) * F.NGW, rr = nr < NTOK ? nr : 0; ra[u] = *(const u32x4*)(rec + (size_t)rr * 8); rb[u] = *(const u32x2*)(rec + (size_t)rr * 8 + 4); }
#pragma unroll
        for (int u = 0; u < 2; ++u) {
            if (!on[u]) continue;
            const int row = rw[u];
            f32x4 v[4]; float s = 0.f;
#pragma unroll
            for (int j = 0; j < 4; ++j) {
                const u32x2 x = xw[u][j], a = ya[u][j], b = yb[u][j];
                v[j].x = __uint_as_float(x.x << 16) + w0[u] * __uint_as_float(a.x << 16) + w1[u] * __uint_as_float(b.x << 16);
                v[j].y = __uint_as_float(x.x & 0xffff0000u) + w0[u] * __uint_as_float(a.x & 0xffff0000u) + w1[u] * __uint_as_float(b.x & 0xffff0000u);
                v[j].z = __uint_as_float(x.y << 16) + w0[u] * __uint_as_float(a.y << 16) + w1[u] * __uint_as_float(b.y << 16);
                v[j].w = __uint_as_float(x.y & 0xffff0000u) + w0[u] * __uint_as_float(a.y & 0xffff0000u) + w1[u] * __uint_as_float(b.y & 0xffff0000u);
                if (LAST) *((f32x4*)(out + (size_t)row * D) + lane + 64 * j) = v[j];
                else { u32x2 o; o.x = pk2(v[j].x, v[j].y); o.y = pk2(v[j].z, v[j].w); *((u32x2*)(xb + (size_t)row * D) + lane + 64 * j) = o; }
                s += (v[j].x * v[j].x + v[j].y * v[j].y) + (v[j].z * v[j].z + v[j].w * v[j].w);
            }
            if (!LAST) {
                const float rstd = 1.0f / sqrtf(wave_sum(s, lane) * (1.0f / D) + NORM_EPS);
#pragma unroll
                for (int j = 0; j < 4; ++j) { const f32x4 gg = *((const f32x4*)gnext + lane + 64 * j);
                    u32x2 o; o.x = pk2(v[j].x * rstd * gg.x, v[j].y * rstd * gg.y); o.y = pk2(v[j].z * rstd * gg.z, v[j].w * rstd * gg.w);
                    *((u32x2*)(hout + (size_t)row * D) + lane + 64 * j) = o; }
            }
        }
    }
}

namespace pg8 {
constexpr int BM = 256, BK = 64, HALF = 128, HTB = HALF * BK * 2  , STAGE_BYTES = 8 * HTB;
__host__ __device__ __forceinline__ int lds_byte(int r, int c) { const int st = (r >> 4) * 2 + (c >> 5), rr = r & 15, cc = c & 31, ob = rr * 64 + cc * 2; return st * 1024 + (ob ^ (((ob >> 9) & 1) << 5)); }
__host__ __device__ __forceinline__ void stage_rc(int b, int& R, int& C) { const int st = b / 1024, sb = b % 1024, swz = sb ^ (((sb >> 9) & 1) << 5); R = (st >> 1) * 16 + swz / 64; C = (st & 1) * 32 + (swz % 64) / 2; }
__host__ __device__ __forceinline__ int perm32(int rho) { const int n = rho >> 4, i = rho & 15; return 8 * (i >> 2) + 4 * n + (i & 3); }

struct Unit { int pm, pn, g, ui; };
struct Gemm { const bf16_t* A; const bf16_t* Bt; int lda, ldb, K; size_t ags, bgs;
    DEVI const char* abase(const Unit& u) const { return (const char*)(A + (size_t)u.g * ags + (size_t)u.pm * BM * lda); }
    DEVI const char* bbase(const Unit& u) const { return (const char*)(Bt + (size_t)u.g * bgs + (size_t)u.pn * BM * ldb); } };
struct NoGather { static constexpr bool ON = false; DEVI unsigned rowoff(const Unit&, int) const { return 0u; } };
struct LdsGather { static constexpr bool ON = true; const LAS unsigned* tab;
    DEVI unsigned rowoff(const Unit& u, int r) const { return tab[u.ui * 256 + r]; } };

typedef float f32x2_t __attribute__((ext_vector_type(2))); typedef __bf16 bf16x2_t __attribute__((ext_vector_type(2)));
DEVI unsigned cvt_pk_bf16(float lo, float hi) { const f32x2_t v = {lo, hi}; const bf16x2_t b = __builtin_convertvector(v, bf16x2_t); return __builtin_bit_cast(unsigned, b); }

template <class Epi, class Sched, class GA, bool ALIGN_EPI>
DEVI void gemm_phase(LAS unsigned char* lds, const Gemm g, const Sched& S, const Epi& E, const GA& ga, int tid_in) {
    const int tid = tid_in, wid = __builtin_amdgcn_readfirstlane(tid >> 6), lane = tid & 63, wr = wid >> 2, wc = wid & 3, fr = lane & 15, fq = lane >> 4;
    const int K = g.K, nt = K / BK;
    unsigned voffA[2], voffB[2]; int RA[2]; unsigned CA[2];
#pragma unroll
    for (int i = 0; i < 2; ++i) { int R, C; stage_rc(tid * 16 + i * 8192, R, C); const int Rb = Epi::PERM ? ((R & ~31) + perm32(R & 31)) : R;
        voffA[i] = (unsigned)(R * g.lda + C) * 2u; voffB[i] = (unsigned)(Rb * g.ldb + C) * 2u; RA[i] = R; CA[i] = (unsigned)C * 2u; }
    const size_t kstep = (size_t)(BK * 2);
    const size_t hstepA = GA::ON ? (size_t)0 : (size_t)HALF * g.lda * 2, hstepB = (size_t)HALF * g.ldb * 2;
    const unsigned ldsw = (unsigned)wid * 1024u;
    const int aoff = lds_byte(wr * 64 + fr, fq * 8), boff = lds_byte(wc * 32 + fr, fq * 8);
#define PG8_SA(b, h) (((b) * 2 + (h)) * HTB)
#define PG8_SB(b, h) ((4 + (b) * 2 + (h)) * HTB)
#define PG8_STAGE2(bufoff, gbase, v0, v1) do { \
        __builtin_amdgcn_global_load_lds((const unsigned*)((const char*)(gbase) + (v0)), (LAS unsigned*)(lds + (bufoff) + ldsw), 16, 0, 0); \
        __builtin_amdgcn_global_load_lds((const unsigned*)((const char*)(gbase) + (v1)), (LAS unsigned*)(lds + (bufoff) + ldsw + 8192), 16, 0, 0); } while (0)
#define PG8_STAGE_B(b, h, bptr) PG8_STAGE2(PG8_SB(b, h), (bptr) + (h) * hstepB, voffB[0], voffB[1])
#define PG8_STAGE_A(b, h, aptr, NX) do { if constexpr (GA::ON) { const unsigned _o0 = (NX) ? vgn[h][0] : vgc[h][0], _o1 = (NX) ? vgn[h][1] : vgc[h][1]; PG8_STAGE2(PG8_SA(b, h), (aptr), _o0, _o1); } \
        else { PG8_STAGE2(PG8_SA(b, h), (aptr) + (h) * hstepA, voffA[0], voffA[1]); } } while (0)
#define PG8_LDA(dst, b, h) do { _Pragma("unroll") for (int m = 0; m < 4; ++m) _Pragma("unroll") for (int k = 0; k < 2; ++k) dst[m][k] = *(const LAS bf16x8*)(lds + PG8_SA(b, h) + aoff + m * 2048 + k * 1024); } while (0)
#define PG8_LDB(dst, b, h) do { _Pragma("unroll") for (int n = 0; n < 2; ++n) _Pragma("unroll") for (int k = 0; k < 2; ++k) dst[n][k] = *(const LAS bf16x8*)(lds + PG8_SB(b, h) + boff + n * 2048 + k * 1024); } while (0)
#define PG8_MMA(ai, bj, At, Bt) do { __builtin_amdgcn_s_setprio(1); _Pragma("unroll") for (int m = 0; m < 4; ++m) _Pragma("unroll") for (int n = 0; n < 2; ++n) _Pragma("unroll") for (int k = 0; k < 2; ++k) \
        acc[ai][bj][m][n] = __builtin_amdgcn_mfma_f32_16x16x32_bf16(Bt[n][k], At[m][k], acc[ai][bj][m][n], 0, 0, 0); __builtin_amdgcn_s_setprio(0); } while (0)
#define PG8_WAIT_V(n) asm volatile("s_waitcnt vmcnt(" #n ")" ::: "memory")
#define PG8_WAIT_L(n) asm volatile("s_waitcnt lgkmcnt(" #n ")" ::: "memory")
#define PG8_BAR __builtin_amdgcn_s_barrier()
#define PG8_SCHED __builtin_amdgcn_sched_barrier(0)
    Unit cur, nxt; int ui = 0;
    if (!S.next(0, cur)) return;
    f32x4 acc[2][2][4][2];
#pragma unroll
    for (int a = 0; a < 2; ++a)
#pragma unroll
        for (int b = 0; b < 2; ++b)
#pragma unroll
            for (int m = 0; m < 4; ++m)
#pragma unroll
                for (int n = 0; n < 2; ++n) acc[a][b][m][n] = (f32x4){0.f, 0.f, 0.f, 0.f};
    bf16x8 At[4][2], B0[2][2], B1[2][2];
    unsigned vgc[2][2] = {{0u, 0u}, {0u, 0u}}, vgn[2][2] = {{0u, 0u}, {0u, 0u}};
    if constexpr (GA::ON) {
#pragma unroll
        for (int h = 0; h < 2; ++h)
#pragma unroll
            for (int i = 0; i < 2; ++i) vgc[h][i] = ga.rowoff(cur, h * HALF + RA[i]) + CA[i];
    }
    const char* cA = GA::ON ? (const char*)g.A : g.abase(cur); const char* cB = g.bbase(cur);
    S.a_ready(cur);
    PG8_STAGE_B(0, 0, cB); PG8_STAGE_B(0, 1, cB); PG8_STAGE_A(0, 0, cA, false); PG8_STAGE_A(0, 1, cA, false);
    if (wr == 1) PG8_BAR;
    PG8_WAIT_V(2); PG8_BAR;
    PG8_STAGE_B(1, 0, cB + kstep); PG8_STAGE_A(1, 0, cA + kstep, false); PG8_STAGE_B(1, 1, cB + kstep);
    PG8_WAIT_V(6); PG8_BAR;
    for (;;) {
        const bool has_next = S.next(ui + 1, nxt);
        const char* nA = has_next ? (GA::ON ? (const char*)g.A : g.abase(nxt)) : cA; const char* nB = has_next ? g.bbase(nxt) : cB;
        if constexpr (GA::ON) {
#pragma unroll
            for (int h = 0; h < 2; ++h)
#pragma unroll
                for (int i = 0; i < 2; ++i) vgn[h][i] = has_next ? ga.rowoff(nxt, h * HALF + RA[i]) + CA[i] : vgc[h][i];
            asm volatile("" : "+v"(vgn[0][0]), "+v"(vgn[0][1]), "+v"(vgn[1][0]), "+v"(vgn[1][1]));
        }
        for (int t = 0; t < nt; t += 2) {
            const bool last = (t == nt - 2);
            const char* a1 = cA + (size_t)(t + 1) * kstep;
            const char* a2 = last ? nA : cA + (size_t)(t + 2) * kstep; const char* b2 = last ? nB : cB + (size_t)(t + 2) * kstep;
            const char* a3 = a2 + kstep; const char* b3 = b2 + kstep;
            if (last && has_next) S.a_ready(nxt);
            PG8_LDB(B0, 0, 0); PG8_LDB(B1, 0, 1); PG8_SCHED; PG8_LDA(At, 0, 0); PG8_STAGE_A(1, 1, a1, false);
            PG8_WAIT_V(8); PG8_WAIT_L(0); PG8_BAR; PG8_MMA(0, 0, At, B0); PG8_MMA(0, 1, At, B1); PG8_BAR; PG8_SCHED;
            PG8_LDA(At, 0, 1); PG8_STAGE_B(0, 0, b2); PG8_STAGE_B(0, 1, b2); PG8_STAGE_A(0, 0, a2, last);
            PG8_WAIT_V(8); PG8_WAIT_L(0); PG8_BAR; PG8_MMA(1, 0, At, B0); PG8_MMA(1, 1, At, B1); PG8_BAR; PG8_SCHED;
            PG8_LDB(B0, 1, 0); PG8_LDB(B1, 1, 1); PG8_SCHED; PG8_LDA(At, 1, 0); PG8_STAGE_A(0, 1, a2, last);
            PG8_WAIT_V(8); PG8_WAIT_L(0); PG8_BAR; PG8_MMA(0, 0, At, B0); PG8_MMA(0, 1, At, B1); PG8_BAR; PG8_SCHED;
            PG8_LDA(At, 1, 1); PG8_STAGE_B(1, 0, b3); PG8_STAGE_B(1, 1, b3); PG8_STAGE_A(1, 0, a3, last);
            PG8_WAIT_V(8); PG8_WAIT_L(0); PG8_BAR; PG8_MMA(1, 0, At, B0); PG8_MMA(1, 1, At, B1); PG8_BAR; PG8_SCHED;
        }
        if constexpr (ALIGN_EPI) { if (wr == 0) PG8_BAR; }
        if constexpr (!Epi::AFTER_DRAIN) { E(acc, cur, wr, wc, fr, fq); S.done(cur); }
        if (!has_next) break;
#pragma unroll
        for (int a = 0; a < 2; ++a)
#pragma unroll
            for (int b = 0; b < 2; ++b)
#pragma unroll
                for (int m = 0; m < 4; ++m)
#pragma unroll
                    for (int n = 0; n < 2; ++n) acc[a][b][m][n] = (f32x4){0.f, 0.f, 0.f, 0.f};
        cur = nxt; cA = nA; cB = nB; ++ui;
        if constexpr (GA::ON) {
#pragma unroll
            for (int h = 0; h < 2; ++h)
#pragma unroll
                for (int i = 0; i < 2; ++i) vgc[h][i] = vgn[h][i];
        }
        if constexpr (ALIGN_EPI) { if (wr == 1) PG8_BAR; }
    }
    PG8_WAIT_V(0);
    if constexpr (!ALIGN_EPI) { if (wr == 0) PG8_BAR; }
    PG8_BAR;
    if constexpr (Epi::AFTER_DRAIN) { E.fused(acc, cur, wr, wc, fr, fq, lds, wid, lane); S.done(cur); }
#undef PG8_SA
#undef PG8_SB
#undef PG8_STAGE2
#undef PG8_STAGE_A
#undef PG8_STAGE_B
#undef PG8_LDA
#undef PG8_LDB
#undef PG8_MMA
#undef PG8_WAIT_V
#undef PG8_WAIT_L
#undef PG8_BAR
#undef PG8_SCHED
}
}

namespace pg8 {
DEVI float fsig(float x) { return __builtin_amdgcn_rcpf(1.0f + __expf(-x)); }
DEVI f32x4 unpk_lo(u32x4 w, int half) {
    const unsigned a = half ? w.z : w.x, b = half ? w.w : w.y;
    return (f32x4){__uint_as_float(a << 16), __uint_as_float(a & 0xffff0000u), __uint_as_float(b << 16), __uint_as_float(b & 0xffff0000u)}; }
DEVI u32x4 pk8(f32x4 v0, f32x4 v1) { u32x4 w; w.x = cvt_pk_bf16(v0[0], v0[1]); w.y = cvt_pk_bf16(v0[2], v0[3]); w.z = cvt_pk_bf16(v1[0], v1[1]); w.w = cvt_pk_bf16(v1[2], v1[3]); return w; }

struct StaticOrder {
    int nM, nN, nwg, G, c;
    DEVI void init(int M, int N, int G_, int c_) { nM = M / BM; nN = N / BM; nwg = nM * nN; G = G_; c = c_; }
    DEVI bool next(int i, Unit& u) const {
        const long L = (long)i * G + c; if (L >= nwg) return false;
        int wgid = (int)L; { const int q = nwg / 8, r = nwg % 8, xcd = wgid % 8, off = wgid / 8; wgid = (xcd < r ? xcd * (q + 1) : r * (q + 1) + (xcd - r) * q) + off; }
        const int nig = 8 * nN, gid = wgid / nig, fm = gid * 8, gsz = (nM - fm) < 8 ? (nM - fm) : 8;
        u.pm = fm + ((wgid % nig) % gsz); u.pn = (wgid % nig) / gsz; u.g = 0; u.ui = i; return true;
    }
    DEVI void a_ready(const Unit&) const {}
    DEVI void done(const Unit&) const {}
};
struct OrderS5A { int G, c; DEVI bool next(int i, Unit& u) const { const int U = i * G + c; if (U >= SSM_G * 4) return false; u.g = U >> 2; u.pm = U & 3; u.pn = 0; u.ui = i; return true; }
    DEVI void a_ready(const Unit&) const {} DEVI void done(const Unit&) const {} };
struct OrderS5C { int G, c; DEVI bool next(int i, Unit& u) const { const int U = i * G + c; if (U >= SSM_G * 8) return false; u.g = U >> 3; u.pm = (U >> 1) & 3; u.pn = U & 1; u.ui = i; return true; }
    DEVI void a_ready(const Unit&) const {} DEVI void done(const Unit&) const {} };
struct OrderMoE { int G, v; const volatile LAS int* tstart;
    DEVI bool next(int i, Unit& u) const { const int U = i * G + v, rt = U >> 2; if (rt >= tstart[NEXP]) return false;
        int e = 0;
#pragma unroll 1
        for (int q = 1; q < NEXP; ++q) e = (rt >= tstart[q]) ? q : e;
        u.pm = rt; u.pn = U & 3; u.g = e; u.ui = i; return true; }
    DEVI void a_ready(const Unit&) const {} DEVI void done(const Unit&) const {} };

template <bool F32IN> struct EpiResBf16 { static constexpr bool PERM = true, AFTER_DRAIN = false; const float* xin32; bf16_t* xb;
    DEVI void operator()(const f32x4 (&acc)[2][2][4][2], const Unit& u, int wr, int wc, int fr, int fq) const {
        const int row0 = u.pm * BM + wr * 64 + fr, col0 = u.pn * BM + wc * 32 + 8 * fq;
#pragma unroll
        for (int ai = 0; ai < 2; ++ai)
#pragma unroll
            for (int m = 0; m < 4; ++m) { const size_t off = (size_t)(row0 + ai * HALF + m * 16) * D + col0;
#pragma unroll
                for (int bj = 0; bj < 2; ++bj) { f32x4 a0, a1;
                    if (F32IN) { a0 = *(const f32x4*)(xin32 + off + bj * HALF); a1 = *(const f32x4*)(xin32 + off + bj * HALF + 4); }
                    else { const u32x4 w = *(const u32x4*)(xb + off + bj * HALF); a0 = unpk_lo(w, 0); a1 = unpk_lo(w, 1); }
                    *(u32x4*)(xb + off + bj * HALF) = pk8(a0 + acc[ai][bj][m][0], a1 + acc[ai][bj][m][1]); }
                if (m & 1) asm volatile("" ::: "memory"); }
    } };
struct EpiMix { static constexpr bool PERM = true, AFTER_DRAIN = false; const bf16_t* sg; const bf16_t* mixa; bf16_t* mixed;
    DEVI void operator()(const f32x4 (&acc)[2][2][4][2], const Unit& u, int wr, int wc, int fr, int fq) const {
        const int row0 = u.pm * BM + wr * 64 + fr, col0 = u.pn * BM + wc * 32 + 8 * fq;
#pragma unroll
        for (int ai = 0; ai < 2; ++ai)
#pragma unroll
            for (int m = 0; m < 4; ++m) { const size_t row = (size_t)(row0 + ai * HALF + m * 16);
#pragma unroll
                for (int bj = 0; bj < 2; ++bj) { const int col = col0 + bj * HALF;
                    const u32x4 a = *(const u32x4*)(mixa + row * 1024 + col), s = *(const u32x4*)(sg + row * 2048 + 1024 + col);
                    const f32x4 o0 = unpk_lo(a, 0) + unpk_lo(s, 0) * acc[ai][bj][m][0], o1 = unpk_lo(a, 1) + unpk_lo(s, 1) * acc[ai][bj][m][1];
                    *(u32x4*)(mixed + row * 1024 + col) = pk8(o0, o1); }
                if (m & 1) asm volatile("" ::: "memory"); }
    } };
struct EpiGlu { static constexpr bool PERM = true, AFTER_DRAIN = false; const bf16_t* sg; bf16_t* mixa;
    DEVI void operator()(const f32x4 (&acc)[2][2][4][2], const Unit& u, int wr, int wc, int fr, int fq) const {
        const int row0 = u.pm * BM + wr * 64 + fr, col = u.pn * HALF + wc * 32 + 8 * fq;
#pragma unroll
        for (int ai = 0; ai < 2; ++ai)
#pragma unroll
            for (int m = 0; m < 4; ++m) { const size_t row = (size_t)(row0 + ai * HALF + m * 16);
                const u32x4 s = *(const u32x4*)(sg + row * 2048 + col);
                f32x4 o[2];
#pragma unroll
                for (int n = 0; n < 2; ++n) { const f32x4 v = acc[ai][0][m][n], gt = acc[ai][1][m][n], sv = unpk_lo(s, n);
                    o[n] = (f32x4){sv[0] * v[0] * fsig(gt[0]), sv[1] * v[1] * fsig(gt[1]), sv[2] * v[2] * fsig(gt[2]), sv[3] * v[3] * fsig(gt[3])}; }
                *(u32x4*)(mixa + row * 1024 + col) = pk8(o[0], o[1]);
                if (m & 1) asm volatile("" ::: "memory"); }
    } };
struct EpiSwiglu { static constexpr bool PERM = true, AFTER_DRAIN = false; bf16_t* hmid;
    DEVI void operator()(const f32x4 (&acc)[2][2][4][2], const Unit& u, int wr, int wc, int fr, int fq) const {
        const int row0 = u.pm * BM + wr * 64 + fr, col = u.pn * HALF + wc * 32 + 8 * fq;
#pragma unroll
        for (int ai = 0; ai < 2; ++ai)
#pragma unroll
            for (int m = 0; m < 4; ++m) { const size_t row = (size_t)(row0 + ai * HALF + m * 16);
                f32x4 o[2];
#pragma unroll
                for (int n = 0; n < 2; ++n) { const f32x4 gt = acc[ai][0][m][n], up = acc[ai][1][m][n];
                    o[n] = (f32x4){gt[0] * fsig(gt[0]) * up[0], gt[1] * fsig(gt[1]) * up[1], gt[2] * fsig(gt[2]) * up[2], gt[3] * fsig(gt[3]) * up[3]}; }
                *(u32x4*)(hmid + row * 512 + col) = pk8(o[0], o[1]); }
    } };
struct EpiStoreBf16 { static constexpr bool PERM = true, AFTER_DRAIN = false; bf16_t* out; int ldc;
    DEVI void operator()(const f32x4 (&acc)[2][2][4][2], const Unit& u, int wr, int wc, int fr, int fq) const {
        const int row0 = u.pm * BM + wr * 64 + fr, col0 = u.pn * BM + wc * 32 + 8 * fq;
#pragma unroll
        for (int ai = 0; ai < 2; ++ai)
#pragma unroll
            for (int m = 0; m < 4; ++m) { bf16_t* rp = out + (size_t)(row0 + ai * HALF + m * 16) * ldc + col0;
#pragma unroll
                for (int bj = 0; bj < 2; ++bj) *(u32x4*)(rp + bj * HALF) = pk8(acc[ai][bj][m][0], acc[ai][bj][m][1]); }
    } };
struct EpiS5Cm { static constexpr bool PERM = true, AFTER_DRAIN = false; const bf16_t* ucat; const float* dskip; bf16_t* z;
    DEVI void operator()(const f32x4 (&acc)[2][2][4][2], const Unit& u, int wr, int wc, int fr, int fq) const {
        const int g = u.g, row0 = u.pm * BM + wr * 64 + fr, col0 = u.pn * BM + wc * 32 + 8 * fq;
        const int co0 = col0 & 15;
        const f32x4 d0 = *(const f32x4*)(dskip + g * 16 + co0), d1 = *(const f32x4*)(dskip + g * 16 + co0 + 4);
#pragma unroll
        for (int ai = 0; ai < 2; ++ai)
#pragma unroll
            for (int m = 0; m < 4; ++m) { const int row = row0 + ai * HALF + m * 16, b = row >> 7, c = row & 127;
#pragma unroll
                for (int bj = 0; bj < 2; ++bj) { const int n = col0 + bj * HALF, t = n >> 4;
                    const u32x4 uu = *(const u32x4*)(ucat + ((size_t)g * UROWS + row) * UK + n);
                    const f32x4 y0 = acc[ai][bj][m][0] + d0 * unpk_lo(uu, 0), y1 = acc[ai][bj][m][1] + d1 * unpk_lo(uu, 1);
                    const f32x4 z0 = (f32x4){gelu_tanh(y0[0]), gelu_tanh(y0[1]), gelu_tanh(y0[2]), gelu_tanh(y0[3])}, z1 = (f32x4){gelu_tanh(y1[0]), gelu_tanh(y1[1]), gelu_tanh(y1[2]), gelu_tanh(y1[3])};
                    *(u32x4*)(z + ((size_t)b * SEQ + c * CHL + t) * 512 + g * 16 + co0) = pk8(z0, z1); } }
    } };
struct EpiS5Am { static constexpr bool PERM = false, AFTER_DRAIN = true; const float* AL; bf16_t* ucat;
    DEVI void fused(f32x4 (&acc)[2][2][4][2], const Unit& u, int wr, int wc, int fr, int fq, LAS unsigned char* lds, int wid, int lane) const {
        LAS float* sl = (LAS float*)lds;
#pragma unroll
        for (int ai = 0; ai < 2; ++ai)
#pragma unroll
            for (int m = 0; m < 4; ++m) { const int row = ai * HALF + wr * 64 + m * 16 + fr;
#pragma unroll
                for (int n = 0; n < 2; ++n) *(LAS f32x4*)(sl + row * 128 + wc * 32 + n * 16 + 4 * fq) = acc[ai][0][m][n]; }
        asm volatile("s_waitcnt lgkmcnt(0)" ::: "memory"); __builtin_amdgcn_s_barrier(); asm volatile("" ::: "memory");
        const int tid = wid * 64 + lane;
        if (tid < 128) { const int bb = tid >> 6, p = tid & 63, g = u.g;
            const float ar = AL[(g * 64 + p) * 2], ai_ = AL[(g * 64 + p) * 2 + 1];
            float hr = 0.f, hi = 0.f;
            for (int c = 0; c < NCH; ++c) { const int row = bb * NCH + c;
                bf16_t* up = ucat + ((size_t)g * UROWS + u.pm * BM + row) * UK + 512 + p;
                up[0] = f2bf(hr); up[64] = f2bf(hi);
                const float sr = sl[row * 128 + p], si = sl[row * 128 + 64 + p];
                const float nr = ar * hr - ai_ * hi + sr, ni = ar * hi + ai_ * hr + si; hr = nr; hi = ni; } }
        asm volatile("s_waitcnt lgkmcnt(0)" ::: "memory"); __builtin_amdgcn_s_barrier(); asm volatile("" ::: "memory");
    } };
struct EpiG1 { static constexpr bool PERM = true, AFTER_DRAIN = false; bf16_t* ucat; bf16_t* q; bf16_t* k; bf16_t* v; bf16_t* sg; const float* qg; const float* kg; const float* rope; float* qraw; float* kraw;
    DEVI void operator()(const f32x4 (&acc)[2][2][4][2], const Unit& u, int wr, int wc, int fr, int fq) const {
        const int pn = u.pn, row0 = u.pm * BM + wr * 64 + fr;
        if (pn < 2) {
#pragma unroll
            for (int ai = 0; ai < 2; ++ai)
#pragma unroll
                for (int m = 0; m < 4; ++m) { const int row = row0 + ai * HALF + m * 16, b = row >> 12, s = row & 4095;
#pragma unroll
                    for (int bj = 0; bj < 2; ++bj) { const int c = pn * BM + bj * HALF + wc * 32 + 8 * fq, g = c >> 4, ci = c & 15;
                        *(u32x4*)(ucat + ((size_t)g * UROWS + b * NCH + (s >> 5)) * UK + (s & 31) * 16 + ci) = pk8(acc[ai][bj][m][0], acc[ai][bj][m][1]); } }
        } else if (pn < 6) {
            const bool isk = pn >= 4; const int hh = (pn & 1) * 4 + wc;
#if G1_RAWQK
            { float* raw = isk ? kraw : qraw;
#pragma unroll
              for (int ai = 0; ai < 2; ++ai)
#pragma unroll
                for (int m = 0; m < 4; ++m) { const int row = row0 + ai * HALF + m * 16;
#pragma unroll
                    for (int bj = 0; bj < 2; ++bj)
#pragma unroll
                        for (int n = 0; n < 2; ++n) *(f32x4*)(raw + (size_t)row * 512 + hh * 64 + 32 * bj + 8 * fq + 4 * n) = acc[ai][bj][m][n]; }
              return; }
#endif
            const float* gn = isk ? kg : qg; bf16_t* dst = isk ? k : q; const float sc = isk ? 1.0f : QSCALE;
            f32x4 gv[2][2];
#pragma unroll
            for (int bj = 0; bj < 2; ++bj)
#pragma unroll
                for (int n = 0; n < 2; ++n) gv[bj][n] = *(const f32x4*)(gn + 32 * bj + 8 * fq + 4 * n);
#pragma unroll
            for (int ai = 0; ai < 2; ++ai)
#pragma unroll
                for (int m = 0; m < 4; ++m) { const int row = row0 + ai * HALF + m * 16, s = row & 4095;
                    float ss = 0.f;
#pragma unroll
                    for (int bj = 0; bj < 2; ++bj)
#pragma unroll
                        for (int n = 0; n < 2; ++n) { const f32x4 x = acc[ai][bj][m][n]; ss += (x[0] * x[0] + x[1] * x[1]) + (x[2] * x[2] + x[3] * x[3]); }
                    ss += xshfl(ss, 16, fq * 16 + fr); ss += xshfl(ss, 32, fq * 16 + fr);
                    const float rstd = 1.0f / sqrtf(ss * (1.0f / 64.0f) + NORM_EPS);
                    f32x4 o1[2], o2[2];
#pragma unroll
                    for (int n = 0; n < 2; ++n) { const float* rp = rope + ((size_t)s * 32 + 8 * fq + 4 * n) * 2;
                        const f32x4 r0 = *(const f32x4*)rp, r1 = *(const f32x4*)(rp + 4);
                        const f32x4 cv = (f32x4){r0[0], r0[2], r1[0], r1[2]}, sv = (f32x4){r0[1], r0[3], r1[1], r1[3]};
                        const f32x4 x1 = acc[ai][0][m][n] * rstd * gv[0][n], x2 = acc[ai][1][m][n] * rstd * gv[1][n];
                        o1[n] = (x1 * cv - x2 * sv) * sc; o2[n] = (x2 * cv + x1 * sv) * sc; }
                    const u32x4 w1 = pk8(o1[0], o1[1]), w2 = pk8(o2[0], o2[1]);
                    bf16_t* dp = dst + (size_t)row * 512 + hh * 64 + 8 * fq;
                    *(u32x4*)dp = w1; *(u32x4*)(dp + 32) = w2;
                    if (m & 1) asm volatile("" ::: "memory"); }
        } else if (pn < 8) {
#pragma unroll
            for (int ai = 0; ai < 2; ++ai)
#pragma unroll
                for (int m = 0; m < 4; ++m) { bf16_t* rp = v + (size_t)(row0 + ai * HALF + m * 16) * 512 + (pn - 6) * BM + wc * 32 + 8 * fq;
#pragma unroll
                    for (int bj = 0; bj < 2; ++bj) *(u32x4*)(rp + bj * HALF) = pk8(acc[ai][bj][m][0], acc[ai][bj][m][1]); }
        } else {
#pragma unroll
            for (int ai = 0; ai < 2; ++ai)
#pragma unroll
                for (int m = 0; m < 4; ++m) { bf16_t* rp = sg + (size_t)(row0 + ai * HALF + m * 16) * 2048 + (pn - 8) * BM + wc * 32 + 8 * fq;
#pragma unroll
                    for (int bj = 0; bj < 2; ++bj) { const f32x4 a = acc[ai][bj][m][0], b = acc[ai][bj][m][1];
                        *(u32x4*)(rp + bj * HALF) = pk8((f32x4){fsig(a[0]), fsig(a[1]), fsig(a[2]), fsig(a[3])}, (f32x4){fsig(b[0]), fsig(b[1]), fsig(b[2]), fsig(b[3])}); } }
        }
    } };
}

struct CvtItem { const float* src; bf16_t* dst; int N, K; };
DEVI void cvt_load(const CvtItem& it, float (&v)[32], int lane) {
#pragma unroll
    for (int i = 0; i < 32; ++i) v[i] = it.src[(size_t)(2 * i + (lane >> 5)) * it.N + (lane & 31)];
}
DEVI void cvt_store(const CvtItem& it, const float (&v)[32], LAS float* scr, int lane) {
#pragma unroll
    for (int i = 0; i < 32; ++i) scr[(2 * i + (lane >> 5)) * 33 + (lane & 31)] = v[i];
    asm volatile("s_waitcnt lgkmcnt(0)" ::: "memory");
    const int c = lane & 7;
#pragma unroll
    for (int j = 0; j < 4; ++j) { const int n = (lane >> 3) + 8 * j; const LAS float* s = scr + (8 * c) * 33 + n;
        u32x4 o; o.x = pk2(s[0 * 33], s[1 * 33]); o.y = pk2(s[2 * 33], s[3 * 33]); o.z = pk2(s[4 * 33], s[5 * 33]); o.w = pk2(s[6 * 33], s[7 * 33]);
        *(u32x4*)(it.dst + (size_t)n * it.K + 8 * c) = o; }
    asm volatile("s_waitcnt lgkmcnt(0)" ::: "memory");
}
constexpr int CV_IN = 16 * 128, CV_GLU = 8 * 64, CV_ATT = 8 * 32, CV_OUT = 16 * 32, CV_GU1 = 16 * 32, CV_DN1 = 8 * 32;
constexpr int CV_PER_LAYER = CV_IN + CV_GLU + CV_ATT + CV_OUT + NEXP * (CV_GU1 + CV_DN1);
DEVI CvtItem cvt_decode(int it, const float* w_in, const float* w_glu, const float* w_attn, const float* w_out, const float* w_gu, const float* w_dn,
                        bf16_t* WIN, bf16_t* WGLU, bf16_t* WATT, bf16_t* WOUT, bf16_t* WGU, bf16_t* WDN) {
    const int l = it / CV_PER_LAYER; int r = it % CV_PER_LAYER;
    const float* W; bf16_t* WT; int K, N, mode;
    if (r < CV_IN) { W = w_in + (size_t)l * D * D_IN; WT = WIN + (size_t)l * D_IN * D; K = D; N = D_IN; mode = 1; }
    else if ((r -= CV_IN) < CV_GLU) { W = w_glu + (size_t)l * 512 * 2048; WT = WGLU + (size_t)l * 2048 * 512; K = 512; N = 2048; mode = 2; }
    else if ((r -= CV_GLU) < CV_ATT) { W = w_attn + (size_t)l * 512 * 1024; WT = WATT + (size_t)l * 1024 * 512; K = 512; N = 1024; mode = 0; }
    else if ((r -= CV_ATT) < CV_OUT) { W = w_out + (size_t)l * 1024 * 1024; WT = WOUT + (size_t)l * 1024 * 1024; K = 1024; N = 1024; mode = 0; }
    else if ((r -= CV_OUT) < NEXP * CV_GU1) { const int e = r / CV_GU1; r %= CV_GU1; W = w_gu + ((size_t)l * NEXP + e) * 1024 * 1024; WT = WGU + ((size_t)l * NEXP + e) * 1024 * 1024; K = 1024; N = 1024; mode = 3; }
    else { r -= NEXP * CV_GU1; const int e = r / CV_DN1; r %= CV_DN1; W = w_dn + ((size_t)l * NEXP + e) * 512 * 1024; WT = WDN + ((size_t)l * NEXP + e) * 1024 * 512; K = 512; N = 1024; mode = 0; }
    const int nblk = N / 32, kb = r / nblk, nb = r % nblk, nd = 32 * nb;
    int ns = nd;
    if (mode == 1) { const int pn = nd >> 8, tc = nd & 255; if (pn >= 2 && pn < 6) { const int sec = pn < 4 ? 512 : 1024, hh = (pn & 1) * 4 + ((tc >> 5) & 3); ns = sec + hh * 64 + 32 * (tc >> 7); } }
    else if (mode == 2) { const int pn = nd >> 8, tc = nd & 255; ns = (tc < 128) ? 128 * pn + tc : 1024 + 128 * pn + (tc - 128); }
    else if (mode == 3) { const int pn = nd >> 8, tc = nd & 255; ns = (tc < 128) ? 128 * pn + tc : 512 + 128 * pn + (tc - 128); }
    return CvtItem{W + (size_t)(64 * kb) * N + ns, WT + (size_t)nd * K + 64 * kb, N, K};
}
constexpr int CVQ_BASE = CV_IN + CV_GLU + CV_ATT + CV_OUT;
constexpr int CVQ_PER_BARRIER = 2;
constexpr int CVQ_TOTAL = DEPTH * CV_PER_LAYER - CVQ_BASE;
constexpr int CVQ_LIM_MOE0 = CV_PER_LAYER - CVQ_BASE;
constexpr int CVQ_LIM_PROJ1 = CVQ_LIM_MOE0 + CVQ_BASE;
struct CvtQ { const float* w_in; const float* w_glu; const float* w_attn; const float* w_out; const float* w_gu; const float* w_dn;
              bf16_t* WIN_; bf16_t* WGLU_; bf16_t* WATT_; bf16_t* WOUT_; bf16_t* WGU_; bf16_t* WDN_; LAS unsigned* head; LAS unsigned char* lds; int wave, lane, c, G;
    DEVI void item(int q) const { const CvtItem c = cvt_decode(q + CVQ_BASE, w_in, w_glu, w_attn, w_out, w_gu, w_dn, WIN_, WGLU_, WATT_, WOUT_, WGU_, WDN_);
        float v[32]; cvt_load(c, v, lane); cvt_store(c, v, (LAS float*)(lds + wave * 16384), lane); }
    DEVI int take() const { unsigned j = 0u; if (lane == 0) j = __hip_atomic_fetch_add(head, 1u, __ATOMIC_RELAXED, __HIP_MEMORY_SCOPE_WORKGROUP); return c + G * __builtin_amdgcn_readfirstlane((int)j); }
    DEVI int peek() const { return c + G * __builtin_amdgcn_readfirstlane((int)__hip_atomic_load(head, __ATOMIC_RELAXED, __HIP_MEMORY_SCOPE_WORKGROUP)); }
    DEVI void run_until(volatile LAS unsigned* genw, unsigned n) const {
        bool empty = peek() >= CVQ_TOTAL; int budget = CVQ_PER_BARRIER;
        while (*genw < n) {
            if (empty || budget == 0) { __builtin_amdgcn_s_sleep(4); continue; }
            --budget;
            const int q = take();
            if (q >= CVQ_TOTAL) { empty = true; continue; }
            item(q);
        }
    }
    DEVI void catchup(int limit) const { for (;;) { if (peek() >= limit) break; const int q = take(); if (q >= CVQ_TOTAL) break; item(q); } }
};
DEVI int fresh_lane() { int l = (int)__builtin_amdgcn_mbcnt_hi(~0u, __builtin_amdgcn_mbcnt_lo(~0u, 0u)); asm volatile("" : "+v"(l)); return l; }
DEVI CvtQ make_cvtq(const Args& a, LAS unsigned char* lds, int wave, int lane) {
    unsigned char* w = a.ws;
    return CvtQ{a.in[2], a.in[11], a.in[14], a.in[15], a.in[21], a.in[22], (bf16_t*)(w + WS_WIN), (bf16_t*)(w + WS_WGLU), (bf16_t*)(w + WS_WATT), (bf16_t*)(w + WS_WOUT), (bf16_t*)(w + WS_WGU), (bf16_t*)(w + WS_WDN),
                (LAS unsigned*)(lds + LDSCTL_OFF) + 5, lds, wave, lane, (int)blockIdx.x, (int)gridDim.x};
}
DEVI void ph_convert_first(const Frame& F, const CvtQ& Q) { for (int it = F.gw; it < CVQ_BASE; it += F.NGW) Q.item(it - CVQ_BASE); }
DEVI void xcd_barrier_w(const XcdBarrier& b, unsigned n, volatile LAS unsigned* genw, const CvtQ& Q) {
    asm volatile("s_waitcnt vmcnt(0)" ::: "memory");
    __syncthreads();
    if (Q.wave == 0) {
        if (threadIdx.x == 0) {
            unsigned* bar = b.bar;
            __builtin_amdgcn_s_waitcnt(0);
            unsigned nloc = b.st[0], nx = b.st[1];
            if (nloc == 0u) { xcd_barrier_complete(bar, b.x, nloc, nx); b.st[0] = nloc; b.st[1] = nx; }
            const unsigned old = xb_add(&bar[XB_XSUB(b.x)], 1u);
            const unsigned gen = old / nloc;
            if (old + 1u == (gen + 1u) * nloc) {
                __builtin_amdgcn_fence(__ATOMIC_RELEASE, "agent");
                asm volatile("s_waitcnt vmcnt(0)" ::: "memory");
                const unsigned og = xb_add(&bar[XB_TOP], 1u);
                const unsigned tg = og / nx;
                if (og + 1u == (tg + 1u) * nx) xb_add(&bar[XB_TOPGEN], 1u);
                else XB_SPIN(xb_ld(&bar[XB_TOPGEN]) == tg, bar);
                __builtin_amdgcn_fence(__ATOMIC_ACQUIRE, "agent");
                xb_add(&bar[XB_XGEN(b.x)], 1u);
                asm volatile("s_waitcnt vmcnt(0)" ::: "memory");
            } else {
                XB_SPIN(xb_ld(&bar[XB_XGEN(b.x)]) == gen, bar);
                __builtin_amdgcn_fence(__ATOMIC_ACQUIRE, "agent");
                asm volatile("s_waitcnt vmcnt(0)" ::: "memory");
            }
            *genw = n;
        }
    } else Q.run_until(genw, n);
    __syncthreads();
}


DEVI void moe_tstart(const Frame& F, const unsigned* cnt, volatile LAS int* tstart) { expert_prefix(F, cnt, tstart, 1); }
DEVI void moe_gather_table(const Frame& F, int v, const unsigned* cnt, const int* list, volatile LAS int* tstart, LAS unsigned* tab) {
    for (int j = F.tid; j < 8 * 256; j += NTHR) {
        const int i = j >> 8, r = j & 255, U = i * F.G + v, rt = U >> 2; if (rt >= tstart[NEXP]) continue;
        int e = 0;
        for (int q = 1; q < NEXP; ++q) e = (rt >= tstart[q]) ? q : e;
        const int n = (int)cnt[e], idx = (rt - tstart[e]) * 256 + r;
        tab[j] = (unsigned)list[(size_t)e * LIST_CAP + (idx < n ? idx : 0)] * (unsigned)(D * 2);
    }
    __syncthreads();
}
DEVI void ph_zero_ksum(const Frame& F, float* ksum) { for (int i = F.gt; i < BATCH * NH * NBLK * 64; i += F.NGT) ksum[i] = 0.f; }

namespace attn_body {
using bf16=__hip_bfloat16;
using bf16x8=__attribute__((ext_vector_type(8)))short;
using s16x4=__attribute__((ext_vector_type(4)))short;
using f32x16=__attribute__((ext_vector_type(16)))float;
using f32x4=__attribute__((ext_vector_type(4)))float;
using u32x4=__attribute__((ext_vector_type(4)))unsigned;
constexpr int BATCH=8,NHEAD=8,SEQ=4096,D=64,DM=NHEAD*D;
constexpr int NW=8,QBLK=32,QB=QBLK*NW,KVBLK=64,NQB=SEQ/QB;
constexpr int ATTN_PITCH=DM, ATTN_UNIT_ROWS=QB;
__device__ __forceinline__ int crow(int r,int hi){return (r&3)+8*(r>>2)+4*hi;}
#define SBAR() __builtin_amdgcn_sched_barrier(0)
__device__ __forceinline__ void cmask(f32x16&p0,f32x16&p1,int jb,int qrel,int hi){
  const float NEG=-INFINITY; int kb=64*jb+4*hi;
  #pragma unroll
  for(int r=0;r<16;++r){int kv=kb+(r&3)+8*(r>>2); if(kv>qrel)p0[r]=NEG; if(kv+32>qrel)p1[r]=NEG;}
}

constexpr int NSLOT=3, SLOTB=8192;
constexpr int LDS_K=0, LDS_V=NSLOT*SLOTB, LDS_WS=2*NSLOT*SLOTB, LDS_OST=LDS_WS+NW*64*4, LDS_BYTES=LDS_OST+NW*4096;
constexpr float C2=0.125f*1.4426950408889634f;
__device__ __forceinline__ void glds16(const void*gsrc,unsigned lds_dst){unsigned keep;
  asm volatile("s_mov_b32 %0, m0\n\ts_mov_b32 m0, %2\n\ts_nop 0\n\tglobal_load_lds_dwordx4 %1, off\n\ts_mov_b32 m0, %0":"=&s"(keep):"v"(gsrc),"s"(lds_dst):"memory");}
__device__ __forceinline__ float max3f(float a,float b,float c){float r;asm("v_max3_f32 %0, %1, %2, %3":"=v"(r):"v"(a),"v"(b),"v"(c));return r;}
__device__ __forceinline__ float max2f(float a,float b){float r;asm("v_max_f32_e32 %0, %1, %2":"=v"(r):"v"(a),"v"(b));return r;}
__device__ __forceinline__ float fadd_s(float a,float b){float r;asm("v_add_f32_e32 %0, %1, %2":"=v"(r):"v"(a),"v"(b));return r;}
__device__ __forceinline__ float fsub_s(float a,float b){float r;asm("v_sub_f32_e32 %0, %1, %2":"=v"(r):"v"(a),"v"(b));return r;}
typedef float f32x2_t __attribute__((ext_vector_type(2))); typedef __bf16 bf16x2_t __attribute__((ext_vector_type(2)));
__device__ __forceinline__ unsigned cvtpk_s(float lo,float hi){f32x2_t v={lo,hi};bf16x2_t b=__builtin_convertvector(v,bf16x2_t);return __builtin_bit_cast(unsigned,b);}
#define WAIT_BAR(N) asm volatile("s_waitcnt vmcnt(" #N ") lgkmcnt(0)\n\ts_barrier":::"memory")

__device__ __forceinline__ void qkt(f32x16&p0,f32x16&p1,const char*Kslot,const bf16x8*qr,const f32x16&negm,int r32,int hi){
  const char*kb=Kslot+hi*1024+r32*16;
  #pragma unroll
  for(int d0=0;d0<4;++d0){
    const bf16x8 b0=*reinterpret_cast<const bf16x8*>(kb+d0*2048);
    const bf16x8 b1=*reinterpret_cast<const bf16x8*>(kb+d0*2048+512);
    if(d0==0){p0=__builtin_amdgcn_mfma_f32_32x32x16_bf16(b0,qr[0],negm,0,0,0);p1=__builtin_amdgcn_mfma_f32_32x32x16_bf16(b1,qr[0],negm,0,0,0);}
    else{p0=__builtin_amdgcn_mfma_f32_32x32x16_bf16(b0,qr[d0],p0,0,0,0);p1=__builtin_amdgcn_mfma_f32_32x32x16_bf16(b1,qr[d0],p1,0,0,0);}}
}
typedef __attribute__((address_space(3))) const char* lds_cptr;
typedef short v4i16_t __attribute__((ext_vector_type(4)));
__device__ __forceinline__ void kload8(bf16x8*kf,lds_cptr kp){
  kf[0]=*(const __attribute__((address_space(3))) bf16x8*)(kp);      kf[1]=*(const __attribute__((address_space(3))) bf16x8*)(kp+512);
  kf[2]=*(const __attribute__((address_space(3))) bf16x8*)(kp+2048); kf[3]=*(const __attribute__((address_space(3))) bf16x8*)(kp+2560);
  kf[4]=*(const __attribute__((address_space(3))) bf16x8*)(kp+4096); kf[5]=*(const __attribute__((address_space(3))) bf16x8*)(kp+4608);
  kf[6]=*(const __attribute__((address_space(3))) bf16x8*)(kp+6144); kf[7]=*(const __attribute__((address_space(3))) bf16x8*)(kp+6656);
}
__device__ __forceinline__ void kload2(bf16x8*kf,lds_cptr kp,int j){ kf[2*j]=*(const __attribute__((address_space(3))) bf16x8*)(kp+j*2048); kf[2*j+1]=*(const __attribute__((address_space(3))) bf16x8*)(kp+j*2048+512); }
__device__ __forceinline__ s16x4 vtr(lds_cptr p){ return __builtin_bit_cast(s16x4,__builtin_amdgcn_ds_read_tr16_b64_v4i16((__attribute__((address_space(3))) v4i16_t*)p)); }
__device__ __forceinline__ float rowmax(const f32x16&p0,const f32x16&p1){
  float a=max3f(p0[0],p0[1],p1[0]),b=max3f(p0[2],p0[3],p1[1]);a=max3f(a,p1[2],p1[3]);
  #pragma unroll
  for(int r=4;r<16;r+=4){a=max3f(a,p0[r],p0[r+1]);b=max3f(b,p0[r+2],p0[r+3]);a=max3f(a,p1[r],p1[r+1]);b=max3f(b,p1[r+2],p1[r+3]);}
  const float m=max2f(a,b);
  auto rr=__builtin_amdgcn_permlane32_swap(__float_as_uint(m),__float_as_uint(m),false,false);
  return max2f(__uint_as_float(rr[0]),__uint_as_float(rr[1]));
}
__device__ __forceinline__ void pv(f32x16*o,int vb,bf16x8 pa0,bf16x8 pa1,bf16x8 pa2,bf16x8 pa3){
  #pragma unroll
  for(int d0=0;d0<2;++d0){s16x4 lo[4],hi[4];
    #pragma unroll
    for(int ks=0;ks<4;++ks){
      asm volatile("ds_read_b64_tr_b16 %0,%1 offset:%c2":"=&v"(lo[ks]):"v"(vb),"i"(d0*4096+ks*1024):"memory");
      asm volatile("ds_read_b64_tr_b16 %0,%1 offset:%c2":"=&v"(hi[ks]):"v"(vb),"i"(d0*4096+ks*1024+512):"memory");}
    asm volatile("s_waitcnt lgkmcnt(0)":::"memory");SBAR();
    #define PK(k) (bf16x8){lo[k][0],lo[k][1],lo[k][2],lo[k][3],hi[k][0],hi[k][1],hi[k][2],hi[k][3]}
    o[d0]=__builtin_amdgcn_mfma_f32_32x32x16_bf16(pa0,PK(0),o[d0],0,0,0);
    o[d0]=__builtin_amdgcn_mfma_f32_32x32x16_bf16(pa1,PK(1),o[d0],0,0,0);
    o[d0]=__builtin_amdgcn_mfma_f32_32x32x16_bf16(pa2,PK(2),o[d0],0,0,0);
    o[d0]=__builtin_amdgcn_mfma_f32_32x32x16_bf16(pa3,PK(3),o[d0],0,0,0);
    #undef PK
  }
}

#ifndef ATTN_STORE16
#define ATTN_STORE16(p,v) (*(u32x4*)(p)=(v))
#endif
template<int THRL> __device__ __forceinline__ void attn_unit(int b,int h,int qb,const bf16*Q,const bf16*__restrict__ K,const bf16*__restrict__ V,bf16*O,const unsigned*__restrict__ sel,char*shm,int tid_in){
  const int tid=tid_in,lane=tid&63,r32=lane&31,hi=lane>>5; const int wid=__builtin_amdgcn_readfirstlane(tid>>6);
  const long rowbase=(long)b*SEQ; const int q0=qb*QB;
  const bf16*Qw=Q+(rowbase+q0+wid*QBLK)*DM+h*D;
  const bf16*Kh=K+rowbase*DM+h*D,*Vh=V+rowbase*DM+h*D;
  const unsigned lds0=(unsigned)(uintptr_t)shm;
  float*wsf=(float*)(shm+LDS_WS)+wid*64;
  const bf16*ksrc=Kh+(long)lane*DM+wid*8;
  const bf16*vsrc=Vh+(long)(16*(wid&3)+(lane>>2))*DM+(wid>>2)*32+(lane&3)*8;
  const unsigned kdst=lds0+LDS_K+wid*1024, vdst=lds0+LDS_V+wid*1024;
  #define DMA_K(t,slot) glds16(ksrc+(long)(t)*KVBLK*DM,(unsigned)__builtin_amdgcn_readfirstlane(kdst+(slot)))
  #define DMA_V(t,slot) glds16(vsrc+(long)(t)*KVBLK*DM,(unsigned)__builtin_amdgcn_readfirstlane(vdst+(slot)))
  const int vb0=(int)(lds0+LDS_V)+((lane>>4)&1)*32+(lane&3)*8+(4*hi+((lane&15)>>2))*64;
  const char*Kbase=shm+LDS_K; bf16x8 kf[8];
  const lds_cptr shm3=(lds_cptr)shm; const lds_cptr kp0=shm3+LDS_K+hi*1024+r32*16; const lds_cptr vp0=shm3+LDS_V+((lane>>4)&1)*32+(lane&3)*8+(4*hi+((lane&15)>>2))*64;
  const int NT=(q0+QB)/KVBLK;
  DMA_K(0,0);DMA_V(0,0);DMA_K(1,SLOTB);
  bf16x8 qr[4];
  #pragma unroll
  for(int d0=0;d0<4;++d0)qr[d0]=*reinterpret_cast<const bf16x8*>(&Qw[(long)r32*DM+d0*16+hi*8]);
  const unsigned selmask=sel[((size_t)(b*NHEAD+h))*SEQ+q0+wid*QBLK+r32];
  const float NEGINF=-INFINITY;
  float mhat=0.f,l_reg=0.f;f32x16 o[2];o[0]=f32x16{};o[1]=f32x16{};f32x16 negm=f32x16{};asm volatile("":"+v"(negm));
  const int qrel=wid*QBLK+r32;
  #define CMASK(P0,P1,t) do{int jb_=(t)-(NT-4); if(jb_>=0)cmask(P0,P1,jb_,qrel,hi);}while(0)
  bool resc=false;
  #define START(P0,P1) do{ const float rm=rowmax(P0,P1); resc=false; \
    { const float dl=__builtin_fmaxf(rm,-64.f); mhat=fadd_s(mhat,dl); \
      _Pragma("unroll") for(int r=0;r<16;++r){P0[r]=fsub_s(P0[r],dl);P1[r]=fsub_s(P1[r],dl);} \
      _Pragma("unroll") for(int r=0;r<16;++r)negm[r]=-mhat; asm volatile("":"+v"(negm)); } \
    _Pragma("unroll") for(int r=0;r<16;++r)P0[r]=__builtin_amdgcn_exp2f(P0[r]); }while(0)
  #define RESC() do{ if(resc){ asm volatile("s_waitcnt lgkmcnt(0)":::"memory"); \
      _Pragma("unroll") for(int d_=0;d_<2;++d_) _Pragma("unroll") for(int r=0;r<16;++r)o[d_][r]*=wsf[crow(r,hi)]; } }while(0)
  f32x16 pA0,pA1,pB0,pB1;
  int sl_prev=0,sl_cur=0,sl_next=SLOTB;
  #define ROT() do{sl_prev=sl_cur;sl_cur=sl_next;sl_next=(sl_next==(NSLOT-1)*SLOTB)?0:sl_next+SLOTB;}while(0)
  DMA_K(2,2*SLOTB);
  WAIT_BAR(3);
  #define SETNEGM(t) do{ const bool keep_=((t)>=NT-4)||(((selmask>>((t)>>2))&1u)!=0u); const float nm_=keep_?-mhat:NEGINF; _Pragma("unroll") for(int r=0;r<16;++r)negm[r]=nm_; asm volatile("":"+v"(negm)); }while(0)
  SETNEGM(0);
  qkt(pA0,pA1,Kbase,qr,negm,r32,hi);asm volatile("s_nop 15\n\ts_nop 7":"+v"(pA0),"+v"(pA1));CMASK(pA0,pA1,0);
  START(pA0,pA1);
  _Pragma("unroll") for(int r=0;r<16;++r)pA1[r]=__builtin_amdgcn_exp2f(pA1[r]);
  WAIT_BAR(0);
  DMA_K(3,0);DMA_V(1,SLOTB);
  ROT();
  kload8(kf,kp0+sl_cur);
  WAIT_BAR(2);
  s16x4 vlo[8],vhi[8]; u32x4 pw0,pw1,pw2,pw3;
  #define PKW(P,B) cvtpk_s(P[B],P[B+1])
  #define PAF(k) __builtin_bit_cast(bf16x8,pw##k)
  #define VFR(i) (bf16x8){vlo[i][0],vlo[i][1],vlo[i][2],vlo[i][3],vhi[i][0],vhi[i][1],vhi[i][2],vhi[i][3]}
  #define PIN(x) asm volatile("":"+v"(x))
  #define MX3(a,b,c) __builtin_fmaxf(__builtin_fmaxf((a),(b)),(c))
  #define GAPA(MF,A0,A1,A2,A3,W0,W1,PW) do{ MF; sacc+=A0; sacc+=A1; sacc+=A2; sacc+=A3; PIN(sacc); W0; W1; PIN(PW); SBAR(); }while(0)
  #define EX(v) __builtin_amdgcn_exp2f(v)
  #define GAPB(MF,X,B) do{ MF; X[B]=EX(X[B]); X[B+1]=EX(X[B+1]); X[B+2]=EX(X[B+2]); X[B+3]=EX(X[B+3]); PIN(X); SBAR(); }while(0)
  #define VRD(i) do{ vlo[i]=vtr(vp_+(((i)>>2)*4096+((i)&3)*1024)); vhi[i]=vtr(vp_+(((i)>>2)*4096+((i)&3)*1024+512)); }while(0)
  #define KRD(G,j) do{ if(G){ kload2(kf,kp0+sl_next,j); SBAR(); } }while(0)
  #define STEP(C0,C1,P0,P1,t,GK,GV,GL) do{ SBAR(); SETNEGM(t); SBAR(); \
    const lds_cptr vp_=vp0+sl_prev; \
    VRD(0); SBAR(); float sacc=(P0[0]+P0[1]); \
    GAPA(C0=__builtin_amdgcn_mfma_f32_32x32x16_bf16(kf[0],qr[0],negm,0,0,0), P0[2],P0[3],P0[4],P0[5],     pw0[0]=PKW(P0,0), pw0[1]=PKW(P0,2), pw0); \
    VRD(4); SBAR(); GAPA(C1=__builtin_amdgcn_mfma_f32_32x32x16_bf16(kf[1],qr[0],negm,0,0,0), P0[6],P0[7],P0[8],P0[9],     pw0[2]=PKW(P0,4), pw0[3]=PKW(P0,6), pw0); \
    VRD(1); SBAR(); GAPA(C0=__builtin_amdgcn_mfma_f32_32x32x16_bf16(kf[2],qr[1],C0,0,0,0),   P0[10],P0[11],P0[12],P0[13], pw1[0]=PKW(P0,8), pw1[1]=PKW(P0,10), pw1); \
    VRD(5); SBAR(); GAPA(C1=__builtin_amdgcn_mfma_f32_32x32x16_bf16(kf[3],qr[1],C1,0,0,0),   P0[14],P0[15],P1[0],P1[1],   pw1[2]=PKW(P0,12),pw1[3]=PKW(P0,14), pw1); \
    VRD(2); SBAR(); GAPA(C0=__builtin_amdgcn_mfma_f32_32x32x16_bf16(kf[4],qr[2],C0,0,0,0),   P1[2],P1[3],P1[4],P1[5],     pw2[0]=PKW(P1,0), pw2[1]=PKW(P1,2), pw2); \
    VRD(6); SBAR(); GAPA(C1=__builtin_amdgcn_mfma_f32_32x32x16_bf16(kf[5],qr[2],C1,0,0,0),   P1[6],P1[7],P1[8],P1[9],     pw2[2]=PKW(P1,4), pw2[3]=PKW(P1,6), pw2); \
    VRD(3); SBAR(); GAPA(C0=__builtin_amdgcn_mfma_f32_32x32x16_bf16(kf[6],qr[3],C0,0,0,0),   P1[10],P1[11],P1[12],P1[13], pw3[0]=PKW(P1,8), pw3[1]=PKW(P1,10), pw3); \
    VRD(7); SBAR(); GAPA(C1=__builtin_amdgcn_mfma_f32_32x32x16_bf16(kf[7],qr[3],C1,0,0,0),   P1[14],P1[15],0.f,0.f,       pw3[2]=PKW(P1,12),pw3[3]=PKW(P1,14), pw3); \
    l_reg+=sacc; \
    if(GK){DMA_K((t)+3,sl_cur);} if(GV){DMA_V((t)+1,sl_next);} \
    CMASK(C0,C1,t); \
    { float a=MX3(C0[0],C0[1],C1[0]),b=MX3(C0[2],C0[3],C1[1]); a=MX3(a,C1[2],C1[3]); \
      _Pragma("unroll") for(int r=4;r<16;r+=4){a=MX3(a,C0[r],C0[r+1]);b=MX3(b,C0[r+2],C0[r+3]);a=MX3(a,C1[r],C1[r+1]);b=MX3(b,C1[r+2],C1[r+3]);} \
      float rm=__builtin_fmaxf(a,b); { auto rr=__builtin_amdgcn_permlane32_swap(__float_as_uint(rm),__float_as_uint(rm),false,false); rm=__builtin_fmaxf(__uint_as_float(rr[0]),__uint_as_float(rr[1])); } \
      resc=false; \
      if(__builtin_expect(__any(rm>(float)THRL),0)){ const float dl=__builtin_fmaxf(rm,0.f); mhat+=dl; \
        _Pragma("unroll") for(int r=0;r<16;++r){C0[r]-=dl;C1[r]-=dl;} \
        const float f=__builtin_amdgcn_exp2f(-dl); l_reg*=f; if(hi==0)wsf[r32]=f; resc=true; } } \
    SBAR(); \
    GAPB(o[0]=__builtin_amdgcn_mfma_f32_32x32x16_bf16(PAF(0),VFR(0),o[0],0,0,0), C0,0); \
    GAPB(o[1]=__builtin_amdgcn_mfma_f32_32x32x16_bf16(PAF(0),VFR(4),o[1],0,0,0), C0,4); \
    KRD(GL,0); GAPB(o[0]=__builtin_amdgcn_mfma_f32_32x32x16_bf16(PAF(1),VFR(1),o[0],0,0,0), C0,8); \
    KRD(GL,1); GAPB(o[1]=__builtin_amdgcn_mfma_f32_32x32x16_bf16(PAF(1),VFR(5),o[1],0,0,0), C0,12); \
    KRD(GL,2); GAPB(o[0]=__builtin_amdgcn_mfma_f32_32x32x16_bf16(PAF(2),VFR(2),o[0],0,0,0), C1,0); \
    KRD(GL,3); GAPB(o[1]=__builtin_amdgcn_mfma_f32_32x32x16_bf16(PAF(2),VFR(6),o[1],0,0,0), C1,4); \
    GAPB(o[0]=__builtin_amdgcn_mfma_f32_32x32x16_bf16(PAF(3),VFR(3),o[0],0,0,0), C1,8); \
    GAPB(o[1]=__builtin_amdgcn_mfma_f32_32x32x16_bf16(PAF(3),VFR(7),o[1],0,0,0), C1,12); \
    }while(0)
  int t=1;
  #undef CMASK
  #define CMASK(P0,P1,t) do{}while(0)
  for(;t+5<NT;t+=2){
    STEP(pB0,pB1,pA0,pA1,t,true,true,true);     WAIT_BAR(2); RESC(); ROT();
    STEP(pA0,pA1,pB0,pB1,t+1,true,true,true);   WAIT_BAR(2); RESC(); ROT();
  }
  #undef CMASK
  #define CMASK(P0,P1,t) do{int jb_=(t)-(NT-4); if(jb_>=0)cmask(P0,P1,jb_,qrel,hi);}while(0)
  #define ENDW(tt) do{ if((tt)+3<NT){WAIT_BAR(2);} else if((tt)+2<NT){WAIT_BAR(1);} else {WAIT_BAR(0);} }while(0)
  for(;t+1<NT;t+=2){
    STEP(pB0,pB1,pA0,pA1,t,(t+3<NT),(t+1<NT),(t+1<NT));       ENDW(t);   RESC(); ROT();
    STEP(pA0,pA1,pB0,pB1,t+1,(t+4<NT),(t+2<NT),(t+2<NT));     ENDW(t+1); RESC(); ROT();
  }
  STEP(pB0,pB1,pA0,pA1,NT-1,false,false,false); RESC();
  { float sacc=pB0[0]+pB0[1]; _Pragma("unroll") for(int r=2;r<16;++r)sacc+=pB0[r]; _Pragma("unroll") for(int r=0;r<16;++r)sacc+=pB1[r]; l_reg+=sacc;
    pw0=(u32x4){PKW(pB0,0),PKW(pB0,2),PKW(pB0,4),PKW(pB0,6)};pw1=(u32x4){PKW(pB0,8),PKW(pB0,10),PKW(pB0,12),PKW(pB0,14)};pw2=(u32x4){PKW(pB1,0),PKW(pB1,2),PKW(pB1,4),PKW(pB1,6)};pw3=(u32x4){PKW(pB1,8),PKW(pB1,10),PKW(pB1,12),PKW(pB1,14)};
    SBAR(); pv(o,vb0+sl_cur,PAF(0),PAF(1),PAF(2),PAF(3)); }
  #undef PKW
  #undef PAF
  #undef VFR
  #undef PIN
  #undef MX3
  #undef GAPA
  #undef GAPB
  #undef EX
  #undef VRD
  #undef KRD
  #undef STEP
  #undef ENDW
  {auto rr=__builtin_amdgcn_permlane32_swap(__float_as_uint(l_reg),__float_as_uint(l_reg),false,false);l_reg=__uint_as_float(rr[0])+__uint_as_float(rr[1]);}
  if(hi==0)wsf[32+r32]=l_reg;asm volatile("s_waitcnt lgkmcnt(0)":::"memory");
  float rli[16];
  #pragma unroll
  for(int r=0;r<16;++r)rli[r]=__builtin_amdgcn_rcpf(wsf[32+crow(r,hi)]);
  bf16*Ow=O+(rowbase+q0+wid*QBLK)*DM+h*D;
  { bf16*stg=(bf16*)(shm+LDS_OST)+wid*2048;
    #pragma unroll
    for(int r=0;r<16;++r){const int orow=crow(r,hi);
      #pragma unroll
      for(int d0=0;d0<2;++d0)stg[orow*64+d0*32+r32]=__float2bfloat16(o[d0][r]*rli[r]);}
    asm volatile("s_waitcnt lgkmcnt(0)":::"memory");
    #pragma unroll
    for(int i=0;i<4;++i){const int row=i*8+(lane>>3),ch=lane&7; const u32x4 v=*(const u32x4*)(stg+row*64+ch*8); ATTN_STORE16(Ow+(long)row*DM+ch*8,v);} }
  asm volatile("s_waitcnt lgkmcnt(0)\n\ts_barrier":::"memory");
  #undef DMA_K
  #undef DMA_V
  #undef CMASK
  #undef START
  #undef SETNEGM
  #undef RESC
  #undef ROT
}
constexpr int ATTN_LDS_BYTES=LDS_BYTES;
struct AttnTensors { const bf16* Q; const bf16* K; const bf16* V; bf16* O; const unsigned* sel; };
struct AttnUnit { int bh; int qb; };
struct StaticOrder {
  int vcu,grid;
  __device__ __forceinline__ explicit StaticOrder(int grid_,int block):vcu((grid_%8==0)?(block%8)*(grid_/8)+block/8:block),grid(grid_){}
  __device__ __forceinline__ bool next(int i,AttnUnit&u)const{
    if(grid==256){ if(i>=4)return false; const int s=vcu&3; u.bh=vcu>>2; u.qb=(i==0)?s:(i==1)?7-s:(i==2)?8+s:15-s; return true; }
    const int U=i*grid+vcu; if(U>=BATCH*NHEAD*NQB)return false; u.bh=U/NQB; u.qb=U%NQB; return true; }
  __device__ __forceinline__ void a_ready(const AttnUnit&)const{}
  __device__ __forceinline__ void done(const AttnUnit&)const{}
};
template<class Sched,int THRL=8> __device__ __forceinline__ void attn_phase(char*lds,const AttnTensors&T,const Sched&S,int tid_in){
  AttnUnit u;
  for(int i=0;S.next(i,u);++i){ S.a_ready(u); attn_unit<THRL>(u.bh/NHEAD,u.bh%NHEAD,u.qb,T.Q,T.K,T.V,T.O,T.sel,lds,tid_in); S.done(u); }
}
#undef SBAR
#undef WAIT_BAR
}


DEVI void ph_moba_select(const Frame& F, const bf16_t* Q, const float* ksum, unsigned* sel) {
    for (int idx = F.gt; idx < BATCH * NH * SEQ; idx += F.NGT) {
        const int s = idx & (SEQ - 1), bh = idx >> 12, b = bh >> 3, hh = bh & 7, qb = s >> 8;
        const bf16_t* qp = Q + ((size_t)b * SEQ + s) * 512 + hh * 64;
        float q[64];
#pragma unroll
        for (int i = 0; i < 8; ++i) { const bf16x8 t = *((const bf16x8*)qp + i);
#pragma unroll
            for (int j = 0; j < 8; ++j) q[8 * i + j] = bf2f((bf16_t)t[j]); }
        float gsc[15];
#pragma unroll
        for (int j = 0; j < 15; ++j) { gsc[j] = -INFINITY;
            if (j < qb) { const float* km = ksum + ((size_t)bh * 16 + j) * 64; float a = 0.f;
#pragma unroll
                for (int i = 0; i < 64; ++i) a += q[i] * km[i];
                gsc[j] = a; } }
        unsigned m = 0u;
#pragma unroll
        for (int t = 0; t < 3; ++t) { float best = -INFINITY; int bi = -1;
#pragma unroll
            for (int j = 0; j < 15; ++j) { const bool ok = (j < qb) && !((m >> j) & 1u) && (gsc[j] > best); best = ok ? gsc[j] : best; bi = ok ? j : bi; }
            if (bi >= 0) m |= 1u << bi; }
        sel[idx] = m;
    }
}


DEVI void ph_router_weights(const Frame& F, const float* wg, const float* we, bf16_t* wr) {
    for (int idx = F.gt; idx < DEPTH * 48 * 1024; idx += F.NGT) {
        const int l = idx / (48 * 1024), r = idx % (48 * 1024), o = r >> 10, kk = r & 1023;
        const float v = (o < 4) ? wg[((size_t)l * D + kk) * 4 + o] : (o < 36) ? we[((size_t)l * D + kk) * 32 + (o - 4)] : 0.f;
        const bf16_t hi = f2bf(v), lo = f2bf(v - bf2f(hi));
        wr[((size_t)l * 2 + 0) * 48 * 1024 + r] = hi; wr[((size_t)l * 2 + 1) * 48 * 1024 + r] = lo;
    }
}
DEVI void ph_norm_router_mfma(const Frame& F, const bf16_t* x, const float* g, const bf16_t* wr, const float* bg, const float* be, bf16_t* h2, unsigned* cnt, int* list, unsigned* rec) {
    const int lane = F.lane, ri = lane & 15, q = lane >> 4;
    LAS float* lg = (LAS float*)(F.lds + F.wave * 3072);
    volatile LAS unsigned* hist = (volatile LAS unsigned*)(F.lds + 8 * 3072);
    const bf16_t* whi = wr; const bf16_t* wlo = wr + 48 * 1024;
    for (int tile = blockIdx.x; tile < NTOK / 128; tile += F.G) {
        if (F.tid < 64) hist[F.tid] = 0u;
        const int row = tile * 128 + F.wave * 16 + ri;
        const bf16_t* xr = x + (size_t)row * D + 8 * q;
        float ss = 0.f;
#pragma unroll
        for (int kk = 0; kk < 32; ++kk) { const u32x4 xw = *(const u32x4*)(xr + 32 * kk); const f32x4 a = pg8::unpk_lo(xw, 0), b = pg8::unpk_lo(xw, 1);
            ss += (a[0] * a[0] + a[1] * a[1]) + (a[2] * a[2] + a[3] * a[3]) + (b[0] * b[0] + b[1] * b[1]) + (b[2] * b[2] + b[3] * b[3]); }
        ss += xshfl(ss, 16, lane); ss += xshfl(ss, 32, lane);
        const float rstd = 1.0f / sqrtf(ss * (1.0f / D) + NORM_EPS);
        f32x4 acc[3] = {(f32x4){0.f, 0.f, 0.f, 0.f}, (f32x4){0.f, 0.f, 0.f, 0.f}, (f32x4){0.f, 0.f, 0.f, 0.f}};
#pragma unroll 2
        for (int kk = 0; kk < 32; ++kk) {
            const int k0 = 32 * kk + 8 * q;
            const u32x4 xw = *(const u32x4*)(xr + 32 * kk); const f32x4 a = pg8::unpk_lo(xw, 0), b = pg8::unpk_lo(xw, 1);
            const f32x4 ga = *(const f32x4*)(g + k0), gb = *(const f32x4*)(g + k0 + 4);
            const f32x4 ha = a * rstd * ga, hb = b * rstd * gb;
            const u32x4 hi = pg8::pk8(ha, hb);
            const f32x4 ra = ha - pg8::unpk_lo(hi, 0), rb = hb - pg8::unpk_lo(hi, 1);
            const u32x4 lo = pg8::pk8(ra, rb);
            *(u32x4*)(h2 + (size_t)row * D + k0) = hi;
            const bf16x8 ahi = __builtin_bit_cast(bf16x8, hi), alo = __builtin_bit_cast(bf16x8, lo);
#pragma unroll
            for (int t = 0; t < 3; ++t) {
                const bf16x8 bh = *(const bf16x8*)(whi + (size_t)(16 * t + ri) * 1024 + k0), bl = *(const bf16x8*)(wlo + (size_t)(16 * t + ri) * 1024 + k0);
                acc[t] = __builtin_amdgcn_mfma_f32_16x16x32_bf16(ahi, bh, acc[t], 0, 0, 0);
                acc[t] = __builtin_amdgcn_mfma_f32_16x16x32_bf16(alo, bh, acc[t], 0, 0, 0);
                acc[t] = __builtin_amdgcn_mfma_f32_16x16x32_bf16(ahi, bl, acc[t], 0, 0, 0);
            }
        }
#pragma unroll
        for (int t = 0; t < 3; ++t)
#pragma unroll
            for (int e = 0; e < 4; ++e) lg[(4 * q + e) * 48 + 16 * t + ri] = acc[t][e];
        __syncthreads();
        int e0 = 0, e1 = 0; float w0 = 0.f, w1 = 0.f; unsigned r0 = 0u, r1 = 0u;
        if (lane < 16) {
            const LAS float* L = lg + lane * 48;
            float gl[4]; int gt = 0; float gm = -INFINITY;
#pragma unroll
            for (int i = 0; i < 4; ++i) { gl[i] = L[i] + bg[i]; if (gl[i] > gm) { gm = gl[i]; gt = i; } }
            float gs = 0.f;
#pragma unroll
            for (int i = 0; i < 4; ++i) gs += __expf(gl[i] - gm);
            const float pgv = 1.0f / gs;
            float el[8]; float em = -INFINITY;
#pragma unroll
            for (int i = 0; i < 8; ++i) { el[i] = L[4 + gt * 8 + i] + be[gt * 8 + i]; em = fmaxf(em, el[i]); }
            int i1 = 0; float v1 = -INFINITY;
#pragma unroll
            for (int i = 0; i < 8; ++i) if (el[i] > v1) { v1 = el[i]; i1 = i; }
            int i2 = 0; float v2 = -INFINITY;
#pragma unroll
            for (int i = 0; i < 8; ++i) if (i != i1 && el[i] > v2) { v2 = el[i]; i2 = i; }
            const float p1 = __expf(v1 - em), p2 = __expf(v2 - em);
            w0 = pgv * p1 / (p1 + p2); w1 = pgv * p2 / (p1 + p2);
            e0 = gt * 8 + i1; e1 = gt * 8 + i2;
            r0 = __hip_atomic_fetch_add((LAS unsigned*)hist + e0, 1u, __ATOMIC_RELAXED, __HIP_MEMORY_SCOPE_WORKGROUP); r1 = __hip_atomic_fetch_add((LAS unsigned*)hist + e1, 1u, __ATOMIC_RELAXED, __HIP_MEMORY_SCOPE_WORKGROUP);
        }
        __syncthreads();
        if (F.tid < 32) { const unsigned n = hist[F.tid]; hist[32 + F.tid] = n ? atomicAdd(cnt + F.tid, n) : 0u; }
        __syncthreads();
        if (lane < 16) {
            const int tok = tile * 128 + F.wave * 16 + lane;
            const unsigned pos0 = hist[32 + e0] + r0, pos1 = hist[32 + e1] + r1;
            list[(size_t)e0 * LIST_CAP + pos0] = tok; list[(size_t)e1 * LIST_CAP + pos1] = tok;
            unsigned* rp = rec + (size_t)tok * 8;
            rp[0] = (unsigned)e0; rp[1] = (unsigned)e1; rp[2] = pos0; rp[3] = pos1; rp[4] = __float_as_uint(w0); rp[5] = __float_as_uint(w1);
        }
        __syncthreads();
    }
}


DEVI void ph_moba_select_mfma(const Frame& F, const bf16_t* Q, const float* ksum, unsigned* sel) {
    const int lane = F.lane, r = lane & 31, h = lane >> 5;
    for (int item = F.gw; item < BATCH * NH * (SEQ / 32); item += F.NGW) {
        const int qt = item & 127, bh = item >> 7, b = bh >> 3, hh = bh & 7, s0 = qt * 32, qb = s0 >> 8;
        if (qb == 0) { if (h == 0) sel[(size_t)bh * SEQ + s0 + r] = 0u; continue; }
        f32x16 acc = {};
#pragma unroll
        for (int s = 0; s < 4; ++s) {
            const bf16x8 bq = *(const bf16x8*)(Q + ((size_t)b * SEQ + s0 + r) * 512 + hh * 64 + 16 * s + 8 * h);
            f32x4 k0 = (f32x4){0.f, 0.f, 0.f, 0.f}, k1 = k0;
            if (r < 16) { const float* kp = ksum + ((size_t)bh * 16 + r) * 64 + 16 * s + 8 * h; k0 = *(const f32x4*)kp; k1 = *(const f32x4*)(kp + 4); }
            const u32x4 hi = pg8::pk8(k0, k1), lo = pg8::pk8(k0 - pg8::unpk_lo(hi, 0), k1 - pg8::unpk_lo(hi, 1));
            acc = __builtin_amdgcn_mfma_f32_32x32x16_bf16(__builtin_bit_cast(bf16x8, hi), bq, acc, 0, 0, 0);
            acc = __builtin_amdgcn_mfma_f32_32x32x16_bf16(__builtin_bit_cast(bf16x8, lo), bq, acc, 0, 0, 0);
        }
        float sc[16];
#pragma unroll
        for (int reg = 0; reg < 8; ++reg) { const float mine = acc[reg], other = xshfl(acc[reg], 32, lane); const int base = (reg & 3) + 8 * (reg >> 2);
            sc[base] = h ? other : mine; sc[base + 4] = h ? mine : other; }
        unsigned m = 0u;
#pragma unroll
        for (int t = 0; t < 3; ++t) { float best = -INFINITY; int bi = -1;
#pragma unroll
            for (int j = 0; j < 15; ++j) { const bool ok = (j < qb) && !((m >> j) & 1u) && (sc[j] > best); best = ok ? sc[j] : best; bi = ok ? j : bi; }
            if (bi >= 0) m |= 1u << bi; }
        if (h == 0) sel[(size_t)bh * SEQ + s0 + r] = m;
    }
}

constexpr int PH_PER_LAYER = 10, N_PHASES = 1 + DEPTH * PH_PER_LAYER;
__global__ void __launch_bounds__(NTHR, 2) mk_fwd(Args a) {
    extern __shared__ __attribute__((aligned(16))) unsigned char lds_raw[];
    Frame F0;
    F0.lds = (LAS unsigned char*)lds_raw;
    F0.tid = threadIdx.x; F0.lane = F0.tid & 63; F0.wave = __builtin_amdgcn_readfirstlane(F0.tid >> 6);
    F0.G = gridDim.x; F0.gw = blockIdx.x * NWAVES + F0.wave; F0.NGW = F0.G * NWAVES; F0.gt = blockIdx.x * NTHR + F0.tid; F0.NGT = F0.G * NTHR;
    volatile LAS unsigned* LCTL = (volatile LAS unsigned*)(F0.lds + LDSCTL_OFF);
    volatile LAS int* pstart = (volatile LAS int*)(F0.lds + LDSCTL_OFF + 256);
    for (int u = F0.tid; u < 256; u += NTHR) LCTL[u] = 0u;
    __syncthreads();
    unsigned* ctl = (unsigned*)(a.ws + WS_CTL);
    XcdBarrier bar = xcd_barrier_post(ctl + CW_BAR + a.li * XCD_BAR_WORDS, LCTL);

#define x_in (a.in[0])
#define norm1_g (a.in[1])
#define w_in (a.in[2])
#define ssm_d (a.in[10])
#define w_glu (a.in[11])
#define qng (a.in[12])
#define kng (a.in[13])
#define w_attn (a.in[14])
#define w_out (a.in[15])
#define norm2_g (a.in[16])
#define wgrp (a.in[17])
#define bgrp (a.in[18])
#define wexp (a.in[19])
#define bexp (a.in[20])
#define w_gu (a.in[21])
#define w_dn (a.in[22])
#define X (a.out)
#define rope ((float*)(ws + WS_ROPE))
#define AL ((float*)(ws + WS_MISC + MISC_AL))
#define ksum ((float*)(ws + WS_MISC + MISC_KSUM))
#define SEL ((unsigned*)(ws + WS_MISC + MISC_SEL))
#define rec ((unsigned*)(ws + WS_REC))
#define list ((int*)(ws + WS_LIST))
#define TC ((bf16_t*)(ws + WS_S5TC))
#define BS ((bf16_t*)(ws + WS_S5BS))
#define H ((bf16_t*)(ws + WS_H))
#define UCAT ((bf16_t*)(ws + WS_UCAT))
#define Qb ((bf16_t*)(ws + WS_Q))
#define Kb ((bf16_t*)(ws + WS_K))
#define Vb ((bf16_t*)(ws + WS_V))
#define SG ((bf16_t*)(ws + WS_SG))
#define Z ((bf16_t*)(ws + WS_Z))
#define ATT ((bf16_t*)(ws + WS_ATT))
#define MIXA ((bf16_t*)(ws + WS_MIXA))
#define MIXED ((bf16_t*)(ws + WS_MIXED))
#define SL ((float*)(ws + WS_SL))
#define HMID ((bf16_t*)(ws + WS_HMID))
#define YBUF ((bf16_t*)(ws + WS_YBUF))
#define QRAW ((float*)(ws + WS_QRAW))
#define KRAW ((float*)(ws + WS_KRAW))
#define WIN ((bf16_t*)(ws + WS_WIN))
#define WGLU ((bf16_t*)(ws + WS_WGLU))
#define WATT ((bf16_t*)(ws + WS_WATT))
#define WOUT ((bf16_t*)(ws + WS_WOUT))
#define WGU ((bf16_t*)(ws + WS_WGU))
#define WDN ((bf16_t*)(ws + WS_WDN))
#define WR ((bf16_t*)(ws + WS_MISC + MISC_WR))
#define XB ((bf16_t*)(ws + WS_XB))
    const int lo = a.ph_lo, hi = a.ph_hi;
    int ph = 0; unsigned bgen = 0u;
#define PH_BEGIN if (ph >= lo && ph < hi) { for (int rep_ = 0; rep_ < ((((unsigned long long)REP_MASK >> ph) & 1ull) ? 2 : 1); ++rep_) { if (rep_) __syncthreads(); Frame P = F0; unsigned long long wz_ = 0ull; asm volatile("" : "+s"(wz_)); unsigned char* ws = a.ws + wz_;     { int t_ = F0.wave * 64 + (int)__builtin_amdgcn_mbcnt_hi(~0u, __builtin_amdgcn_mbcnt_lo(~0u, 0u)); asm volatile("" : "+v"(t_));     P.tid = t_; P.lane = t_ & 63; P.gt = (int)blockIdx.x * NTHR + t_; P.wave = __builtin_amdgcn_readfirstlane(t_ >> 6); P.gw = (int)blockIdx.x * NWAVES + P.wave; }
#define PH_END   } if (ph + 1 < hi) { ++bgen; xcd_barrier_w(bar, bgen, LCTL + 4, make_cvtq(a, F0.lds, F0.wave, fresh_lane())); } } ++ph;

    const int vcu = (F0.G % 8 == 0) ? ((int)blockIdx.x % 8) * (F0.G / 8) + (int)blockIdx.x / 8 : (int)blockIdx.x;
    LAS unsigned char* ring = F0.lds;
    volatile LAS int* tstart = (volatile LAS int*)(F0.lds + LDSCTL_OFF + 512);
    LAS unsigned* gtab = (LAS unsigned*)(F0.lds + GTAB_OFF);

    PH_BEGIN
        ph_rope_table(P, rope);
        for (int it4 = blockIdx.x; it4 < DEPTH * SSM_G * 4; it4 += P.G) { const int it = it4 >> 2;
            s5_tables_item(it / SSM_G, it % SSM_G, a.in[3], a.in[4], a.in[5], a.in[6], a.in[7], a.in[8], a.in[9],
                           TC + (size_t)it * 512 * 640, BS + (size_t)it * 128 * 512, AL + (size_t)it * 128, (LAS float*)P.lds, P.tid, NTHR, it4 & 3); }
        ph_rmsnorm(P, x_in, norm1_g, H);
        ph_convert_first(P, make_cvtq(a, F0.lds, P.wave, P.lane));
        ph_router_weights(P, wgrp, wexp, WR);
    PH_END

    for (int l = 0; l < DEPTH; ++l) {
#define xin ((l == 0) ? x_in : (const float*)X)
#define cnt ((unsigned*)(ws + WS_CTL) + CW_CNT + l * NEXP)
        PH_BEGIN
            pg8::Gemm g{H, WIN + (size_t)l * D_IN * D, D, D, D, 0, 0}; pg8::StaticOrder S; S.init(NTOK, D_IN, P.G, (int)blockIdx.x);
            pg8::EpiG1 E{UCAT, Qb, Kb, Vb, SG, qng + l * 64, kng + l * 64, rope, QRAW, KRAW};
            pg8::gemm_phase<pg8::EpiG1, pg8::StaticOrder, pg8::NoGather, G1_ALIGN>(ring, g, S, E, pg8::NoGather{}, P.tid);
        PH_END
        PH_BEGIN
            if (P.G == 256) { if (blockIdx.x >= 128) { Frame Q2 = P; Q2.gw = P.gw - 128 * NWAVES; Q2.NGW = 128 * NWAVES; ph_ksum(Q2, Kb, ksum); } } else ph_ksum(P, Kb, ksum);
            { pg8::Gemm g{UCAT, BS + (size_t)l * SSM_G * 128 * 512, UK, 512, 512, (size_t)UROWS * UK, (size_t)128 * 512}; pg8::OrderS5A S{P.G, (int)blockIdx.x};
              pg8::EpiS5Am E{AL + (size_t)l * SSM_G * 128, UCAT};
              pg8::gemm_phase<pg8::EpiS5Am, pg8::OrderS5A, pg8::NoGather, false>(ring, g, S, E, pg8::NoGather{}, P.tid); }
        PH_END
        PH_BEGIN
            ph_moba_select_mfma(P, Qb, ksum, SEL);
            { pg8::Gemm g{UCAT, TC + (size_t)l * SSM_G * 512 * 640, UK, UK, UK, (size_t)UROWS * UK, (size_t)512 * 640}; pg8::OrderS5C S{P.G, (int)blockIdx.x};
              pg8::EpiS5Cm E{UCAT, ssm_d + l * SSM_W, Z};
              pg8::gemm_phase<pg8::EpiS5Cm, pg8::OrderS5C, pg8::NoGather, false>(ring, g, S, E, pg8::NoGather{}, P.tid); }
        PH_END
        PH_BEGIN
            { const attn_body::AttnTensors AT{(const attn_body::bf16*)Qb, (const attn_body::bf16*)Kb, (const attn_body::bf16*)Vb, (attn_body::bf16*)ATT, SEL};
              const attn_body::StaticOrder SA((int)P.G, (int)blockIdx.x);
              attn_body::attn_phase<attn_body::StaticOrder>((char*)lds_raw, AT, SA, P.tid); }
            { pg8::Gemm g{Z, WGLU + (size_t)l * 2048 * 512, 512, 512, 512, 0, 0}; pg8::StaticOrder S; S.init(NTOK, 2048, P.G, (int)blockIdx.x);
              pg8::EpiGlu E{SG, MIXA};
              pg8::gemm_phase<pg8::EpiGlu, pg8::StaticOrder, pg8::NoGather, true>(ring, g, S, E, pg8::NoGather{}, P.tid); }
        PH_END
        PH_BEGIN
            pg8::Gemm g{ATT, WATT + (size_t)l * 1024 * 512, 512, 512, 512, 0, 0}; pg8::StaticOrder S; S.init(NTOK, 1024, P.G, (int)blockIdx.x);
            pg8::EpiMix E{SG, MIXA, MIXED};
            pg8::gemm_phase<pg8::EpiMix, pg8::StaticOrder, pg8::NoGather, true>(ring, g, S, E, pg8::NoGather{}, P.tid);
        PH_END
        PH_BEGIN
            pg8::Gemm g{MIXED, WOUT + (size_t)l * 1024 * 1024, 1024, 1024, 1024, 0, 0}; pg8::StaticOrder S; S.init(NTOK, 1024, P.G, (int)blockIdx.x);
            if (l == 0) { pg8::EpiResBf16<true> E{x_in, XB}; pg8::gemm_phase<pg8::EpiResBf16<true>, pg8::StaticOrder, pg8::NoGather, true>(ring, g, S, E, pg8::NoGather{}, P.tid); }
            else { pg8::EpiResBf16<false> E{nullptr, XB}; pg8::gemm_phase<pg8::EpiResBf16<false>, pg8::StaticOrder, pg8::NoGather, true>(ring, g, S, E, pg8::NoGather{}, P.tid); }
        PH_END
        PH_BEGIN make_cvtq(a, F0.lds, P.wave, P.lane).catchup(l == 0 ? CVQ_LIM_MOE0 : CVQ_TOTAL); __syncthreads(); ph_norm_router_mfma(P, XB, norm2_g + l * D, WR + (size_t)l * 2 * 48 * 1024, bgrp + l * 4, bexp + l * 32, H, cnt, list, rec); PH_END
        PH_BEGIN
            moe_tstart(P, cnt, tstart); moe_gather_table(P, vcu, cnt, list, tstart, gtab);
            pg8::Gemm g{H, WGU + (size_t)l * NEXP * 1024 * 1024, D, 1024, 1024, 0, (size_t)1024 * 1024}; pg8::OrderMoE S{P.G, vcu, tstart};
            pg8::EpiSwiglu E{HMID};
            pg8::gemm_phase<pg8::EpiSwiglu, pg8::OrderMoE, pg8::LdsGather, true>(ring, g, S, E, pg8::LdsGather{gtab}, P.tid);
        PH_END
        PH_BEGIN
            moe_tstart(P, cnt, tstart);
            pg8::Gemm g{HMID, WDN + (size_t)l * NEXP * 1024 * 512, 512, 512, 512, 0, (size_t)1024 * 512}; pg8::OrderMoE S{P.G, vcu, tstart};
            pg8::EpiStoreBf16 E{YBUF, 1024};
            pg8::gemm_phase<pg8::EpiStoreBf16, pg8::OrderMoE, pg8::NoGather, true>(ring, g, S, E, pg8::NoGather{}, P.tid);
        PH_END
        PH_BEGIN
            if (l + 1 < DEPTH) { make_cvtq(a, F0.lds, P.wave, P.lane).catchup(CVQ_LIM_PROJ1); __syncthreads(); }
            compute_pstart(P, cnt, pstart);
            if (l + 1 < DEPTH) ph_combine<false>(P, XB, X, YBUF, rec, pstart, norm1_g + (l + 1) * D, H);
            else ph_combine<true>(P, XB, X, YBUF, rec, pstart, nullptr, H);
        PH_END
    }
#undef PH_BEGIN
#undef PH_END
#undef x_in
#undef norm1_g
#undef w_in
#undef ssm_d
#undef w_glu
#undef qng
#undef kng
#undef w_attn
#undef w_out
#undef norm2_g
#undef wgrp
#undef bgrp
#undef wexp
#undef bexp
#undef w_gu
#undef w_dn
#undef X
#undef rope
#undef AL
#undef ksum
#undef SEL
#undef rec
#undef list
#undef TC
#undef BS
#undef H
#undef UCAT
#undef Qb
#undef Kb
#undef Vb
#undef SG
#undef Z
#undef ATT
#undef MIXA
#undef MIXED
#undef SL
#undef HMID
#undef YBUF
#undef QRAW
#undef KRAW
#undef WIN
#undef WGLU
#undef WATT
#undef WOUT
#undef WGU
#undef WDN
#undef WR
#undef XB
#undef xin
#undef cnt
}

extern "C" void kernel_launch(void* const* d_in, const int* in_sizes, int n_in, void* d_out, int out_size, void* d_ws, size_t ws_size, hipStream_t stream) {
    static int grid = 0;
    if (grid == 0) {
        if (n_in != 23 || ws_size < WS_END || out_size != NTOK * D) { fprintf(stderr, "kernel_launch: unexpected n_in %d / ws_size %zu / out_size %d; nothing launched\n", n_in, ws_size, out_size); grid = -1; return; }
        int dev = 0, cus = 0, per_cu = 0;
        if (hipGetDevice(&dev) != hipSuccess || hipDeviceGetAttribute(&cus, hipDeviceAttributeMultiprocessorCount, dev) != hipSuccess) { grid = -1; return; }
        if (hipFuncSetAttribute((const void*)mk_fwd, hipFuncAttributeMaxDynamicSharedMemorySize, LDS_BYTES) != hipSuccess) { fprintf(stderr, "kernel_launch: hipFuncSetAttribute failed\n"); grid = -1; return; }
        if (hipOccupancyMaxActiveBlocksPerMultiprocessor(&per_cu, (const void*)mk_fwd, NTHR, LDS_BYTES) != hipSuccess || per_cu < 1) { fprintf(stderr, "kernel_launch: occupancy query says %d\n", per_cu); }
        (void)hipGetLastError();
        grid = cus;
    }
    if (grid < 0) return;
    if (hipMemsetAsync((char*)d_ws + WS_CTL, 0, CTL_BYTES, stream) != hipSuccess) return;
    Args a{};
    for (int i = 0; i < 23; ++i) a.in[i] = (const float*)d_in[i];
    a.out = (float*)d_out; a.ws = (unsigned char*)d_ws;
#if MK_PER_PHASE
    for (int p = 0; p < N_PHASES; ++p) { a.ph_lo = p; a.ph_hi = p + 1; a.li = p; hipLaunchKernelGGL(mk_fwd, dim3(grid), dim3(NTHR), LDS_BYTES, stream, a); }
#else
    a.ph_lo = 0; a.ph_hi = N_PHASES; a.li = 0;
    hipLaunchKernelGGL(mk_fwd, dim3(grid), dim3(NTHR), LDS_BYTES, stream, a);
#endif
}
```

```cpp
#include <hip/hip_runtime.h>
#include <hip/hip_bf16.h>
#include <cstdint>
#include <cstdio>
#include <cmath>

#define DEVI __device__ __forceinline__
#define GAS __attribute__((address_space(1)))
#define LAS __attribute__((address_space(3)))
typedef unsigned short bf16_t;
typedef short bf16x8 __attribute__((ext_vector_type(8)));
typedef float f32x4 __attribute__((ext_vector_type(4)));
typedef float f32x16 __attribute__((ext_vector_type(16)));
typedef unsigned u32x4 __attribute__((ext_vector_type(4)));
typedef unsigned u32x2 __attribute__((ext_vector_type(2)));
typedef float cf32 __attribute__((ext_vector_type(2)));

#ifndef OPT_G1
#define OPT_G1 1
#endif
#ifndef G1_RAWQK
#define G1_RAWQK 0
#endif
#ifndef OPT_S5
#define OPT_S5 1
#endif
#ifndef OPT_G3
#define OPT_G3 1
#endif
#ifndef OPT_G4
#define OPT_G4 1
#endif
#ifndef OPT_G5
#define OPT_G5 1
#endif
#ifndef OPT_ATT
#define OPT_ATT 1
#endif
#ifndef REP_MASK
#define REP_MASK 0ull
#endif
#ifndef BAR_TWICE
#define BAR_TWICE 0
#endif
#ifndef G1_ALIGN
#define G1_ALIGN true
#endif
#ifndef OPT_RT
#define OPT_RT 1
#endif
#ifndef OPT_M1
#define OPT_M1 1
#endif
#ifndef OPT_M2
#define OPT_M2 1
#endif
#ifndef MK_PER_PHASE
#define MK_PER_PHASE 0
#endif

constexpr int D = 1024, BATCH = 8, SEQ = 4096, NTOK = BATCH * SEQ, DEPTH = 2;
constexpr int SSM_G = 32, SSM_C = 16, SSM_W = 512, SSM_P = 64;
constexpr int NH = 8, HD = 64, AW = 512, MOBA_B = 256, NBLK = SEQ / MOBA_B;
constexpr int D_IN = 4096;
constexpr int NEXP = 32, DEXP = 512;
constexpr int CHL = 32, NCH = SEQ / CHL, UK = 640, UROWS = BATCH * NCH;
constexpr int SLOT_CAP = 2 * NTOK + NEXP * 256;
constexpr int LIST_CAP = NTOK;
constexpr float NORM_EPS = 1e-6f;
constexpr float QSCALE = 0.125f * 1.4426950408889634f;
constexpr int NWAVES = 8, NTHR = 512;

constexpr size_t MiB = 1u << 20;
constexpr size_t WS_CTL = 0, CTL_BYTES = 1 * MiB;
constexpr size_t WS_ROPE = 1 * MiB;
constexpr size_t WS_MISC = 2 * MiB;
constexpr size_t WS_REC = 4 * MiB;
constexpr size_t WS_LIST = 5 * MiB;
constexpr size_t WS_S5TC = 16 * MiB;
constexpr size_t WS_S5BS = 56 * MiB;
constexpr size_t WS_WIN = 66 * MiB, WS_WGLU = 82 * MiB, WS_WATT = 86 * MiB, WS_WOUT = 88 * MiB, WS_WGU = 92 * MiB, WS_WDN = 220 * MiB;
constexpr size_t WS_H = 284 * MiB;
constexpr size_t WS_UCAT = 348 * MiB;
constexpr size_t WS_Q = 388 * MiB, WS_K = 420 * MiB, WS_V = 452 * MiB;
constexpr size_t WS_SG = 484 * MiB;
constexpr size_t WS_Z = 612 * MiB;
constexpr size_t WS_ATT = 644 * MiB;
constexpr size_t WS_MIXA = 676 * MiB, WS_MIXED = 740 * MiB;
constexpr size_t WS_SL = 804 * MiB;
constexpr size_t WS_XB = 820 * MiB;
constexpr size_t WS_END = 884 * MiB;
constexpr size_t WS_HMID = WS_UCAT;
constexpr size_t WS_YBUF = WS_SG;
constexpr size_t WS_QRAW = WS_MIXA, WS_KRAW = WS_MIXED;
constexpr size_t MISC_AL = 0;
constexpr size_t MISC_KSUM = 64 * 1024;
constexpr size_t MISC_SEL = 512 * 1024;
constexpr size_t MISC_WR = 1536 * 1024;
constexpr int CW_CNT = 64;
constexpr int CW_CVQ = 1024;
constexpr int CW_BAR = 4096;
constexpr int MAX_LAUNCHES = 64;

constexpr int RING_BYTES = 131072;
constexpr int GTAB_OFF = 160 * 1024 - 9 * 1024;
constexpr int LDSCTL_OFF = 160 * 1024 - 1024;
constexpr int SCRATCH_BYTES = GTAB_OFF;
constexpr int LDS_BYTES = 160 * 1024;

DEVI float bf2f(bf16_t v) { return __uint_as_float((unsigned)v << 16); }
DEVI bf16_t f2bf(float f) { unsigned u = __float_as_uint(f); return (bf16_t)((u + 0x7fffu + ((u >> 16) & 1u)) >> 16); }
DEVI unsigned pk2(float lo, float hi) { return (unsigned)f2bf(lo) | ((unsigned)f2bf(hi) << 16); }
DEVI float sigmoidf_(float x) { return 1.f / (1.f + __expf(-x)); }
DEVI float gelu_tanh(float x) { const float u2 = 1.5957691216057308f * (x + 0.044715f * x * x * x); return x * __builtin_amdgcn_rcpf(1.0f + __expf(-u2)); }
DEVI float xshfl(float v, int o, int lane) { return __int_as_float(__builtin_amdgcn_ds_bpermute((lane ^ o) << 2, __float_as_int(v))); }
DEVI float wave_sum(float v, int lane) {
#pragma unroll
    for (int o = 1; o < 64; o <<= 1) v += xshfl(v, o, lane);
    return v;
}
DEVI float wave_max(float v) {
#pragma unroll
    for (int o = 1; o < 64; o <<= 1) v = fmaxf(v, __shfl_xor(v, o));
    return v;
}

#define XB_TMO      128
#define XB_XCNT(j)  (256  + 64 * (j))
#define XB_XSUB(j)  (1280 + 64 * (j))
#define XB_XGEN(j)  (2304 + 64 * (j))
#define XB_TOP      3328
#define XB_TOPGEN   3392
#define XCD_BAR_WORDS 3456
#define XB_SPIN_CAP (1u << 18)
DEVI unsigned xb_ld(unsigned* p)              { return __hip_atomic_load(p, __ATOMIC_RELAXED, __HIP_MEMORY_SCOPE_AGENT); }
DEVI unsigned xb_add(unsigned* p, unsigned v) { return __hip_atomic_fetch_add(p, v, __ATOMIC_RELAXED, __HIP_MEMORY_SCOPE_AGENT); }
DEVI unsigned xb_xcc_id() { return (unsigned)__builtin_amdgcn_s_getreg((3 << 11) | 20) & 0xFu; }
#define XB_SPIN(cond, bar) do { unsigned _sp = 0; while (cond) { __builtin_amdgcn_s_sleep(1); \
    if ((++_sp & 255u) == 0u) { if (xb_ld(&(bar)[XB_TMO])) break; if (_sp > XB_SPIN_CAP) { atomicAdd(&(bar)[XB_TMO], 1u); break; } } } } while (0)
struct XcdBarrier { unsigned* bar; unsigned x; volatile LAS unsigned* st; };
DEVI XcdBarrier xcd_barrier_post(unsigned* bar, volatile LAS unsigned* st) {
    XcdBarrier b; b.bar = bar; b.x = xb_xcc_id(); b.st = st;
    if (threadIdx.x == 0) (void)xb_add(&bar[XB_XCNT(b.x)], 1u);
    return b;
}
DEVI void xcd_barrier_complete(unsigned* bar, unsigned x, unsigned& nloc, unsigned& nx) {
    const unsigned G = gridDim.x * gridDim.y * gridDim.z;
    unsigned sum, cnt, mine, sp = 0u;
    for (;;) {
        sum = 0u; cnt = 0u; mine = 0u;
#pragma unroll
        for (unsigned j = 0; j < 16; ++j) { const unsigned c = xb_ld(&bar[XB_XCNT(j)]); sum += c; cnt += (c > 0u) ? 1u : 0u; mine = (j == x) ? c : mine; }
        if (sum == G) break;
        __builtin_amdgcn_s_sleep(1);
        if ((++sp & 255u) == 0u) { if (xb_ld(&bar[XB_TMO])) break; if (sp > XB_SPIN_CAP) { atomicAdd(&bar[XB_TMO], 1u); break; } }
    }
    nloc = mine > 0u ? mine : 1u; nx = cnt > 0u ? cnt : 1u;
}
DEVI void xcd_barrier(const XcdBarrier& b) {
    asm volatile("s_waitcnt vmcnt(0)" ::: "memory");
    __syncthreads();
    if (threadIdx.x == 0) {
        unsigned* bar = b.bar;
        __builtin_amdgcn_s_waitcnt(0);
        unsigned nloc = b.st[0], nx = b.st[1];
        if (nloc == 0u) { xcd_barrier_complete(bar, b.x, nloc, nx); b.st[0] = nloc; b.st[1] = nx; }
        const unsigned old = xb_add(&bar[XB_XSUB(b.x)], 1u);
        const unsigned gen = old / nloc;
        if (old + 1u == (gen + 1u) * nloc) {
            __builtin_amdgcn_fence(__ATOMIC_RELEASE, "agent");
            asm volatile("s_waitcnt vmcnt(0)" ::: "memory");
            const unsigned og = xb_add(&bar[XB_TOP], 1u);
            const unsigned tg = og / nx;
            if (og + 1u == (tg + 1u) * nx) xb_add(&bar[XB_TOPGEN], 1u);
            else XB_SPIN(xb_ld(&bar[XB_TOPGEN]) == tg, bar);
            __builtin_amdgcn_fence(__ATOMIC_ACQUIRE, "agent");
            xb_add(&bar[XB_XGEN(b.x)], 1u);
            asm volatile("s_waitcnt vmcnt(0)" ::: "memory");
        } else {
            XB_SPIN(xb_ld(&bar[XB_XGEN(b.x)]) == gen, bar);
            __builtin_amdgcn_fence(__ATOMIC_ACQUIRE, "agent");
            asm volatile("s_waitcnt vmcnt(0)" ::: "memory");
        }
    }
    __syncthreads();
}

struct Args { const float* in[23]; float* out; unsigned char* ws; int ph_lo, ph_hi, li, pad; };
struct Frame { int tid, lane, wave, gw, NGW, gt, NGT, G; LAS unsigned char* lds; };

DEVI void ph_rope_table(const Frame& F, float* rope) {
    for (int idx = F.gt; idx < SEQ * 32; idx += F.NGT) {
        const int s = idx >> 5, i = idx & 31;
        const float inv = powf(10000.0f, -(float)(2 * i) / 64.0f);
        const float ang = (float)s * inv;
        float sn, cs; sincosf(ang, &sn, &cs);
        rope[2 * idx] = cs; rope[2 * idx + 1] = sn;
    }
}
DEVI void s5_tables_item(int l, int g, const float* a_re, const float* a_im, const float* log_dt, const float* b_re, const float* b_im,
                         const float* c_re, const float* c_im, bf16_t* TC, bf16_t* BS, float* AL, LAS float* lds, int tid, int nthr, int part) {
    LAS cf32* pw = (LAS cf32*)lds;
    LAS cf32* Cc = pw + 33 * 64;
    LAS cf32* Bb = Cc + 16 * 64;
    LAS cf32* fp = Bb + 64 * 16;
    LAS float* Kt = (LAS float*)(fp + 64);
    const int lg = l * SSM_G + g;
    const float dt = expf(log_dt[lg]);
    for (int i = tid; i < 33 * 64; i += nthr) {
        const int tau = i >> 6, p = i & 63;
        const float lr = a_re[lg * 64 + p], li = a_im[lg * 64 + p];
        const float mag = expf(lr * dt * (float)tau);
        float sn, cs; sincosf(li * dt * (float)tau, &sn, &cs);
        pw[i] = (cf32){mag * cs, mag * sn};
    }
    for (int i = tid; i < 16 * 64; i += nthr) Cc[i] = (cf32){c_re[(size_t)lg * 1024 + i], c_im[(size_t)lg * 1024 + i]};
    __syncthreads();
    for (int p = tid; p < 64; p += nthr) {
        const float lr = a_re[lg * 64 + p], li = a_im[lg * 64 + p];
        const cf32 ab = pw[64 + p];
        const float den = lr * lr + li * li, nre = ab.x - 1.0f;
        fp[p] = (cf32){(nre * lr + ab.y * li) / den, (ab.y * lr - nre * li) / den};
    }
    __syncthreads();
    for (int i = tid; i < 64 * 16; i += nthr) {
        const cf32 f = fp[i >> 4];
        const float br = b_re[(size_t)lg * 1024 + i], bi = b_im[(size_t)lg * 1024 + i];
        Bb[i] = (cf32){f.x * br - f.y * bi, f.x * bi + f.y * br};
    }
    __syncthreads();
    LAS cf32* Xc = (LAS cf32*)(Kt + 8 * 256);
    for (int i = tid; i < 8 * 16 * 64; i += nthr) { const int tl = i >> 10, co = (i >> 6) & 15, p = i & 63;
        const cf32 c = Cc[co * 64 + p], w = pw[(8 * part + tl) * 64 + p];
        Xc[i] = (cf32){c.x * w.x - c.y * w.y, c.x * w.y + c.y * w.x}; }
    __syncthreads();
    for (int i = tid; i < 8 * 256; i += nthr) {
        const int tl = i >> 8, co = (i >> 4) & 15, ci = i & 15;
        float acc = 0.f;
        for (int p = 0; p < 64; ++p) { const cf32 x = Xc[(tl * 16 + co) * 64 + p], b = Bb[p * 16 + ci]; acc += x.x * b.x - x.y * b.y; }
        Kt[i] = acc;
    }
    __syncthreads();
    for (int i = tid; i < 32 * 8 * 16 * 2; i += nthr) {
        const int t = i >> 8, tl = (i >> 5) & 7, co = (i >> 1) & 15, ch = i & 1, tp = t - (8 * part + tl);
        if (tp < 0) continue;
        const LAS float* kp = Kt + (tl * 16 + co) * 16 + 8 * ch;
        u32x4 o; o.x = pk2(kp[0], kp[1]); o.y = pk2(kp[2], kp[3]); o.z = pk2(kp[4], kp[5]); o.w = pk2(kp[6], kp[7]);
        *(u32x4*)(TC + (size_t)(t * 16 + co) * 640 + tp * 16 + 8 * ch) = o;
    }
    for (int i = tid; i < 128 * 64; i += nthr) {
        const int n = part * 128 + (i >> 6), col = 8 * (i & 63), t = n >> 4;
        if (col >= 16 * (t + 1)) *(u32x4*)(TC + (size_t)n * 640 + col) = (u32x4){0u, 0u, 0u, 0u};
    }
    for (int i = part * 128 * 128 + tid; i < (part + 1) * 128 * 128; i += nthr) {
        const int n = i >> 7, kc = i & 127, t = n >> 4, co = n & 15, p = kc & 63;
        const cf32 c = Cc[co * 64 + p], w = pw[(t + 1) * 64 + p];
        const float xr = c.x * w.x - c.y * w.y, xi = c.x * w.y + c.y * w.x;
        TC[(size_t)n * 640 + 512 + kc] = f2bf(kc < 64 ? xr : -xi);
    }
    for (int i = part * 32 * 512 + tid; i < (part + 1) * 32 * 512; i += nthr) {
        const int row = i >> 9, kk = i & 511, p = row & 63, tp = kk >> 4, ci = kk & 15;
        const cf32 w = pw[(31 - tp) * 64 + p], b = Bb[p * 16 + ci];
        BS[i] = f2bf(row < 64 ? (w.x * b.x - w.y * b.y) : (w.x * b.y + w.y * b.x));
    }
    if (part == 0) for (int i = tid; i < 64; i += nthr) { AL[2 * i] = pw[32 * 64 + i].x; AL[2 * i + 1] = pw[32 * 64 + i].y; }
    __syncthreads();
}

DEVI void ph_rmsnorm(const Frame& F, const float* x, const float* g, bf16_t* out) {
    constexpr int R = 4;
    for (int row0 = F.gw; row0 < NTOK; row0 += R * F.NGW) {
        f32x4 v[R][4];
#pragma unroll
        for (int u = 0; u < R; ++u) { const int row = (row0 + u * F.NGW < NTOK) ? row0 + u * F.NGW : row0; const f32x4* xr = (const f32x4*)(x + (size_t)row * D) + F.lane;
#pragma unroll
            for (int j = 0; j < 4; ++j) v[u][j] = xr[64 * j]; }
#pragma unroll
        for (int u = 0; u < R; ++u) { const int row = row0 + u * F.NGW; if (row >= NTOK) continue;
            float s = 0.f;
#pragma unroll
            for (int j = 0; j < 4; ++j) s += (v[u][j].x * v[u][j].x + v[u][j].y * v[u][j].y) + (v[u][j].z * v[u][j].z + v[u][j].w * v[u][j].w);
            const float rstd = 1.0f / sqrtf(wave_sum(s, F.lane) * (1.0f / D) + NORM_EPS);
#pragma unroll
            for (int j = 0; j < 4; ++j) { const f32x4 gg = *((const f32x4*)g + F.lane + 64 * j);
                u32x2 o; o.x = pk2(v[u][j].x * rstd * gg.x, v[u][j].y * rstd * gg.y); o.y = pk2(v[u][j].z * rstd * gg.z, v[u][j].w * rstd * gg.w);
                *((u32x2*)(out + (size_t)row * D) + F.lane + 64 * j) = o; } }
    }
}

template <int BMODE, class RowF, class Epi>
DEVI void sg_phase(const Frame& F, int ny, const RowF& rowf, const void* Bv, size_t bstride, int ldb, int K, int nct, int cstep, int off2, const Epi& epi) {
    const int lane = F.lane, r = lane & 31, h = lane >> 5;
    int base = 0;
    for (int y = 0; y < ny; ++y) {
        const int nrows = rowf.nrows(y), nrt = (nrows + 31) / 32, ntile = nrt * nct;
        const float* Bf = (const float*)Bv + (size_t)y * bstride;
        const bf16_t* Bt = (const bf16_t*)Bv + (size_t)y * bstride;
        int first = (F.gw - base % F.NGW + F.NGW) % F.NGW;
        for (int tile = first; tile < ntile; tile += F.NGW) {
            const int rt = tile / nct, ct = tile % nct, c0 = ct * cstep, c1 = c0 + off2;
            const int arow_i = rt * 32 + r;
            const bf16_t* arow = (arow_i < nrows) ? rowf(y, arow_i) : nullptr;
            f32x16 acc0 = {}, acc1 = {};
            for (int k = 0; k < K; k += 16) {
                bf16x8 a = {};
                if (arow) a = *(const bf16x8*)(arow + k + 8 * h);
                bf16x8 b0, b1;
                if (BMODE == 0) {
#pragma unroll
                    for (int j = 0; j < 8; ++j) { b0[j] = (short)f2bf(Bf[(size_t)(k + 8 * h + j) * ldb + c0 + r]); b1[j] = (short)f2bf(Bf[(size_t)(k + 8 * h + j) * ldb + c1 + r]); }
                } else {
                    b0 = *(const bf16x8*)(Bt + (size_t)(c0 + r) * ldb + k + 8 * h);
                    b1 = *(const bf16x8*)(Bt + (size_t)(c1 + r) * ldb + k + 8 * h);
                }
                acc0 = __builtin_amdgcn_mfma_f32_32x32x16_bf16(a, b0, acc0, 0, 0, 0);
                acc1 = __builtin_amdgcn_mfma_f32_32x32x16_bf16(a, b1, acc1, 0, 0, 0);
            }
#pragma unroll
            for (int reg = 0; reg < 16; ++reg) {
                const int row = rt * 32 + (reg & 3) + 8 * (reg >> 2) + 4 * h;
                if (row < nrows) epi(y, row, c0 + r, c1 + r, acc0[reg], acc1[reg]);
            }
        }
        base += ntile;
    }
}

struct RowPlain { const bf16_t* A; int lda; int n; size_t ystride;
    DEVI int nrows(int) const { return n; }
    DEVI const bf16_t* operator()(int y, int r) const { return A + (size_t)y * ystride + (size_t)r * lda; } };

struct EpiG1sPerm;
struct EpiG1s { bf16_t* ucat; float* qraw; float* kraw; bf16_t* v; bf16_t* sg;
    DEVI void one(int row, int c, float a) const {
        if (c < 512) { const int b = row >> 12, s = row & 4095, g = c >> 4, ci = c & 15;
            ucat[((size_t)g * UROWS + b * NCH + (s >> 5)) * UK + (s & 31) * 16 + ci] = f2bf(a); }
        else if (c < 1024) qraw[(size_t)row * 512 + (c - 512)] = a;
        else if (c < 1536) kraw[(size_t)row * 512 + (c - 1024)] = a;
        else if (c < 2048) v[(size_t)row * 512 + (c - 1536)] = f2bf(a);
        else sg[(size_t)row * 2048 + (c - 2048)] = f2bf(sigmoidf_(a));
    }
    DEVI void operator()(int, int row, int c0, int c1, float a0, float a1) const { one(row, c0, a0); one(row, c1, a1); } };

DEVI int g1_unperm(int cp) { const int pn = cp >> 8, tc = cp & 255; if (pn < 2 || pn >= 6) return cp; const int sec = pn < 4 ? 512 : 1024, hh = (pn & 1) * 4 + ((tc >> 5) & 3); return sec + hh * 64 + 32 * (tc >> 7) + (tc & 31); }
#ifndef G1_FIX_MASK
#define G1_FIX_MASK 0
#endif
DEVI bool g1_sel(int c) { const int sec = c < 512 ? 1 : c < 1024 ? 2 : c < 1536 ? 4 : c < 2048 ? 8 : 16; return (G1_FIX_MASK & sec) != 0; }
struct EpiG1sPerm { EpiG1s e; DEVI void operator()(int, int row, int c0, int c1, float a0, float a1) const { e.one(row, g1_unperm(c0), a0); e.one(row, g1_unperm(c1), a1); } };
struct EpiG1sFix { EpiG1s e; DEVI void operator()(int, int row, int c0, int c1, float a0, float a1) const { const int n0 = g1_unperm(c0), n1 = g1_unperm(c1); if (g1_sel(n0)) e.one(row, n0, a0); if (g1_sel(n1)) e.one(row, n1, a1); } };
DEVI void ph_qkpost(const Frame& F, const float* qraw, const float* kraw, const float* qg, const float* kg, const float* rope, bf16_t* Q, bf16_t* K) {
    for (int idx = F.gt; idx < NTOK * 16; idx += F.NGT) {
        const int which = idx & 1, hh = (idx >> 1) & 7, tok = idx >> 4;
        const float* src = (which ? kraw : qraw) + (size_t)tok * 512 + hh * 64;
        const float* gn = which ? kg : qg;
        float x[64]; float ss = 0.f;
#pragma unroll
        for (int i = 0; i < 16; ++i) { const f32x4 t = *((const f32x4*)src + i); x[4 * i] = t.x; x[4 * i + 1] = t.y; x[4 * i + 2] = t.z; x[4 * i + 3] = t.w; ss += (t.x * t.x + t.y * t.y) + (t.z * t.z + t.w * t.w); }
        const float rstd = 1.0f / sqrtf(ss * (1.0f / 64.0f) + NORM_EPS);
        const int s = tok & (SEQ - 1);
        const float sc = which ? 1.0f : QSCALE;
        bf16_t* dst = (which ? K : Q) + (size_t)tok * 512 + hh * 64;
#pragma unroll
        for (int i = 0; i < 32; ++i) {
            const float x1 = x[i] * rstd * gn[i], x2 = x[i + 32] * rstd * gn[i + 32];
            const float cs = rope[(s * 32 + i) * 2], sn = rope[(s * 32 + i) * 2 + 1];
            dst[i] = f2bf((x1 * cs - x2 * sn) * sc);
            dst[i + 32] = f2bf((x2 * cs + x1 * sn) * sc);
        }
    }
}
DEVI void ph_ksum(const Frame& F, const bf16_t* K, float* ksum) {
    const int lane = F.lane, rg = lane >> 3, c = lane & 7;
    for (int w = F.gw; w < BATCH * NH * NBLK; w += F.NGW) {
        const int blk = w & 15, hh = (w >> 4) & 7, b = w >> 7;
        const bf16_t* kp = K + ((size_t)b * SEQ + blk * 256 + rg) * 512 + hh * 64 + c * 8;
        float acc[8];
#pragma unroll
        for (int j = 0; j < 8; ++j) acc[j] = 0.f;
#pragma unroll 8
        for (int i = 0; i < 32; ++i) { const bf16x8 v = *(const bf16x8*)(kp + (size_t)i * 8 * 512);
#pragma unroll
            for (int j = 0; j < 8; ++j) acc[j] += bf2f((bf16_t)v[j]); }
#pragma unroll
        for (int j = 0; j < 8; ++j) { float t = acc[j]; t += xshfl(t, 8, lane); t += xshfl(t, 16, lane); t += xshfl(t, 32, lane); acc[j] = t; }
        if (rg == 0) { float* o = ksum + (size_t)w * 64 + c * 8; *(f32x4*)o = (f32x4){acc[0], acc[1], acc[2], acc[3]}; *(f32x4*)(o + 4) = (f32x4){acc[4], acc[5], acc[6], acc[7]}; }
    }
}

DEVI void ph_attn_simple(const Frame& F, const bf16_t* Q, const bf16_t* K, const bf16_t* V, const float* ksum, bf16_t* O) {
    const int lane = F.lane;
    for (int w = F.gw; w < BATCH * NH * SEQ; w += F.NGW) {
        const int s = w & (SEQ - 1), hh = (w >> 12) & 7, b = w >> 15;
        const int qb = s >> 8;
        const bf16_t* qp = Q + ((size_t)b * SEQ + s) * 512 + hh * 64;
        float q[64];
#pragma unroll
        for (int i = 0; i < 8; ++i) { const bf16x8 t = *((const bf16x8*)qp + i);
#pragma unroll
            for (int j = 0; j < 8; ++j) q[8 * i + j] = bf2f((bf16_t)t[j]); }
        float gsc = -INFINITY;
        if (lane < qb) { const float* km = ksum + ((size_t)(b * 8 + hh) * 16 + lane) * 64; float a = 0.f;
#pragma unroll
            for (int i = 0; i < 64; ++i) a += q[i] * km[i];
            gsc = a; }
        int blks[4]; int nsel = 0;
#pragma unroll
        for (int t = 0; t < 3; ++t) {
            float best = -INFINITY; int bi = -1;
            for (int j = 0; j < 15; ++j) { const float v = __shfl(gsc, j); const bool used = (t > 0 && j == blks[0]) || (t > 1 && j == blks[1]); if (j < qb && !used && v > best) { best = v; bi = j; } }
            blks[t] = bi; if (bi >= 0) nsel = t + 1;
        }
        blks[3] = qb;
        float sc[4][4]; float m = -INFINITY;
#pragma unroll
        for (int t = 0; t < 4; ++t) {
            const bool on = (t == 3) || (t < nsel);
            const int blk = on ? blks[t] : 0;
#pragma unroll
            for (int i = 0; i < 4; ++i) {
                const int key = blk * 256 + lane + 64 * i;
                float a = -INFINITY;
                if (on && (t < 3 || key <= s)) {
                    const bf16_t* kp = K + ((size_t)b * SEQ + key) * 512 + hh * 64; a = 0.f;
#pragma unroll
                    for (int c = 0; c < 8; ++c) { const bf16x8 kk = *((const bf16x8*)kp + c);
#pragma unroll
                        for (int j = 0; j < 8; ++j) a += q[8 * c + j] * bf2f((bf16_t)kk[j]); }
                }
                sc[t][i] = a; m = fmaxf(m, a);
            }
        }
        m = wave_max(m);
        float l = 0.f;
#pragma unroll
        for (int t = 0; t < 4; ++t)
#pragma unroll
            for (int i = 0; i < 4; ++i) { const float p = exp2f(sc[t][i] - m); sc[t][i] = p; l += p; }
        l = wave_sum(l, lane);
        float o = 0.f;
#pragma unroll
        for (int t = 0; t < 4; ++t) {
            const bool on = (t == 3) || (t < nsel);
            if (!on) continue;
            const int blk = blks[t];
#pragma unroll
            for (int i = 0; i < 4; ++i) {
                const float pv = sc[t][i];
                for (int j = 0; j < 64; ++j) {
                    const float p = __shfl(pv, j);
                    const int key = blk * 256 + j + 64 * i;
                    if (p != 0.f) o += p * bf2f(V[((size_t)b * SEQ + key) * 512 + hh * 64 + lane]);
                }
            }
        }
        O[((size_t)b * SEQ + s) * 512 + hh * 64 + lane] = f2bf(o / l);
    }
}

struct EpiS5A { float* sl; DEVI void operator()(int y, int row, int c0, int c1, float a0, float a1) const { float* p = sl + ((size_t)y * UROWS + row) * 128; p[c0] = a0; p[c1] = a1; } };
DEVI void ph_s5_scan(const Frame& F, const float* sl, const float* AL, bf16_t* ucat) {
    for (int idx = F.gt; idx < SSM_G * BATCH * 64; idx += F.NGT) {
        const int p = idx & 63, b = (idx >> 6) & 7, g = idx >> 9;
        const float ar = AL[(g * 64 + p) * 2], ai = AL[(g * 64 + p) * 2 + 1];
        float hr = 0.f, hi = 0.f;
        for (int c = 0; c < NCH; ++c) {
            const size_t row = (size_t)g * UROWS + b * NCH + c;
            ucat[row * UK + 512 + p] = f2bf(hr); ucat[row * UK + 576 + p] = f2bf(hi);
            const float sr = sl[row * 128 + p], si = sl[row * 128 + 64 + p];
            const float nr = ar * hr - ai * hi + sr, ni = ar * hi + ai * hr + si; hr = nr; hi = ni;
        }
    }
}
struct EpiS5C { const bf16_t* ucat; const float* dskip; bf16_t* z;
    DEVI void one(int g, int row, int n, float a) const {
        const int t = n >> 4, co = n & 15, b = row >> 7, c = row & 127;
        const float u = bf2f(ucat[((size_t)g * UROWS + row) * UK + n]);
        const float y = a + dskip[g * 16 + co] * u;
        z[((size_t)b * SEQ + c * CHL + t) * 512 + g * 16 + co] = f2bf(gelu_tanh(y));
    }
    DEVI void operator()(int y, int row, int c0, int c1, float a0, float a1) const { one(y, row, c0, a0); one(y, row, c1, a1); } };

struct EpiG3s { const bf16_t* sg; bf16_t* mixa;
    DEVI void operator()(int, int row, int c0, int c1, float val, float gate) const { mixa[(size_t)row * 1024 + c0] = f2bf(bf2f(sg[(size_t)row * 2048 + c0]) * val * sigmoidf_(gate)); } };
struct EpiG4s { const bf16_t* sg; const bf16_t* mixa; bf16_t* mixed;
    DEVI void one(int row, int c, float a) const { mixed[(size_t)row * 1024 + c] = f2bf(bf2f(mixa[(size_t)row * 1024 + c]) + bf2f(sg[(size_t)row * 2048 + 1024 + c]) * a); }
    DEVI void operator()(int, int row, int c0, int c1, float a0, float a1) const { one(row, c0, a0); one(row, c1, a1); } };
struct EpiG5s { const float* xin; float* xout;
    DEVI void operator()(int, int row, int c0, int c1, float a0, float a1) const { xout[(size_t)row * 1024 + c0] = xin[(size_t)row * 1024 + c0] + a0; xout[(size_t)row * 1024 + c1] = xin[(size_t)row * 1024 + c1] + a1; } };

DEVI void ph_norm_router(const Frame& F, const float* x, const float* g, const float* wg, const float* bg, const float* we, const float* be,
                         bf16_t* h2, unsigned* cnt, int* list, unsigned* rec) {
    const int lane = F.lane;
    for (int row = F.gw; row < NTOK; row += F.NGW) {
        const f32x4* xr = (const f32x4*)(x + (size_t)row * D) + lane;
        f32x4 v[4]; float s = 0.f;
#pragma unroll
        for (int j = 0; j < 4; ++j) { v[j] = xr[64 * j]; s += (v[j].x * v[j].x + v[j].y * v[j].y) + (v[j].z * v[j].z + v[j].w * v[j].w); }
        const float rstd = 1.0f / sqrtf(wave_sum(s, lane) * (1.0f / D) + NORM_EPS);
        float acc[36];
#pragma unroll
        for (int o = 0; o < 36; ++o) acc[o] = 0.f;
#pragma unroll
        for (int j = 0; j < 4; ++j) {
            const f32x4 gg = *((const f32x4*)g + lane + 64 * j);
            const float hv[4] = {v[j].x * rstd * gg.x, v[j].y * rstd * gg.y, v[j].z * rstd * gg.z, v[j].w * rstd * gg.w};
            u32x2 o; o.x = pk2(hv[0], hv[1]); o.y = pk2(hv[2], hv[3]);
            *((u32x2*)(h2 + (size_t)row * D) + lane + 64 * j) = o;
#pragma unroll
            for (int e = 0; e < 4; ++e) {
                const int k = 4 * lane + 256 * j + e;
                const f32x4 w4 = *(const f32x4*)(wg + (size_t)k * 4);
                acc[0] += hv[e] * w4.x; acc[1] += hv[e] * w4.y; acc[2] += hv[e] * w4.z; acc[3] += hv[e] * w4.w;
#pragma unroll
                for (int q = 0; q < 8; ++q) { const f32x4 w = *(const f32x4*)(we + (size_t)k * 32 + 4 * q);
                    acc[4 + 4 * q] += hv[e] * w.x; acc[5 + 4 * q] += hv[e] * w.y; acc[6 + 4 * q] += hv[e] * w.z; acc[7 + 4 * q] += hv[e] * w.w; }
            }
        }
#pragma unroll
        for (int o = 0; o < 36; ++o) acc[o] = wave_sum(acc[o], lane);
        if (lane == 0) {
            float gl[4]; int gt = 0; float gm = -INFINITY;
#pragma unroll
            for (int i = 0; i < 4; ++i) { gl[i] = acc[i] + bg[i]; if (gl[i] > gm) { gm = gl[i]; gt = i; } }
            float gs = 0.f;
#pragma unroll
            for (int i = 0; i < 4; ++i) gs += __expf(gl[i] - gm);
            const float pg = 1.0f / gs;
            float el[8]; float em = -INFINITY;
#pragma unroll
            for (int i = 0; i < 8; ++i) { float t = 0.f;
#pragma unroll
                for (int gq = 0; gq < 4; ++gq) t = (gq == gt) ? acc[4 + gq * 8 + i] + be[gq * 8 + i] : t;
                el[i] = t; em = fmaxf(em, t); }
            int i1 = 0; float v1 = -INFINITY;
#pragma unroll
            for (int i = 0; i < 8; ++i) if (el[i] > v1) { v1 = el[i]; i1 = i; }
            int i2 = 0; float v2 = -INFINITY;
#pragma unroll
            for (int i = 0; i < 8; ++i) if (i != i1 && el[i] > v2) { v2 = el[i]; i2 = i; }
            const float p1 = __expf(v1 - em), p2 = __expf(v2 - em);
            const float w0 = pg * p1 / (p1 + p2), w1 = pg * p2 / (p1 + p2);
            const int e0 = gt * 8 + i1, e1 = gt * 8 + i2;
            const unsigned pos0 = atomicAdd(cnt + e0, 1u), pos1 = atomicAdd(cnt + e1, 1u);
            list[(size_t)e0 * LIST_CAP + pos0] = row; list[(size_t)e1 * LIST_CAP + pos1] = row;
            unsigned* rp = rec + (size_t)row * 8;
            rp[0] = (unsigned)e0; rp[1] = (unsigned)e1; rp[2] = pos0; rp[3] = pos1; rp[4] = __float_as_uint(w0); rp[5] = __float_as_uint(w1);
        }
    }
}
DEVI void expert_prefix(const Frame& F, const unsigned* cnt, volatile LAS int* out, int mul) {
    if (F.wave == 0) { const int lane = F.lane;
        int c = (lane < NEXP) ? (int)((__hip_atomic_load(cnt + (lane & 31), __ATOMIC_RELAXED, __HIP_MEMORY_SCOPE_AGENT) + 255u) / 256u) : 0;
        int s = c;
#pragma unroll
        for (int d = 1; d < 32; d <<= 1) { const int t = __builtin_amdgcn_ds_bpermute(((lane - d) & 63) << 2, s); if (lane >= d) s += t; }
        if (lane < NEXP) out[lane] = (s - c) * mul;
        if (lane == NEXP - 1) out[NEXP] = s * mul; }
    __syncthreads();
}
DEVI void compute_pstart(const Frame& F, const unsigned* cnt, volatile LAS int* pstart) { expert_prefix(F, cnt, pstart, 256); }
struct RowM1 { const bf16_t* h2; const int* list; const unsigned* cnt;
    DEVI int nrows(int y) const { return (int)cnt[y]; }
    DEVI const bf16_t* operator()(int y, int r) const { return h2 + (size_t)list[(size_t)y * LIST_CAP + r] * D; } };
struct EpiM1s { bf16_t* hmid; volatile LAS int* pstart;
    DEVI void operator()(int y, int row, int c0, int c1, float gt, float up) const { hmid[((size_t)pstart[y] + row) * 512 + c0] = f2bf(gt * sigmoidf_(gt) * up); } };
struct RowM2 { const bf16_t* hmid; volatile LAS int* pstart; const unsigned* cnt;
    DEVI int nrows(int y) const { return (int)cnt[y]; }
    DEVI const bf16_t* operator()(int y, int r) const { return hmid + ((size_t)pstart[y] + r) * 512; } };
struct EpiM2s { bf16_t* ybuf; volatile LAS int* pstart;
    DEVI void operator()(int y, int row, int c0, int c1, float a0, float a1) const { bf16_t* p = ybuf + ((size_t)pstart[y] + row) * 1024; p[c0] = f2bf(a0); p[c1] = f2bf(a1); } };
template <bool LAST>
DEVI void ph_combine(const Frame& F, bf16_t* xb, float* out, const bf16_t* ybuf, const unsigned* rec, volatile LAS int* pstart, const float* gnext, bf16_t* hout) {
    const int lane = F.lane;
    u32x4 ra[2]; u32x2 rb[2];
#pragma unroll
    for (int u = 0; u < 2; ++u) { const int rr = (F.gw + u * F.NGW < NTOK) ? F.gw + u * F.NGW : 0; ra[u] = *(const u32x4*)(rec + (size_t)rr * 8); rb[u] = *(const u32x2*)(rec + (size_t)rr * 8 + 4); }
    for (int row0 = F.gw; row0 < NTOK; row0 += 2 * F.NGW) {
        int rw[2]; const bf16_t* y0[2]; const bf16_t* y1[2]; float w0[2], w1[2]; bool on[2];
#pragma unroll
        for (int u = 0; u < 2; ++u) { rw[u] = row0 + u * F.NGW; on[u] = rw[u] < NTOK;
            y0[u] = ybuf + ((size_t)pstart[(int)ra[u].x] + ra[u].z) * 1024; y1[u] = ybuf + ((size_t)pstart[(int)ra[u].y] + ra[u].w) * 1024;
            w0[u] = __uint_as_float(rb[u].x); w1[u] = __uint_as_float(rb[u].y); }
        u32x2 xw[2][4], ya[2][4], yb[2][4];
#pragma unroll
        for (int u = 0; u < 2; ++u)
#pragma unroll
            for (int j = 0; j < 4; ++j) { const int rr = on[u] ? rw[u] : row0;
                xw[u][j] = *((const u32x2*)(xb + (size_t)rr * D) + lane + 64 * j); ya[u][j] = *((const u32x2*)y0[u] + lane + 64 * j); yb[u][j] = *((const u32x2*)y1[u] + lane + 64 * j); }
#pragma unroll
        for (int u = 0; u < 2; ++u) { const int nr = row0 + (2 + u) * F.NGW, rr = nr < NTOK ? nr : 0; ra[u] = *(const u32x4*)(rec + (size_t)rr * 8); rb[u] = *(const u32x2*)(rec + (size_t)rr * 8 + 4); }
#pragma unroll
        for (int u = 0; u < 2; ++u) {
            if (!on[u]) continue;
            const int row = rw[u];
            f32x4 v[4]; float s = 0.f;
#pragma unroll
            for (int j = 0; j < 4; ++j) {
                const u32x2 x = xw[u][j], a = ya[u][j], b = yb[u][j];
                v[j].x = __uint_as_float(x.x << 16) + w0[u] * __uint_as_float(a.x << 16) + w1[u] * __uint_as_float(b.x << 16);
                v[j].y = __uint_as_float(x.x & 0xffff0000u) + w0[u] * __uint_as_float(a.x & 0xffff0000u) + w1[u] * __uint_as_float(b.x & 0xffff0000u);
                v[j].z = __uint_as_float(x.y << 16) + w0[u] * __uint_as_float(a.y << 16) + w1[u] * __uint_as_float(b.y << 16);
                v[j].w = __uint_as_float(x.y & 0xffff0000u) + w0[u] * __uint_as_float(a.y & 0xffff0000u) + w1[u] * __uint_as_float(b.y & 0xffff0000u);
                if (LAST) *((f32x4*)(out + (size_t)row * D) + lane + 64 * j) = v[j];
                else { u32x2 o; o.x = pk2(v[j].x, v[j].y); o.y = pk2(v[j].z, v[j].w); *((u32x2*)(xb + (size_t)row * D) + lane + 64 * j) = o; }
                s += (v[j].x * v[j].x + v[j].y * v[j].y) + (v[j].z * v[j].z + v[j].w * v[j].w);
            }
            if (!LAST) {
                const float rstd = 1.0f / sqrtf(wave_sum(s, lane) * (1.0f / D) + NORM_EPS);
#pragma unroll
                for (int j = 0; j < 4; ++j) { const f32x4 gg = *((const f32x4*)gnext + lane + 64 * j);
                    u32x2 o; o.x = pk2(v[j].x * rstd * gg.x, v[j].y * rstd * gg.y); o.y = pk2(v[j].z * rstd * gg.z, v[j].w * rstd * gg.w);
                    *((u32x2*)(hout + (size_t)row * D) + lane + 64 * j) = o; }
            }
        }
    }
}

namespace pg8 {
constexpr int BM = 256, BK = 64, HALF = 128, HTB = HALF * BK * 2  , STAGE_BYTES = 8 * HTB;
__host__ __device__ __forceinline__ int lds_byte(int r, int c) { const int st = (r >> 4) * 2 + (c >> 5), rr = r & 15, cc = c & 31, ob = rr * 64 + cc * 2; return st * 1024 + (ob ^ (((ob >> 9) & 1) << 5)); }
__host__ __device__ __forceinline__ void stage_rc(int b, int& R, int& C) { const int st = b / 1024, sb = b % 1024, swz = sb ^ (((sb >> 9) & 1) << 5); R = (st >> 1) * 16 + swz / 64; C = (st & 1) * 32 + (swz % 64) / 2; }
__host__ __device__ __forceinline__ int perm32(int rho) { const int n = rho >> 4, i = rho & 15; return 8 * (i >> 2) + 4 * n + (i & 3); }

struct Unit { int pm, pn, g, ui; };
struct Gemm { const bf16_t* A; const bf16_t* Bt; int lda, ldb, K; size_t ags, bgs;
    DEVI const char* abase(const Unit& u) const { return (const char*)(A + (size_t)u.g * ags + (size_t)u.pm * BM * lda); }
    DEVI const char* bbase(const Unit& u) const { return (const char*)(Bt + (size_t)u.g * bgs + (size_t)u.pn * BM * ldb); } };
struct NoGather { static constexpr bool ON = false; DEVI unsigned rowoff(const Unit&, int) const { return 0u; } };
struct LdsGather { static constexpr bool ON = true; const LAS unsigned* tab;
    DEVI unsigned rowoff(const Unit& u, int r) const { return tab[u.ui * 256 + r]; } };

typedef float f32x2_t __attribute__((ext_vector_type(2))); typedef __bf16 bf16x2_t __attribute__((ext_vector_type(2)));
DEVI unsigned cvt_pk_bf16(float lo, float hi) { const f32x2_t v = {lo, hi}; const bf16x2_t b = __builtin_convertvector(v, bf16x2_t); return __builtin_bit_cast(unsigned, b); }

template <class Epi, class Sched, class GA, bool ALIGN_EPI>
DEVI void gemm_phase(LAS unsigned char* lds, const Gemm g, const Sched& S, const Epi& E, const GA& ga, int tid_in) {
    const int tid = tid_in, wid = __builtin_amdgcn_readfirstlane(tid >> 6), lane = tid & 63, wr = wid >> 2, wc = wid & 3, fr = lane & 15, fq = lane >> 4;
    const int K = g.K, nt = K / BK;
    unsigned voffA[2], voffB[2]; int RA[2]; unsigned CA[2];
#pragma unroll
    for (int i = 0; i < 2; ++i) { int R, C; stage_rc(tid * 16 + i * 8192, R, C); const int Rb = Epi::PERM ? ((R & ~31) + perm32(R & 31)) : R;
        voffA[i] = (unsigned)(R * g.lda + C) * 2u; voffB[i] = (unsigned)(Rb * g.ldb + C) * 2u; RA[i] = R; CA[i] = (unsigned)C * 2u; }
    const size_t kstep = (size_t)(BK * 2);
    const size_t hstepA = GA::ON ? (size_t)0 : (size_t)HALF * g.lda * 2, hstepB = (size_t)HALF * g.ldb * 2;
    const unsigned ldsw = (unsigned)wid * 1024u;
    const int aoff = lds_byte(wr * 64 + fr, fq * 8), boff = lds_byte(wc * 32 + fr, fq * 8);
#define PG8_SA(b, h) (((b) * 2 + (h)) * HTB)
#define PG8_SB(b, h) ((4 + (b) * 2 + (h)) * HTB)
#define PG8_STAGE2(bufoff, gbase, v0, v1) do { \
        __builtin_amdgcn_global_load_lds((const unsigned*)((const char*)(gbase) + (v0)), (LAS unsigned*)(lds + (bufoff) + ldsw), 16, 0, 0); \
        __builtin_amdgcn_global_load_lds((const unsigned*)((const char*)(gbase) + (v1)), (LAS unsigned*)(lds + (bufoff) + ldsw + 8192), 16, 0, 0); } while (0)
#define PG8_STAGE_B(b, h, bptr) PG8_STAGE2(PG8_SB(b, h), (bptr) + (h) * hstepB, voffB[0], voffB[1])
#define PG8_STAGE_A(b, h, aptr, NX) do { if constexpr (GA::ON) { const unsigned _o0 = (NX) ? vgn[h][0] : vgc[h][0], _o1 = (NX) ? vgn[h][1] : vgc[h][1]; PG8_STAGE2(PG8_SA(b, h), (aptr), _o0, _o1); } \
        else { PG8_STAGE2(PG8_SA(b, h), (aptr) + (h) * hstepA, voffA[0], voffA[1]); } } while (0)
#define PG8_LDA(dst, b, h) do { _Pragma("unroll") for (int m = 0; m < 4; ++m) _Pragma("unroll") for (int k = 0; k < 2; ++k) dst[m][k] = *(const LAS bf16x8*)(lds + PG8_SA(b, h) + aoff + m * 2048 + k * 1024); } while (0)
#define PG8_LDB(dst, b, h) do { _Pragma("unroll") for (int n = 0; n < 2; ++n) _Pragma("unroll") for (int k = 0; k < 2; ++k) dst[n][k] = *(const LAS bf16x8*)(lds + PG8_SB(b, h) + boff + n * 2048 + k * 1024); } while (0)
#define PG8_MMA(ai, bj, At, Bt) do { __builtin_amdgcn_s_setprio(1); _Pragma("unroll") for (int m = 0; m < 4; ++m) _Pragma("unroll") for (int n = 0; n < 2; ++n) _Pragma("unroll") for (int k = 0; k < 2; ++k) \
        acc[ai][bj][m][n] = __builtin_amdgcn_mfma_f32_16x16x32_bf16(Bt[n][k], At[m][k], acc[ai][bj][m][n], 0, 0, 0); __builtin_amdgcn_s_setprio(0); } while (0)
#define PG8_WAIT_V(n) asm volatile("s_waitcnt vmcnt(" #n ")" ::: "memory")
#define PG8_WAIT_L(n) asm volatile("s_waitcnt lgkmcnt(" #n ")" ::: "memory")
#define PG8_BAR __builtin_amdgcn_s_barrier()
#define PG8_SCHED __builtin_amdgcn_sched_barrier(0)
    Unit cur, nxt; int ui = 0;
    if (!S.next(0, cur)) return;
    f32x4 acc[2][2][4][2];
#pragma unroll
    for (int a = 0; a < 2; ++a)
#pragma unroll
        for (int b = 0; b < 2; ++b)
#pragma unroll
            for (int m = 0; m < 4; ++m)
#pragma unroll
                for (int n = 0; n < 2; ++n) acc[a][b][m][n] = (f32x4){0.f, 0.f, 0.f, 0.f};
    bf16x8 At[4][2], B0[2][2], B1[2][2];
    unsigned vgc[2][2] = {{0u, 0u}, {0u, 0u}}, vgn[2][2] = {{0u, 0u}, {0u, 0u}};
    if constexpr (GA::ON) {
#pragma unroll
        for (int h = 0; h < 2; ++h)
#pragma unroll
            for (int i = 0; i < 2; ++i) vgc[h][i] = ga.rowoff(cur, h * HALF + RA[i]) + CA[i];
    }
    const char* cA = GA::ON ? (const char*)g.A : g.abase(cur); const char* cB = g.bbase(cur);
    S.a_ready(cur);
    PG8_STAGE_B(0, 0, cB); PG8_STAGE_B(0, 1, cB); PG8_STAGE_A(0, 0, cA, false); PG8_STAGE_A(0, 1, cA, false);
    if (wr == 1) PG8_BAR;
    PG8_WAIT_V(2); PG8_BAR;
    PG8_STAGE_B(1, 0, cB + kstep); PG8_STAGE_A(1, 0, cA + kstep, false); PG8_STAGE_B(1, 1, cB + kstep);
    PG8_WAIT_V(6); PG8_BAR;
    for (;;) {
        const bool has_next = S.next(ui + 1, nxt);
        const char* nA = has_next ? (GA::ON ? (const char*)g.A : g.abase(nxt)) : cA; const char* nB = has_next ? g.bbase(nxt) : cB;
        if constexpr (GA::ON) {
#pragma unroll
            for (int h = 0; h < 2; ++h)
#pragma unroll
                for (int i = 0; i < 2; ++i) vgn[h][i] = has_next ? ga.rowoff(nxt, h * HALF + RA[i]) + CA[i] : vgc[h][i];
            asm volatile("" : "+v"(vgn[0][0]), "+v"(vgn[0][1]), "+v"(vgn[1][0]), "+v"(vgn[1][1]));
        }
        for (int t = 0; t < nt; t += 2) {
            const bool last = (t == nt - 2);
            const char* a1 = cA + (size_t)(t + 1) * kstep;
            const char* a2 = last ? nA : cA + (size_t)(t + 2) * kstep; const char* b2 = last ? nB : cB + (size_t)(t + 2) * kstep;
            const char* a3 = a2 + kstep; const char* b3 = b2 + kstep;
            if (last && has_next) S.a_ready(nxt);
            PG8_LDB(B0, 0, 0); PG8_LDB(B1, 0, 1); PG8_SCHED; PG8_LDA(At, 0, 0); PG8_STAGE_A(1, 1, a1, false);
            PG8_WAIT_V(8); PG8_WAIT_L(0); PG8_BAR; PG8_MMA(0, 0, At, B0); PG8_MMA(0, 1, At, B1); PG8_BAR; PG8_SCHED;
            PG8_LDA(At, 0, 1); PG8_STAGE_B(0, 0, b2); PG8_STAGE_B(0, 1, b2); PG8_STAGE_A(0, 0, a2, last);
            PG8_WAIT_V(8); PG8_WAIT_L(0); PG8_BAR; PG8_MMA(1, 0, At, B0); PG8_MMA(1, 1, At, B1); PG8_BAR; PG8_SCHED;
            PG8_LDB(B0, 1, 0); PG8_LDB(B1, 1, 1); PG8_SCHED; PG8_LDA(At, 1, 0); PG8_STAGE_A(0, 1, a2, last);
            PG8_WAIT_V(8); PG8_WAIT_L(0); PG8_BAR; PG8_MMA(0, 0, At, B0); PG8_MMA(0, 1, At, B1); PG8_BAR; PG8_SCHED;
            PG8_LDA(At, 1, 1); PG8_STAGE_B(1, 0, b3); PG8_STAGE_B(1, 1, b3); PG8_STAGE_A(1, 0, a3, last);
            PG8_WAIT_V(8); PG8_WAIT_L(0); PG8_BAR; PG8_MMA(1, 0, At, B0); PG8_MMA(1, 1, At, B1); PG8_BAR; PG8_SCHED;
        }
        if constexpr (ALIGN_EPI) { if (wr == 0) PG8_BAR; }
        if constexpr (!Epi::AFTER_DRAIN) { E(acc, cur, wr, wc, fr, fq); S.done(cur); }
        if (!has_next) break;
#pragma unroll
        for (int a = 0; a < 2; ++a)
#pragma unroll
            for (int b = 0; b < 2; ++b)
#pragma unroll
                for (int m = 0; m < 4; ++m)
#pragma unroll
                    for (int n = 0; n < 2; ++n) acc[a][b][m][n] = (f32x4){0.f, 0.f, 0.f, 0.f};
        cur = nxt; cA = nA; cB = nB; ++ui;
        if constexpr (GA::ON) {
#pragma unroll
            for (int h = 0; h < 2; ++h)
#pragma unroll
                for (int i = 0; i < 2; ++i) vgc[h][i] = vgn[h][i];
        }
        if constexpr (ALIGN_EPI) { if (wr == 1) PG8_BAR; }
    }
    PG8_WAIT_V(0);
    if constexpr (!ALIGN_EPI) { if (wr == 0) PG8_BAR; }
    PG8_BAR;
    if constexpr (Epi::AFTER_DRAIN) { E.fused(acc, cur, wr, wc, fr, fq, lds, wid, lane); S.done(cur); }
#undef PG8_SA
#undef PG8_SB
#undef PG8_STAGE2
#undef PG8_STAGE_A
#undef PG8_STAGE_B
#undef PG8_LDA
#undef PG8_LDB
#undef PG8_MMA
#undef PG8_WAIT_V
#undef PG8_WAIT_L
#undef PG8_BAR
#undef PG8_SCHED
}
}

namespace pg8 {
DEVI float fsig(float x) { return __builtin_amdgcn_rcpf(1.0f + __expf(-x)); }
DEVI f32x4 unpk_lo(u32x4 w, int half) {
    const unsigned a = half ? w.z : w.x, b = half ? w.w : w.y;
    return (f32x4){__uint_as_float(a << 16), __uint_as_float(a & 0xffff0000u), __uint_as_float(b << 16), __uint_as_float(b & 0xffff0000u)}; }
DEVI u32x4 pk8(f32x4 v0, f32x4 v1) { u32x4 w; w.x = cvt_pk_bf16(v0[0], v0[1]); w.y = cvt_pk_bf16(v0[2], v0[3]); w.z = cvt_pk_bf16(v1[0], v1[1]); w.w = cvt_pk_bf16(v1[2], v1[3]); return w; }

struct StaticOrder {
    int nM, nN, nwg, G, c;
    DEVI void init(int M, int N, int G_, int c_) { nM = M / BM; nN = N / BM; nwg = nM * nN; G = G_; c = c_; }
    DEVI bool next(int i, Unit& u) const {
        const long L = (long)i * G + c; if (L >= nwg) return false;
        int wgid = (int)L; { const int q = nwg / 8, r = nwg % 8, xcd = wgid % 8, off = wgid / 8; wgid = (xcd < r ? xcd * (q + 1) : r * (q + 1) + (xcd - r) * q) + off; }
        const int nig = 8 * nN, gid = wgid / nig, fm = gid * 8, gsz = (nM - fm) < 8 ? (nM - fm) : 8;
        u.pm = fm + ((wgid % nig) % gsz); u.pn = (wgid % nig) / gsz; u.g = 0; u.ui = i; return true;
    }
    DEVI void a_ready(const Unit&) const {}
    DEVI void done(const Unit&) const {}
};
struct OrderS5A { int G, c; DEVI bool next(int i, Unit& u) const { const int U = i * G + c; if (U >= SSM_G * 4) return false; u.g = U >> 2; u.pm = U & 3; u.pn = 0; u.ui = i; return true; }
    DEVI void a_ready(const Unit&) const {} DEVI void done(const Unit&) const {} };
struct OrderS5C { int G, c; DEVI bool next(int i, Unit& u) const { const int U = i * G + c; if (U >= SSM_G * 8) return false; u.g = U >> 3; u.pm = (U >> 1) & 3; u.pn = U & 1; u.ui = i; return true; }
    DEVI void a_ready(const Unit&) const {} DEVI void done(const Unit&) const {} };
struct OrderMoE { int G, v; const volatile LAS int* tstart;
    DEVI bool next(int i, Unit& u) const { const int U = i * G + v, rt = U >> 2; if (rt >= tstart[NEXP]) return false;
        int e = 0;
#pragma unroll 1
        for (int q = 1; q < NEXP; ++q) e = (rt >= tstart[q]) ? q : e;
        u.pm = rt; u.pn = U & 3; u.g = e; u.ui = i; return true; }
    DEVI void a_ready(const Unit&) const {} DEVI void done(const Unit&) const {} };

template <bool F32IN> struct EpiResBf16 { static constexpr bool PERM = true, AFTER_DRAIN = false; const float* xin32; bf16_t* xb;
    DEVI void operator()(const f32x4 (&acc)[2][2][4][2], const Unit& u, int wr, int wc, int fr, int fq) const {
        const int row0 = u.pm * BM + wr * 64 + fr, col0 = u.pn * BM + wc * 32 + 8 * fq;
#pragma unroll
        for (int ai = 0; ai < 2; ++ai)
#pragma unroll
            for (int m = 0; m < 4; ++m) { const size_t off = (size_t)(row0 + ai * HALF + m * 16) * D + col0;
#pragma unroll
                for (int bj = 0; bj < 2; ++bj) { f32x4 a0, a1;
                    if (F32IN) { a0 = *(const f32x4*)(xin32 + off + bj * HALF); a1 = *(const f32x4*)(xin32 + off + bj * HALF + 4); }
                    else { const u32x4 w = *(const u32x4*)(xb + off + bj * HALF); a0 = unpk_lo(w, 0); a1 = unpk_lo(w, 1); }
                    *(u32x4*)(xb + off + bj * HALF) = pk8(a0 + acc[ai][bj][m][0], a1 + acc[ai][bj][m][1]); }
                if (m & 1) asm volatile("" ::: "memory"); }
    } };
struct EpiMix { static constexpr bool PERM = true, AFTER_DRAIN = false; const bf16_t* sg; const bf16_t* mixa; bf16_t* mixed;
    DEVI void operator()(const f32x4 (&acc)[2][2][4][2], const Unit& u, int wr, int wc, int fr, int fq) const {
        const int row0 = u.pm * BM + wr * 64 + fr, col0 = u.pn * BM + wc * 32 + 8 * fq;
#pragma unroll
        for (int ai = 0; ai < 2; ++ai)
#pragma unroll
            for (int m = 0; m < 4; ++m) { const size_t row = (size_t)(row0 + ai * HALF + m * 16);
#pragma unroll
                for (int bj = 0; bj < 2; ++bj) { const int col = col0 + bj * HALF;
                    const u32x4 a = *(const u32x4*)(mixa + row * 1024 + col), s = *(const u32x4*)(sg + row * 2048 + 1024 + col);
                    const f32x4 o0 = unpk_lo(a, 0) + unpk_lo(s, 0) * acc[ai][bj][m][0], o1 = unpk_lo(a, 1) + unpk_lo(s, 1) * acc[ai][bj][m][1];
                    *(u32x4*)(mixed + row * 1024 + col) = pk8(o0, o1); }
                if (m & 1) asm volatile("" ::: "memory"); }
    } };
struct EpiGlu { static constexpr bool PERM = true, AFTER_DRAIN = false; const bf16_t* sg; bf16_t* mixa;
    DEVI void operator()(const f32x4 (&acc)[2][2][4][2], const Unit& u, int wr, int wc, int fr, int fq) const {
        const int row0 = u.pm * BM + wr * 64 + fr, col = u.pn * HALF + wc * 32 + 8 * fq;
#pragma unroll
        for (int ai = 0; ai < 2; ++ai)
#pragma unroll
            for (int m = 0; m < 4; ++m) { const size_t row = (size_t)(row0 + ai * HALF + m * 16);
                const u32x4 s = *(const u32x4*)(sg + row * 2048 + col);
                f32x4 o[2];
#pragma unroll
                for (int n = 0; n < 2; ++n) { const f32x4 v = acc[ai][0][m][n], gt = acc[ai][1][m][n], sv = unpk_lo(s, n);
                    o[n] = (f32x4){sv[0] * v[0] * fsig(gt[0]), sv[1] * v[1] * fsig(gt[1]), sv[2] * v[2] * fsig(gt[2]), sv[3] * v[3] * fsig(gt[3])}; }
                *(u32x4*)(mixa + row * 1024 + col) = pk8(o[0], o[1]);
                if (m & 1) asm volatile("" ::: "memory"); }
    } };
struct EpiSwiglu { static constexpr bool PERM = true, AFTER_DRAIN = false; bf16_t* hmid;
    DEVI void operator()(const f32x4 (&acc)[2][2][4][2], const Unit& u, int wr, int wc, int fr, int fq) const {
        const int row0 = u.pm * BM + wr * 64 + fr, col = u.pn * HALF + wc * 32 + 8 * fq;
#pragma unroll
        for (int ai = 0; ai < 2; ++ai)
#pragma unroll
            for (int m = 0; m < 4; ++m) { const size_t row = (size_t)(row0 + ai * HALF + m * 16);
                f32x4 o[2];
#pragma unroll
                for (int n = 0; n < 2; ++n) { const f32x4 gt = acc[ai][0][m][n], up = acc[ai][1][m][n];
                    o[n] = (f32x4){gt[0] * fsig(gt[0]) * up[0], gt[1] * fsig(gt[1]) * up[1], gt[2] * fsig(gt[2]) * up[2], gt[3] * fsig(gt[3]) * up[3]}; }
                *(u32x4*)(hmid + row * 512 + col) = pk8(o[0], o[1]); }
    } };
struct EpiStoreBf16 { static constexpr bool PERM = true, AFTER_DRAIN = false; bf16_t* out; int ldc;
    DEVI void operator()(const f32x4 (&acc)[2][2][4][2], const Unit& u, int wr, int wc, int fr, int fq) const {
        const int row0 = u.pm * BM + wr * 64 + fr, col0 = u.pn * BM + wc * 32 + 8 * fq;
#pragma unroll
        for (int ai = 0; ai < 2; ++ai)
#pragma unroll
            for (int m = 0; m < 4; ++m) { bf16_t* rp = out + (size_t)(row0 + ai * HALF + m * 16) * ldc + col0;
#pragma unroll
                for (int bj = 0; bj < 2; ++bj) *(u32x4*)(rp + bj * HALF) = pk8(acc[ai][bj][m][0], acc[ai][bj][m][1]); }
    } };
struct EpiS5Cm { static constexpr bool PERM = true, AFTER_DRAIN = false; const bf16_t* ucat; const float* dskip; bf16_t* z;
    DEVI void operator()(const f32x4 (&acc)[2][2][4][2], const Unit& u, int wr, int wc, int fr, int fq) const {
        const int g = u.g, row0 = u.pm * BM + wr * 64 + fr, col0 = u.pn * BM + wc * 32 + 8 * fq;
        const int co0 = col0 & 15;
        const f32x4 d0 = *(const f32x4*)(dskip + g * 16 + co0), d1 = *(const f32x4*)(dskip + g * 16 + co0 + 4);
#pragma unroll
        for (int ai = 0; ai < 2; ++ai)
#pragma unroll
            for (int m = 0; m < 4; ++m) { const int row = row0 + ai * HALF + m * 16, b = row >> 7, c = row & 127;
#pragma unroll
                for (int bj = 0; bj < 2; ++bj) { const int n = col0 + bj * HALF, t = n >> 4;
                    const u32x4 uu = *(const u32x4*)(ucat + ((size_t)g * UROWS + row) * UK + n);
                    const f32x4 y0 = acc[ai][bj][m][0] + d0 * unpk_lo(uu, 0), y1 = acc[ai][bj][m][1] + d1 * unpk_lo(uu, 1);
                    const f32x4 z0 = (f32x4){gelu_tanh(y0[0]), gelu_tanh(y0[1]), gelu_tanh(y0[2]), gelu_tanh(y0[3])}, z1 = (f32x4){gelu_tanh(y1[0]), gelu_tanh(y1[1]), gelu_tanh(y1[2]), gelu_tanh(y1[3])};
                    *(u32x4*)(z + ((size_t)b * SEQ + c * CHL + t) * 512 + g * 16 + co0) = pk8(z0, z1); } }
    } };
struct EpiS5Am { static constexpr bool PERM = false, AFTER_DRAIN = true; const float* AL; bf16_t* ucat;
    DEVI void fused(f32x4 (&acc)[2][2][4][2], const Unit& u, int wr, int wc, int fr, int fq, LAS unsigned char* lds, int wid, int lane) const {
        LAS float* sl = (LAS float*)lds;
#pragma unroll
        for (int ai = 0; ai < 2; ++ai)
#pragma unroll
            for (int m = 0; m < 4; ++m) { const int row = ai * HALF + wr * 64 + m * 16 + fr;
#pragma unroll
                for (int n = 0; n < 2; ++n) *(LAS f32x4*)(sl + row * 128 + wc * 32 + n * 16 + 4 * fq) = acc[ai][0][m][n]; }
        asm volatile("s_waitcnt lgkmcnt(0)" ::: "memory"); __builtin_amdgcn_s_barrier(); asm volatile("" ::: "memory");
        const int tid = wid * 64 + lane;
        if (tid < 128) { const int bb = tid >> 6, p = tid & 63, g = u.g;
            const float ar = AL[(g * 64 + p) * 2], ai_ = AL[(g * 64 + p) * 2 + 1];
            float hr = 0.f, hi = 0.f;
            for (int c = 0; c < NCH; ++c) { const int row = bb * NCH + c;
                bf16_t* up = ucat + ((size_t)g * UROWS + u.pm * BM + row) * UK + 512 + p;
                up[0] = f2bf(hr); up[64] = f2bf(hi);
                const float sr = sl[row * 128 + p], si = sl[row * 128 + 64 + p];
                const float nr = ar * hr - ai_ * hi + sr, ni = ar * hi + ai_ * hr + si; hr = nr; hi = ni; } }
        asm volatile("s_waitcnt lgkmcnt(0)" ::: "memory"); __builtin_amdgcn_s_barrier(); asm volatile("" ::: "memory");
    } };
struct EpiG1 { static constexpr bool PERM = true, AFTER_DRAIN = false; bf16_t* ucat; bf16_t* q; bf16_t* k; bf16_t* v; bf16_t* sg; const float* qg; const float* kg; const float* rope; float* qraw; float* kraw;
    DEVI void operator()(const f32x4 (&acc)[2][2][4][2], const Unit& u, int wr, int wc, int fr, int fq) const {
        const int pn = u.pn, row0 = u.pm * BM + wr * 64 + fr;
        if (pn < 2) {
#pragma unroll
            for (int ai = 0; ai < 2; ++ai)
#pragma unroll
                for (int m = 0; m < 4; ++m) { const int row = row0 + ai * HALF + m * 16, b = row >> 12, s = row & 4095;
#pragma unroll
                    for (int bj = 0; bj < 2; ++bj) { const int c = pn * BM + bj * HALF + wc * 32 + 8 * fq, g = c >> 4, ci = c & 15;
                        *(u32x4*)(ucat + ((size_t)g * UROWS + b * NCH + (s >> 5)) * UK + (s & 31) * 16 + ci) = pk8(acc[ai][bj][m][0], acc[ai][bj][m][1]); } }
        } else if (pn < 6) {
            const bool isk = pn >= 4; const int hh = (pn & 1) * 4 + wc;
#if G1_RAWQK
            { float* raw = isk ? kraw : qraw;
#pragma unroll
              for (int ai = 0; ai < 2; ++ai)
#pragma unroll
                for (int m = 0; m < 4; ++m) { const int row = row0 + ai * HALF + m * 16;
#pragma unroll
                    for (int bj = 0; bj < 2; ++bj)
#pragma unroll
                        for (int n = 0; n < 2; ++n) *(f32x4*)(raw + (size_t)row * 512 + hh * 64 + 32 * bj + 8 * fq + 4 * n) = acc[ai][bj][m][n]; }
              return; }
#endif
            const float* gn = isk ? kg : qg; bf16_t* dst = isk ? k : q; const float sc = isk ? 1.0f : QSCALE;
            f32x4 gv[2][2];
#pragma unroll
            for (int bj = 0; bj < 2; ++bj)
#pragma unroll
                for (int n = 0; n < 2; ++n) gv[bj][n] = *(const f32x4*)(gn + 32 * bj + 8 * fq + 4 * n);
#pragma unroll
            for (int ai = 0; ai < 2; ++ai)
#pragma unroll
                for (int m = 0; m < 4; ++m) { const int row = row0 + ai * HALF + m * 16, s = row & 4095;
                    float ss = 0.f;
#pragma unroll
                    for (int bj = 0; bj < 2; ++bj)
#pragma unroll
                        for (int n = 0; n < 2; ++n) { const f32x4 x = acc[ai][bj][m][n]; ss += (x[0] * x[0] + x[1] * x[1]) + (x[2] * x[2] + x[3] * x[3]); }
                    ss += xshfl(ss, 16, fq * 16 + fr); ss += xshfl(ss, 32, fq * 16 + fr);
                    const float rstd = 1.0f / sqrtf(ss * (1.0f / 64.0f) + NORM_EPS);
                    f32x4 o1[2], o2[2];
#pragma unroll
                    for (int n = 0; n < 2; ++n) { const float* rp = rope + ((size_t)s * 32 + 8 * fq + 4 * n) * 2;
                        const f32x4 r0 = *(const f32x4*)rp, r1 = *(const f32x4*)(rp + 4);
                        const f32x4 cv = (f32x4){r0[0], r0[2], r1[0], r1[2]}, sv = (f32x4){r0[1], r0[3], r1[1], r1[3]};
                        const f32x4 x1 = acc[ai][0][m][n] * rstd * gv[0][n], x2 = acc[ai][1][m][n] * rstd * gv[1][n];
                        o1[n] = (x1 * cv - x2 * sv) * sc; o2[n] = (x2 * cv + x1 * sv) * sc; }
                    const u32x4 w1 = pk8(o1[0], o1[1]), w2 = pk8(o2[0], o2[1]);
                    bf16_t* dp = dst + (size_t)row * 512 + hh * 64 + 8 * fq;
                    *(u32x4*)dp = w1; *(u32x4*)(dp + 32) = w2;
                    if (m & 1) asm volatile("" ::: "memory"); }
        } else if (pn < 8) {
#pragma unroll
            for (int ai = 0; ai < 2; ++ai)
#pragma unroll
                for (int m = 0; m < 4; ++m) { bf16_t* rp = v + (size_t)(row0 + ai * HALF + m * 16) * 512 + (pn - 6) * BM + wc * 32 + 8 * fq;
#pragma unroll
                    for (int bj = 0; bj < 2; ++bj) *(u32x4*)(rp + bj * HALF) = pk8(acc[ai][bj][m][0], acc[ai][bj][m][1]); }
        } else {
#pragma unroll
            for (int ai = 0; ai < 2; ++ai)
#pragma unroll
                for (int m = 0; m < 4; ++m) { bf16_t* rp = sg + (size_t)(row0 + ai * HALF + m * 16) * 2048 + (pn - 8) * BM + wc * 32 + 8 * fq;
#pragma unroll
                    for (int bj = 0; bj < 2; ++bj) { const f32x4 a = acc[ai][bj][m][0], b = acc[ai][bj][m][1];
                        *(u32x4*)(rp + bj * HALF) = pk8((f32x4){fsig(a[0]), fsig(a[1]), fsig(a[2]), fsig(a[3])}, (f32x4){fsig(b[0]), fsig(b[1]), fsig(b[2]), fsig(b[3])}); } }
        }
    } };
}

struct CvtItem { const float* src; bf16_t* dst; int N, K; };
DEVI void cvt_load(const CvtItem& it, float (&v)[32], int lane) {
#pragma unroll
    for (int i = 0; i < 32; ++i) v[i] = it.src[(size_t)(2 * i + (lane >> 5)) * it.N + (lane & 31)];
}
DEVI void cvt_store(const CvtItem& it, const float (&v)[32], LAS float* scr, int lane) {
#pragma unroll
    for (int i = 0; i < 32; ++i) scr[(2 * i + (lane >> 5)) * 33 + (lane & 31)] = v[i];
    asm volatile("s_waitcnt lgkmcnt(0)" ::: "memory");
    const int c = lane & 7;
#pragma unroll
    for (int j = 0; j < 4; ++j) { const int n = (lane >> 3) + 8 * j; const LAS float* s = scr + (8 * c) * 33 + n;
        u32x4 o; o.x = pk2(s[0 * 33], s[1 * 33]); o.y = pk2(s[2 * 33], s[3 * 33]); o.z = pk2(s[4 * 33], s[5 * 33]); o.w = pk2(s[6 * 33], s[7 * 33]);
        *(u32x4*)(it.dst + (size_t)n * it.K + 8 * c) = o; }
    asm volatile("s_waitcnt lgkmcnt(0)" ::: "memory");
}
constexpr int CV_IN = 16 * 128, CV_GLU = 8 * 64, CV_ATT = 8 * 32, CV_OUT = 16 * 32, CV_GU1 = 16 * 32, CV_DN1 = 8 * 32;
constexpr int CV_PER_LAYER = CV_IN + CV_GLU + CV_ATT + CV_OUT + NEXP * (CV_GU1 + CV_DN1);
DEVI CvtItem cvt_decode(int it, const float* w_in, const float* w_glu, const float* w_attn, const float* w_out, const float* w_gu, const float* w_dn,
                        bf16_t* WIN, bf16_t* WGLU, bf16_t* WATT, bf16_t* WOUT, bf16_t* WGU, bf16_t* WDN) {
    const int l = it / CV_PER_LAYER; int r = it % CV_PER_LAYER;
    const float* W; bf16_t* WT; int K, N, mode;
    if (r < CV_IN) { W = w_in + (size_t)l * D * D_IN; WT = WIN + (size_t)l * D_IN * D; K = D; N = D_IN; mode = 1; }
    else if ((r -= CV_IN) < CV_GLU) { W = w_glu + (size_t)l * 512 * 2048; WT = WGLU + (size_t)l * 2048 * 512; K = 512; N = 2048; mode = 2; }
    else if ((r -= CV_GLU) < CV_ATT) { W = w_attn + (size_t)l * 512 * 1024; WT = WATT + (size_t)l * 1024 * 512; K = 512; N = 1024; mode = 0; }
    else if ((r -= CV_ATT) < CV_OUT) { W = w_out + (size_t)l * 1024 * 1024; WT = WOUT + (size_t)l * 1024 * 1024; K = 1024; N = 1024; mode = 0; }
    else if ((r -= CV_OUT) < NEXP * CV_GU1) { const int e = r / CV_GU1; r %= CV_GU1; W = w_gu + ((size_t)l * NEXP + e) * 1024 * 1024; WT = WGU + ((size_t)l * NEXP + e) * 1024 * 1024; K = 1024; N = 1024; mode = 3; }
    else { r -= NEXP * CV_GU1; const int e = r / CV_DN1; r %= CV_DN1; W = w_dn + ((size_t)l * NEXP + e) * 512 * 1024; WT = WDN + ((size_t)l * NEXP + e) * 1024 * 512; K = 512; N = 1024; mode = 0; }
    const int nblk = N / 32, kb = r / nblk, nb = r % nblk, nd = 32 * nb;
    int ns = nd;
    if (mode == 1) { const int pn = nd >> 8, tc = nd & 255; if (pn >= 2 && pn < 6) { const int sec = pn < 4 ? 512 : 1024, hh = (pn & 1) * 4 + ((tc >> 5) & 3); ns = sec + hh * 64 + 32 * (tc >> 7); } }
    else if (mode == 2) { const int pn = nd >> 8, tc = nd & 255; ns = (tc < 128) ? 128 * pn + tc : 1024 + 128 * pn + (tc - 128); }
    else if (mode == 3) { const int pn = nd >> 8, tc = nd & 255; ns = (tc < 128) ? 128 * pn + tc : 512 + 128 * pn + (tc - 128); }
    return CvtItem{W + (size_t)(64 * kb) * N + ns, WT + (size_t)nd * K + 64 * kb, N, K};
}
constexpr int CVQ_BASE = CV_IN + CV_GLU + CV_ATT + CV_OUT;
constexpr int CVQ_PER_BARRIER = 2;
constexpr int CVQ_TOTAL = DEPTH * CV_PER_LAYER - CVQ_BASE;
constexpr int CVQ_LIM_MOE0 = CV_PER_LAYER - CVQ_BASE;
constexpr int CVQ_LIM_PROJ1 = CVQ_LIM_MOE0 + CVQ_BASE;
struct CvtQ { const float* w_in; const float* w_glu; const float* w_attn; const float* w_out; const float* w_gu; const float* w_dn;
              bf16_t* WIN_; bf16_t* WGLU_; bf16_t* WATT_; bf16_t* WOUT_; bf16_t* WGU_; bf16_t* WDN_; LAS unsigned* head; LAS unsigned char* lds; int wave, lane, c, G;
    DEVI void item(int q) const { const CvtItem c = cvt_decode(q + CVQ_BASE, w_in, w_glu, w_attn, w_out, w_gu, w_dn, WIN_, WGLU_, WATT_, WOUT_, WGU_, WDN_);
        float v[32]; cvt_load(c, v, lane); cvt_store(c, v, (LAS float*)(lds + wave * 16384), lane); }
    DEVI int take() const { unsigned j = 0u; if (lane == 0) j = __hip_atomic_fetch_add(head, 1u, __ATOMIC_RELAXED, __HIP_MEMORY_SCOPE_WORKGROUP); return c + G * __builtin_amdgcn_readfirstlane((int)j); }
    DEVI int peek() const { return c + G * __builtin_amdgcn_readfirstlane((int)__hip_atomic_load(head, __ATOMIC_RELAXED, __HIP_MEMORY_SCOPE_WORKGROUP)); }
    DEVI void run_until(volatile LAS unsigned* genw, unsigned n) const {
        bool empty = peek() >= CVQ_TOTAL; int budget = CVQ_PER_BARRIER;
        while (*genw < n) {
            if (empty || budget == 0) { __builtin_amdgcn_s_sleep(4); continue; }
            --budget;
            const int q = take();
            if (q >= CVQ_TOTAL) { empty = true; continue; }
            item(q);
        }
    }
    DEVI void catchup(int limit) const { for (;;) { if (peek() >= limit) break; const int q = take(); if (q >= CVQ_TOTAL) break; item(q); } }
};
DEVI int fresh_lane() { int l = (int)__builtin_amdgcn_mbcnt_hi(~0u, __builtin_amdgcn_mbcnt_lo(~0u, 0u)); asm volatile("" : "+v"(l)); return l; }
DEVI CvtQ make_cvtq(const Args& a, LAS unsigned char* lds, int wave, int lane) {
    unsigned char* w = a.ws;
    return CvtQ{a.in[2], a.in[11], a.in[14], a.in[15], a.in[21], a.in[22], (bf16_t*)(w + WS_WIN), (bf16_t*)(w + WS_WGLU), (bf16_t*)(w + WS_WATT), (bf16_t*)(w + WS_WOUT), (bf16_t*)(w + WS_WGU), (bf16_t*)(w + WS_WDN),
                (LAS unsigned*)(lds + LDSCTL_OFF) + 5, lds, wave, lane, (int)blockIdx.x, (int)gridDim.x};
}
DEVI void ph_convert_first(const Frame& F, const CvtQ& Q) { for (int it = F.gw; it < CVQ_BASE; it += F.NGW) Q.item(it - CVQ_BASE); }
DEVI void xcd_barrier_w(const XcdBarrier& b, unsigned n, volatile LAS unsigned* genw, const CvtQ& Q) {
    asm volatile("s_waitcnt vmcnt(0)" ::: "memory");
    __syncthreads();
    if (Q.wave == 0) {
        if (threadIdx.x == 0) {
            unsigned* bar = b.bar;
            __builtin_amdgcn_s_waitcnt(0);
            unsigned nloc = b.st[0], nx = b.st[1];
            if (nloc == 0u) { xcd_barrier_complete(bar, b.x, nloc, nx); b.st[0] = nloc; b.st[1] = nx; }
            const unsigned old = xb_add(&bar[XB_XSUB(b.x)], 1u);
            const unsigned gen = old / nloc;
            if (old + 1u == (gen + 1u) * nloc) {
                __builtin_amdgcn_fence(__ATOMIC_RELEASE, "agent");
                asm volatile("s_waitcnt vmcnt(0)" ::: "memory");
                const unsigned og = xb_add(&bar[XB_TOP], 1u);
                const unsigned tg = og / nx;
                if (og + 1u == (tg + 1u) * nx) xb_add(&bar[XB_TOPGEN], 1u);
                else XB_SPIN(xb_ld(&bar[XB_TOPGEN]) == tg, bar);
                __builtin_amdgcn_fence(__ATOMIC_ACQUIRE, "agent");
                xb_add(&bar[XB_XGEN(b.x)], 1u);
                asm volatile("s_waitcnt vmcnt(0)" ::: "memory");
            } else {
                XB_SPIN(xb_ld(&bar[XB_XGEN(b.x)]) == gen, bar);
                __builtin_amdgcn_fence(__ATOMIC_ACQUIRE, "agent");
                asm volatile("s_waitcnt vmcnt(0)" ::: "memory");
            }
            *genw = n;
        }
    } else Q.run_until(genw, n);
    __syncthreads();
}


DEVI void moe_tstart(const Frame& F, const unsigned* cnt, volatile LAS int* tstart) { expert_prefix(F, cnt, tstart, 1); }
DEVI void moe_gather_table(const Frame& F, int v, const unsigned* cnt, const int* list, volatile LAS int* tstart, LAS unsigned* tab) {
    for (int j = F.tid; j < 8 * 256; j += NTHR) {
        const int i = j >> 8, r = j & 255, U = i * F.G + v, rt = U >> 2; if (rt >= tstart[NEXP]) continue;
        int e = 0;
        for (int q = 1; q < NEXP; ++q) e = (rt >= tstart[q]) ? q : e;
        const int n = (int)cnt[e], idx = (rt - tstart[e]) * 256 + r;
        tab[j] = (unsigned)list[(size_t)e * LIST_CAP + (idx < n ? idx : 0)] * (unsigned)(D * 2);
    }
    __syncthreads();
}
DEVI void ph_zero_ksum(const Frame& F, float* ksum) { for (int i = F.gt; i < BATCH * NH * NBLK * 64; i += F.NGT) ksum[i] = 0.f; }

namespace attn_body {
using bf16=__hip_bfloat16;
using bf16x8=__attribute__((ext_vector_type(8)))short;
using s16x4=__attribute__((ext_vector_type(4)))short;
using f32x16=__attribute__((ext_vector_type(16)))float;
using f32x4=__attribute__((ext_vector_type(4)))float;
using u32x4=__attribute__((ext_vector_type(4)))unsigned;
constexpr int BATCH=8,NHEAD=8,SEQ=4096,D=64,DM=NHEAD*D;
constexpr int NW=8,QBLK=32,QB=QBLK*NW,KVBLK=64,NQB=SEQ/QB;
constexpr int ATTN_PITCH=DM, ATTN_UNIT_ROWS=QB;
__device__ __forceinline__ int crow(int r,int hi){return (r&3)+8*(r>>2)+4*hi;}
#define SBAR() __builtin_amdgcn_sched_barrier(0)
__device__ __forceinline__ void cmask(f32x16&p0,f32x16&p1,int jb,int qrel,int hi){
  const float NEG=-INFINITY; int kb=64*jb+4*hi;
  #pragma unroll
  for(int r=0;r<16;++r){int kv=kb+(r&3)+8*(r>>2); if(kv>qrel)p0[r]=NEG; if(kv+32>qrel)p1[r]=NEG;}
}

constexpr int NSLOT=3, SLOTB=8192;
constexpr int LDS_K=0, LDS_V=NSLOT*SLOTB, LDS_WS=2*NSLOT*SLOTB, LDS_OST=LDS_WS+NW*64*4, LDS_BYTES=LDS_OST+NW*4096;
constexpr float C2=0.125f*1.4426950408889634f;
__device__ __forceinline__ void glds16(const void*gsrc,unsigned lds_dst){unsigned keep;
  asm volatile("s_mov_b32 %0, m0\n\ts_mov_b32 m0, %2\n\ts_nop 0\n\tglobal_load_lds_dwordx4 %1, off\n\ts_mov_b32 m0, %0":"=&s"(keep):"v"(gsrc),"s"(lds_dst):"memory");}
__device__ __forceinline__ float max3f(float a,float b,float c){float r;asm("v_max3_f32 %0, %1, %2, %3":"=v"(r):"v"(a),"v"(b),"v"(c));return r;}
__device__ __forceinline__ float max2f(float a,float b){float r;asm("v_max_f32_e32 %0, %1, %2":"=v"(r):"v"(a),"v"(b));return r;}
__device__ __forceinline__ float fadd_s(float a,float b){float r;asm("v_add_f32_e32 %0, %1, %2":"=v"(r):"v"(a),"v"(b));return r;}
__device__ __forceinline__ float fsub_s(float a,float b){float r;asm("v_sub_f32_e32 %0, %1, %2":"=v"(r):"v"(a),"v"(b));return r;}
typedef float f32x2_t __attribute__((ext_vector_type(2))); typedef __bf16 bf16x2_t __attribute__((ext_vector_type(2)));
__device__ __forceinline__ unsigned cvtpk_s(float lo,float hi){f32x2_t v={lo,hi};bf16x2_t b=__builtin_convertvector(v,bf16x2_t);return __builtin_bit_cast(unsigned,b);}
#define WAIT_BAR(N) asm volatile("s_waitcnt vmcnt(" #N ") lgkmcnt(0)\n\ts_barrier":::"memory")

__device__ __forceinline__ void qkt(f32x16&p0,f32x16&p1,const char*Kslot,const bf16x8*qr,const f32x16&negm,int r32,int hi){
  const char*kb=Kslot+hi*1024+r32*16;
  #pragma unroll
  for(int d0=0;d0<4;++d0){
    const bf16x8 b0=*reinterpret_cast<const bf16x8*>(kb+d0*2048);
    const bf16x8 b1=*reinterpret_cast<const bf16x8*>(kb+d0*2048+512);
    if(d0==0){p0=__builtin_amdgcn_mfma_f32_32x32x16_bf16(b0,qr[0],negm,0,0,0);p1=__builtin_amdgcn_mfma_f32_32x32x16_bf16(b1,qr[0],negm,0,0,0);}
    else{p0=__builtin_amdgcn_mfma_f32_32x32x16_bf16(b0,qr[d0],p0,0,0,0);p1=__builtin_amdgcn_mfma_f32_32x32x16_bf16(b1,qr[d0],p1,0,0,0);}}
}
typedef __attribute__((address_space(3))) const char* lds_cptr;
typedef short v4i16_t __attribute__((ext_vector_type(4)));
__device__ __forceinline__ void kload8(bf16x8*kf,lds_cptr kp){
  kf[0]=*(const __attribute__((address_space(3))) bf16x8*)(kp);      kf[1]=*(const __attribute__((address_space(3))) bf16x8*)(kp+512);
  kf[2]=*(const __attribute__((address_space(3))) bf16x8*)(kp+2048); kf[3]=*(const __attribute__((address_space(3))) bf16x8*)(kp+2560);
  kf[4]=*(const __attribute__((address_space(3))) bf16x8*)(kp+4096); kf[5]=*(const __attribute__((address_space(3))) bf16x8*)(kp+4608);
  kf[6]=*(const __attribute__((address_space(3))) bf16x8*)(kp+6144); kf[7]=*(const __attribute__((address_space(3))) bf16x8*)(kp+6656);
}
__device__ __forceinline__ void kload2(bf16x8*kf,lds_cptr kp,int j){ kf[2*j]=*(const __attribute__((address_space(3))) bf16x8*)(kp+j*2048); kf[2*j+1]=*(const __attribute__((address_space(3))) bf16x8*)(kp+j*2048+512); }
__device__ __forceinline__ s16x4 vtr(lds_cptr p){ return __builtin_bit_cast(s16x4,__builtin_amdgcn_ds_read_tr16_b64_v4i16((__attribute__((address_space(3))) v4i16_t*)p)); }
__device__ __forceinline__ float rowmax(const f32x16&p0,const f32x16&p1){
  float a=max3f(p0[0],p0[1],p1[0]),b=max3f(p0[2],p0[3],p1[1]);a=max3f(a,p1[2],p1[3]);
  #pragma unroll
  for(int r=4;r<16;r+=4){a=max3f(a,p0[r],p0[r+1]);b=max3f(b,p0[r+2],p0[r+3]);a=max3f(a,p1[r],p1[r+1]);b=max3f(b,p1[r+2],p1[r+3]);}
  const float m=max2f(a,b);
  auto rr=__builtin_amdgcn_permlane32_swap(__float_as_uint(m),__float_as_uint(m),false,false);
  return max2f(__uint_as_float(rr[0]),__uint_as_float(rr[1]));
}
__device__ __forceinline__ void pv(f32x16*o,int vb,bf16x8 pa0,bf16x8 pa1,bf16x8 pa2,bf16x8 pa3){
  #pragma unroll
  for(int d0=0;d0<2;++d0){s16x4 lo[4],hi[4];
    #pragma unroll
    for(int ks=0;ks<4;++ks){
      asm volatile("ds_read_b64_tr_b16 %0,%1 offset:%c2":"=&v"(lo[ks]):"v"(vb),"i"(d0*4096+ks*1024):"memory");
      asm volatile("ds_read_b64_tr_b16 %0,%1 offset:%c2":"=&v"(hi[ks]):"v"(vb),"i"(d0*4096+ks*1024+512):"memory");}
    asm volatile("s_waitcnt lgkmcnt(0)":::"memory");SBAR();
    #define PK(k) (bf16x8){lo[k][0],lo[k][1],lo[k][2],lo[k][3],hi[k][0],hi[k][1],hi[k][2],hi[k][3]}
    o[d0]=__builtin_amdgcn_mfma_f32_32x32x16_bf16(pa0,PK(0),o[d0],0,0,0);
    o[d0]=__builtin_amdgcn_mfma_f32_32x32x16_bf16(pa1,PK(1),o[d0],0,0,0);
    o[d0]=__builtin_amdgcn_mfma_f32_32x32x16_bf16(pa2,PK(2),o[d0],0,0,0);
    o[d0]=__builtin_amdgcn_mfma_f32_32x32x16_bf16(pa3,PK(3),o[d0],0,0,0);
    #undef PK
  }
}

#ifndef ATTN_STORE16
#define ATTN_STORE16(p,v) (*(u32x4*)(p)=(v))
#endif
template<int THRL> __device__ __forceinline__ void attn_unit(int b,int h,int qb,const bf16*Q,const bf16*__restrict__ K,const bf16*__restrict__ V,bf16*O,const unsigned*__restrict__ sel,char*shm,int tid_in){
  const int tid=tid_in,lane=tid&63,r32=lane&31,hi=lane>>5; const int wid=__builtin_amdgcn_readfirstlane(tid>>6);
  const long rowbase=(long)b*SEQ; const int q0=qb*QB;
  const bf16*Qw=Q+(rowbase+q0+wid*QBLK)*DM+h*D;
  const bf16*Kh=K+rowbase*DM+h*D,*Vh=V+rowbase*DM+h*D;
  const unsigned lds0=(unsigned)(uintptr_t)shm;
  float*wsf=(float*)(shm+LDS_WS)+wid*64;
  const bf16*ksrc=Kh+(long)lane*DM+wid*8;
  const bf16*vsrc=Vh+(long)(16*(wid&3)+(lane>>2))*DM+(wid>>2)*32+(lane&3)*8;
  const unsigned kdst=lds0+LDS_K+wid*1024, vdst=lds0+LDS_V+wid*1024;
  #define DMA_K(t,slot) glds16(ksrc+(long)(t)*KVBLK*DM,(unsigned)__builtin_amdgcn_readfirstlane(kdst+(slot)))
  #define DMA_V(t,slot) glds16(vsrc+(long)(t)*KVBLK*DM,(unsigned)__builtin_amdgcn_readfirstlane(vdst+(slot)))
  const int vb0=(int)(lds0+LDS_V)+((lane>>4)&1)*32+(lane&3)*8+(4*hi+((lane&15)>>2))*64;
  const char*Kbase=shm+LDS_K; bf16x8 kf[8];
  const lds_cptr shm3=(lds_cptr)shm; const lds_cptr kp0=shm3+LDS_K+hi*1024+r32*16; const lds_cptr vp0=shm3+LDS_V+((lane>>4)&1)*32+(lane&3)*8+(4*hi+((lane&15)>>2))*64;
  const int NT=(q0+QB)/KVBLK;
  DMA_K(0,0);DMA_V(0,0);DMA_K(1,SLOTB);
  bf16x8 qr[4];
  #pragma unroll
  for(int d0=0;d0<4;++d0)qr[d0]=*reinterpret_cast<const bf16x8*>(&Qw[(long)r32*DM+d0*16+hi*8]);
  const unsigned selmask=sel[((size_t)(b*NHEAD+h))*SEQ+q0+wid*QBLK+r32];
  const float NEGINF=-INFINITY;
  float mhat=0.f,l_reg=0.f;f32x16 o[2];o[0]=f32x16{};o[1]=f32x16{};f32x16 negm=f32x16{};asm volatile("":"+v"(negm));
  const int qrel=wid*QBLK+r32;
  #define CMASK(P0,P1,t) do{int jb_=(t)-(NT-4); if(jb_>=0)cmask(P0,P1,jb_,qrel,hi);}while(0)
  bool resc=false;
  #define START(P0,P1) do{ const float rm=rowmax(P0,P1); resc=false; \
    { const float dl=__builtin_fmaxf(rm,-64.f); mhat=fadd_s(mhat,dl); \
      _Pragma("unroll") for(int r=0;r<16;++r){P0[r]=fsub_s(P0[r],dl);P1[r]=fsub_s(P1[r],dl);} \
      _Pragma("unroll") for(int r=0;r<16;++r)negm[r]=-mhat; asm volatile("":"+v"(negm)); } \
    _Pragma("unroll") for(int r=0;r<16;++r)P0[r]=__builtin_amdgcn_exp2f(P0[r]); }while(0)
  #define RESC() do{ if(resc){ asm volatile("s_waitcnt lgkmcnt(0)":::"memory"); \
      _Pragma("unroll") for(int d_=0;d_<2;++d_) _Pragma("unroll") for(int r=0;r<16;++r)o[d_][r]*=wsf[crow(r,hi)]; } }while(0)
  f32x16 pA0,pA1,pB0,pB1;
  int sl_prev=0,sl_cur=0,sl_next=SLOTB;
  #define ROT() do{sl_prev=sl_cur;sl_cur=sl_next;sl_next=(sl_next==(NSLOT-1)*SLOTB)?0:sl_next+SLOTB;}while(0)
  DMA_K(2,2*SLOTB);
  WAIT_BAR(3);
  #define SETNEGM(t) do{ const bool keep_=((t)>=NT-4)||(((selmask>>((t)>>2))&1u)!=0u); const float nm_=keep_?-mhat:NEGINF; _Pragma("unroll") for(int r=0;r<16;++r)negm[r]=nm_; asm volatile("":"+v"(negm)); }while(0)
  SETNEGM(0);
  qkt(pA0,pA1,Kbase,qr,negm,r32,hi);asm volatile("s_nop 15\n\ts_nop 7":"+v"(pA0),"+v"(pA1));CMASK(pA0,pA1,0);
  START(pA0,pA1);
  _Pragma("unroll") for(int r=0;r<16;++r)pA1[r]=__builtin_amdgcn_exp2f(pA1[r]);
  WAIT_BAR(0);
  DMA_K(3,0);DMA_V(1,SLOTB);
  ROT();
  kload8(kf,kp0+sl_cur);
  WAIT_BAR(2);
  s16x4 vlo[8],vhi[8]; u32x4 pw0,pw1,pw2,pw3;
  #define PKW(P,B) cvtpk_s(P[B],P[B+1])
  #define PAF(k) __builtin_bit_cast(bf16x8,pw##k)
  #define VFR(i) (bf16x8){vlo[i][0],vlo[i][1],vlo[i][2],vlo[i][3],vhi[i][0],vhi[i][1],vhi[i][2],vhi[i][3]}
  #define PIN(x) asm volatile("":"+v"(x))
  #define MX3(a,b,c) __builtin_fmaxf(__builtin_fmaxf((a),(b)),(c))
  #define GAPA(MF,A0,A1,A2,A3,W0,W1,PW) do{ MF; sacc+=A0; sacc+=A1; sacc+=A2; sacc+=A3; PIN(sacc); W0; W1; PIN(PW); SBAR(); }while(0)
  #define EX(v) __builtin_amdgcn_exp2f(v)
  #define GAPB(MF,X,B) do{ MF; X[B]=EX(X[B]); X[B+1]=EX(X[B+1]); X[B+2]=EX(X[B+2]); X[B+3]=EX(X[B+3]); PIN(X); SBAR(); }while(0)
  #define VRD(i) do{ vlo[i]=vtr(vp_+(((i)>>2)*4096+((i)&3)*1024)); vhi[i]=vtr(vp_+(((i)>>2)*4096+((i)&3)*1024+512)); }while(0)
  #define KRD(G,j) do{ if(G){ kload2(kf,kp0+sl_next,j); SBAR(); } }while(0)
  #define STEP(C0,C1,P0,P1,t,GK,GV,GL) do{ SBAR(); SETNEGM(t); SBAR(); \
    const lds_cptr vp_=vp0+sl_prev; \
    VRD(0); SBAR(); float sacc=(P0[0]+P0[1]); \
    GAPA(C0=__builtin_amdgcn_mfma_f32_32x32x16_bf16(kf[0],qr[0],negm,0,0,0), P0[2],P0[3],P0[4],P0[5],     pw0[0]=PKW(P0,0), pw0[1]=PKW(P0,2), pw0); \
    VRD(4); SBAR(); GAPA(C1=__builtin_amdgcn_mfma_f32_32x32x16_bf16(kf[1],qr[0],negm,0,0,0), P0[6],P0[7],P0[8],P0[9],     pw0[2]=PKW(P0,4), pw0[3]=PKW(P0,6), pw0); \
    VRD(1); SBAR(); GAPA(C0=__builtin_amdgcn_mfma_f32_32x32x16_bf16(kf[2],qr[1],C0,0,0,0),   P0[10],P0[11],P0[12],P0[13], pw1[0]=PKW(P0,8), pw1[1]=PKW(P0,10), pw1); \
    VRD(5); SBAR(); GAPA(C1=__builtin_amdgcn_mfma_f32_32x32x16_bf16(kf[3],qr[1],C1,0,0,0),   P0[14],P0[15],P1[0],P1[1],   pw1[2]=PKW(P0,12),pw1[3]=PKW(P0,14), pw1); \
    VRD(2); SBAR(); GAPA(C0=__builtin_amdgcn_mfma_f32_32x32x16_bf16(kf[4],qr[2],C0,0,0,0),   P1[2],P1[3],P1[4],P1[5],     pw2[0]=PKW(P1,0), pw2[1]=PKW(P1,2), pw2); \
    VRD(6); SBAR(); GAPA(C1=__builtin_amdgcn_mfma_f32_32x32x16_bf16(kf[5],qr[2],C1,0,0,0),   P1[6],P1[7],P1[8],P1[9],     pw2[2]=PKW(P1,4), pw2[3]=PKW(P1,6), pw2); \
    VRD(3); SBAR(); GAPA(C0=__builtin_amdgcn_mfma_f32_32x32x16_bf16(kf[6],qr[3],C0,0,0,0),   P1[10],P1[11],P1[12],P1[13], pw3[0]=PKW(P1,8), pw3[1]=PKW(P1,10), pw3); \
    VRD(7); SBAR(); GAPA(C1=__builtin_amdgcn_mfma_f32_32x32x16_bf16(kf[7],qr[3],C1,0,0,0),   P1[14],P1[15],0.f,0.f,       pw3[2]=PKW(P1,12),pw3[3]=PKW(P1,14), pw3); \
    l_reg+=sacc; \
    if(GK){DMA_K((t)+3,sl_cur);} if(GV){DMA_V((t)+1,sl_next);} \
    CMASK(C0,C1,t); \
    { float a=MX3(C0[0],C0[1],C1[0]),b=MX3(C0[2],C0[3],C1[1]); a=MX3(a,C1[2],C1[3]); \
      _Pragma("unroll") for(int r=4;r<16;r+=4){a=MX3(a,C0[r],C0[r+1]);b=MX3(b,C0[r+2],C0[r+3]);a=MX3(a,C1[r],C1[r+1]);b=MX3(b,C1[r+2],C1[r+3]);} \
      float rm=__builtin_fmaxf(a,b); { auto rr=__builtin_amdgcn_permlane32_swap(__float_as_uint(rm),__float_as_uint(rm),false,false); rm=__builtin_fmaxf(__uint_as_float(rr[0]),__uint_as_float(rr[1])); } \
      resc=false; \
      if(__builtin_expect(__any(rm>(float)THRL),0)){ const float dl=__builtin_fmaxf(rm,0.f); mhat+=dl; \
        _Pragma("unroll") for(int r=0;r<16;++r){C0[r]-=dl;C1[r]-=dl;} \
        const float f=__builtin_amdgcn_exp2f(-dl); l_reg*=f; if(hi==0)wsf[r32]=f; resc=true; } } \
    SBAR(); \
    GAPB(o[0]=__builtin_amdgcn_mfma_f32_32x32x16_bf16(PAF(0),VFR(0),o[0],0,0,0), C0,0); \
    GAPB(o[1]=__builtin_amdgcn_mfma_f32_32x32x16_bf16(PAF(0),VFR(4),o[1],0,0,0), C0,4); \
    KRD(GL,0); GAPB(o[0]=__builtin_amdgcn_mfma_f32_32x32x16_bf16(PAF(1),VFR(1),o[0],0,0,0), C0,8); \
    KRD(GL,1); GAPB(o[1]=__builtin_amdgcn_mfma_f32_32x32x16_bf16(PAF(1),VFR(5),o[1],0,0,0), C0,12); \
    KRD(GL,2); GAPB(o[0]=__builtin_amdgcn_mfma_f32_32x32x16_bf16(PAF(2),VFR(2),o[0],0,0,0), C1,0); \
    KRD(GL,3); GAPB(o[1]=__builtin_amdgcn_mfma_f32_32x32x16_bf16(PAF(2),VFR(6),o[1],0,0,0), C1,4); \
    GAPB(o[0]=__builtin_amdgcn_mfma_f32_32x32x16_bf16(PAF(3),VFR(3),o[0],0,0,0), C1,8); \
    GAPB(o[1]=__builtin_amdgcn_mfma_f32_32x32x16_bf16(PAF(3),VFR(7),o[1],0,0,0), C1,12); \
    }while(0)
  int t=1;
  #undef CMASK
  #define CMASK(P0,P1,t) do{}while(0)
  for(;t+5<NT;t+=2){
    STEP(pB0,pB1,pA0,pA1,t,true,true,true);     WAIT_BAR(2); RESC(); ROT();
    STEP(pA0,pA1,pB0,pB1,t+1,true,true,true);   WAIT_BAR(2); RESC(); ROT();
  }
  #undef CMASK
  #define CMASK(P0,P1,t) do{int jb_=(t)-(NT-4); if(jb_>=0)cmask(P0,P1,jb_,qrel,hi);}while(0)
  #define ENDW(tt) do{ if((tt)+3<NT){WAIT_BAR(2);} else if((tt)+2<NT){WAIT_BAR(1);} else {WAIT_BAR(0);} }while(0)
  for(;t+1<NT;t+=2){
    STEP(pB0,pB1,pA0,pA1,t,(t+3<NT),(t+1<NT),(t+1<NT));       ENDW(t);   RESC(); ROT();
    STEP(pA0,pA1,pB0,pB1,t+1,(t+4<NT),(t+2<NT),(t+2<NT));     ENDW(t+1); RESC(); ROT();
  }
  STEP(pB0,pB1,pA0,pA1,NT-1,false,false,false); RESC();
  { float sacc=pB0[0]+pB0[1]; _Pragma("unroll") for(int r=2;r<16;++r)sacc+=pB0[r]; _Pragma("unroll") for(int r=0;r<16;++r)sacc+=pB1[r]; l_reg+=sacc;
    pw0=(u32x4){PKW(pB0,0),PKW(pB0,2),PKW(pB0,4),PKW(pB0,6)};pw1=(u32x4){PKW(pB0,8),PKW(pB0,10),PKW(pB0,12),PKW(pB0,14)};pw2=(u32x4){PKW(pB1,0),PKW(pB1,2),PKW(pB1,4),PKW(pB1,6)};pw3=(u32x4){PKW(pB1,8),PKW(pB1,10),PKW(pB1,12),PKW(pB1,14)};
    SBAR(); pv(o,vb0+sl_cur,PAF(0),PAF(1),PAF(2),PAF(3)); }
  #undef PKW
  #undef PAF
  #undef VFR
  #undef PIN
  #undef MX3
  #undef GAPA
  #undef GAPB
  #undef EX
  #undef VRD
  #undef KRD
  #undef STEP
  #undef ENDW
  {auto rr=__builtin_amdgcn_permlane32_swap(__float_as_uint(l_reg),__float_as_uint(l_reg),false,false);l_reg=__uint_as_float(rr[0])+__uint_as_float(rr[1]);}
  if(hi==0)wsf[32+r32]=l_reg;asm volatile("s_waitcnt lgkmcnt(0)":::"memory");
  float rli[16];
  #pragma unroll
  for(int r=0;r<16;++r)rli[r]=__builtin_amdgcn_rcpf(wsf[32+crow(r,hi)]);
  bf16*Ow=O+(rowbase+q0+wid*QBLK)*DM+h*D;
  { bf16*stg=(bf16*)(shm+LDS_OST)+wid*2048;
    #pragma unroll
    for(int r=0;r<16;++r){const int orow=crow(r,hi);
      #pragma unroll
      for(int d0=0;d0<2;++d0)stg[orow*64+d0*32+r32]=__float2bfloat16(o[d0][r]*rli[r]);}
    asm volatile("s_waitcnt lgkmcnt(0)":::"memory");
    #pragma unroll
    for(int i=0;i<4;++i){const int row=i*8+(lane>>3),ch=lane&7; const u32x4 v=*(const u32x4*)(stg+row*64+ch*8); ATTN_STORE16(Ow+(long)row*DM+ch*8,v);} }
  asm volatile("s_waitcnt lgkmcnt(0)\n\ts_barrier":::"memory");
  #undef DMA_K
  #undef DMA_V
  #undef CMASK
  #undef START
  #undef SETNEGM
  #undef RESC
  #undef ROT
}
constexpr int ATTN_LDS_BYTES=LDS_BYTES;
struct AttnTensors { const bf16* Q; const bf16* K; const bf16* V; bf16* O; const unsigned* sel; };
struct AttnUnit { int bh; int qb; };
struct StaticOrder {
  int vcu,grid;
  __device__ __forceinline__ explicit StaticOrder(int grid_,int block):vcu((grid_%8==0)?(block%8)*(grid_/8)+block/8:block),grid(grid_){}
  __device__ __forceinline__ bool next(int i,AttnUnit&u)const{
    if(grid==256){ if(i>=4)return false; const int s=vcu&3; u.bh=vcu>>2; u.qb=(i==0)?s:(i==1)?7-s:(i==2)?8+s:15-s; return true; }
    const int U=i*grid+vcu; if(U>=BATCH*NHEAD*NQB)return false; u.bh=U/NQB; u.qb=U%NQB; return true; }
  __device__ __forceinline__ void a_ready(const AttnUnit&)const{}
  __device__ __forceinline__ void done(const AttnUnit&)const{}
};
template<class Sched,int THRL=8> __device__ __forceinline__ void attn_phase(char*lds,const AttnTensors&T,const Sched&S,int tid_in){
  AttnUnit u;
  for(int i=0;S.next(i,u);++i){ S.a_ready(u); attn_unit<THRL>(u.bh/NHEAD,u.bh%NHEAD,u.qb,T.Q,T.K,T.V,T.O,T.sel,lds,tid_in); S.done(u); }
}
#undef SBAR
#undef WAIT_BAR
}


DEVI void ph_moba_select(const Frame& F, const bf16_t* Q, const float* ksum, unsigned* sel) {
    for (int idx = F.gt; idx < BATCH * NH * SEQ; idx += F.NGT) {
        const int s = idx & (SEQ - 1), bh = idx >> 12, b = bh >> 3, hh = bh & 7, qb = s >> 8;
        const bf16_t* qp = Q + ((size_t)b * SEQ + s) * 512 + hh * 64;
        float q[64];
#pragma unroll
        for (int i = 0; i < 8; ++i) { const bf16x8 t = *((const bf16x8*)qp + i);
#pragma unroll
            for (int j = 0; j < 8; ++j) q[8 * i + j] = bf2f((bf16_t)t[j]); }
        float gsc[15];
#pragma unroll
        for (int j = 0; j < 15; ++j) { gsc[j] = -INFINITY;
            if (j < qb) { const float* km = ksum + ((size_t)bh * 16 + j) * 64; float a = 0.f;
#pragma unroll
                for (int i = 0; i < 64; ++i) a += q[i] * km[i];
                gsc[j] = a; } }
        unsigned m = 0u;
#pragma unroll
        for (int t = 0; t < 3; ++t) { float best = -INFINITY; int bi = -1;
#pragma unroll
            for (int j = 0; j < 15; ++j) { const bool ok = (j < qb) && !((m >> j) & 1u) && (gsc[j] > best); best = ok ? gsc[j] : best; bi = ok ? j : bi; }
            if (bi >= 0) m |= 1u << bi; }
        sel[idx] = m;
    }
}


DEVI void ph_router_weights(const Frame& F, const float* wg, const float* we, bf16_t* wr) {
    for (int idx = F.gt; idx < DEPTH * 48 * 1024; idx += F.NGT) {
        const int l = idx / (48 * 1024), r = idx % (48 * 1024), o = r >> 10, kk = r & 1023;
        const float v = (o < 4) ? wg[((size_t)l * D + kk) * 4 + o] : (o < 36) ? we[((size_t)l * D + kk) * 32 + (o - 4)] : 0.f;
        const bf16_t hi = f2bf(v), lo = f2bf(v - bf2f(hi));
        wr[((size_t)l * 2 + 0) * 48 * 1024 + r] = hi; wr[((size_t)l * 2 + 1) * 48 * 1024 + r] = lo;
    }
}
DEVI void ph_norm_router_mfma(const Frame& F, const bf16_t* x, const float* g, const bf16_t* wr, const float* bg, const float* be, bf16_t* h2, unsigned* cnt, int* list, unsigned* rec) {
    const int lane = F.lane, ri = lane & 15, q = lane >> 4;
    constexpr int WPITCH = 2064, WLO_OFF = 36 * WPITCH, LG_OFF = 2 * 36 * WPITCH;
    static_assert(LG_OFF <= SCRATCH_BYTES, "router LDS");
    LAS unsigned char* wl = F.lds;
    LAS float* lg = (LAS float*)(F.lds + F.wave * 3072);
    volatile LAS unsigned* hist = (volatile LAS unsigned*)(F.lds + 8 * 3072);
    for (int tile = blockIdx.x; tile < NTOK / 128; tile += F.G) {
        for (int i = F.tid; i < 2 * 36 * 128; i += NTHR) { const int hl = i / (36 * 128), r = (i / 128) % 36, c = i % 128;
            *(LAS u32x4*)(wl + hl * WLO_OFF + r * WPITCH + c * 16) = *(const u32x4*)(wr + (size_t)hl * 48 * 1024 + (size_t)r * 1024 + c * 8); }
        __syncthreads();
        const int row = tile * 128 + F.wave * 16 + ri;
        const bf16_t* xr = x + (size_t)row * D + 8 * q;
        float ss = 0.f;
#pragma unroll
        for (int kk = 0; kk < 32; ++kk) { const u32x4 xw = *(const u32x4*)(xr + 32 * kk); const f32x4 a = pg8::unpk_lo(xw, 0), b = pg8::unpk_lo(xw, 1);
            ss += (a[0] * a[0] + a[1] * a[1]) + (a[2] * a[2] + a[3] * a[3]) + (b[0] * b[0] + b[1] * b[1]) + (b[2] * b[2] + b[3] * b[3]); }
        ss += xshfl(ss, 16, lane); ss += xshfl(ss, 32, lane);
        const float rstd = 1.0f / sqrtf(ss * (1.0f / D) + NORM_EPS);
        f32x4 acc[3] = {(f32x4){0.f, 0.f, 0.f, 0.f}, (f32x4){0.f, 0.f, 0.f, 0.f}, (f32x4){0.f, 0.f, 0.f, 0.f}};
#pragma unroll 2
        for (int kk = 0; kk < 32; ++kk) {
            const int k0 = 32 * kk + 8 * q;
            const u32x4 xw = *(const u32x4*)(xr + 32 * kk); const f32x4 a = pg8::unpk_lo(xw, 0), b = pg8::unpk_lo(xw, 1);
            const f32x4 ga = *(const f32x4*)(g + k0), gb = *(const f32x4*)(g + k0 + 4);
            const f32x4 ha = a * rstd * ga, hb = b * rstd * gb;
            const u32x4 hi = pg8::pk8(ha, hb);
            const f32x4 ra = ha - pg8::unpk_lo(hi, 0), rb = hb - pg8::unpk_lo(hi, 1);
            const u32x4 lo = pg8::pk8(ra, rb);
            *(u32x4*)(h2 + (size_t)row * D + k0) = hi;
            const bf16x8 ahi = __builtin_bit_cast(bf16x8, hi), alo = __builtin_bit_cast(bf16x8, lo);
#pragma unroll
            for (int t = 0; t < 3; ++t) {
                const int wrow = 16 * t + ri; bf16x8 bh = {}, bl = {};
                if (wrow < 36) { bh = *(const LAS bf16x8*)(wl + wrow * WPITCH + k0 * 2); bl = *(const LAS bf16x8*)(wl + WLO_OFF + wrow * WPITCH + k0 * 2); }
                acc[t] = __builtin_amdgcn_mfma_f32_16x16x32_bf16(ahi, bh, acc[t], 0, 0, 0);
                acc[t] = __builtin_amdgcn_mfma_f32_16x16x32_bf16(alo, bh, acc[t], 0, 0, 0);
                acc[t] = __builtin_amdgcn_mfma_f32_16x16x32_bf16(ahi, bl, acc[t], 0, 0, 0);
            }
        }
        __syncthreads();
        if (F.tid < 64) hist[F.tid] = 0u;
#pragma unroll
        for (int t = 0; t < 3; ++t)
#pragma unroll
            for (int e = 0; e < 4; ++e) lg[(4 * q + e) * 48 + 16 * t + ri] = acc[t][e];
        __syncthreads();
        int e0 = 0, e1 = 0; float w0 = 0.f, w1 = 0.f; unsigned r0 = 0u, r1 = 0u;
        if (lane < 16) {
            const LAS float* L = lg + lane * 48;
            float gl[4]; int gt = 0; float gm = -INFINITY;
#pragma unroll
            for (int i = 0; i < 4; ++i) { gl[i] = L[i] + bg[i]; if (gl[i] > gm) { gm = gl[i]; gt = i; } }
            float gs = 0.f;
#pragma unroll
            for (int i = 0; i < 4; ++i) gs += __expf(gl[i] - gm);
            const float pgv = 1.0f / gs;
            float el[8]; float em = -INFINITY;
#pragma unroll
            for (int i = 0; i < 8; ++i) { el[i] = L[4 + gt * 8 + i] + be[gt * 8 + i]; em = fmaxf(em, el[i]); }
            int i1 = 0; float v1 = -INFINITY;
#pragma unroll
            for (int i = 0; i < 8; ++i) if (el[i] > v1) { v1 = el[i]; i1 = i; }
            int i2 = 0; float v2 = -INFINITY;
#pragma unroll
            for (int i = 0; i < 8; ++i) if (i != i1 && el[i] > v2) { v2 = el[i]; i2 = i; }
            const float p1 = __expf(v1 - em), p2 = __expf(v2 - em);
            w0 = pgv * p1 / (p1 + p2); w1 = pgv * p2 / (p1 + p2);
            e0 = gt * 8 + i1; e1 = gt * 8 + i2;
            r0 = __hip_atomic_fetch_add((LAS unsigned*)hist + e0, 1u, __ATOMIC_RELAXED, __HIP_MEMORY_SCOPE_WORKGROUP); r1 = __hip_atomic_fetch_add((LAS unsigned*)hist + e1, 1u, __ATOMIC_RELAXED, __HIP_MEMORY_SCOPE_WORKGROUP);
        }
        __syncthreads();
        if (F.tid < 32) { const unsigned n = hist[F.tid]; hist[32 + F.tid] = n ? atomicAdd(cnt + F.tid, n) : 0u; }
        __syncthreads();
        if (lane < 16) {
            const int tok = tile * 128 + F.wave * 16 + lane;
            const unsigned pos0 = hist[32 + e0] + r0, pos1 = hist[32 + e1] + r1;
            list[(size_t)e0 * LIST_CAP + pos0] = tok; list[(size_t)e1 * LIST_CAP + pos1] = tok;
            unsigned* rp = rec + (size_t)tok * 8;
            rp[0] = (unsigned)e0; rp[1] = (unsigned)e1; rp[2] = pos0; rp[3] = pos1; rp[4] = __float_as_uint(w0); rp[5] = __float_as_uint(w1);
        }
        __syncthreads();
    }
}


DEVI void ph_moba_select_mfma(const Frame& F, const bf16_t* Q, const float* ksum, unsigned* sel) {
    const int lane = F.lane, r = lane & 31, h = lane >> 5;
    for (int item = F.gw; item < BATCH * NH * (SEQ / 32); item += F.NGW) {
        const int qt = item & 127, bh = item >> 7, b = bh >> 3, hh = bh & 7, s0 = qt * 32, qb = s0 >> 8;
        if (qb == 0) { if (h == 0) sel[(size_t)bh * SEQ + s0 + r] = 0u; continue; }
        f32x16 acc = {};
#pragma unroll
        for (int s = 0; s < 4; ++s) {
            const bf16x8 bq = *(const bf16x8*)(Q + ((size_t)b * SEQ + s0 + r) * 512 + hh * 64 + 16 * s + 8 * h);
            f32x4 k0 = (f32x4){0.f, 0.f, 0.f, 0.f}, k1 = k0;
            if (r < 16) { const float* kp = ksum + ((size_t)bh * 16 + r) * 64 + 16 * s + 8 * h; k0 = *(const f32x4*)kp; k1 = *(const f32x4*)(kp + 4); }
            const u32x4 hi = pg8::pk8(k0, k1), lo = pg8::pk8(k0 - pg8::unpk_lo(hi, 0), k1 - pg8::unpk_lo(hi, 1));
            acc = __builtin_amdgcn_mfma_f32_32x32x16_bf16(__builtin_bit_cast(bf16x8, hi), bq, acc, 0, 0, 0);
            acc = __builtin_amdgcn_mfma_f32_32x32x16_bf16(__builtin_bit_cast(bf16x8, lo), bq, acc, 0, 0, 0);
        }
        float sc[16];
#pragma unroll
        for (int reg = 0; reg < 8; ++reg) { const float mine = acc[reg], other = xshfl(acc[reg], 32, lane); const int base = (reg & 3) + 8 * (reg >> 2);
            sc[base] = h ? other : mine; sc[base + 4] = h ? mine : other; }
        unsigned m = 0u;
#pragma unroll
        for (int t = 0; t < 3; ++t) { float best = -INFINITY; int bi = -1;
#pragma unroll
            for (int j = 0; j < 15; ++j) { const bool ok = (j < qb) && !((m >> j) & 1u) && (sc[j] > best); best = ok ? sc[j] : best; bi = ok ? j : bi; }
            if (bi >= 0) m |= 1u << bi; }
        if (h == 0) sel[(size_t)bh * SEQ + s0 + r] = m;
    }
}

constexpr int PH_PER_LAYER = 10, N_PHASES = 1 + DEPTH * PH_PER_LAYER;
__global__ void __launch_bounds__(NTHR, 2) mk_fwd(Args a) {
    extern __shared__ __attribute__((aligned(16))) unsigned char lds_raw[];
    Frame F0;
    F0.lds = (LAS unsigned char*)lds_raw;
    F0.tid = threadIdx.x; F0.lane = F0.tid & 63; F0.wave = __builtin_amdgcn_readfirstlane(F0.tid >> 6);
    F0.G = gridDim.x; F0.gw = blockIdx.x * NWAVES + F0.wave; F0.NGW = F0.G * NWAVES; F0.gt = blockIdx.x * NTHR + F0.tid; F0.NGT = F0.G * NTHR;
    volatile LAS unsigned* LCTL = (volatile LAS unsigned*)(F0.lds + LDSCTL_OFF);
    volatile LAS int* pstart = (volatile LAS int*)(F0.lds + LDSCTL_OFF + 256);
    for (int u = F0.tid; u < 256; u += NTHR) LCTL[u] = 0u;
    __syncthreads();
    unsigned* ctl = (unsigned*)(a.ws + WS_CTL);
    XcdBarrier bar = xcd_barrier_post(ctl + CW_BAR + a.li * XCD_BAR_WORDS, LCTL);

#define x_in (a.in[0])
#define norm1_g (a.in[1])
#define w_in (a.in[2])
#define ssm_d (a.in[10])
#define w_glu (a.in[11])
#define qng (a.in[12])
#define kng (a.in[13])
#define w_attn (a.in[14])
#define w_out (a.in[15])
#define norm2_g (a.in[16])
#define wgrp (a.in[17])
#define bgrp (a.in[18])
#define wexp (a.in[19])
#define bexp (a.in[20])
#define w_gu (a.in[21])
#define w_dn (a.in[22])
#define X (a.out)
#define rope ((float*)(ws + WS_ROPE))
#define AL ((float*)(ws + WS_MISC + MISC_AL))
#define ksum ((float*)(ws + WS_MISC + MISC_KSUM))
#define SEL ((unsigned*)(ws + WS_MISC + MISC_SEL))
#define rec ((unsigned*)(ws + WS_REC))
#define list ((int*)(ws + WS_LIST))
#define TC ((bf16_t*)(ws + WS_S5TC))
#define BS ((bf16_t*)(ws + WS_S5BS))
#define H ((bf16_t*)(ws + WS_H))
#define UCAT ((bf16_t*)(ws + WS_UCAT))
#define Qb ((bf16_t*)(ws + WS_Q))
#define Kb ((bf16_t*)(ws + WS_K))
#define Vb ((bf16_t*)(ws + WS_V))
#define SG ((bf16_t*)(ws + WS_SG))
#define Z ((bf16_t*)(ws + WS_Z))
#define ATT ((bf16_t*)(ws + WS_ATT))
#define MIXA ((bf16_t*)(ws + WS_MIXA))
#define MIXED ((bf16_t*)(ws + WS_MIXED))
#define SL ((float*)(ws + WS_SL))
#define HMID ((bf16_t*)(ws + WS_HMID))
#define YBUF ((bf16_t*)(ws + WS_YBUF))
#define QRAW ((float*)(ws + WS_QRAW))
#define KRAW ((float*)(ws + WS_KRAW))
#define WIN ((bf16_t*)(ws + WS_WIN))
#define WGLU ((bf16_t*)(ws + WS_WGLU))
#define WATT ((bf16_t*)(ws + WS_WATT))
#define WOUT ((bf16_t*)(ws + WS_WOUT))
#define WGU ((bf16_t*)(ws + WS_WGU))
#define WDN ((bf16_t*)(ws + WS_WDN))
#define WR ((bf16_t*)(ws + WS_MISC + MISC_WR))
#define XB ((bf16_t*)(ws + WS_XB))
    const int lo = a.ph_lo, hi = a.ph_hi;
    int ph = 0; unsigned bgen = 0u;
#define PH_BEGIN if (ph >= lo && ph < hi) { for (int rep_ = 0; rep_ < ((((unsigned long long)REP_MASK >> ph) & 1ull) ? 2 : 1); ++rep_) { if (rep_) __syncthreads(); Frame P = F0; unsigned long long wz_ = 0ull; asm volatile("" : "+s"(wz_)); unsigned char* ws = a.ws + wz_;     { int t_ = F0.wave * 64 + (int)__builtin_amdgcn_mbcnt_hi(~0u, __builtin_amdgcn_mbcnt_lo(~0u, 0u)); asm volatile("" : "+v"(t_));     P.tid = t_; P.lane = t_ & 63; P.gt = (int)blockIdx.x * NTHR + t_; P.wave = __builtin_amdgcn_readfirstlane(t_ >> 6); P.gw = (int)blockIdx.x * NWAVES + P.wave; }
#define PH_END   } if (ph + 1 < hi) { ++bgen; xcd_barrier_w(bar, bgen, LCTL + 4, make_cvtq(a, F0.lds, F0.wave, fresh_lane())); } } ++ph;

    const int vcu = (F0.G % 8 == 0) ? ((int)blockIdx.x % 8) * (F0.G / 8) + (int)blockIdx.x / 8 : (int)blockIdx.x;
    LAS unsigned char* ring = F0.lds;
    volatile LAS int* tstart = (volatile LAS int*)(F0.lds + LDSCTL_OFF + 512);
    LAS unsigned* gtab = (LAS unsigned*)(F0.lds + GTAB_OFF);

    PH_BEGIN
        ph_rope_table(P, rope);
        for (int it4 = blockIdx.x; it4 < DEPTH * SSM_G * 4; it4 += P.G) { const int it = it4 >> 2;
            s5_tables_item(it / SSM_G, it % SSM_G, a.in[3], a.in[4], a.in[5], a.in[6], a.in[7], a.in[8], a.in[9],
                           TC + (size_t)it * 512 * 640, BS + (size_t)it * 128 * 512, AL + (size_t)it * 128, (LAS float*)P.lds, P.tid, NTHR, it4 & 3); }
        ph_rmsnorm(P, x_in, norm1_g, H);
        ph_convert_first(P, make_cvtq(a, F0.lds, P.wave, P.lane));
        ph_router_weights(P, wgrp, wexp, WR);
    PH_END

    for (int l = 0; l < DEPTH; ++l) {
#define xin ((l == 0) ? x_in : (const float*)X)
#define cnt ((unsigned*)(ws + WS_CTL) + CW_CNT + l * NEXP)
        PH_BEGIN
            pg8::Gemm g{H, WIN + (size_t)l * D_IN * D, D, D, D, 0, 0}; pg8::StaticOrder S; S.init(NTOK, D_IN, P.G, (int)blockIdx.x);
            pg8::EpiG1 E{UCAT, Qb, Kb, Vb, SG, qng + l * 64, kng + l * 64, rope, QRAW, KRAW};
            pg8::gemm_phase<pg8::EpiG1, pg8::StaticOrder, pg8::NoGather, G1_ALIGN>(ring, g, S, E, pg8::NoGather{}, P.tid);
        PH_END
        PH_BEGIN
            if (P.G == 256) { if (vcu >= 128) { Frame Q2 = P; Q2.gw = (vcu - 128) * NWAVES + P.wave; Q2.NGW = 128 * NWAVES; ph_ksum(Q2, Kb, ksum); } } else ph_ksum(P, Kb, ksum);
            { pg8::Gemm g{UCAT, BS + (size_t)l * SSM_G * 128 * 512, UK, 512, 512, (size_t)UROWS * UK, (size_t)128 * 512}; pg8::OrderS5A S{P.G, vcu};
              pg8::EpiS5Am E{AL + (size_t)l * SSM_G * 128, UCAT};
              pg8::gemm_phase<pg8::EpiS5Am, pg8::OrderS5A, pg8::NoGather, false>(ring, g, S, E, pg8::NoGather{}, P.tid); }
        PH_END
        PH_BEGIN
            ph_moba_select_mfma(P, Qb, ksum, SEL);
            { pg8::Gemm g{UCAT, TC + (size_t)l * SSM_G * 512 * 640, UK, UK, UK, (size_t)UROWS * UK, (size_t)512 * 640}; pg8::OrderS5C S{P.G, vcu};
              pg8::EpiS5Cm E{UCAT, ssm_d + l * SSM_W, Z};
              pg8::gemm_phase<pg8::EpiS5Cm, pg8::OrderS5C, pg8::NoGather, false>(ring, g, S, E, pg8::NoGather{}, P.tid); }
        PH_END
        PH_BEGIN
            { const attn_body::AttnTensors AT{(const attn_body::bf16*)Qb, (const attn_body::bf16*)Kb, (const attn_body::bf16*)Vb, (attn_body::bf16*)ATT, SEL};
              const attn_body::StaticOrder SA((int)P.G, (int)blockIdx.x);
              attn_body::attn_phase<attn_body::StaticOrder>((char*)lds_raw, AT, SA, P.tid); }
            { pg8::Gemm g{Z, WGLU + (size_t)l * 2048 * 512, 512, 512, 512, 0, 0}; pg8::StaticOrder S; S.init(NTOK, 2048, P.G, (int)blockIdx.x);
              pg8::EpiGlu E{SG, MIXA};
              pg8::gemm_phase<pg8::EpiGlu, pg8::StaticOrder, pg8::NoGather, true>(ring, g, S, E, pg8::NoGather{}, P.tid); }
        PH_END
        PH_BEGIN
            pg8::Gemm g{ATT, WATT + (size_t)l * 1024 * 512, 512, 512, 512, 0, 0}; pg8::StaticOrder S; S.init(NTOK, 1024, P.G, (int)blockIdx.x);
            pg8::EpiMix E{SG, MIXA, MIXED};
            pg8::gemm_phase<pg8::EpiMix, pg8::StaticOrder, pg8::NoGather, true>(ring, g, S, E, pg8::NoGather{}, P.tid);
        PH_END
        PH_BEGIN
            pg8::Gemm g{MIXED, WOUT + (size_t)l * 1024 * 1024, 1024, 1024, 1024, 0, 0}; pg8::StaticOrder S; S.init(NTOK, 1024, P.G, (int)blockIdx.x);
            if (l == 0) { pg8::EpiResBf16<true> E{x_in, XB}; pg8::gemm_phase<pg8::EpiResBf16<true>, pg8::StaticOrder, pg8::NoGather, true>(ring, g, S, E, pg8::NoGather{}, P.tid); }
            else { pg8::EpiResBf16<false> E{nullptr, XB}; pg8::gemm_phase<pg8::EpiResBf16<false>, pg8::StaticOrder, pg8::NoGather, true>(ring, g, S, E, pg8::NoGather{}, P.tid); }
        PH_END
        PH_BEGIN make_cvtq(a, F0.lds, P.wave, P.lane).catchup(l == 0 ? CVQ_LIM_MOE0 : CVQ_TOTAL); __syncthreads(); ph_norm_router_mfma(P, XB, norm2_g + l * D, WR + (size_t)l * 2 * 48 * 1024, bgrp + l * 4, bexp + l * 32, H, cnt, list, rec); PH_END
        PH_BEGIN
            moe_tstart(P, cnt, tstart); moe_gather_table(P, vcu, cnt, list, tstart, gtab);
            pg8::Gemm g{H, WGU + (size_t)l * NEXP * 1024 * 1024, D, 1024, 1024, 0, (size_t)1024 * 1024}; pg8::OrderMoE S{P.G, vcu, tstart};
            pg8::EpiSwiglu E{HMID};
            pg8::gemm_phase<pg8::EpiSwiglu, pg8::OrderMoE, pg8::LdsGather, true>(ring, g, S, E, pg8::LdsGather{gtab}, P.tid);
        PH_END
        PH_BEGIN
            moe_tstart(P, cnt, tstart);
            pg8::Gemm g{HMID, WDN + (size_t)l * NEXP * 1024 * 512, 512, 512, 512, 0, (size_t)1024 * 512}; pg8::OrderMoE S{P.G, vcu, tstart};
            pg8::EpiStoreBf16 E{YBUF, 1024};
            pg8::gemm_phase<pg8::EpiStoreBf16, pg8::OrderMoE, pg8::NoGather, true>(ring, g, S, E, pg8::NoGather{}, P.tid);
        PH_END
        PH_BEGIN
            if (l + 1 < DEPTH) { make_cvtq(a, F0.lds, P.wave, P.lane).catchup(CVQ_LIM_PROJ1); __syncthreads(); }
            compute_pstart(P, cnt, pstart);
            if (l + 1 < DEPTH) ph_combine<false>(P, XB, X, YBUF, rec, pstart, norm1_g + (l + 1) * D, H);
            else ph_combine<true>(P, XB, X, YBUF, rec, pstart, nullptr, H);
        PH_END
    }
#undef PH_BEGIN
#undef PH_END
#undef x_in
#undef norm1_g
#undef w_in
#undef ssm_d
#undef w_glu
#undef qng
#undef kng
#undef w_attn
#undef w_out
#undef norm2_g
#undef wgrp
#undef bgrp
#undef wexp
#undef bexp
#undef w_gu
#undef w_dn
#undef X
#undef rope
#undef AL
#undef ksum
#undef SEL
#undef rec
#undef list
#undef TC
#undef BS
#undef H
#undef UCAT
#undef Qb
#undef Kb
#undef Vb
#undef SG
#undef Z
#undef ATT
#undef MIXA
#undef MIXED
#undef SL
#undef HMID
#undef YBUF
#undef QRAW
#undef KRAW
#undef WIN
#undef WGLU
#undef WATT
#undef WOUT
#undef WGU
#undef WDN
#undef WR
#undef XB
#undef xin
#undef cnt
}

extern "C" void kernel_launch(void* const* d_in, const int* in_sizes, int n_in, void* d_out, int out_size, void* d_ws, size_t ws_size, hipStream_t stream) {
    static int grid = 0;
    if (grid == 0) {
        if (n_in != 23 || ws_size < WS_END || out_size != NTOK * D) { fprintf(stderr, "kernel_launch: unexpected n_in %d / ws_size %zu / out_size %d; nothing launched\n", n_in, ws_size, out_size); grid = -1; return; }
        int dev = 0, cus = 0, per_cu = 0;
        if (hipGetDevice(&dev) != hipSuccess || hipDeviceGetAttribute(&cus, hipDeviceAttributeMultiprocessorCount, dev) != hipSuccess) { grid = -1; return; }
        if (hipFuncSetAttribute((const void*)mk_fwd, hipFuncAttributeMaxDynamicSharedMemorySize, LDS_BYTES) != hipSuccess) { fprintf(stderr, "kernel_launch: hipFuncSetAttribute failed\n"); grid = -1; return; }
        if (hipOccupancyMaxActiveBlocksPerMultiprocessor(&per_cu, (const void*)mk_fwd, NTHR, LDS_BYTES) != hipSuccess || per_cu < 1) { fprintf(stderr, "kernel_launch: occupancy query says %d\n", per_cu); }
        (void)hipGetLastError();
        grid = cus;
    }
    if (grid < 0) return;
    if (hipMemsetAsync((char*)d_ws + WS_CTL, 0, CTL_BYTES, stream) != hipSuccess) return;
    Args a{};
    for (int i = 0; i < 23; ++i) a.in[i] = (const float*)d_in[i];
    a.out = (float*)d_out; a.ws = (unsigned char*)d_ws;
#if MK_PER_PHASE
    for (int p = 0; p < N_PHASES; ++p) { a.ph_lo = p; a.ph_hi = p + 1; a.li = p; hipLaunchKernelGGL(mk_fwd, dim3(grid), dim3(NTHR), LDS_BYTES, stream, a); }
#else
    a.ph_lo = 0; a.ph_hi = N_PHASES; a.li = 0;
    hipLaunchKernelGGL(mk_fwd, dim3(grid), dim3(NTHR), LDS_BYTES, stream, a);
#endif
}
```

```cpp
#include <hip/hip_runtime.h>
#include <hip/hip_bf16.h>
#include <cstdint>
#include <cstdio>
#include <cmath>

#define DEVI __device__ __forceinline__
#define GAS __attribute__((address_space(1)))
#define LAS __attribute__((address_space(3)))
typedef unsigned short bf16_t;
typedef short bf16x8 __attribute__((ext_vector_type(8)));
typedef float f32x4 __attribute__((ext_vector_type(4)));
typedef float f32x16 __attribute__((ext_vector_type(16)));
typedef unsigned u32x4 __attribute__((ext_vector_type(4)));
typedef unsigned u32x2 __attribute__((ext_vector_type(2)));
typedef float cf32 __attribute__((ext_vector_type(2)));

#ifndef OPT_G1
#define OPT_G1 1
#endif
#ifndef G1_RAWQK
#define G1_RAWQK 0
#endif
#ifndef OPT_S5
#define OPT_S5 1
#endif
#ifndef OPT_G3
#define OPT_G3 1
#endif
#ifndef OPT_G4
#define OPT_G4 1
#endif
#ifndef OPT_G5
#define OPT_G5 1
#endif
#ifndef OPT_ATT
#define OPT_ATT 1
#endif
#ifndef REP_MASK
#define REP_MASK 0ull
#endif
#ifndef BAR_TWICE
#define BAR_TWICE 0
#endif
#ifndef G1_ALIGN
#define G1_ALIGN true
#endif
#ifndef OPT_RT
#define OPT_RT 1
#endif
#ifndef OPT_M1
#define OPT_M1 1
#endif
#ifndef OPT_M2
#define OPT_M2 1
#endif
#ifndef MK_PER_PHASE
#define MK_PER_PHASE 0
#endif

constexpr int D = 1024, BATCH = 8, SEQ = 4096, NTOK = BATCH * SEQ, DEPTH = 2;
constexpr int SSM_G = 32, SSM_C = 16, SSM_W = 512, SSM_P = 64;
constexpr int NH = 8, HD = 64, AW = 512, MOBA_B = 256, NBLK = SEQ / MOBA_B;
constexpr int D_IN = 4096;
constexpr int NEXP = 32, DEXP = 512;
constexpr int CHL = 32, NCH = SEQ / CHL, UK = 640, UROWS = BATCH * NCH;
constexpr int SLOT_CAP = 2 * NTOK + NEXP * 256;
constexpr int LIST_CAP = NTOK;
constexpr float NORM_EPS = 1e-6f;
constexpr float QSCALE = 0.125f * 1.4426950408889634f;
constexpr int NWAVES = 8, NTHR = 512;

constexpr size_t MiB = 1u << 20;
constexpr size_t WS_CTL = 0, CTL_BYTES = 1 * MiB;
constexpr size_t WS_ROPE = 1 * MiB;
constexpr size_t WS_MISC = 2 * MiB;
constexpr size_t WS_REC = 4 * MiB;
constexpr size_t WS_LIST = 5 * MiB;
constexpr size_t WS_S5TC = 16 * MiB;
constexpr size_t WS_S5BS = 56 * MiB;
constexpr size_t WS_WIN = 66 * MiB, WS_WGLU = 82 * MiB, WS_WATT = 86 * MiB, WS_WOUT = 88 * MiB, WS_WGU = 92 * MiB, WS_WDN = 220 * MiB;
constexpr size_t WS_H = 284 * MiB;
constexpr size_t WS_UCAT = 348 * MiB;
constexpr size_t WS_Q = 388 * MiB, WS_K = 420 * MiB, WS_V = 452 * MiB;
constexpr size_t WS_SG = 484 * MiB;
constexpr size_t WS_Z = 612 * MiB;
constexpr size_t WS_ATT = 644 * MiB;
constexpr size_t WS_MIXA = 676 * MiB, WS_MIXED = 740 * MiB;
constexpr size_t WS_SL = 804 * MiB;
constexpr size_t WS_XB = 820 * MiB;
constexpr size_t WS_END = 884 * MiB;
constexpr size_t WS_HMID = WS_UCAT;
constexpr size_t WS_YBUF = WS_SG;
constexpr size_t WS_QRAW = WS_MIXA, WS_KRAW = WS_MIXED;
constexpr size_t MISC_AL = 0;
constexpr size_t MISC_KSUM = 64 * 1024;
constexpr size_t MISC_SEL = 512 * 1024;
constexpr size_t MISC_WR = 1536 * 1024;
constexpr int CW_CNT = 64;
constexpr int CW_CVQ = 1024;
constexpr int CW_BAR = 4096;
constexpr int MAX_LAUNCHES = 64;

constexpr int RING_BYTES = 131072;
constexpr int GTAB_OFF = 160 * 1024 - 9 * 1024;
constexpr int LDSCTL_OFF = 160 * 1024 - 1024;
constexpr int SCRATCH_BYTES = GTAB_OFF;
constexpr int LDS_BYTES = 160 * 1024;

DEVI float bf2f(bf16_t v) { return __uint_as_float((unsigned)v << 16); }
DEVI bf16_t f2bf(float f) { unsigned u = __float_as_uint(f); return (bf16_t)((u + 0x7fffu + ((u >> 16) & 1u)) >> 16); }
DEVI unsigned pk2(float lo, float hi) { return (unsigned)f2bf(lo) | ((unsigned)f2bf(hi) << 16); }
typedef float g_f32x2 __attribute__((ext_vector_type(2))); typedef __bf16 g_bf16x2 __attribute__((ext_vector_type(2)));
DEVI unsigned cvtpk(float lo, float hi) { const g_f32x2 v = {lo, hi}; const g_bf16x2 b = __builtin_convertvector(v, g_bf16x2); return __builtin_bit_cast(unsigned, b); }
DEVI u32x4 pack8(f32x4 a, f32x4 b) { u32x4 w; w.x = cvtpk(a[0], a[1]); w.y = cvtpk(a[2], a[3]); w.z = cvtpk(b[0], b[1]); w.w = cvtpk(b[2], b[3]); return w; }
DEVI f32x4 unpk8(u32x4 w, int half) { const unsigned a = half ? w.z : w.x, b = half ? w.w : w.y; return (f32x4){__uint_as_float(a << 16), __uint_as_float(a & 0xffff0000u), __uint_as_float(b << 16), __uint_as_float(b & 0xffff0000u)}; }
DEVI float sigmoidf_(float x) { return 1.f / (1.f + __expf(-x)); }
DEVI float gelu_tanh(float x) { const float u2 = 1.5957691216057308f * (x + 0.044715f * x * x * x); return x * __builtin_amdgcn_rcpf(1.0f + __expf(-u2)); }
DEVI float xshfl(float v, int o, int lane) { return __int_as_float(__builtin_amdgcn_ds_bpermute((lane ^ o) << 2, __float_as_int(v))); }
DEVI float wave_sum(float v, int lane) {
#pragma unroll
    for (int o = 1; o < 64; o <<= 1) v += xshfl(v, o, lane);
    return v;
}
DEVI float wave_max(float v) {
#pragma unroll
    for (int o = 1; o < 64; o <<= 1) v = fmaxf(v, __shfl_xor(v, o));
    return v;
}

#define XB_TMO      128
#define XB_XCNT(j)  (256  + 64 * (j))
#define XB_XSUB(j)  (1280 + 64 * (j))
#define XB_XGEN(j)  (2304 + 64 * (j))
#define XB_TOP      3328
#define XB_TOPGEN   3392
#define XCD_BAR_WORDS 3456
#define XB_SPIN_CAP (1u << 18)
DEVI unsigned xb_ld(unsigned* p)              { return __hip_atomic_load(p, __ATOMIC_RELAXED, __HIP_MEMORY_SCOPE_AGENT); }
DEVI unsigned xb_add(unsigned* p, unsigned v) { return __hip_atomic_fetch_add(p, v, __ATOMIC_RELAXED, __HIP_MEMORY_SCOPE_AGENT); }
DEVI unsigned xb_xcc_id() { return (unsigned)__builtin_amdgcn_s_getreg((3 << 11) | 20) & 0xFu; }
#define XB_SPIN(cond, bar) do { unsigned _sp = 0; while (cond) { __builtin_amdgcn_s_sleep(1); \
    if ((++_sp & 255u) == 0u) { if (xb_ld(&(bar)[XB_TMO])) break; if (_sp > XB_SPIN_CAP) { atomicAdd(&(bar)[XB_TMO], 1u); break; } } } } while (0)
struct XcdBarrier { unsigned* bar; unsigned x; volatile LAS unsigned* st; };
DEVI XcdBarrier xcd_barrier_post(unsigned* bar, volatile LAS unsigned* st) {
    XcdBarrier b; b.bar = bar; b.x = xb_xcc_id(); b.st = st;
    if (threadIdx.x == 0) (void)xb_add(&bar[XB_XCNT(b.x)], 1u);
    return b;
}
DEVI void xcd_barrier_complete(unsigned* bar, unsigned x, unsigned& nloc, unsigned& nx) {
    const unsigned G = gridDim.x * gridDim.y * gridDim.z;
    unsigned sum, cnt, mine, sp = 0u;
    for (;;) {
        sum = 0u; cnt = 0u; mine = 0u;
#pragma unroll
        for (unsigned j = 0; j < 16; ++j) { const unsigned c = xb_ld(&bar[XB_XCNT(j)]); sum += c; cnt += (c > 0u) ? 1u : 0u; mine = (j == x) ? c : mine; }
        if (sum == G) break;
        __builtin_amdgcn_s_sleep(1);
        if ((++sp & 255u) == 0u) { if (xb_ld(&bar[XB_TMO])) break; if (sp > XB_SPIN_CAP) { atomicAdd(&bar[XB_TMO], 1u); break; } }
    }
    nloc = mine > 0u ? mine : 1u; nx = cnt > 0u ? cnt : 1u;
}
DEVI void xcd_barrier(const XcdBarrier& b) {
    asm volatile("s_waitcnt vmcnt(0)" ::: "memory");
    __syncthreads();
    if (threadIdx.x == 0) {
        unsigned* bar = b.bar;
        __builtin_amdgcn_s_waitcnt(0);
        unsigned nloc = b.st[0], nx = b.st[1];
        if (nloc == 0u) { xcd_barrier_complete(bar, b.x, nloc, nx); b.st[0] = nloc; b.st[1] = nx; }
        const unsigned old = xb_add(&bar[XB_XSUB(b.x)], 1u);
        const unsigned gen = old / nloc;
        if (old + 1u == (gen + 1u) * nloc) {
            __builtin_amdgcn_fence(__ATOMIC_RELEASE, "agent");
            asm volatile("s_waitcnt vmcnt(0)" ::: "memory");
            const unsigned og = xb_add(&bar[XB_TOP], 1u);
            const unsigned tg = og / nx;
            if (og + 1u == (tg + 1u) * nx) xb_add(&bar[XB_TOPGEN], 1u);
            else XB_SPIN(xb_ld(&bar[XB_TOPGEN]) == tg, bar);
            __builtin_amdgcn_fence(__ATOMIC_ACQUIRE, "agent");
            xb_add(&bar[XB_XGEN(b.x)], 1u);
            asm volatile("s_waitcnt vmcnt(0)" ::: "memory");
        } else {
            XB_SPIN(xb_ld(&bar[XB_XGEN(b.x)]) == gen, bar);
            __builtin_amdgcn_fence(__ATOMIC_ACQUIRE, "agent");
            asm volatile("s_waitcnt vmcnt(0)" ::: "memory");
        }
    }
    __syncthreads();
}

struct Args { const float* in[23]; float* out; unsigned char* ws; int ph_lo, ph_hi, li, pad; };
struct Frame { int tid, lane, wave, gw, NGW, gt, NGT, G; LAS unsigned char* lds; };

DEVI void ph_rope_table(const Frame& F, float* rope) {
    for (int idx = F.gt; idx < SEQ * 32; idx += F.NGT) {
        const int s = idx >> 5, i = idx & 31;
        const float inv = powf(10000.0f, -(float)(2 * i) / 64.0f);
        const float ang = (float)s * inv;
        float sn, cs; sincosf(ang, &sn, &cs);
        rope[2 * idx] = cs; rope[2 * idx + 1] = sn;
    }
}
DEVI void s5_tables_item(int l, int g, const float* a_re, const float* a_im, const float* log_dt, const float* b_re, const float* b_im,
                         const float* c_re, const float* c_im, bf16_t* TC, bf16_t* BS, float* AL, LAS float* lds, int tid, int nthr, int part) {
    LAS cf32* pw = (LAS cf32*)lds;
    LAS cf32* Cc = pw + 33 * 64;
    LAS cf32* Bb = Cc + 16 * 64;
    LAS cf32* fp = Bb + 64 * 16;
    LAS float* Kt = (LAS float*)(fp + 64);
    const int lg = l * SSM_G + g;
    const float dt = expf(log_dt[lg]);
    for (int i = tid; i < 33 * 64; i += nthr) {
        const int tau = i >> 6, p = i & 63;
        const float lr = a_re[lg * 64 + p], li = a_im[lg * 64 + p];
        const float mag = expf(lr * dt * (float)tau);
        float sn, cs; sincosf(li * dt * (float)tau, &sn, &cs);
        pw[i] = (cf32){mag * cs, mag * sn};
    }
    for (int i = tid; i < 16 * 64; i += nthr) Cc[i] = (cf32){c_re[(size_t)lg * 1024 + i], c_im[(size_t)lg * 1024 + i]};
    __syncthreads();
    for (int p = tid; p < 64; p += nthr) {
        const float lr = a_re[lg * 64 + p], li = a_im[lg * 64 + p];
        const cf32 ab = pw[64 + p];
        const float den = lr * lr + li * li, nre = ab.x - 1.0f;
        fp[p] = (cf32){(nre * lr + ab.y * li) / den, (ab.y * lr - nre * li) / den};
    }
    __syncthreads();
    for (int i = tid; i < 64 * 16; i += nthr) {
        const cf32 f = fp[i >> 4];
        const float br = b_re[(size_t)lg * 1024 + i], bi = b_im[(size_t)lg * 1024 + i];
        Bb[i] = (cf32){f.x * br - f.y * bi, f.x * bi + f.y * br};
    }
    __syncthreads();
    LAS cf32* Xc = (LAS cf32*)(Kt + 8 * 256);
    for (int i = tid; i < 8 * 16 * 64; i += nthr) { const int tl = i >> 10, co = (i >> 6) & 15, p = i & 63;
        const cf32 c = Cc[co * 64 + p], w = pw[(8 * part + tl) * 64 + p];
        Xc[i] = (cf32){c.x * w.x - c.y * w.y, c.x * w.y + c.y * w.x}; }
    __syncthreads();
    for (int i = tid; i < 8 * 256; i += nthr) {
        const int tl = i >> 8, co = (i >> 4) & 15, ci = i & 15;
        float acc = 0.f;
        for (int p = 0; p < 64; ++p) { const cf32 x = Xc[(tl * 16 + co) * 64 + p], b = Bb[p * 16 + ci]; acc += x.x * b.x - x.y * b.y; }
        Kt[i] = acc;
    }
    __syncthreads();
    for (int i = tid; i < 32 * 8 * 16 * 2; i += nthr) {
        const int t = i >> 8, tl = (i >> 5) & 7, co = (i >> 1) & 15, ch = i & 1, tp = t - (8 * part + tl);
        if (tp < 0) continue;
        const LAS float* kp = Kt + (tl * 16 + co) * 16 + 8 * ch;
        u32x4 o; o.x = pk2(kp[0], kp[1]); o.y = pk2(kp[2], kp[3]); o.z = pk2(kp[4], kp[5]); o.w = pk2(kp[6], kp[7]);
        *(u32x4*)(TC + (size_t)(t * 16 + co) * 640 + tp * 16 + 8 * ch) = o;
    }
    for (int i = tid; i < 128 * 64; i += nthr) {
        const int n = part * 128 + (i >> 6), col = 8 * (i & 63), t = n >> 4;
        if (col >= 16 * (t + 1)) *(u32x4*)(TC + (size_t)n * 640 + col) = (u32x4){0u, 0u, 0u, 0u};
    }
    for (int i = part * 128 * 128 + tid; i < (part + 1) * 128 * 128; i += nthr) {
        const int n = i >> 7, kc = i & 127, t = n >> 4, co = n & 15, p = kc & 63;
        const cf32 c = Cc[co * 64 + p], w = pw[(t + 1) * 64 + p];
        const float xr = c.x * w.x - c.y * w.y, xi = c.x * w.y + c.y * w.x;
        TC[(size_t)n * 640 + 512 + kc] = f2bf(kc < 64 ? xr : -xi);
    }
    for (int i = part * 32 * 512 + tid; i < (part + 1) * 32 * 512; i += nthr) {
        const int row = i >> 9, kk = i & 511, p = row & 63, tp = kk >> 4, ci = kk & 15;
        const cf32 w = pw[(31 - tp) * 64 + p], b = Bb[p * 16 + ci];
        BS[i] = f2bf(row < 64 ? (w.x * b.x - w.y * b.y) : (w.x * b.y + w.y * b.x));
    }
    if (part == 0) for (int i = tid; i < 64; i += nthr) { AL[2 * i] = pw[32 * 64 + i].x; AL[2 * i + 1] = pw[32 * 64 + i].y; }
    __syncthreads();
}

DEVI void ph_rmsnorm(const Frame& F, const float* x, const float* g, bf16_t* out) {
    constexpr int R = 4;
    for (int row0 = F.gw; row0 < NTOK; row0 += R * F.NGW) {
        f32x4 v[R][4];
#pragma unroll
        for (int u = 0; u < R; ++u) { const int row = (row0 + u * F.NGW < NTOK) ? row0 + u * F.NGW : row0; const f32x4* xr = (const f32x4*)(x + (size_t)row * D);
#pragma unroll
            for (int j = 0; j < 2; ++j) { v[u][2 * j] = xr[2 * (F.lane + 64 * j)]; v[u][2 * j + 1] = xr[2 * (F.lane + 64 * j) + 1]; } }
#pragma unroll
        for (int u = 0; u < R; ++u) { const int row = row0 + u * F.NGW; if (row >= NTOK) continue;
            float s = 0.f;
#pragma unroll
            for (int j = 0; j < 4; ++j) s += (v[u][j].x * v[u][j].x + v[u][j].y * v[u][j].y) + (v[u][j].z * v[u][j].z + v[u][j].w * v[u][j].w);
            const float rstd = 1.0f / sqrtf(wave_sum(s, F.lane) * (1.0f / D) + NORM_EPS);
#pragma unroll
            for (int j = 0; j < 2; ++j) { const f32x4 g0 = *((const f32x4*)g + 2 * (F.lane + 64 * j)), g1 = *((const f32x4*)g + 2 * (F.lane + 64 * j) + 1);
                *((u32x4*)(out + (size_t)row * D) + F.lane + 64 * j) = pack8(v[u][2 * j] * rstd * g0, v[u][2 * j + 1] * rstd * g1); } }
    }
}

template <int BMODE, class RowF, class Epi>
DEVI void sg_phase(const Frame& F, int ny, const RowF& rowf, const void* Bv, size_t bstride, int ldb, int K, int nct, int cstep, int off2, const Epi& epi) {
    const int lane = F.lane, r = lane & 31, h = lane >> 5;
    int base = 0;
    for (int y = 0; y < ny; ++y) {
        const int nrows = rowf.nrows(y), nrt = (nrows + 31) / 32, ntile = nrt * nct;
        const float* Bf = (const float*)Bv + (size_t)y * bstride;
        const bf16_t* Bt = (const bf16_t*)Bv + (size_t)y * bstride;
        int first = (F.gw - base % F.NGW + F.NGW) % F.NGW;
        for (int tile = first; tile < ntile; tile += F.NGW) {
            const int rt = tile / nct, ct = tile % nct, c0 = ct * cstep, c1 = c0 + off2;
            const int arow_i = rt * 32 + r;
            const bf16_t* arow = (arow_i < nrows) ? rowf(y, arow_i) : nullptr;
            f32x16 acc0 = {}, acc1 = {};
            for (int k = 0; k < K; k += 16) {
                bf16x8 a = {};
                if (arow) a = *(const bf16x8*)(arow + k + 8 * h);
                bf16x8 b0, b1;
                if (BMODE == 0) {
#pragma unroll
                    for (int j = 0; j < 8; ++j) { b0[j] = (short)f2bf(Bf[(size_t)(k + 8 * h + j) * ldb + c0 + r]); b1[j] = (short)f2bf(Bf[(size_t)(k + 8 * h + j) * ldb + c1 + r]); }
                } else {
                    b0 = *(const bf16x8*)(Bt + (size_t)(c0 + r) * ldb + k + 8 * h);
                    b1 = *(const bf16x8*)(Bt + (size_t)(c1 + r) * ldb + k + 8 * h);
                }
                acc0 = __builtin_amdgcn_mfma_f32_32x32x16_bf16(a, b0, acc0, 0, 0, 0);
                acc1 = __builtin_amdgcn_mfma_f32_32x32x16_bf16(a, b1, acc1, 0, 0, 0);
            }
#pragma unroll
            for (int reg = 0; reg < 16; ++reg) {
                const int row = rt * 32 + (reg & 3) + 8 * (reg >> 2) + 4 * h;
                if (row < nrows) epi(y, row, c0 + r, c1 + r, acc0[reg], acc1[reg]);
            }
        }
        base += ntile;
    }
}

struct RowPlain { const bf16_t* A; int lda; int n; size_t ystride;
    DEVI int nrows(int) const { return n; }
    DEVI const bf16_t* operator()(int y, int r) const { return A + (size_t)y * ystride + (size_t)r * lda; } };

struct EpiG1sPerm;
struct EpiG1s { bf16_t* ucat; float* qraw; float* kraw; bf16_t* v; bf16_t* sg;
    DEVI void one(int row, int c, float a) const {
        if (c < 512) { const int b = row >> 12, s = row & 4095, g = c >> 4, ci = c & 15;
            ucat[((size_t)g * UROWS + b * NCH + (s >> 5)) * UK + (s & 31) * 16 + ci] = f2bf(a); }
        else if (c < 1024) qraw[(size_t)row * 512 + (c - 512)] = a;
        else if (c < 1536) kraw[(size_t)row * 512 + (c - 1024)] = a;
        else if (c < 2048) v[(size_t)row * 512 + (c - 1536)] = f2bf(a);
        else sg[(size_t)row * 2048 + (c - 2048)] = f2bf(sigmoidf_(a));
    }
    DEVI void operator()(int, int row, int c0, int c1, float a0, float a1) const { one(row, c0, a0); one(row, c1, a1); } };

DEVI int g1_unperm(int cp) { const int pn = cp >> 8, tc = cp & 255; if (pn < 2 || pn >= 6) return cp; const int sec = pn < 4 ? 512 : 1024, hh = (pn & 1) * 4 + ((tc >> 5) & 3); return sec + hh * 64 + 32 * (tc >> 7) + (tc & 31); }
#ifndef G1_FIX_MASK
#define G1_FIX_MASK 0
#endif
DEVI bool g1_sel(int c) { const int sec = c < 512 ? 1 : c < 1024 ? 2 : c < 1536 ? 4 : c < 2048 ? 8 : 16; return (G1_FIX_MASK & sec) != 0; }
struct EpiG1sPerm { EpiG1s e; DEVI void operator()(int, int row, int c0, int c1, float a0, float a1) const { e.one(row, g1_unperm(c0), a0); e.one(row, g1_unperm(c1), a1); } };
struct EpiG1sFix { EpiG1s e; DEVI void operator()(int, int row, int c0, int c1, float a0, float a1) const { const int n0 = g1_unperm(c0), n1 = g1_unperm(c1); if (g1_sel(n0)) e.one(row, n0, a0); if (g1_sel(n1)) e.one(row, n1, a1); } };
DEVI void ph_qkpost(const Frame& F, const float* qraw, const float* kraw, const float* qg, const float* kg, const float* rope, bf16_t* Q, bf16_t* K) {
    for (int idx = F.gt; idx < NTOK * 16; idx += F.NGT) {
        const int which = idx & 1, hh = (idx >> 1) & 7, tok = idx >> 4;
        const float* src = (which ? kraw : qraw) + (size_t)tok * 512 + hh * 64;
        const float* gn = which ? kg : qg;
        float x[64]; float ss = 0.f;
#pragma unroll
        for (int i = 0; i < 16; ++i) { const f32x4 t = *((const f32x4*)src + i); x[4 * i] = t.x; x[4 * i + 1] = t.y; x[4 * i + 2] = t.z; x[4 * i + 3] = t.w; ss += (t.x * t.x + t.y * t.y) + (t.z * t.z + t.w * t.w); }
        const float rstd = 1.0f / sqrtf(ss * (1.0f / 64.0f) + NORM_EPS);
        const int s = tok & (SEQ - 1);
        const float sc = which ? 1.0f : QSCALE;
        bf16_t* dst = (which ? K : Q) + (size_t)tok * 512 + hh * 64;
#pragma unroll
        for (int i = 0; i < 32; ++i) {
            const float x1 = x[i] * rstd * gn[i], x2 = x[i + 32] * rstd * gn[i + 32];
            const float cs = rope[(s * 32 + i) * 2], sn = rope[(s * 32 + i) * 2 + 1];
            dst[i] = f2bf((x1 * cs - x2 * sn) * sc);
            dst[i + 32] = f2bf((x2 * cs + x1 * sn) * sc);
        }
    }
}
DEVI void ph_ksum(const Frame& F, const bf16_t* K, float* ksum) {
    const int lane = F.lane, rg = lane >> 3, c = lane & 7;
    for (int w = F.gw; w < BATCH * NH * NBLK; w += F.NGW) {
        const int blk = w & 15, hh = (w >> 4) & 7, b = w >> 7;
        const bf16_t* kp = K + ((size_t)b * SEQ + blk * 256 + rg) * 512 + hh * 64 + c * 8;
        float acc[8];
#pragma unroll
        for (int j = 0; j < 8; ++j) acc[j] = 0.f;
#pragma unroll 8
        for (int i = 0; i < 32; ++i) { const bf16x8 v = *(const bf16x8*)(kp + (size_t)i * 8 * 512);
#pragma unroll
            for (int j = 0; j < 8; ++j) acc[j] += bf2f((bf16_t)v[j]); }
#pragma unroll
        for (int j = 0; j < 8; ++j) { float t = acc[j]; t += xshfl(t, 8, lane); t += xshfl(t, 16, lane); t += xshfl(t, 32, lane); acc[j] = t; }
        if (rg == 0) { float* o = ksum + (size_t)w * 64 + c * 8; *(f32x4*)o = (f32x4){acc[0], acc[1], acc[2], acc[3]}; *(f32x4*)(o + 4) = (f32x4){acc[4], acc[5], acc[6], acc[7]}; }
    }
}

DEVI void ph_attn_simple(const Frame& F, const bf16_t* Q, const bf16_t* K, const bf16_t* V, const float* ksum, bf16_t* O) {
    const int lane = F.lane;
    for (int w = F.gw; w < BATCH * NH * SEQ; w += F.NGW) {
        const int s = w & (SEQ - 1), hh = (w >> 12) & 7, b = w >> 15;
        const int qb = s >> 8;
        const bf16_t* qp = Q + ((size_t)b * SEQ + s) * 512 + hh * 64;
        float q[64];
#pragma unroll
        for (int i = 0; i < 8; ++i) { const bf16x8 t = *((const bf16x8*)qp + i);
#pragma unroll
            for (int j = 0; j < 8; ++j) q[8 * i + j] = bf2f((bf16_t)t[j]); }
        float gsc = -INFINITY;
        if (lane < qb) { const float* km = ksum + ((size_t)(b * 8 + hh) * 16 + lane) * 64; float a = 0.f;
#pragma unroll
            for (int i = 0; i < 64; ++i) a += q[i] * km[i];
            gsc = a; }
        int blks[4]; int nsel = 0;
#pragma unroll
        for (int t = 0; t < 3; ++t) {
            float best = -INFINITY; int bi = -1;
            for (int j = 0; j < 15; ++j) { const float v = __shfl(gsc, j); const bool used = (t > 0 && j == blks[0]) || (t > 1 && j == blks[1]); if (j < qb && !used && v > best) { best = v; bi = j; } }
            blks[t] = bi; if (bi >= 0) nsel = t + 1;
        }
        blks[3] = qb;
        float sc[4][4]; float m = -INFINITY;
#pragma unroll
        for (int t = 0; t < 4; ++t) {
            const bool on = (t == 3) || (t < nsel);
            const int blk = on ? blks[t] : 0;
#pragma unroll
            for (int i = 0; i < 4; ++i) {
                const int key = blk * 256 + lane + 64 * i;
                float a = -INFINITY;
                if (on && (t < 3 || key <= s)) {
                    const bf16_t* kp = K + ((size_t)b * SEQ + key) * 512 + hh * 64; a = 0.f;
#pragma unroll
                    for (int c = 0; c < 8; ++c) { const bf16x8 kk = *((const bf16x8*)kp + c);
#pragma unroll
                        for (int j = 0; j < 8; ++j) a += q[8 * c + j] * bf2f((bf16_t)kk[j]); }
                }
                sc[t][i] = a; m = fmaxf(m, a);
            }
        }
        m = wave_max(m);
        float l = 0.f;
#pragma unroll
        for (int t = 0; t < 4; ++t)
#pragma unroll
            for (int i = 0; i < 4; ++i) { const float p = exp2f(sc[t][i] - m); sc[t][i] = p; l += p; }
        l = wave_sum(l, lane);
        float o = 0.f;
#pragma unroll
        for (int t = 0; t < 4; ++t) {
            const bool on = (t == 3) || (t < nsel);
            if (!on) continue;
            const int blk = blks[t];
#pragma unroll
            for (int i = 0; i < 4; ++i) {
                const float pv = sc[t][i];
                for (int j = 0; j < 64; ++j) {
                    const float p = __shfl(pv, j);
                    const int key = blk * 256 + j + 64 * i;
                    if (p != 0.f) o += p * bf2f(V[((size_t)b * SEQ + key) * 512 + hh * 64 + lane]);
                }
            }
        }
        O[((size_t)b * SEQ + s) * 512 + hh * 64 + lane] = f2bf(o / l);
    }
}

struct EpiS5A { float* sl; DEVI void operator()(int y, int row, int c0, int c1, float a0, float a1) const { float* p = sl + ((size_t)y * UROWS + row) * 128; p[c0] = a0; p[c1] = a1; } };
DEVI void ph_s5_scan(const Frame& F, const float* sl, const float* AL, bf16_t* ucat) {
    for (int idx = F.gt; idx < SSM_G * BATCH * 64; idx += F.NGT) {
        const int p = idx & 63, b = (idx >> 6) & 7, g = idx >> 9;
        const float ar = AL[(g * 64 + p) * 2], ai = AL[(g * 64 + p) * 2 + 1];
        float hr = 0.f, hi = 0.f;
        for (int c = 0; c < NCH; ++c) {
            const size_t row = (size_t)g * UROWS + b * NCH + c;
            ucat[row * UK + 512 + p] = f2bf(hr); ucat[row * UK + 576 + p] = f2bf(hi);
            const float sr = sl[row * 128 + p], si = sl[row * 128 + 64 + p];
            const float nr = ar * hr - ai * hi + sr, ni = ar * hi + ai * hr + si; hr = nr; hi = ni;
        }
    }
}
struct EpiS5C { const bf16_t* ucat; const float* dskip; bf16_t* z;
    DEVI void one(int g, int row, int n, float a) const {
        const int t = n >> 4, co = n & 15, b = row >> 7, c = row & 127;
        const float u = bf2f(ucat[((size_t)g * UROWS + row) * UK + n]);
        const float y = a + dskip[g * 16 + co] * u;
        z[((size_t)b * SEQ + c * CHL + t) * 512 + g * 16 + co] = f2bf(gelu_tanh(y));
    }
    DEVI void operator()(int y, int row, int c0, int c1, float a0, float a1) const { one(y, row, c0, a0); one(y, row, c1, a1); } };

struct EpiG3s { const bf16_t* sg; bf16_t* mixa;
    DEVI void operator()(int, int row, int c0, int c1, float val, float gate) const { mixa[(size_t)row * 1024 + c0] = f2bf(bf2f(sg[(size_t)row * 2048 + c0]) * val * sigmoidf_(gate)); } };
struct EpiG4s { const bf16_t* sg; const bf16_t* mixa; bf16_t* mixed;
    DEVI void one(int row, int c, float a) const { mixed[(size_t)row * 1024 + c] = f2bf(bf2f(mixa[(size_t)row * 1024 + c]) + bf2f(sg[(size_t)row * 2048 + 1024 + c]) * a); }
    DEVI void operator()(int, int row, int c0, int c1, float a0, float a1) const { one(row, c0, a0); one(row, c1, a1); } };
struct EpiG5s { const float* xin; float* xout;
    DEVI void operator()(int, int row, int c0, int c1, float a0, float a1) const { xout[(size_t)row * 1024 + c0] = xin[(size_t)row * 1024 + c0] + a0; xout[(size_t)row * 1024 + c1] = xin[(size_t)row * 1024 + c1] + a1; } };

DEVI void ph_norm_router(const Frame& F, const float* x, const float* g, const float* wg, const float* bg, const float* we, const float* be,
                         bf16_t* h2, unsigned* cnt, int* list, unsigned* rec) {
    const int lane = F.lane;
    for (int row = F.gw; row < NTOK; row += F.NGW) {
        const f32x4* xr = (const f32x4*)(x + (size_t)row * D) + lane;
        f32x4 v[4]; float s = 0.f;
#pragma unroll
        for (int j = 0; j < 4; ++j) { v[j] = xr[64 * j]; s += (v[j].x * v[j].x + v[j].y * v[j].y) + (v[j].z * v[j].z + v[j].w * v[j].w); }
        const float rstd = 1.0f / sqrtf(wave_sum(s, lane) * (1.0f / D) + NORM_EPS);
        float acc[36];
#pragma unroll
        for (int o = 0; o < 36; ++o) acc[o] = 0.f;
#pragma unroll
        for (int j = 0; j < 4; ++j) {
            const f32x4 gg = *((const f32x4*)g + lane + 64 * j);
            const float hv[4] = {v[j].x * rstd * gg.x, v[j].y * rstd * gg.y, v[j].z * rstd * gg.z, v[j].w * rstd * gg.w};
            u32x2 o; o.x = pk2(hv[0], hv[1]); o.y = pk2(hv[2], hv[3]);
            *((u32x2*)(h2 + (size_t)row * D) + lane + 64 * j) = o;
#pragma unroll
            for (int e = 0; e < 4; ++e) {
                const int k = 4 * lane + 256 * j + e;
                const f32x4 w4 = *(const f32x4*)(wg + (size_t)k * 4);
                acc[0] += hv[e] * w4.x; acc[1] += hv[e] * w4.y; acc[2] += hv[e] * w4.z; acc[3] += hv[e] * w4.w;
#pragma unroll
                for (int q = 0; q < 8; ++q) { const f32x4 w = *(const f32x4*)(we + (size_t)k * 32 + 4 * q);
                    acc[4 + 4 * q] += hv[e] * w.x; acc[5 + 4 * q] += hv[e] * w.y; acc[6 + 4 * q] += hv[e] * w.z; acc[7 + 4 * q] += hv[e] * w.w; }
            }
        }
#pragma unroll
        for (int o = 0; o < 36; ++o) acc[o] = wave_sum(acc[o], lane);
        if (lane == 0) {
            float gl[4]; int gt = 0; float gm = -INFINITY;
#pragma unroll
            for (int i = 0; i < 4; ++i) { gl[i] = acc[i] + bg[i]; if (gl[i] > gm) { gm = gl[i]; gt = i; } }
            float gs = 0.f;
#pragma unroll
            for (int i = 0; i < 4; ++i) gs += __expf(gl[i] - gm);
            const float pg = 1.0f / gs;
            float el[8]; float em = -INFINITY;
#pragma unroll
            for (int i = 0; i < 8; ++i) { float t = 0.f;
#pragma unroll
                for (int gq = 0; gq < 4; ++gq) t = (gq == gt) ? acc[4 + gq * 8 + i] + be[gq * 8 + i] : t;
                el[i] = t; em = fmaxf(em, t); }
            int i1 = 0; float v1 = -INFINITY;
#pragma unroll
            for (int i = 0; i < 8; ++i) if (el[i] > v1) { v1 = el[i]; i1 = i; }
            int i2 = 0; float v2 = -INFINITY;
#pragma unroll
            for (int i = 0; i < 8; ++i) if (i != i1 && el[i] > v2) { v2 = el[i]; i2 = i; }
            const float p1 = __expf(v1 - em), p2 = __expf(v2 - em);
            const float w0 = pg * p1 / (p1 + p2), w1 = pg * p2 / (p1 + p2);
            const int e0 = gt * 8 + i1, e1 = gt * 8 + i2;
            const unsigned pos0 = atomicAdd(cnt + e0, 1u), pos1 = atomicAdd(cnt + e1, 1u);
            list[(size_t)e0 * LIST_CAP + pos0] = row; list[(size_t)e1 * LIST_CAP + pos1] = row;
            unsigned* rp = rec + (size_t)row * 8;
            rp[0] = (unsigned)e0; rp[1] = (unsigned)e1; rp[2] = pos0; rp[3] = pos1; rp[4] = __float_as_uint(w0); rp[5] = __float_as_uint(w1);
        }
    }
}
DEVI void expert_prefix(const Frame& F, const unsigned* cnt, volatile LAS int* out, int mul) {
    if (F.wave == 0) { const int lane = F.lane;
        int c = (lane < NEXP) ? (int)((__hip_atomic_load(cnt + (lane & 31), __ATOMIC_RELAXED, __HIP_MEMORY_SCOPE_AGENT) + 255u) / 256u) : 0;
        int s = c;
#pragma unroll
        for (int d = 1; d < 32; d <<= 1) { const int t = __builtin_amdgcn_ds_bpermute(((lane - d) & 63) << 2, s); if (lane >= d) s += t; }
        if (lane < NEXP) out[lane] = (s - c) * mul;
        if (lane == NEXP - 1) out[NEXP] = s * mul; }
    __syncthreads();
}
DEVI void compute_pstart(const Frame& F, const unsigned* cnt, volatile LAS int* pstart) { expert_prefix(F, cnt, pstart, 256); }
struct RowM1 { const bf16_t* h2; const int* list; const unsigned* cnt;
    DEVI int nrows(int y) const { return (int)cnt[y]; }
    DEVI const bf16_t* operator()(int y, int r) const { return h2 + (size_t)list[(size_t)y * LIST_CAP + r] * D; } };
struct EpiM1s { bf16_t* hmid; volatile LAS int* pstart;
    DEVI void operator()(int y, int row, int c0, int c1, float gt, float up) const { hmid[((size_t)pstart[y] + row) * 512 + c0] = f2bf(gt * sigmoidf_(gt) * up); } };
struct RowM2 { const bf16_t* hmid; volatile LAS int* pstart; const unsigned* cnt;
    DEVI int nrows(int y) const { return (int)cnt[y]; }
    DEVI const bf16_t* operator()(int y, int r) const { return hmid + ((size_t)pstart[y] + r) * 512; } };
struct EpiM2s { bf16_t* ybuf; volatile LAS int* pstart;
    DEVI void operator()(int y, int row, int c0, int c1, float a0, float a1) const { bf16_t* p = ybuf + ((size_t)pstart[y] + row) * 1024; p[c0] = f2bf(a0); p[c1] = f2bf(a1); } };
template <bool LAST>
DEVI void ph_combine(const Frame& F, bf16_t* xb, float* out, const bf16_t* ybuf, const unsigned* rec, volatile LAS int* pstart, const float* gnext, bf16_t* hout) {
    const int lane = F.lane;
    u32x4 ra[2]; u32x2 rb[2];
#pragma unroll
    for (int u = 0; u < 2; ++u) { const int rr = (F.gw + u * F.NGW < NTOK) ? F.gw + u * F.NGW : 0; ra[u] = *(const u32x4*)(rec + (size_t)rr * 8); rb[u] = *(const u32x2*)(rec + (size_t)rr * 8 + 4); }
    for (int row0 = F.gw; row0 < NTOK; row0 += 2 * F.NGW) {
        int rw[2]; const bf16_t* y0[2]; const bf16_t* y1[2]; float w0[2], w1[2]; bool on[2];
#pragma unroll
        for (int u = 0; u < 2; ++u) { rw[u] = row0 + u * F.NGW; on[u] = rw[u] < NTOK;
            y0[u] = ybuf + ((size_t)pstart[(int)ra[u].x] + ra[u].z) * 1024; y1[u] = ybuf + ((size_t)pstart[(int)ra[u].y] + ra[u].w) * 1024;
            w0[u] = __uint_as_float(rb[u].x); w1[u] = __uint_as_float(rb[u].y); }
        u32x4 xw[2][2], ya[2][2], yb[2][2];
#pragma unroll
        for (int u = 0; u < 2; ++u)
#pragma unroll
            for (int j = 0; j < 2; ++j) { const int rr = on[u] ? rw[u] : row0;
                xw[u][j] = *((const u32x4*)(xb + (size_t)rr * D) + lane + 64 * j); ya[u][j] = *((const u32x4*)y0[u] + lane + 64 * j); yb[u][j] = *((const u32x4*)y1[u] + lane + 64 * j); }
#pragma unroll
        for (int u = 0; u < 2; ++u) { const int nr = row0 + (2 + u) * F.NGW, rr = nr < NTOK ? nr : 0; ra[u] = *(const u32x4*)(rec + (size_t)rr * 8); rb[u] = *(const u32x2*)(rec + (size_t)rr * 8 + 4); }
#pragma unroll
        for (int u = 0; u < 2; ++u) {
            if (!on[u]) continue;
            const int row = rw[u];
            f32x4 v[2][2]; float s = 0.f;
#pragma unroll
            for (int j = 0; j < 2; ++j) {
#pragma unroll
                for (int hf = 0; hf < 2; ++hf) { v[j][hf] = unpk8(xw[u][j], hf) + unpk8(ya[u][j], hf) * w0[u] + unpk8(yb[u][j], hf) * w1[u];
                    s += (v[j][hf][0] * v[j][hf][0] + v[j][hf][1] * v[j][hf][1]) + (v[j][hf][2] * v[j][hf][2] + v[j][hf][3] * v[j][hf][3]); }
                if (LAST) { f32x4* op = (f32x4*)(out + (size_t)row * D) + 2 * (lane + 64 * j); op[0] = v[j][0]; op[1] = v[j][1]; }
                else *((u32x4*)(xb + (size_t)row * D) + lane + 64 * j) = pack8(v[j][0], v[j][1]);
            }
            if (!LAST) {
                const float rstd = 1.0f / sqrtf(wave_sum(s, lane) * (1.0f / D) + NORM_EPS);
#pragma unroll
                for (int j = 0; j < 2; ++j) { const f32x4 g0 = *((const f32x4*)gnext + 2 * (lane + 64 * j)), g1 = *((const f32x4*)gnext + 2 * (lane + 64 * j) + 1);
                    *((u32x4*)(hout + (size_t)row * D) + lane + 64 * j) = pack8(v[j][0] * rstd * g0, v[j][1] * rstd * g1); }
            }
        }
    }
}

namespace pg8 {
constexpr int BM = 256, BK = 64, HALF = 128, HTB = HALF * BK * 2  , STAGE_BYTES = 8 * HTB;
__host__ __device__ __forceinline__ int lds_byte(int r, int c) { const int st = (r >> 4) * 2 + (c >> 5), rr = r & 15, cc = c & 31, ob = rr * 64 + cc * 2; return st * 1024 + (ob ^ (((ob >> 9) & 1) << 5)); }
__host__ __device__ __forceinline__ void stage_rc(int b, int& R, int& C) { const int st = b / 1024, sb = b % 1024, swz = sb ^ (((sb >> 9) & 1) << 5); R = (st >> 1) * 16 + swz / 64; C = (st & 1) * 32 + (swz % 64) / 2; }
__host__ __device__ __forceinline__ int perm32(int rho) { const int n = rho >> 4, i = rho & 15; return 8 * (i >> 2) + 4 * n + (i & 3); }

struct Unit { int pm, pn, g, ui; };
struct Gemm { const bf16_t* A; const bf16_t* Bt; int lda, ldb, K; size_t ags, bgs;
    DEVI const char* abase(const Unit& u) const { return (const char*)(A + (size_t)u.g * ags + (size_t)u.pm * BM * lda); }
    DEVI const char* bbase(const Unit& u) const { return (const char*)(Bt + (size_t)u.g * bgs + (size_t)u.pn * BM * ldb); } };
struct NoGather { static constexpr bool ON = false; DEVI unsigned rowoff(const Unit&, int) const { return 0u; } };
struct LdsGather { static constexpr bool ON = true; const LAS unsigned* tab;
    DEVI unsigned rowoff(const Unit& u, int r) const { return tab[u.ui * 256 + r]; } };

typedef float f32x2_t __attribute__((ext_vector_type(2))); typedef __bf16 bf16x2_t __attribute__((ext_vector_type(2)));
DEVI unsigned cvt_pk_bf16(float lo, float hi) { const f32x2_t v = {lo, hi}; const bf16x2_t b = __builtin_convertvector(v, bf16x2_t); return __builtin_bit_cast(unsigned, b); }

template <class Epi, class Sched, class GA, bool ALIGN_EPI>
DEVI void gemm_phase(LAS unsigned char* lds, const Gemm g, const Sched& S, const Epi& E, const GA& ga, int tid_in) {
    const int tid = tid_in, wid = __builtin_amdgcn_readfirstlane(tid >> 6), lane = tid & 63, wr = wid >> 2, wc = wid & 3, fr = lane & 15, fq = lane >> 4;
    const int K = g.K, nt = K / BK;
    unsigned voffA[2], voffB[2]; int RA[2]; unsigned CA[2];
#pragma unroll
    for (int i = 0; i < 2; ++i) { int R, C; stage_rc(tid * 16 + i * 8192, R, C); const int Rb = Epi::PERM ? ((R & ~31) + perm32(R & 31)) : R;
        voffA[i] = (unsigned)(R * g.lda + C) * 2u; voffB[i] = (unsigned)(Rb * g.ldb + C) * 2u; RA[i] = R; CA[i] = (unsigned)C * 2u; }
    const size_t kstep = (size_t)(BK * 2);
    const size_t hstepA = GA::ON ? (size_t)0 : (size_t)HALF * g.lda * 2, hstepB = (size_t)HALF * g.ldb * 2;
    const unsigned ldsw = (unsigned)wid * 1024u;
    const int aoff = lds_byte(wr * 64 + fr, fq * 8), boff = lds_byte(wc * 32 + fr, fq * 8);
#define PG8_SA(b, h) (((b) * 2 + (h)) * HTB)
#define PG8_SB(b, h) ((4 + (b) * 2 + (h)) * HTB)
#define PG8_STAGE2(bufoff, gbase, v0, v1) do { \
        __builtin_amdgcn_global_load_lds((const unsigned*)((const char*)(gbase) + (v0)), (LAS unsigned*)(lds + (bufoff) + ldsw), 16, 0, 0); \
        __builtin_amdgcn_global_load_lds((const unsigned*)((const char*)(gbase) + (v1)), (LAS unsigned*)(lds + (bufoff) + ldsw + 8192), 16, 0, 0); } while (0)
#define PG8_STAGE_B(b, h, bptr) PG8_STAGE2(PG8_SB(b, h), (bptr) + (h) * hstepB, voffB[0], voffB[1])
#define PG8_STAGE_A(b, h, aptr, NX) do { if constexpr (GA::ON) { const unsigned _o0 = (NX) ? vgn[h][0] : vgc[h][0], _o1 = (NX) ? vgn[h][1] : vgc[h][1]; PG8_STAGE2(PG8_SA(b, h), (aptr), _o0, _o1); } \
        else { PG8_STAGE2(PG8_SA(b, h), (aptr) + (h) * hstepA, voffA[0], voffA[1]); } } while (0)
#define PG8_LDA(dst, b, h) do { _Pragma("unroll") for (int m = 0; m < 4; ++m) _Pragma("unroll") for (int k = 0; k < 2; ++k) dst[m][k] = *(const LAS bf16x8*)(lds + PG8_SA(b, h) + aoff + m * 2048 + k * 1024); } while (0)
#define PG8_LDB(dst, b, h) do { _Pragma("unroll") for (int n = 0; n < 2; ++n) _Pragma("unroll") for (int k = 0; k < 2; ++k) dst[n][k] = *(const LAS bf16x8*)(lds + PG8_SB(b, h) + boff + n * 2048 + k * 1024); } while (0)
#define PG8_MMA(ai, bj, At, Bt) do { __builtin_amdgcn_s_setprio(1); _Pragma("unroll") for (int m = 0; m < 4; ++m) _Pragma("unroll") for (int n = 0; n < 2; ++n) _Pragma("unroll") for (int k = 0; k < 2; ++k) \
        acc[ai][bj][m][n] = __builtin_amdgcn_mfma_f32_16x16x32_bf16(Bt[n][k], At[m][k], acc[ai][bj][m][n], 0, 0, 0); __builtin_amdgcn_s_setprio(0); } while (0)
#define PG8_WAIT_V(n) asm volatile("s_waitcnt vmcnt(" #n ")" ::: "memory")
#define PG8_WAIT_L(n) asm volatile("s_waitcnt lgkmcnt(" #n ")" ::: "memory")
#define PG8_BAR __builtin_amdgcn_s_barrier()
#define PG8_SCHED __builtin_amdgcn_sched_barrier(0)
    Unit cur, nxt; int ui = 0;
    if (!S.next(0, cur)) return;
    f32x4 acc[2][2][4][2];
#pragma unroll
    for (int a = 0; a < 2; ++a)
#pragma unroll
        for (int b = 0; b < 2; ++b)
#pragma unroll
            for (int m = 0; m < 4; ++m)
#pragma unroll
                for (int n = 0; n < 2; ++n) acc[a][b][m][n] = (f32x4){0.f, 0.f, 0.f, 0.f};
    bf16x8 At[4][2], B0[2][2], B1[2][2];
    unsigned vgc[2][2] = {{0u, 0u}, {0u, 0u}}, vgn[2][2] = {{0u, 0u}, {0u, 0u}};
    if constexpr (GA::ON) {
#pragma unroll
        for (int h = 0; h < 2; ++h)
#pragma unroll
            for (int i = 0; i < 2; ++i) vgc[h][i] = ga.rowoff(cur, h * HALF + RA[i]) + CA[i];
    }
    const char* cA = GA::ON ? (const char*)g.A : g.abase(cur); const char* cB = g.bbase(cur);
    S.a_ready(cur);
    PG8_STAGE_B(0, 0, cB); PG8_STAGE_B(0, 1, cB); PG8_STAGE_A(0, 0, cA, false); PG8_STAGE_A(0, 1, cA, false);
    if (wr == 1) PG8_BAR;
    PG8_WAIT_V(2); PG8_BAR;
    PG8_STAGE_B(1, 0, cB + kstep); PG8_STAGE_A(1, 0, cA + kstep, false); PG8_STAGE_B(1, 1, cB + kstep);
    PG8_WAIT_V(6); PG8_BAR;
    for (;;) {
        const bool has_next = S.next(ui + 1, nxt);
        const char* nA = has_next ? (GA::ON ? (const char*)g.A : g.abase(nxt)) : cA; const char* nB = has_next ? g.bbase(nxt) : cB;
        if constexpr (GA::ON) {
#pragma unroll
            for (int h = 0; h < 2; ++h)
#pragma unroll
                for (int i = 0; i < 2; ++i) vgn[h][i] = has_next ? ga.rowoff(nxt, h * HALF + RA[i]) + CA[i] : vgc[h][i];
            asm volatile("" : "+v"(vgn[0][0]), "+v"(vgn[0][1]), "+v"(vgn[1][0]), "+v"(vgn[1][1]));
        }
        for (int t = 0; t < nt; t += 2) {
            const bool last = (t == nt - 2);
            const char* a1 = cA + (size_t)(t + 1) * kstep;
            const char* a2 = last ? nA : cA + (size_t)(t + 2) * kstep; const char* b2 = last ? nB : cB + (size_t)(t + 2) * kstep;
            const char* a3 = a2 + kstep; const char* b3 = b2 + kstep;
            if (last && has_next) S.a_ready(nxt);
            PG8_LDB(B0, 0, 0); PG8_LDB(B1, 0, 1); PG8_SCHED; PG8_LDA(At, 0, 0); PG8_STAGE_A(1, 1, a1, false);
            PG8_WAIT_V(8); PG8_WAIT_L(0); PG8_BAR; PG8_MMA(0, 0, At, B0); PG8_MMA(0, 1, At, B1); PG8_BAR; PG8_SCHED;
            PG8_LDA(At, 0, 1); PG8_STAGE_B(0, 0, b2); PG8_STAGE_B(0, 1, b2); PG8_STAGE_A(0, 0, a2, last);
            PG8_WAIT_V(8); PG8_WAIT_L(0); PG8_BAR; PG8_MMA(1, 0, At, B0); PG8_MMA(1, 1, At, B1); PG8_BAR; PG8_SCHED;
            PG8_LDB(B0, 1, 0); PG8_LDB(B1, 1, 1); PG8_SCHED; PG8_LDA(At, 1, 0); PG8_STAGE_A(0, 1, a2, last);
            PG8_WAIT_V(8); PG8_WAIT_L(0); PG8_BAR; PG8_MMA(0, 0, At, B0); PG8_MMA(0, 1, At, B1); PG8_BAR; PG8_SCHED;
            PG8_LDA(At, 1, 1); PG8_STAGE_B(1, 0, b3); PG8_STAGE_B(1, 1, b3); PG8_STAGE_A(1, 0, a3, last);
            PG8_WAIT_V(8); PG8_WAIT_L(0); PG8_BAR; PG8_MMA(1, 0, At, B0); PG8_MMA(1, 1, At, B1); PG8_BAR; PG8_SCHED;
        }
        if constexpr (ALIGN_EPI) { if (wr == 0) PG8_BAR; }
        if constexpr (!Epi::AFTER_DRAIN) { E(acc, cur, wr, wc, fr, fq); S.done(cur); }
        if (!has_next) break;
#pragma unroll
        for (int a = 0; a < 2; ++a)
#pragma unroll
            for (int b = 0; b < 2; ++b)
#pragma unroll
                for (int m = 0; m < 4; ++m)
#pragma unroll
                    for (int n = 0; n < 2; ++n) acc[a][b][m][n] = (f32x4){0.f, 0.f, 0.f, 0.f};
        cur = nxt; cA = nA; cB = nB; ++ui;
        if constexpr (GA::ON) {
#pragma unroll
            for (int h = 0; h < 2; ++h)
#pragma unroll
                for (int i = 0; i < 2; ++i) vgc[h][i] = vgn[h][i];
        }
        if constexpr (ALIGN_EPI) { if (wr == 1) PG8_BAR; }
    }
    PG8_WAIT_V(0);
    if constexpr (!ALIGN_EPI) { if (wr == 0) PG8_BAR; }
    PG8_BAR;
    if constexpr (Epi::AFTER_DRAIN) { E.fused(acc, cur, wr, wc, fr, fq, lds, wid, lane); S.done(cur); }
#undef PG8_SA
#undef PG8_SB
#undef PG8_STAGE2
#undef PG8_STAGE_A
#undef PG8_STAGE_B
#undef PG8_LDA
#undef PG8_LDB
#undef PG8_MMA
#undef PG8_WAIT_V
#undef PG8_WAIT_L
#undef PG8_BAR
#undef PG8_SCHED
}
}

namespace pg8 {
DEVI float fsig(float x) { return __builtin_amdgcn_rcpf(1.0f + __expf(-x)); }
DEVI f32x4 unpk_lo(u32x4 w, int half) {
    const unsigned a = half ? w.z : w.x, b = half ? w.w : w.y;
    return (f32x4){__uint_as_float(a << 16), __uint_as_float(a & 0xffff0000u), __uint_as_float(b << 16), __uint_as_float(b & 0xffff0000u)}; }
DEVI u32x4 pk8(f32x4 v0, f32x4 v1) { u32x4 w; w.x = cvt_pk_bf16(v0[0], v0[1]); w.y = cvt_pk_bf16(v0[2], v0[3]); w.z = cvt_pk_bf16(v1[0], v1[1]); w.w = cvt_pk_bf16(v1[2], v1[3]); return w; }

struct StaticOrder {
    int nM, nN, nwg, G, c;
    DEVI void init(int M, int N, int G_, int c_) { nM = M / BM; nN = N / BM; nwg = nM * nN; G = G_; c = c_; }
    DEVI bool next(int i, Unit& u) const {
        const long L = (long)i * G + c; if (L >= nwg) return false;
        int wgid = (int)L; { const int q = nwg / 8, r = nwg % 8, xcd = wgid % 8, off = wgid / 8; wgid = (xcd < r ? xcd * (q + 1) : r * (q + 1) + (xcd - r) * q) + off; }
        const int nig = 8 * nN, gid = wgid / nig, fm = gid * 8, gsz = (nM - fm) < 8 ? (nM - fm) : 8;
        u.pm = fm + ((wgid % nig) % gsz); u.pn = (wgid % nig) / gsz; u.g = 0; u.ui = i; return true;
    }
    DEVI void a_ready(const Unit&) const {}
    DEVI void done(const Unit&) const {}
};
struct OrderS5A { int G, c; DEVI bool next(int i, Unit& u) const { const int U = i * G + c; if (U >= SSM_G * 4) return false; u.g = U >> 2; u.pm = U & 3; u.pn = 0; u.ui = i; return true; }
    DEVI void a_ready(const Unit&) const {} DEVI void done(const Unit&) const {} };
struct OrderS5C { int G, c; DEVI bool next(int i, Unit& u) const { const int U = i * G + c; if (U >= SSM_G * 8) return false; u.g = U >> 3; u.pm = (U >> 1) & 3; u.pn = U & 1; u.ui = i; return true; }
    DEVI void a_ready(const Unit&) const {} DEVI void done(const Unit&) const {} };
struct OrderMoE { int G, v; const volatile LAS int* tstart;
    DEVI bool next(int i, Unit& u) const { const int U = i * G + v, rt = U >> 2; if (rt >= tstart[NEXP]) return false;
        int e = 0;
#pragma unroll 1
        for (int q = 1; q < NEXP; ++q) e = (rt >= tstart[q]) ? q : e;
        u.pm = rt; u.pn = U & 3; u.g = e; u.ui = i; return true; }
    DEVI void a_ready(const Unit&) const {} DEVI void done(const Unit&) const {} };

template <bool F32IN> struct EpiResBf16 { static constexpr bool PERM = true, AFTER_DRAIN = false; const float* xin32; bf16_t* xb; float* ssq;
    DEVI void operator()(const f32x4 (&acc)[2][2][4][2], const Unit& u, int wr, int wc, int fr, int fq) const {
        const int row0 = u.pm * BM + wr * 64 + fr, col0 = u.pn * BM + wc * 32 + 8 * fq;
        float sq[2][4] = {{0.f, 0.f, 0.f, 0.f}, {0.f, 0.f, 0.f, 0.f}};
#pragma unroll
        for (int ai = 0; ai < 2; ++ai)
#pragma unroll
            for (int m = 0; m < 4; ++m) { const size_t off = (size_t)(row0 + ai * HALF + m * 16) * D + col0;
#pragma unroll
                for (int bj = 0; bj < 2; ++bj) { f32x4 a0, a1;
                    if (F32IN) { a0 = *(const f32x4*)(xin32 + off + bj * HALF); a1 = *(const f32x4*)(xin32 + off + bj * HALF + 4); }
                    else { const u32x4 w = *(const u32x4*)(xb + off + bj * HALF); a0 = unpk_lo(w, 0); a1 = unpk_lo(w, 1); }
                    const f32x4 o0 = a0 + acc[ai][bj][m][0], o1 = a1 + acc[ai][bj][m][1];
                    sq[ai][m] += (o0[0] * o0[0] + o0[1] * o0[1]) + (o0[2] * o0[2] + o0[3] * o0[3]) + (o1[0] * o1[0] + o1[1] * o1[1]) + (o1[2] * o1[2] + o1[3] * o1[3]);
                    *(u32x4*)(xb + off + bj * HALF) = pk8(o0, o1); }
                if (m == 3) asm volatile("" ::: "memory");     }
#pragma unroll
        for (int ai = 0; ai < 2; ++ai)
#pragma unroll
            for (int m = 0; m < 4; ++m) { float s = sq[ai][m]; s += xshfl(s, 16, fq * 16 + fr); s += xshfl(s, 32, fq * 16 + fr);
                if (fq == 0) ssq[(size_t)(row0 + ai * HALF + m * 16) * 16 + u.pn * 4 + wc] = s; }
    } };
struct EpiMix { static constexpr bool PERM = true, AFTER_DRAIN = false; const bf16_t* sg; const bf16_t* mixa; bf16_t* mixed;
    DEVI void operator()(const f32x4 (&acc)[2][2][4][2], const Unit& u, int wr, int wc, int fr, int fq) const {
        const int row0 = u.pm * BM + wr * 64 + fr, col0 = u.pn * BM + wc * 32 + 8 * fq;
#pragma unroll
        for (int ai = 0; ai < 2; ++ai)
#pragma unroll
            for (int m = 0; m < 4; ++m) { const size_t row = (size_t)(row0 + ai * HALF + m * 16);
#pragma unroll
                for (int bj = 0; bj < 2; ++bj) { const int col = col0 + bj * HALF;
                    const u32x4 a = *(const u32x4*)(mixa + row * 1024 + col), s = *(const u32x4*)(sg + row * 2048 + 1024 + col);
                    const f32x4 o0 = unpk_lo(a, 0) + unpk_lo(s, 0) * acc[ai][bj][m][0], o1 = unpk_lo(a, 1) + unpk_lo(s, 1) * acc[ai][bj][m][1];
                    *(u32x4*)(mixed + row * 1024 + col) = pk8(o0, o1); }
                if (m == 3) asm volatile("" ::: "memory");     }
    } };
struct EpiGlu { static constexpr bool PERM = true, AFTER_DRAIN = false; const bf16_t* sg; bf16_t* mixa;
    DEVI void operator()(const f32x4 (&acc)[2][2][4][2], const Unit& u, int wr, int wc, int fr, int fq) const {
        const int row0 = u.pm * BM + wr * 64 + fr, col = u.pn * HALF + wc * 32 + 8 * fq;
#pragma unroll
        for (int ai = 0; ai < 2; ++ai)
#pragma unroll
            for (int m = 0; m < 4; ++m) { const size_t row = (size_t)(row0 + ai * HALF + m * 16);
                const u32x4 s = *(const u32x4*)(sg + row * 2048 + col);
                f32x4 o[2];
#pragma unroll
                for (int n = 0; n < 2; ++n) { const f32x4 v = acc[ai][0][m][n], gt = acc[ai][1][m][n], sv = unpk_lo(s, n);
                    o[n] = (f32x4){sv[0] * v[0] * fsig(gt[0]), sv[1] * v[1] * fsig(gt[1]), sv[2] * v[2] * fsig(gt[2]), sv[3] * v[3] * fsig(gt[3])}; }
                *(u32x4*)(mixa + row * 1024 + col) = pk8(o[0], o[1]);
                if (m == 3) asm volatile("" ::: "memory");     }
    } };
struct EpiSwiglu { static constexpr bool PERM = true, AFTER_DRAIN = false; bf16_t* hmid;
    DEVI void operator()(const f32x4 (&acc)[2][2][4][2], const Unit& u, int wr, int wc, int fr, int fq) const {
        const int row0 = u.pm * BM + wr * 64 + fr, col = u.pn * HALF + wc * 32 + 8 * fq;
#pragma unroll
        for (int ai = 0; ai < 2; ++ai)
#pragma unroll
            for (int m = 0; m < 4; ++m) { const size_t row = (size_t)(row0 + ai * HALF + m * 16);
                f32x4 o[2];
#pragma unroll
                for (int n = 0; n < 2; ++n) { const f32x4 gt = acc[ai][0][m][n], up = acc[ai][1][m][n];
                    o[n] = (f32x4){gt[0] * fsig(gt[0]) * up[0], gt[1] * fsig(gt[1]) * up[1], gt[2] * fsig(gt[2]) * up[2], gt[3] * fsig(gt[3]) * up[3]}; }
                *(u32x4*)(hmid + row * 512 + col) = pk8(o[0], o[1]); }
    } };
struct EpiStoreBf16 { static constexpr bool PERM = true, AFTER_DRAIN = false; bf16_t* out; int ldc;
    DEVI void operator()(const f32x4 (&acc)[2][2][4][2], const Unit& u, int wr, int wc, int fr, int fq) const {
        const int row0 = u.pm * BM + wr * 64 + fr, col0 = u.pn * BM + wc * 32 + 8 * fq;
#pragma unroll
        for (int ai = 0; ai < 2; ++ai)
#pragma unroll
            for (int m = 0; m < 4; ++m) { bf16_t* rp = out + (size_t)(row0 + ai * HALF + m * 16) * ldc + col0;
#pragma unroll
                for (int bj = 0; bj < 2; ++bj) *(u32x4*)(rp + bj * HALF) = pk8(acc[ai][bj][m][0], acc[ai][bj][m][1]); }
    } };
struct EpiS5Cm { static constexpr bool PERM = true, AFTER_DRAIN = false; const bf16_t* ucat; const float* dskip; bf16_t* z;
    DEVI void operator()(const f32x4 (&acc)[2][2][4][2], const Unit& u, int wr, int wc, int fr, int fq) const {
        const int g = u.g, row0 = u.pm * BM + wr * 64 + fr, col0 = u.pn * BM + wc * 32 + 8 * fq;
        const int co0 = col0 & 15;
        const f32x4 d0 = *(const f32x4*)(dskip + g * 16 + co0), d1 = *(const f32x4*)(dskip + g * 16 + co0 + 4);
#pragma unroll
        for (int ai = 0; ai < 2; ++ai)
#pragma unroll
            for (int m = 0; m < 4; ++m) { const int row = row0 + ai * HALF + m * 16, b = row >> 7, c = row & 127;
#pragma unroll
                for (int bj = 0; bj < 2; ++bj) { const int n = col0 + bj * HALF, t = n >> 4;
                    const u32x4 uu = *(const u32x4*)(ucat + ((size_t)g * UROWS + row) * UK + n);
                    const f32x4 y0 = acc[ai][bj][m][0] + d0 * unpk_lo(uu, 0), y1 = acc[ai][bj][m][1] + d1 * unpk_lo(uu, 1);
                    const f32x4 z0 = (f32x4){gelu_tanh(y0[0]), gelu_tanh(y0[1]), gelu_tanh(y0[2]), gelu_tanh(y0[3])}, z1 = (f32x4){gelu_tanh(y1[0]), gelu_tanh(y1[1]), gelu_tanh(y1[2]), gelu_tanh(y1[3])};
                    *(u32x4*)(z + ((size_t)b * SEQ + c * CHL + t) * 512 + g * 16 + co0) = pk8(z0, z1); } }
    } };
struct EpiS5Am { static constexpr bool PERM = false, AFTER_DRAIN = true; const float* AL; bf16_t* ucat;
    DEVI void fused(f32x4 (&acc)[2][2][4][2], const Unit& u, int wr, int wc, int fr, int fq, LAS unsigned char* lds, int wid, int lane) const {
        LAS float* sl = (LAS float*)lds;
#pragma unroll
        for (int ai = 0; ai < 2; ++ai)
#pragma unroll
            for (int m = 0; m < 4; ++m) { const int row = ai * HALF + wr * 64 + m * 16 + fr;
#pragma unroll
                for (int n = 0; n < 2; ++n) *(LAS f32x4*)(sl + row * 128 + wc * 32 + n * 16 + 4 * fq) = acc[ai][0][m][n]; }
        asm volatile("s_waitcnt lgkmcnt(0)" ::: "memory"); __builtin_amdgcn_s_barrier(); asm volatile("" ::: "memory");
        const int tid = wid * 64 + lane;
        if (tid < 128) { const int bb = tid >> 6, p = tid & 63, g = u.g;
            const float ar = AL[(g * 64 + p) * 2], ai_ = AL[(g * 64 + p) * 2 + 1];
            float hr = 0.f, hi = 0.f;
            for (int c = 0; c < NCH; ++c) { const int row = bb * NCH + c;
                bf16_t* up = ucat + ((size_t)g * UROWS + u.pm * BM + row) * UK + 512 + p;
                up[0] = f2bf(hr); up[64] = f2bf(hi);
                const float sr = sl[row * 128 + p], si = sl[row * 128 + 64 + p];
                const float nr = ar * hr - ai_ * hi + sr, ni = ar * hi + ai_ * hr + si; hr = nr; hi = ni; } }
        asm volatile("s_waitcnt lgkmcnt(0)" ::: "memory"); __builtin_amdgcn_s_barrier(); asm volatile("" ::: "memory");
    } };
struct EpiG1 { static constexpr bool PERM = true, AFTER_DRAIN = false; bf16_t* ucat; bf16_t* q; bf16_t* k; bf16_t* v; bf16_t* sg; const float* qg; const float* kg; const float* rope; float* qraw; float* kraw; float* ksum2;
    DEVI void operator()(const f32x4 (&acc)[2][2][4][2], const Unit& u, int wr, int wc, int fr, int fq) const {
        const int pn = u.pn, row0 = u.pm * BM + wr * 64 + fr;
        if (pn < 2) {
#pragma unroll
            for (int ai = 0; ai < 2; ++ai)
#pragma unroll
                for (int m = 0; m < 4; ++m) { const int row = row0 + ai * HALF + m * 16, b = row >> 12, s = row & 4095;
#pragma unroll
                    for (int bj = 0; bj < 2; ++bj) { const int c = pn * BM + bj * HALF + wc * 32 + 8 * fq, g = c >> 4, ci = c & 15;
                        *(u32x4*)(ucat + ((size_t)g * UROWS + b * NCH + (s >> 5)) * UK + (s & 31) * 16 + ci) = pk8(acc[ai][bj][m][0], acc[ai][bj][m][1]); } }
        } else if (pn < 6) {
            const bool isk = pn >= 4; const int hh = (pn & 1) * 4 + wc;
#if G1_RAWQK
            { float* raw = isk ? kraw : qraw;
#pragma unroll
              for (int ai = 0; ai < 2; ++ai)
#pragma unroll
                for (int m = 0; m < 4; ++m) { const int row = row0 + ai * HALF + m * 16;
#pragma unroll
                    for (int bj = 0; bj < 2; ++bj)
#pragma unroll
                        for (int n = 0; n < 2; ++n) *(f32x4*)(raw + (size_t)row * 512 + hh * 64 + 32 * bj + 8 * fq + 4 * n) = acc[ai][bj][m][n]; }
              return; }
#endif
            const float* gn = isk ? kg : qg; bf16_t* dst = isk ? k : q; const float sc = isk ? 1.0f : QSCALE;
            f32x4 gv[2][2];
#pragma unroll
            for (int bj = 0; bj < 2; ++bj)
#pragma unroll
                for (int n = 0; n < 2; ++n) gv[bj][n] = *(const f32x4*)(gn + 32 * bj + 8 * fq + 4 * n);
            f32x4 cs[2][2] = {{(f32x4){0.f, 0.f, 0.f, 0.f}, (f32x4){0.f, 0.f, 0.f, 0.f}}, {(f32x4){0.f, 0.f, 0.f, 0.f}, (f32x4){0.f, 0.f, 0.f, 0.f}}};
#pragma unroll
            for (int ai = 0; ai < 2; ++ai)
#pragma unroll
                for (int m = 0; m < 4; ++m) { const int row = row0 + ai * HALF + m * 16, s = row & 4095;
                    float ss = 0.f;
#pragma unroll
                    for (int bj = 0; bj < 2; ++bj)
#pragma unroll
                        for (int n = 0; n < 2; ++n) { const f32x4 x = acc[ai][bj][m][n]; ss += (x[0] * x[0] + x[1] * x[1]) + (x[2] * x[2] + x[3] * x[3]); }
                    ss += xshfl(ss, 16, fq * 16 + fr); ss += xshfl(ss, 32, fq * 16 + fr);
                    const float rstd = 1.0f / sqrtf(ss * (1.0f / 64.0f) + NORM_EPS);
                    f32x4 o1[2], o2[2];
#pragma unroll
                    for (int n = 0; n < 2; ++n) { const float* rp = rope + ((size_t)s * 32 + 8 * fq + 4 * n) * 2;
                        const f32x4 r0 = *(const f32x4*)rp, r1 = *(const f32x4*)(rp + 4);
                        const f32x4 cv = (f32x4){r0[0], r0[2], r1[0], r1[2]}, sv = (f32x4){r0[1], r0[3], r1[1], r1[3]};
                        const f32x4 x1 = acc[ai][0][m][n] * rstd * gv[0][n], x2 = acc[ai][1][m][n] * rstd * gv[1][n];
                        o1[n] = (x1 * cv - x2 * sv) * sc; o2[n] = (x2 * cv + x1 * sv) * sc; }
                    const u32x4 w1 = pk8(o1[0], o1[1]), w2 = pk8(o2[0], o2[1]);
                    bf16_t* dp = dst + (size_t)row * 512 + hh * 64 + 8 * fq;
                    *(u32x4*)dp = w1; *(u32x4*)(dp + 32) = w2;
                    if (isk) { cs[0][0] += unpk_lo(w1, 0); cs[0][1] += unpk_lo(w1, 1); cs[1][0] += unpk_lo(w2, 0); cs[1][1] += unpk_lo(w2, 1); }
                    if (m & 1) asm volatile("" ::: "memory"); }
            if (isk) {
#pragma unroll
                for (int bj = 0; bj < 2; ++bj)
#pragma unroll
                    for (int n = 0; n < 2; ++n)
#pragma unroll
                        for (int e = 0; e < 4; ++e) { float t = cs[bj][n][e]; const int ln = fq * 16 + fr; t += xshfl(t, 1, ln); t += xshfl(t, 2, ln); t += xshfl(t, 4, ln); t += xshfl(t, 8, ln); cs[bj][n][e] = t; }
                if (fr == 0) { float* kp = ksum2 + ((((size_t)(u.pm >> 4) * 8 + hh) * 16 + (u.pm & 15)) * 2 + wr) * 64 + 8 * fq;
#pragma unroll
                    for (int bj = 0; bj < 2; ++bj)
#pragma unroll
                        for (int n = 0; n < 2; ++n) *(f32x4*)(kp + 32 * bj + 4 * n) = cs[bj][n]; }
            }
        } else if (pn < 8) {
#pragma unroll
            for (int ai = 0; ai < 2; ++ai)
#pragma unroll
                for (int m = 0; m < 4; ++m) { bf16_t* rp = v + (size_t)(row0 + ai * HALF + m * 16) * 512 + (pn - 6) * BM + wc * 32 + 8 * fq;
#pragma unroll
                    for (int bj = 0; bj < 2; ++bj) *(u32x4*)(rp + bj * HALF) = pk8(acc[ai][bj][m][0], acc[ai][bj][m][1]); }
        } else {
#pragma unroll
            for (int ai = 0; ai < 2; ++ai)
#pragma unroll
                for (int m = 0; m < 4; ++m) { bf16_t* rp = sg + (size_t)(row0 + ai * HALF + m * 16) * 2048 + (pn - 8) * BM + wc * 32 + 8 * fq;
#pragma unroll
                    for (int bj = 0; bj < 2; ++bj) { const f32x4 a = acc[ai][bj][m][0], b = acc[ai][bj][m][1];
                        *(u32x4*)(rp + bj * HALF) = pk8((f32x4){fsig(a[0]), fsig(a[1]), fsig(a[2]), fsig(a[3])}, (f32x4){fsig(b[0]), fsig(b[1]), fsig(b[2]), fsig(b[3])}); } }
        }
    } };
}

struct CvtItem { const float* src; bf16_t* dst; int N, K; };
DEVI void cvt_load(const CvtItem& it, float (&v)[32], int lane) {
#pragma unroll
    for (int i = 0; i < 32; ++i) v[i] = it.src[(size_t)(2 * i + (lane >> 5)) * it.N + (lane & 31)];
}
DEVI void cvt_store(const CvtItem& it, const float (&v)[32], LAS float* scr, int lane) {
#pragma unroll
    for (int i = 0; i < 32; ++i) scr[(2 * i + (lane >> 5)) * 33 + (lane & 31)] = v[i];
    asm volatile("s_waitcnt lgkmcnt(0)" ::: "memory");
    const int c = lane & 7;
#pragma unroll
    for (int j = 0; j < 4; ++j) { const int n = (lane >> 3) + 8 * j; const LAS float* s = scr + (8 * c) * 33 + n;
        u32x4 o; o.x = pk2(s[0 * 33], s[1 * 33]); o.y = pk2(s[2 * 33], s[3 * 33]); o.z = pk2(s[4 * 33], s[5 * 33]); o.w = pk2(s[6 * 33], s[7 * 33]);
        *(u32x4*)(it.dst + (size_t)n * it.K + 8 * c) = o; }
    asm volatile("s_waitcnt lgkmcnt(0)" ::: "memory");
}
constexpr int CV_IN = 16 * 128, CV_GLU = 8 * 64, CV_ATT = 8 * 32, CV_OUT = 16 * 32, CV_GU1 = 16 * 32, CV_DN1 = 8 * 32;
constexpr int CV_PER_LAYER = CV_IN + CV_GLU + CV_ATT + CV_OUT + NEXP * (CV_GU1 + CV_DN1);
DEVI CvtItem cvt_decode(int it, const float* w_in, const float* w_glu, const float* w_attn, const float* w_out, const float* w_gu, const float* w_dn,
                        bf16_t* WIN, bf16_t* WGLU, bf16_t* WATT, bf16_t* WOUT, bf16_t* WGU, bf16_t* WDN) {
    const int l = it / CV_PER_LAYER; int r = it % CV_PER_LAYER;
    const float* W; bf16_t* WT; int K, N, mode;
    if (r < CV_IN) { W = w_in + (size_t)l * D * D_IN; WT = WIN + (size_t)l * D_IN * D; K = D; N = D_IN; mode = 1; }
    else if ((r -= CV_IN) < CV_GLU) { W = w_glu + (size_t)l * 512 * 2048; WT = WGLU + (size_t)l * 2048 * 512; K = 512; N = 2048; mode = 2; }
    else if ((r -= CV_GLU) < CV_ATT) { W = w_attn + (size_t)l * 512 * 1024; WT = WATT + (size_t)l * 1024 * 512; K = 512; N = 1024; mode = 0; }
    else if ((r -= CV_ATT) < CV_OUT) { W = w_out + (size_t)l * 1024 * 1024; WT = WOUT + (size_t)l * 1024 * 1024; K = 1024; N = 1024; mode = 0; }
    else if ((r -= CV_OUT) < NEXP * CV_GU1) { const int e = r / CV_GU1; r %= CV_GU1; W = w_gu + ((size_t)l * NEXP + e) * 1024 * 1024; WT = WGU + ((size_t)l * NEXP + e) * 1024 * 1024; K = 1024; N = 1024; mode = 3; }
    else { r -= NEXP * CV_GU1; const int e = r / CV_DN1; r %= CV_DN1; W = w_dn + ((size_t)l * NEXP + e) * 512 * 1024; WT = WDN + ((size_t)l * NEXP + e) * 1024 * 512; K = 512; N = 1024; mode = 0; }
    const int nblk = N / 32, kb = r / nblk, nb = r % nblk, nd = 32 * nb;
    int ns = nd;
    if (mode == 1) { const int pn = nd >> 8, tc = nd & 255; if (pn >= 2 && pn < 6) { const int sec = pn < 4 ? 512 : 1024, hh = (pn & 1) * 4 + ((tc >> 5) & 3); ns = sec + hh * 64 + 32 * (tc >> 7); } }
    else if (mode == 2) { const int pn = nd >> 8, tc = nd & 255; ns = (tc < 128) ? 128 * pn + tc : 1024 + 128 * pn + (tc - 128); }
    else if (mode == 3) { const int pn = nd >> 8, tc = nd & 255; ns = (tc < 128) ? 128 * pn + tc : 512 + 128 * pn + (tc - 128); }
    return CvtItem{W + (size_t)(64 * kb) * N + ns, WT + (size_t)nd * K + 64 * kb, N, K};
}
constexpr int CVQ_BASE = CV_IN + CV_GLU + CV_ATT + CV_OUT;
constexpr int CVQ_PER_BARRIER = 2;
constexpr int CVQ_TOTAL = DEPTH * CV_PER_LAYER - CVQ_BASE;
constexpr int CVQ_LIM_MOE0 = CV_PER_LAYER - CVQ_BASE;
constexpr int CVQ_LIM_PROJ1 = CVQ_LIM_MOE0 + CVQ_BASE;
struct CvtQ { const float* w_in; const float* w_glu; const float* w_attn; const float* w_out; const float* w_gu; const float* w_dn;
              bf16_t* WIN_; bf16_t* WGLU_; bf16_t* WATT_; bf16_t* WOUT_; bf16_t* WGU_; bf16_t* WDN_; LAS unsigned* head; LAS unsigned char* lds; int wave, lane, c, G;
    DEVI void item(int q) const { const CvtItem c = cvt_decode(q + CVQ_BASE, w_in, w_glu, w_attn, w_out, w_gu, w_dn, WIN_, WGLU_, WATT_, WOUT_, WGU_, WDN_);
        float v[32]; cvt_load(c, v, lane); cvt_store(c, v, (LAS float*)(lds + wave * 16384), lane); }
    DEVI int take() const { unsigned j = 0u; if (lane == 0) j = __hip_atomic_fetch_add(head, 1u, __ATOMIC_RELAXED, __HIP_MEMORY_SCOPE_WORKGROUP); return c + G * __builtin_amdgcn_readfirstlane((int)j); }
    DEVI int peek() const { return c + G * __builtin_amdgcn_readfirstlane((int)__hip_atomic_load(head, __ATOMIC_RELAXED, __HIP_MEMORY_SCOPE_WORKGROUP)); }
    DEVI void run_until(volatile LAS unsigned* genw, unsigned n) const {
        bool empty = peek() >= CVQ_TOTAL; int budget = CVQ_PER_BARRIER;
        while (*genw < n) {
            if (empty || budget == 0) { __builtin_amdgcn_s_sleep(4); continue; }
            --budget;
            const int q = take();
            if (q >= CVQ_TOTAL) { empty = true; continue; }
            item(q);
        }
    }
    DEVI void catchup(int limit) const { for (;;) { if (peek() >= limit) break; const int q = take(); if (q >= CVQ_TOTAL) break; item(q); } }
};
DEVI int fresh_lane() { int l = (int)__builtin_amdgcn_mbcnt_hi(~0u, __builtin_amdgcn_mbcnt_lo(~0u, 0u)); asm volatile("" : "+v"(l)); return l; }
DEVI CvtQ make_cvtq(const Args& a, LAS unsigned char* lds, int wave, int lane) {
    unsigned char* w = a.ws;
    return CvtQ{a.in[2], a.in[11], a.in[14], a.in[15], a.in[21], a.in[22], (bf16_t*)(w + WS_WIN), (bf16_t*)(w + WS_WGLU), (bf16_t*)(w + WS_WATT), (bf16_t*)(w + WS_WOUT), (bf16_t*)(w + WS_WGU), (bf16_t*)(w + WS_WDN),
                (LAS unsigned*)(lds + LDSCTL_OFF) + 5, lds, wave, lane, (int)blockIdx.x, (int)gridDim.x};
}
DEVI void ph_convert_first(const Frame& F, const CvtQ& Q) { for (int it = F.gw; it < CVQ_BASE; it += F.NGW) Q.item(it - CVQ_BASE); }
DEVI void xcd_barrier_w(const XcdBarrier& b, unsigned n, volatile LAS unsigned* genw, const CvtQ& Q) {
    asm volatile("s_waitcnt vmcnt(0)" ::: "memory");
    __syncthreads();
    if (Q.wave == 0) {
        if (threadIdx.x == 0) {
            unsigned* bar = b.bar;
            __builtin_amdgcn_s_waitcnt(0);
            unsigned nloc = b.st[0], nx = b.st[1];
            if (nloc == 0u) { xcd_barrier_complete(bar, b.x, nloc, nx); b.st[0] = nloc; b.st[1] = nx; }
            const unsigned old = xb_add(&bar[XB_XSUB(b.x)], 1u);
            const unsigned gen = old / nloc;
            if (old + 1u == (gen + 1u) * nloc) {
                __builtin_amdgcn_fence(__ATOMIC_RELEASE, "agent");
                asm volatile("s_waitcnt vmcnt(0)" ::: "memory");
                const unsigned og = xb_add(&bar[XB_TOP], 1u);
                const unsigned tg = og / nx;
                if (og + 1u == (tg + 1u) * nx) xb_add(&bar[XB_TOPGEN], 1u);
                else XB_SPIN(xb_ld(&bar[XB_TOPGEN]) == tg, bar);
                __builtin_amdgcn_fence(__ATOMIC_ACQUIRE, "agent");
                xb_add(&bar[XB_XGEN(b.x)], 1u);
                asm volatile("s_waitcnt vmcnt(0)" ::: "memory");
            } else {
                XB_SPIN(xb_ld(&bar[XB_XGEN(b.x)]) == gen, bar);
                __builtin_amdgcn_fence(__ATOMIC_ACQUIRE, "agent");
                asm volatile("s_waitcnt vmcnt(0)" ::: "memory");
            }
            *genw = n;
        }
    } else Q.run_until(genw, n);
    __syncthreads();
}


DEVI void moe_tstart(const Frame& F, const unsigned* cnt, volatile LAS int* tstart) { expert_prefix(F, cnt, tstart, 1); }
DEVI void moe_gather_table(const Frame& F, int v, const unsigned* cnt, const int* list, volatile LAS int* tstart, LAS unsigned* tab) {
    for (int j = F.tid; j < 8 * 256; j += NTHR) {
        const int i = j >> 8, r = j & 255, U = i * F.G + v, rt = U >> 2; if (rt >= tstart[NEXP]) continue;
        int e = 0;
        for (int q = 1; q < NEXP; ++q) e = (rt >= tstart[q]) ? q : e;
        const int n = (int)cnt[e], idx = (rt - tstart[e]) * 256 + r;
        tab[j] = (unsigned)list[(size_t)e * LIST_CAP + (idx < n ? idx : 0)] * (unsigned)(D * 2);
    }
    __syncthreads();
}
DEVI void ph_zero_ksum(const Frame& F, float* ksum) { for (int i = F.gt; i < BATCH * NH * NBLK * 64; i += F.NGT) ksum[i] = 0.f; }

namespace attn_body {
using bf16=__hip_bfloat16;
using bf16x8=__attribute__((ext_vector_type(8)))short;
using s16x4=__attribute__((ext_vector_type(4)))short;
using f32x16=__attribute__((ext_vector_type(16)))float;
using f32x4=__attribute__((ext_vector_type(4)))float;
using u32x4=__attribute__((ext_vector_type(4)))unsigned;
constexpr int BATCH=8,NHEAD=8,SEQ=4096,D=64,DM=NHEAD*D;
constexpr int NW=8,QBLK=32,QB=QBLK*NW,KVBLK=64,NQB=SEQ/QB;
constexpr int ATTN_PITCH=DM, ATTN_UNIT_ROWS=QB;
__device__ __forceinline__ int crow(int r,int hi){return (r&3)+8*(r>>2)+4*hi;}
#define SBAR() __builtin_amdgcn_sched_barrier(0)
__device__ __forceinline__ void cmask(f32x16&p0,f32x16&p1,int jb,int qrel,int hi){
  const float NEG=-INFINITY; int kb=64*jb+4*hi;
  #pragma unroll
  for(int r=0;r<16;++r){int kv=kb+(r&3)+8*(r>>2); if(kv>qrel)p0[r]=NEG; if(kv+32>qrel)p1[r]=NEG;}
}

constexpr int NSLOT=3, SLOTB=8192;
constexpr int LDS_K=0, LDS_V=NSLOT*SLOTB, LDS_WS=2*NSLOT*SLOTB, LDS_OST=LDS_WS+NW*64*4, LDS_BYTES=LDS_OST+NW*4096;
constexpr float C2=0.125f*1.4426950408889634f;
__device__ __forceinline__ void glds16(const void*gsrc,unsigned lds_dst){unsigned keep;
  asm volatile("s_mov_b32 %0, m0\n\ts_mov_b32 m0, %2\n\ts_nop 0\n\tglobal_load_lds_dwordx4 %1, off\n\ts_mov_b32 m0, %0":"=&s"(keep):"v"(gsrc),"s"(lds_dst):"memory");}
__device__ __forceinline__ float max3f(float a,float b,float c){float r;asm("v_max3_f32 %0, %1, %2, %3":"=v"(r):"v"(a),"v"(b),"v"(c));return r;}
__device__ __forceinline__ float max2f(float a,float b){float r;asm("v_max_f32_e32 %0, %1, %2":"=v"(r):"v"(a),"v"(b));return r;}
__device__ __forceinline__ float fadd_s(float a,float b){float r;asm("v_add_f32_e32 %0, %1, %2":"=v"(r):"v"(a),"v"(b));return r;}
__device__ __forceinline__ float fsub_s(float a,float b){float r;asm("v_sub_f32_e32 %0, %1, %2":"=v"(r):"v"(a),"v"(b));return r;}
typedef float f32x2_t __attribute__((ext_vector_type(2))); typedef __bf16 bf16x2_t __attribute__((ext_vector_type(2)));
__device__ __forceinline__ unsigned cvtpk_s(float lo,float hi){f32x2_t v={lo,hi};bf16x2_t b=__builtin_convertvector(v,bf16x2_t);return __builtin_bit_cast(unsigned,b);}
#define WAIT_BAR(N) asm volatile("s_waitcnt vmcnt(" #N ") lgkmcnt(0)\n\ts_barrier":::"memory")

__device__ __forceinline__ void qkt(f32x16&p0,f32x16&p1,const char*Kslot,const bf16x8*qr,const f32x16&negm,int r32,int hi){
  const char*kb=Kslot+hi*1024+r32*16;
  #pragma unroll
  for(int d0=0;d0<4;++d0){
    const bf16x8 b0=*reinterpret_cast<const bf16x8*>(kb+d0*2048);
    const bf16x8 b1=*reinterpret_cast<const bf16x8*>(kb+d0*2048+512);
    if(d0==0){p0=__builtin_amdgcn_mfma_f32_32x32x16_bf16(b0,qr[0],negm,0,0,0);p1=__builtin_amdgcn_mfma_f32_32x32x16_bf16(b1,qr[0],negm,0,0,0);}
    else{p0=__builtin_amdgcn_mfma_f32_32x32x16_bf16(b0,qr[d0],p0,0,0,0);p1=__builtin_amdgcn_mfma_f32_32x32x16_bf16(b1,qr[d0],p1,0,0,0);}}
}
typedef __attribute__((address_space(3))) const char* lds_cptr;
typedef short v4i16_t __attribute__((ext_vector_type(4)));
__device__ __forceinline__ void kload8(bf16x8*kf,lds_cptr kp){
  kf[0]=*(const __attribute__((address_space(3))) bf16x8*)(kp);      kf[1]=*(const __attribute__((address_space(3))) bf16x8*)(kp+512);
  kf[2]=*(const __attribute__((address_space(3))) bf16x8*)(kp+2048); kf[3]=*(const __attribute__((address_space(3))) bf16x8*)(kp+2560);
  kf[4]=*(const __attribute__((address_space(3))) bf16x8*)(kp+4096); kf[5]=*(const __attribute__((address_space(3))) bf16x8*)(kp+4608);
  kf[6]=*(const __attribute__((address_space(3))) bf16x8*)(kp+6144); kf[7]=*(const __attribute__((address_space(3))) bf16x8*)(kp+6656);
}
__device__ __forceinline__ void kload2(bf16x8*kf,lds_cptr kp,int j){ kf[2*j]=*(const __attribute__((address_space(3))) bf16x8*)(kp+j*2048); kf[2*j+1]=*(const __attribute__((address_space(3))) bf16x8*)(kp+j*2048+512); }
__device__ __forceinline__ s16x4 vtr(lds_cptr p){ return __builtin_bit_cast(s16x4,__builtin_amdgcn_ds_read_tr16_b64_v4i16((__attribute__((address_space(3))) v4i16_t*)p)); }
__device__ __forceinline__ float rowmax(const f32x16&p0,const f32x16&p1){
  float a=max3f(p0[0],p0[1],p1[0]),b=max3f(p0[2],p0[3],p1[1]);a=max3f(a,p1[2],p1[3]);
  #pragma unroll
  for(int r=4;r<16;r+=4){a=max3f(a,p0[r],p0[r+1]);b=max3f(b,p0[r+2],p0[r+3]);a=max3f(a,p1[r],p1[r+1]);b=max3f(b,p1[r+2],p1[r+3]);}
  const float m=max2f(a,b);
  auto rr=__builtin_amdgcn_permlane32_swap(__float_as_uint(m),__float_as_uint(m),false,false);
  return max2f(__uint_as_float(rr[0]),__uint_as_float(rr[1]));
}
__device__ __forceinline__ void pv(f32x16*o,int vb,bf16x8 pa0,bf16x8 pa1,bf16x8 pa2,bf16x8 pa3){
  #pragma unroll
  for(int d0=0;d0<2;++d0){s16x4 lo[4],hi[4];
    #pragma unroll
    for(int ks=0;ks<4;++ks){
      asm volatile("ds_read_b64_tr_b16 %0,%1 offset:%c2":"=&v"(lo[ks]):"v"(vb),"i"(d0*4096+ks*1024):"memory");
      asm volatile("ds_read_b64_tr_b16 %0,%1 offset:%c2":"=&v"(hi[ks]):"v"(vb),"i"(d0*4096+ks*1024+512):"memory");}
    asm volatile("s_waitcnt lgkmcnt(0)":::"memory");SBAR();
    #define PK(k) (bf16x8){lo[k][0],lo[k][1],lo[k][2],lo[k][3],hi[k][0],hi[k][1],hi[k][2],hi[k][3]}
    o[d0]=__builtin_amdgcn_mfma_f32_32x32x16_bf16(pa0,PK(0),o[d0],0,0,0);
    o[d0]=__builtin_amdgcn_mfma_f32_32x32x16_bf16(pa1,PK(1),o[d0],0,0,0);
    o[d0]=__builtin_amdgcn_mfma_f32_32x32x16_bf16(pa2,PK(2),o[d0],0,0,0);
    o[d0]=__builtin_amdgcn_mfma_f32_32x32x16_bf16(pa3,PK(3),o[d0],0,0,0);
    #undef PK
  }
}

#ifndef ATTN_STORE16
#define ATTN_STORE16(p,v) (*(u32x4*)(p)=(v))
#endif
template<int THRL> __device__ __forceinline__ void attn_unit(int b,int h,int qb,const bf16*Q,const bf16*__restrict__ K,const bf16*__restrict__ V,bf16*O,const unsigned*__restrict__ sel,char*shm,int tid_in){
  const int tid=tid_in,lane=tid&63,r32=lane&31,hi=lane>>5; const int wid=__builtin_amdgcn_readfirstlane(tid>>6);
  const long rowbase=(long)b*SEQ; const int q0=qb*QB;
  const bf16*Qw=Q+(rowbase+q0+wid*QBLK)*DM+h*D;
  const bf16*Kh=K+rowbase*DM+h*D,*Vh=V+rowbase*DM+h*D;
  const unsigned lds0=(unsigned)(uintptr_t)shm;
  float*wsf=(float*)(shm+LDS_WS)+wid*64;
  const bf16*ksrc=Kh+(long)lane*DM+wid*8;
  const bf16*vsrc=Vh+(long)(16*(wid&3)+(lane>>2))*DM+(wid>>2)*32+(lane&3)*8;
  const unsigned kdst=lds0+LDS_K+wid*1024, vdst=lds0+LDS_V+wid*1024;
  #define DMA_K(t,slot) glds16(ksrc+(long)(t)*KVBLK*DM,(unsigned)__builtin_amdgcn_readfirstlane(kdst+(slot)))
  #define DMA_V(t,slot) glds16(vsrc+(long)(t)*KVBLK*DM,(unsigned)__builtin_amdgcn_readfirstlane(vdst+(slot)))
  const int vb0=(int)(lds0+LDS_V)+((lane>>4)&1)*32+(lane&3)*8+(4*hi+((lane&15)>>2))*64;
  const char*Kbase=shm+LDS_K; bf16x8 kf[8];
  const lds_cptr shm3=(lds_cptr)shm; const lds_cptr kp0=shm3+LDS_K+hi*1024+r32*16; const lds_cptr vp0=shm3+LDS_V+((lane>>4)&1)*32+(lane&3)*8+(4*hi+((lane&15)>>2))*64;
  const int NT=(q0+QB)/KVBLK;
  DMA_K(0,0);DMA_V(0,0);DMA_K(1,SLOTB);
  bf16x8 qr[4];
  #pragma unroll
  for(int d0=0;d0<4;++d0)qr[d0]=*reinterpret_cast<const bf16x8*>(&Qw[(long)r32*DM+d0*16+hi*8]);
  const unsigned selmask=sel[((size_t)(b*NHEAD+h))*SEQ+q0+wid*QBLK+r32];
  const float NEGINF=-INFINITY;
  float mhat=0.f,l_reg=0.f;f32x16 o[2];o[0]=f32x16{};o[1]=f32x16{};f32x16 negm=f32x16{};asm volatile("":"+v"(negm));
  const int qrel=wid*QBLK+r32;
  #define CMASK(P0,P1,t) do{int jb_=(t)-(NT-4); if(jb_>=0)cmask(P0,P1,jb_,qrel,hi);}while(0)
  bool resc=false;
  #define START(P0,P1) do{ const float rm=rowmax(P0,P1); resc=false; \
    { const float dl=__builtin_fmaxf(rm,-64.f); mhat=fadd_s(mhat,dl); \
      _Pragma("unroll") for(int r=0;r<16;++r){P0[r]=fsub_s(P0[r],dl);P1[r]=fsub_s(P1[r],dl);} \
      _Pragma("unroll") for(int r=0;r<16;++r)negm[r]=-mhat; asm volatile("":"+v"(negm)); } \
    _Pragma("unroll") for(int r=0;r<16;++r)P0[r]=__builtin_amdgcn_exp2f(P0[r]); }while(0)
  #define RESC() do{ if(resc){ asm volatile("s_waitcnt lgkmcnt(0)":::"memory"); \
      _Pragma("unroll") for(int d_=0;d_<2;++d_) _Pragma("unroll") for(int r=0;r<16;++r)o[d_][r]*=wsf[crow(r,hi)]; } }while(0)
  f32x16 pA0,pA1,pB0,pB1;
  int sl_prev=0,sl_cur=0,sl_next=SLOTB;
  #define ROT() do{sl_prev=sl_cur;sl_cur=sl_next;sl_next=(sl_next==(NSLOT-1)*SLOTB)?0:sl_next+SLOTB;}while(0)
  DMA_K(2,2*SLOTB);
  WAIT_BAR(3);
  #define SETNEGM(t) do{ const bool keep_=((t)>=NT-4)||(((selmask>>((t)>>2))&1u)!=0u); const float nm_=keep_?-mhat:NEGINF; _Pragma("unroll") for(int r=0;r<16;++r)negm[r]=nm_; asm volatile("":"+v"(negm)); }while(0)
  SETNEGM(0);
  qkt(pA0,pA1,Kbase,qr,negm,r32,hi);asm volatile("s_nop 15\n\ts_nop 7":"+v"(pA0),"+v"(pA1));CMASK(pA0,pA1,0);
  START(pA0,pA1);
  _Pragma("unroll") for(int r=0;r<16;++r)pA1[r]=__builtin_amdgcn_exp2f(pA1[r]);
  WAIT_BAR(0);
  DMA_K(3,0);DMA_V(1,SLOTB);
  ROT();
  kload8(kf,kp0+sl_cur);
  WAIT_BAR(2);
  s16x4 vlo[8],vhi[8]; u32x4 pw0,pw1,pw2,pw3;
  #define PKW(P,B) cvtpk_s(P[B],P[B+1])
  #define PAF(k) __builtin_bit_cast(bf16x8,pw##k)
  #define VFR(i) (bf16x8){vlo[i][0],vlo[i][1],vlo[i][2],vlo[i][3],vhi[i][0],vhi[i][1],vhi[i][2],vhi[i][3]}
  #define PIN(x) asm volatile("":"+v"(x))
  #define MX3(a,b,c) __builtin_fmaxf(__builtin_fmaxf((a),(b)),(c))
  #define GAPA(MF,A0,A1,A2,A3,W0,W1,PW) do{ MF; sacc+=A0; sacc+=A1; sacc+=A2; sacc+=A3; PIN(sacc); W0; W1; PIN(PW); SBAR(); }while(0)
  #define EX(v) __builtin_amdgcn_exp2f(v)
  #define GAPB(MF,X,B) do{ MF; X[B]=EX(X[B]); X[B+1]=EX(X[B+1]); X[B+2]=EX(X[B+2]); X[B+3]=EX(X[B+3]); PIN(X); SBAR(); }while(0)
  #define VRD(i) do{ vlo[i]=vtr(vp_+(((i)>>2)*4096+((i)&3)*1024)); vhi[i]=vtr(vp_+(((i)>>2)*4096+((i)&3)*1024+512)); }while(0)
  #define KRD(G,j) do{ if(G){ kload2(kf,kp0+sl_next,j); SBAR(); } }while(0)
  #define STEP(C0,C1,P0,P1,t,GK,GV,GL) do{ SBAR(); SETNEGM(t); SBAR(); \
    const lds_cptr vp_=vp0+sl_prev; \
    VRD(0); SBAR(); float sacc=(P0[0]+P0[1]); \
    GAPA(C0=__builtin_amdgcn_mfma_f32_32x32x16_bf16(kf[0],qr[0],negm,0,0,0), P0[2],P0[3],P0[4],P0[5],     pw0[0]=PKW(P0,0), pw0[1]=PKW(P0,2), pw0); \
    VRD(4); SBAR(); GAPA(C1=__builtin_amdgcn_mfma_f32_32x32x16_bf16(kf[1],qr[0],negm,0,0,0), P0[6],P0[7],P0[8],P0[9],     pw0[2]=PKW(P0,4), pw0[3]=PKW(P0,6), pw0); \
    VRD(1); SBAR(); GAPA(C0=__builtin_amdgcn_mfma_f32_32x32x16_bf16(kf[2],qr[1],C0,0,0,0),   P0[10],P0[11],P0[12],P0[13], pw1[0]=PKW(P0,8), pw1[1]=PKW(P0,10), pw1); \
    VRD(5); SBAR(); GAPA(C1=__builtin_amdgcn_mfma_f32_32x32x16_bf16(kf[3],qr[1],C1,0,0,0),   P0[14],P0[15],P1[0],P1[1],   pw1[2]=PKW(P0,12),pw1[3]=PKW(P0,14), pw1); \
    VRD(2); SBAR(); GAPA(C0=__builtin_amdgcn_mfma_f32_32x32x16_bf16(kf[4],qr[2],C0,0,0,0),   P1[2],P1[3],P1[4],P1[5],     pw2[0]=PKW(P1,0), pw2[1]=PKW(P1,2), pw2); \
    VRD(6); SBAR(); GAPA(C1=__builtin_amdgcn_mfma_f32_32x32x16_bf16(kf[5],qr[2],C1,0,0,0),   P1[6],P1[7],P1[8],P1[9],     pw2[2]=PKW(P1,4), pw2[3]=PKW(P1,6), pw2); \
    VRD(3); SBAR(); GAPA(C0=__builtin_amdgcn_mfma_f32_32x32x16_bf16(kf[6],qr[3],C0,0,0,0),   P1[10],P1[11],P1[12],P1[13], pw3[0]=PKW(P1,8), pw3[1]=PKW(P1,10), pw3); \
    VRD(7); SBAR(); GAPA(C1=__builtin_amdgcn_mfma_f32_32x32x16_bf16(kf[7],qr[3],C1,0,0,0),   P1[14],P1[15],0.f,0.f,       pw3[2]=PKW(P1,12),pw3[3]=PKW(P1,14), pw3); \
    l_reg+=sacc; \
    if(GK){DMA_K((t)+3,sl_cur);} if(GV){DMA_V((t)+1,sl_next);} \
    CMASK(C0,C1,t); \
    { float a=MX3(C0[0],C0[1],C1[0]),b=MX3(C0[2],C0[3],C1[1]); a=MX3(a,C1[2],C1[3]); \
      _Pragma("unroll") for(int r=4;r<16;r+=4){a=MX3(a,C0[r],C0[r+1]);b=MX3(b,C0[r+2],C0[r+3]);a=MX3(a,C1[r],C1[r+1]);b=MX3(b,C1[r+2],C1[r+3]);} \
      float rm=__builtin_fmaxf(a,b); { auto rr=__builtin_amdgcn_permlane32_swap(__float_as_uint(rm),__float_as_uint(rm),false,false); rm=__builtin_fmaxf(__uint_as_float(rr[0]),__uint_as_float(rr[1])); } \
      resc=false; \
      if(__builtin_expect(__any(rm>(float)THRL),0)){ const float dl=__builtin_fmaxf(rm,0.f); mhat+=dl; \
        _Pragma("unroll") for(int r=0;r<16;++r){C0[r]-=dl;C1[r]-=dl;} \
        const float f=__builtin_amdgcn_exp2f(-dl); l_reg*=f; if(hi==0)wsf[r32]=f; resc=true; } } \
    SBAR(); \
    GAPB(o[0]=__builtin_amdgcn_mfma_f32_32x32x16_bf16(PAF(0),VFR(0),o[0],0,0,0), C0,0); \
    GAPB(o[1]=__builtin_amdgcn_mfma_f32_32x32x16_bf16(PAF(0),VFR(4),o[1],0,0,0), C0,4); \
    KRD(GL,0); GAPB(o[0]=__builtin_amdgcn_mfma_f32_32x32x16_bf16(PAF(1),VFR(1),o[0],0,0,0), C0,8); \
    KRD(GL,1); GAPB(o[1]=__builtin_amdgcn_mfma_f32_32x32x16_bf16(PAF(1),VFR(5),o[1],0,0,0), C0,12); \
    KRD(GL,2); GAPB(o[0]=__builtin_amdgcn_mfma_f32_32x32x16_bf16(PAF(2),VFR(2),o[0],0,0,0), C1,0); \
    KRD(GL,3); GAPB(o[1]=__builtin_amdgcn_mfma_f32_32x32x16_bf16(PAF(2),VFR(6),o[1],0,0,0), C1,4); \
    GAPB(o[0]=__builtin_amdgcn_mfma_f32_32x32x16_bf16(PAF(3),VFR(3),o[0],0,0,0), C1,8); \
    GAPB(o[1]=__builtin_amdgcn_mfma_f32_32x32x16_bf16(PAF(3),VFR(7),o[1],0,0,0), C1,12); \
    }while(0)
  int t=1;
  #undef CMASK
  #define CMASK(P0,P1,t) do{}while(0)
  for(;t+5<NT;t+=2){
    STEP(pB0,pB1,pA0,pA1,t,true,true,true);     WAIT_BAR(2); RESC(); ROT();
    STEP(pA0,pA1,pB0,pB1,t+1,true,true,true);   WAIT_BAR(2); RESC(); ROT();
  }
  #undef CMASK
  #define CMASK(P0,P1,t) do{int jb_=(t)-(NT-4); if(jb_>=0)cmask(P0,P1,jb_,qrel,hi);}while(0)
  #define ENDW(tt) do{ if((tt)+3<NT){WAIT_BAR(2);} else if((tt)+2<NT){WAIT_BAR(1);} else {WAIT_BAR(0);} }while(0)
  for(;t+1<NT;t+=2){
    STEP(pB0,pB1,pA0,pA1,t,(t+3<NT),(t+1<NT),(t+1<NT));       ENDW(t);   RESC(); ROT();
    STEP(pA0,pA1,pB0,pB1,t+1,(t+4<NT),(t+2<NT),(t+2<NT));     ENDW(t+1); RESC(); ROT();
  }
  STEP(pB0,pB1,pA0,pA1,NT-1,false,false,false); RESC();
  { float sacc=pB0[0]+pB0[1]; _Pragma("unroll") for(int r=2;r<16;++r)sacc+=pB0[r]; _Pragma("unroll") for(int r=0;r<16;++r)sacc+=pB1[r]; l_reg+=sacc;
    pw0=(u32x4){PKW(pB0,0),PKW(pB0,2),PKW(pB0,4),PKW(pB0,6)};pw1=(u32x4){PKW(pB0,8),PKW(pB0,10),PKW(pB0,12),PKW(pB0,14)};pw2=(u32x4){PKW(pB1,0),PKW(pB1,2),PKW(pB1,4),PKW(pB1,6)};pw3=(u32x4){PKW(pB1,8),PKW(pB1,10),PKW(pB1,12),PKW(pB1,14)};
    SBAR(); pv(o,vb0+sl_cur,PAF(0),PAF(1),PAF(2),PAF(3)); }
  #undef PKW
  #undef PAF
  #undef VFR
  #undef PIN
  #undef MX3
  #undef GAPA
  #undef GAPB
  #undef EX
  #undef VRD
  #undef KRD
  #undef STEP
  #undef ENDW
  {auto rr=__builtin_amdgcn_permlane32_swap(__float_as_uint(l_reg),__float_as_uint(l_reg),false,false);l_reg=__uint_as_float(rr[0])+__uint_as_float(rr[1]);}
  if(hi==0)wsf[32+r32]=l_reg;asm volatile("s_waitcnt lgkmcnt(0)":::"memory");
  float rli[16];
  #pragma unroll
  for(int r=0;r<16;++r)rli[r]=__builtin_amdgcn_rcpf(wsf[32+crow(r,hi)]);
  bf16*Ow=O+(rowbase+q0+wid*QBLK)*DM+h*D;
  { bf16*stg=(bf16*)(shm+LDS_OST)+wid*2048;
    #pragma unroll
    for(int r=0;r<16;++r){const int orow=crow(r,hi);
      #pragma unroll
      for(int d0=0;d0<2;++d0)stg[orow*64+d0*32+r32]=__float2bfloat16(o[d0][r]*rli[r]);}
    asm volatile("s_waitcnt lgkmcnt(0)":::"memory");
    #pragma unroll
    for(int i=0;i<4;++i){const int row=i*8+(lane>>3),ch=lane&7; const u32x4 v=*(const u32x4*)(stg+row*64+ch*8); ATTN_STORE16(Ow+(long)row*DM+ch*8,v);} }
  asm volatile("s_waitcnt lgkmcnt(0)\n\ts_barrier":::"memory");
  #undef DMA_K
  #undef DMA_V
  #undef CMASK
  #undef START
  #undef SETNEGM
  #undef RESC
  #undef ROT
}
constexpr int ATTN_LDS_BYTES=LDS_BYTES;
struct AttnTensors { const bf16* Q; const bf16* K; const bf16* V; bf16* O; const unsigned* sel; };
struct AttnUnit { int bh; int qb; };
struct StaticOrder {
  int vcu,grid;
  __device__ __forceinline__ explicit StaticOrder(int grid_,int block):vcu((grid_%8==0)?(block%8)*(grid_/8)+block/8:block),grid(grid_){}
  __device__ __forceinline__ bool next(int i,AttnUnit&u)const{
    if(grid==256){ if(i>=4)return false; const int s=vcu&3; u.bh=vcu>>2; u.qb=(i==0)?s:(i==1)?7-s:(i==2)?8+s:15-s; return true; }
    const int U=i*grid+vcu; if(U>=BATCH*NHEAD*NQB)return false; u.bh=U/NQB; u.qb=U%NQB; return true; }
  __device__ __forceinline__ void a_ready(const AttnUnit&)const{}
  __device__ __forceinline__ void done(const AttnUnit&)const{}
};
template<class Sched,int THRL=8> __device__ __forceinline__ void attn_phase(char*lds,const AttnTensors&T,const Sched&S,int tid_in){
  AttnUnit u;
  for(int i=0;S.next(i,u);++i){ S.a_ready(u); attn_unit<THRL>(u.bh/NHEAD,u.bh%NHEAD,u.qb,T.Q,T.K,T.V,T.O,T.sel,lds,tid_in); S.done(u); }
}
#undef SBAR
#undef WAIT_BAR
}


DEVI void ph_moba_select(const Frame& F, const bf16_t* Q, const float* ksum, unsigned* sel) {
    for (int idx = F.gt; idx < BATCH * NH * SEQ; idx += F.NGT) {
        const int s = idx & (SEQ - 1), bh = idx >> 12, b = bh >> 3, hh = bh & 7, qb = s >> 8;
        const bf16_t* qp = Q + ((size_t)b * SEQ + s) * 512 + hh * 64;
        float q[64];
#pragma unroll
        for (int i = 0; i < 8; ++i) { const bf16x8 t = *((const bf16x8*)qp + i);
#pragma unroll
            for (int j = 0; j < 8; ++j) q[8 * i + j] = bf2f((bf16_t)t[j]); }
        float gsc[15];
#pragma unroll
        for (int j = 0; j < 15; ++j) { gsc[j] = -INFINITY;
            if (j < qb) { const float* km = ksum + ((size_t)bh * 16 + j) * 64; float a = 0.f;
#pragma unroll
                for (int i = 0; i < 64; ++i) a += q[i] * km[i];
                gsc[j] = a; } }
        unsigned m = 0u;
#pragma unroll
        for (int t = 0; t < 3; ++t) { float best = -INFINITY; int bi = -1;
#pragma unroll
            for (int j = 0; j < 15; ++j) { const bool ok = (j < qb) && !((m >> j) & 1u) && (gsc[j] > best); best = ok ? gsc[j] : best; bi = ok ? j : bi; }
            if (bi >= 0) m |= 1u << bi; }
        sel[idx] = m;
    }
}


DEVI void ph_router_weights(const Frame& F, const float* wg, const float* we, bf16_t* wr) {
    for (int idx = F.gt; idx < DEPTH * 48 * 1024; idx += F.NGT) {
        const int l = idx / (48 * 1024), r = idx % (48 * 1024), o = r >> 10, kk = r & 1023;
        const float v = (o < 4) ? wg[((size_t)l * D + kk) * 4 + o] : (o < 36) ? we[((size_t)l * D + kk) * 32 + (o - 4)] : 0.f;
        const bf16_t hi = f2bf(v), lo = f2bf(v - bf2f(hi));
        wr[((size_t)l * 2 + 0) * 48 * 1024 + r] = hi; wr[((size_t)l * 2 + 1) * 48 * 1024 + r] = lo;
    }
}
DEVI void ph_norm_router_mfma(const Frame& F, const bf16_t* x, const float* ssq, const float* g, const bf16_t* wr, const float* bg, const float* be, bf16_t* h2, unsigned* cnt, int* list, unsigned* rec) {
    const int lane = F.lane, ri = lane & 15, q = lane >> 4;
    constexpr int WPITCH = 2064, WLO_OFF = 36 * WPITCH, LG_OFF = 2 * 36 * WPITCH;
    static_assert(LG_OFF <= SCRATCH_BYTES, "router LDS");
    LAS unsigned char* wl = F.lds;
    LAS float* lg = (LAS float*)(F.lds + F.wave * 3072);
    volatile LAS unsigned* hist = (volatile LAS unsigned*)(F.lds + 8 * 3072);
    for (int tile = blockIdx.x; tile < NTOK / 128; tile += F.G) {
        for (int i = F.tid; i < 2 * 36 * 128; i += NTHR) { const int hl = i / (36 * 128), r = (i / 128) % 36, c = i % 128;
            *(LAS u32x4*)(wl + hl * WLO_OFF + r * WPITCH + c * 16) = *(const u32x4*)(wr + (size_t)hl * 48 * 1024 + (size_t)r * 1024 + c * 8); }
        __syncthreads();
        const int row = tile * 128 + F.wave * 16 + ri;
        const bf16_t* xr = x + (size_t)row * D + 8 * q;
        float ss;
        { const f32x4* sp = (const f32x4*)(ssq + (size_t)row * 16); const f32x4 s0 = sp[0], s1 = sp[1], s2 = sp[2], s3 = sp[3];
          ss = ((s0[0] + s0[1]) + (s0[2] + s0[3])) + ((s1[0] + s1[1]) + (s1[2] + s1[3])) + ((s2[0] + s2[1]) + (s2[2] + s2[3])) + ((s3[0] + s3[1]) + (s3[2] + s3[3])); }
        const float rstd = 1.0f / sqrtf(ss * (1.0f / D) + NORM_EPS);
        f32x4 acc[3] = {(f32x4){0.f, 0.f, 0.f, 0.f}, (f32x4){0.f, 0.f, 0.f, 0.f}, (f32x4){0.f, 0.f, 0.f, 0.f}};
#pragma unroll 2
        for (int kk = 0; kk < 32; ++kk) {
            const int k0 = 32 * kk + 8 * q;
            const u32x4 xw = *(const u32x4*)(xr + 32 * kk); const f32x4 a = pg8::unpk_lo(xw, 0), b = pg8::unpk_lo(xw, 1);
            const f32x4 ga = *(const f32x4*)(g + k0), gb = *(const f32x4*)(g + k0 + 4);
            const f32x4 ha = a * rstd * ga, hb = b * rstd * gb;
            const u32x4 hi = pg8::pk8(ha, hb);
            const f32x4 ra = ha - pg8::unpk_lo(hi, 0), rb = hb - pg8::unpk_lo(hi, 1);
            const u32x4 lo = pg8::pk8(ra, rb);
            *(u32x4*)(h2 + (size_t)row * D + k0) = hi;
            const bf16x8 ahi = __builtin_bit_cast(bf16x8, hi), alo = __builtin_bit_cast(bf16x8, lo);
#pragma unroll
            for (int t = 0; t < 3; ++t) {
                const int wrow = 16 * t + ri; bf16x8 bh = {}, bl = {};
                if (wrow < 36) { bh = *(const LAS bf16x8*)(wl + wrow * WPITCH + k0 * 2); bl = *(const LAS bf16x8*)(wl + WLO_OFF + wrow * WPITCH + k0 * 2); }
                acc[t] = __builtin_amdgcn_mfma_f32_16x16x32_bf16(ahi, bh, acc[t], 0, 0, 0);
                acc[t] = __builtin_amdgcn_mfma_f32_16x16x32_bf16(alo, bh, acc[t], 0, 0, 0);
                acc[t] = __builtin_amdgcn_mfma_f32_16x16x32_bf16(ahi, bl, acc[t], 0, 0, 0);
            }
        }
        __syncthreads();
        if (F.tid < 64) hist[F.tid] = 0u;
#pragma unroll
        for (int t = 0; t < 3; ++t)
#pragma unroll
            for (int e = 0; e < 4; ++e) lg[(4 * q + e) * 48 + 16 * t + ri] = acc[t][e];
        __syncthreads();
        int e0 = 0, e1 = 0; float w0 = 0.f, w1 = 0.f; unsigned r0 = 0u, r1 = 0u;
        if (lane < 16) {
            const LAS float* L = lg + lane * 48;
            float gl[4]; int gt = 0; float gm = -INFINITY;
#pragma unroll
            for (int i = 0; i < 4; ++i) { gl[i] = L[i] + bg[i]; if (gl[i] > gm) { gm = gl[i]; gt = i; } }
            float gs = 0.f;
#pragma unroll
            for (int i = 0; i < 4; ++i) gs += __expf(gl[i] - gm);
            const float pgv = 1.0f / gs;
            float el[8]; float em = -INFINITY;
#pragma unroll
            for (int i = 0; i < 8; ++i) { el[i] = L[4 + gt * 8 + i] + be[gt * 8 + i]; em = fmaxf(em, el[i]); }
            int i1 = 0; float v1 = -INFINITY;
#pragma unroll
            for (int i = 0; i < 8; ++i) if (el[i] > v1) { v1 = el[i]; i1 = i; }
            int i2 = 0; float v2 = -INFINITY;
#pragma unroll
            for (int i = 0; i < 8; ++i) if (i != i1 && el[i] > v2) { v2 = el[i]; i2 = i; }
            const float p1 = __expf(v1 - em), p2 = __expf(v2 - em);
            w0 = pgv * p1 / (p1 + p2); w1 = pgv * p2 / (p1 + p2);
            e0 = gt * 8 + i1; e1 = gt * 8 + i2;
            r0 = __hip_atomic_fetch_add((LAS unsigned*)hist + e0, 1u, __ATOMIC_RELAXED, __HIP_MEMORY_SCOPE_WORKGROUP); r1 = __hip_atomic_fetch_add((LAS unsigned*)hist + e1, 1u, __ATOMIC_RELAXED, __HIP_MEMORY_SCOPE_WORKGROUP);
        }
        __syncthreads();
        if (F.tid < 32) { const unsigned n = hist[F.tid]; hist[32 + F.tid] = n ? atomicAdd(cnt + F.tid, n) : 0u; }
        __syncthreads();
        if (lane < 16) {
            const int tok = tile * 128 + F.wave * 16 + lane;
            const unsigned pos0 = hist[32 + e0] + r0, pos1 = hist[32 + e1] + r1;
            list[(size_t)e0 * LIST_CAP + pos0] = tok; list[(size_t)e1 * LIST_CAP + pos1] = tok;
            unsigned* rp = rec + (size_t)tok * 8;
            rp[0] = (unsigned)e0; rp[1] = (unsigned)e1; rp[2] = pos0; rp[3] = pos1; rp[4] = __float_as_uint(w0); rp[5] = __float_as_uint(w1);
        }
        __syncthreads();
    }
}


DEVI void ph_moba_select_mfma(const Frame& F, const bf16_t* Q, const float* ksum, unsigned* sel) {
    const int lane = F.lane, r = lane & 31, h = lane >> 5;
    for (int item = F.gw; item < BATCH * NH * (SEQ / 32); item += F.NGW) {
        const int qt = item & 127, bh = item >> 7, b = bh >> 3, hh = bh & 7, s0 = qt * 32, qb = s0 >> 8;
        if (qb == 0) { if (h == 0) sel[(size_t)bh * SEQ + s0 + r] = 0u; continue; }
        f32x16 acc = {};
#pragma unroll
        for (int s = 0; s < 4; ++s) {
            const bf16x8 bq = *(const bf16x8*)(Q + ((size_t)b * SEQ + s0 + r) * 512 + hh * 64 + 16 * s + 8 * h);
            f32x4 k0 = (f32x4){0.f, 0.f, 0.f, 0.f}, k1 = k0;
            if (r < 16) { const float* kp = ksum + (((size_t)bh * 16 + r) * 2) * 64 + 16 * s + 8 * h; k0 = *(const f32x4*)kp + *(const f32x4*)(kp + 64); k1 = *(const f32x4*)(kp + 4) + *(const f32x4*)(kp + 68); }
            const u32x4 hi = pg8::pk8(k0, k1), lo = pg8::pk8(k0 - pg8::unpk_lo(hi, 0), k1 - pg8::unpk_lo(hi, 1));
            acc = __builtin_amdgcn_mfma_f32_32x32x16_bf16(__builtin_bit_cast(bf16x8, hi), bq, acc, 0, 0, 0);
            acc = __builtin_amdgcn_mfma_f32_32x32x16_bf16(__builtin_bit_cast(bf16x8, lo), bq, acc, 0, 0, 0);
        }
        float sc[16];
#pragma unroll
        for (int reg = 0; reg < 8; ++reg) { const float mine = acc[reg], other = xshfl(acc[reg], 32, lane); const int base = (reg & 3) + 8 * (reg >> 2);
            sc[base] = h ? other : mine; sc[base + 4] = h ? mine : other; }
        unsigned m = 0u;
#pragma unroll
        for (int t = 0; t < 3; ++t) { float best = -INFINITY; int bi = -1;
#pragma unroll
            for (int j = 0; j < 15; ++j) { const bool ok = (j < qb) && !((m >> j) & 1u) && (sc[j] > best); best = ok ? sc[j] : best; bi = ok ? j : bi; }
            if (bi >= 0) m |= 1u << bi; }
        if (h == 0) sel[(size_t)bh * SEQ + s0 + r] = m;
    }
}

constexpr int PH_PER_LAYER = 10, N_PHASES = 1 + DEPTH * PH_PER_LAYER;
__global__ void __launch_bounds__(NTHR, 2) mk_fwd(Args a) {
    extern __shared__ __attribute__((aligned(16))) unsigned char lds_raw[];
    Frame F0;
    F0.lds = (LAS unsigned char*)lds_raw;
    F0.tid = threadIdx.x; F0.lane = F0.tid & 63; F0.wave = __builtin_amdgcn_readfirstlane(F0.tid >> 6);
    F0.G = gridDim.x; F0.gw = blockIdx.x * NWAVES + F0.wave; F0.NGW = F0.G * NWAVES; F0.gt = blockIdx.x * NTHR + F0.tid; F0.NGT = F0.G * NTHR;
    volatile LAS unsigned* LCTL = (volatile LAS unsigned*)(F0.lds + LDSCTL_OFF);
    volatile LAS int* pstart = (volatile LAS int*)(F0.lds + LDSCTL_OFF + 256);
    for (int u = F0.tid; u < 256; u += NTHR) LCTL[u] = 0u;
    __syncthreads();
    unsigned* ctl = (unsigned*)(a.ws + WS_CTL);
    XcdBarrier bar = xcd_barrier_post(ctl + CW_BAR + a.li * XCD_BAR_WORDS, LCTL);

#define x_in (a.in[0])
#define norm1_g (a.in[1])
#define w_in (a.in[2])
#define ssm_d (a.in[10])
#define w_glu (a.in[11])
#define qng (a.in[12])
#define kng (a.in[13])
#define w_attn (a.in[14])
#define w_out (a.in[15])
#define norm2_g (a.in[16])
#define wgrp (a.in[17])
#define bgrp (a.in[18])
#define wexp (a.in[19])
#define bexp (a.in[20])
#define w_gu (a.in[21])
#define w_dn (a.in[22])
#define X (a.out)
#define rope ((float*)(ws + WS_ROPE))
#define AL ((float*)(ws + WS_MISC + MISC_AL))
#define ksum ((float*)(ws + WS_SL + 4 * MiB))
#define SEL ((unsigned*)(ws + WS_MISC + MISC_SEL))
#define rec ((unsigned*)(ws + WS_REC))
#define list ((int*)(ws + WS_LIST))
#define TC ((bf16_t*)(ws + WS_S5TC))
#define BS ((bf16_t*)(ws + WS_S5BS))
#define H ((bf16_t*)(ws + WS_H))
#define UCAT ((bf16_t*)(ws + WS_UCAT))
#define Qb ((bf16_t*)(ws + WS_Q))
#define Kb ((bf16_t*)(ws + WS_K))
#define Vb ((bf16_t*)(ws + WS_V))
#define SG ((bf16_t*)(ws + WS_SG))
#define Z ((bf16_t*)(ws + WS_Z))
#define ATT ((bf16_t*)(ws + WS_ATT))
#define MIXA ((bf16_t*)(ws + WS_MIXA))
#define MIXED ((bf16_t*)(ws + WS_MIXED))
#define SL ((float*)(ws + WS_SL))
#define HMID ((bf16_t*)(ws + WS_HMID))
#define YBUF ((bf16_t*)(ws + WS_YBUF))
#define QRAW ((float*)(ws + WS_QRAW))
#define KRAW ((float*)(ws + WS_KRAW))
#define WIN ((bf16_t*)(ws + WS_WIN))
#define WGLU ((bf16_t*)(ws + WS_WGLU))
#define WATT ((bf16_t*)(ws + WS_WATT))
#define WOUT ((bf16_t*)(ws + WS_WOUT))
#define WGU ((bf16_t*)(ws + WS_WGU))
#define WDN ((bf16_t*)(ws + WS_WDN))
#define WR ((bf16_t*)(ws + WS_MISC + MISC_WR))
#define XB ((bf16_t*)(ws + WS_XB))
#define SSQ ((float*)(ws + WS_SL))
    const int lo = a.ph_lo, hi = a.ph_hi;
    int ph = 0; unsigned bgen = 0u;
#define PH_BEGIN if (ph >= lo && ph < hi) { for (int rep_ = 0; rep_ < ((((unsigned long long)REP_MASK >> ph) & 1ull) ? 2 : 1); ++rep_) { if (rep_) __syncthreads(); Frame P = F0; unsigned long long wz_ = 0ull; asm volatile("" : "+s"(wz_)); unsigned char* ws = a.ws + wz_;     { int t_ = F0.wave * 64 + (int)__builtin_amdgcn_mbcnt_hi(~0u, __builtin_amdgcn_mbcnt_lo(~0u, 0u)); asm volatile("" : "+v"(t_));     P.tid = t_; P.lane = t_ & 63; P.gt = (int)blockIdx.x * NTHR + t_; P.wave = __builtin_amdgcn_readfirstlane(t_ >> 6); P.gw = (int)blockIdx.x * NWAVES + P.wave; }
#define PH_END   } if (ph + 1 < hi) { ++bgen; xcd_barrier_w(bar, bgen, LCTL + 4, make_cvtq(a, F0.lds, F0.wave, fresh_lane())); } } ++ph;

    const int vcu = (F0.G % 8 == 0) ? ((int)blockIdx.x % 8) * (F0.G / 8) + (int)blockIdx.x / 8 : (int)blockIdx.x;
    LAS unsigned char* ring = F0.lds;
    volatile LAS int* tstart = (volatile LAS int*)(F0.lds + LDSCTL_OFF + 512);
    LAS unsigned* gtab = (LAS unsigned*)(F0.lds + GTAB_OFF);

    PH_BEGIN
        ph_rope_table(P, rope);
        for (int it4 = blockIdx.x; it4 < DEPTH * SSM_G * 4; it4 += P.G) { const int it = it4 >> 2;
            s5_tables_item(it / SSM_G, it % SSM_G, a.in[3], a.in[4], a.in[5], a.in[6], a.in[7], a.in[8], a.in[9],
                           TC + (size_t)it * 512 * 640, BS + (size_t)it * 128 * 512, AL + (size_t)it * 128, (LAS float*)P.lds, P.tid, NTHR, it4 & 3); }
        ph_rmsnorm(P, x_in, norm1_g, H);
        ph_convert_first(P, make_cvtq(a, F0.lds, P.wave, P.lane));
        ph_router_weights(P, wgrp, wexp, WR);
    PH_END

    for (int l = 0; l < DEPTH; ++l) {
#define xin ((l == 0) ? x_in : (const float*)X)
#define cnt ((unsigned*)(ws + WS_CTL) + CW_CNT + l * NEXP)
        PH_BEGIN
            pg8::Gemm g{H, WIN + (size_t)l * D_IN * D, D, D, D, 0, 0}; pg8::StaticOrder S; S.init(NTOK, D_IN, P.G, (int)blockIdx.x);
            pg8::EpiG1 E{UCAT, Qb, Kb, Vb, SG, qng + l * 64, kng + l * 64, rope, QRAW, KRAW, ksum};
            pg8::gemm_phase<pg8::EpiG1, pg8::StaticOrder, pg8::NoGather, G1_ALIGN>(ring, g, S, E, pg8::NoGather{}, P.tid);
        PH_END
        PH_BEGIN
            if (P.G == 256) { if (vcu >= 128) { Frame Q2 = P; Q2.gw = (vcu - 128) * NWAVES + P.wave; Q2.NGW = 128 * NWAVES; ph_moba_select_mfma(Q2, Qb, ksum, SEL); } } else ph_moba_select_mfma(P, Qb, ksum, SEL);
            { pg8::Gemm g{UCAT, BS + (size_t)l * SSM_G * 128 * 512, UK, 512, 512, (size_t)UROWS * UK, (size_t)128 * 512}; pg8::OrderS5A S{P.G, vcu};
              pg8::EpiS5Am E{AL + (size_t)l * SSM_G * 128, UCAT};
              pg8::gemm_phase<pg8::EpiS5Am, pg8::OrderS5A, pg8::NoGather, false>(ring, g, S, E, pg8::NoGather{}, P.tid); }
        PH_END
        PH_BEGIN
            { pg8::Gemm g{UCAT, TC + (size_t)l * SSM_G * 512 * 640, UK, UK, UK, (size_t)UROWS * UK, (size_t)512 * 640}; pg8::OrderS5C S{P.G, vcu};
              pg8::EpiS5Cm E{UCAT, ssm_d + l * SSM_W, Z};
              pg8::gemm_phase<pg8::EpiS5Cm, pg8::OrderS5C, pg8::NoGather, false>(ring, g, S, E, pg8::NoGather{}, P.tid); }
        PH_END
        PH_BEGIN
            { const attn_body::AttnTensors AT{(const attn_body::bf16*)Qb, (const attn_body::bf16*)Kb, (const attn_body::bf16*)Vb, (attn_body::bf16*)ATT, SEL};
              const attn_body::StaticOrder SA((int)P.G, (int)blockIdx.x);
              attn_body::attn_phase<attn_body::StaticOrder>((char*)lds_raw, AT, SA, P.tid); }
            { pg8::Gemm g{Z, WGLU + (size_t)l * 2048 * 512, 512, 512, 512, 0, 0}; pg8::StaticOrder S; S.init(NTOK, 2048, P.G, (int)blockIdx.x);
              pg8::EpiGlu E{SG, MIXA};
              pg8::gemm_phase<pg8::EpiGlu, pg8::StaticOrder, pg8::NoGather, true>(ring, g, S, E, pg8::NoGather{}, P.tid); }
        PH_END
        PH_BEGIN
            pg8::Gemm g{ATT, WATT + (size_t)l * 1024 * 512, 512, 512, 512, 0, 0}; pg8::StaticOrder S; S.init(NTOK, 1024, P.G, (int)blockIdx.x);
            pg8::EpiMix E{SG, MIXA, MIXED};
            pg8::gemm_phase<pg8::EpiMix, pg8::StaticOrder, pg8::NoGather, true>(ring, g, S, E, pg8::NoGather{}, P.tid);
        PH_END
        PH_BEGIN
            pg8::Gemm g{MIXED, WOUT + (size_t)l * 1024 * 1024, 1024, 1024, 1024, 0, 0}; pg8::StaticOrder S; S.init(NTOK, 1024, P.G, (int)blockIdx.x);
            if (l == 0) { pg8::EpiResBf16<true> E{x_in, XB, SSQ}; pg8::gemm_phase<pg8::EpiResBf16<true>, pg8::StaticOrder, pg8::NoGather, true>(ring, g, S, E, pg8::NoGather{}, P.tid); }
            else { pg8::EpiResBf16<false> E{nullptr, XB, SSQ}; pg8::gemm_phase<pg8::EpiResBf16<false>, pg8::StaticOrder, pg8::NoGather, true>(ring, g, S, E, pg8::NoGather{}, P.tid); }
        PH_END
        PH_BEGIN make_cvtq(a, F0.lds, P.wave, P.lane).catchup(l == 0 ? CVQ_LIM_MOE0 : CVQ_TOTAL); __syncthreads(); ph_norm_router_mfma(P, XB, SSQ, norm2_g + l * D, WR + (size_t)l * 2 * 48 * 1024, bgrp + l * 4, bexp + l * 32, H, cnt, list, rec); PH_END
        PH_BEGIN
            moe_tstart(P, cnt, tstart); moe_gather_table(P, vcu, cnt, list, tstart, gtab);
            pg8::Gemm g{H, WGU + (size_t)l * NEXP * 1024 * 1024, D, 1024, 1024, 0, (size_t)1024 * 1024}; pg8::OrderMoE S{P.G, vcu, tstart};
            pg8::EpiSwiglu E{HMID};
            pg8::gemm_phase<pg8::EpiSwiglu, pg8::OrderMoE, pg8::LdsGather, true>(ring, g, S, E, pg8::LdsGather{gtab}, P.tid);
        PH_END
        PH_BEGIN
            moe_tstart(P, cnt, tstart);
            pg8::Gemm g{HMID, WDN + (size_t)l * NEXP * 1024 * 512, 512, 512, 512, 0, (size_t)1024 * 512}; pg8::OrderMoE S{P.G, vcu, tstart};
            pg8::EpiStoreBf16 E{YBUF, 1024};
            pg8::gemm_phase<pg8::EpiStoreBf16, pg8::OrderMoE, pg8::NoGather, true>(ring, g, S, E, pg8::NoGather{}, P.tid);
        PH_END
        PH_BEGIN
            if (l + 1 < DEPTH) { make_cvtq(a, F0.lds, P.wave, P.lane).catchup(CVQ_LIM_PROJ1); __syncthreads(); }
            compute_pstart(P, cnt, pstart);
            if (l + 1 < DEPTH) ph_combine<false>(P, XB, X, YBUF, rec, pstart, norm1_g + (l + 1) * D, H);
            else ph_combine<true>(P, XB, X, YBUF, rec, pstart, nullptr, H);
        PH_END
    }
#undef PH_BEGIN
#undef PH_END
#undef x_in
#undef norm1_g
#undef w_in
#undef ssm_d
#undef w_glu
#undef qng
#undef kng
#undef w_attn
#undef w_out
#undef norm2_g
#undef wgrp
#undef bgrp
#undef wexp
#undef bexp
#undef w_gu
#undef w_dn
#undef X
#undef rope
#undef AL
#undef ksum
#undef SEL
#undef rec
#undef list
#undef TC
#undef BS
#undef H
#undef UCAT
#undef Qb
#undef Kb
#undef Vb
#undef SG
#undef Z
#undef ATT
#undef MIXA
#undef MIXED
#undef SL
#undef HMID
#undef YBUF
#undef QRAW
#undef KRAW
#undef WIN
#undef WGLU
#undef WATT
#undef WOUT
#undef WGU
#undef WDN
#undef WR
#undef XB
#undef SSQ
#undef xin
#undef cnt
}

extern "C" void kernel_launch(void* const* d_in, const int* in_sizes, int n_in, void* d_out, int out_size, void* d_ws, size_t ws_size, hipStream_t stream) {
    static int grid = 0;
    if (grid == 0) {
        if (n_in != 23 || ws_size < WS_END || out_size != NTOK * D) { fprintf(stderr, "kernel_launch: unexpected n_in %d / ws_size %zu / out_size %d; nothing launched\n", n_in, ws_size, out_size); grid = -1; return; }
        int dev = 0, cus = 0, per_cu = 0;
        if (hipGetDevice(&dev) != hipSuccess || hipDeviceGetAttribute(&cus, hipDeviceAttributeMultiprocessorCount, dev) != hipSuccess) { grid = -1; return; }
        if (hipFuncSetAttribute((const void*)mk_fwd, hipFuncAttributeMaxDynamicSharedMemorySize, LDS_BYTES) != hipSuccess) { fprintf(stderr, "kernel_launch: hipFuncSetAttribute failed\n"); grid = -1; return; }
        if (hipOccupancyMaxActiveBlocksPerMultiprocessor(&per_cu, (const void*)mk_fwd, NTHR, LDS_BYTES) != hipSuccess || per_cu < 1) { fprintf(stderr, "kernel_launch: occupancy query says %d\n", per_cu); }
        (void)hipGetLastError();
        grid = cus;
    }
    if (grid < 0) return;
    if (hipMemsetAsync((char*)d_ws + WS_CTL, 0, CTL_BYTES, stream) != hipSuccess) return;
    Args a{};
    for (int i = 0; i < 23; ++i) a.in[i] = (const float*)d_in[i];
    a.out = (float*)d_out; a.ws = (unsigned char*)d_ws;
#if MK_PER_PHASE
    for (int p = 0; p < N_PHASES; ++p) { a.ph_lo = p; a.ph_hi = p + 1; a.li = p; hipLaunchKernelGGL(mk_fwd, dim3(grid), dim3(NTHR), LDS_BYTES, stream, a); }
#else
    a.ph_lo = 0; a.ph_hi = N_PHASES; a.li = 0;
    hipLaunchKernelGGL(mk_fwd, dim3(grid), dim3(NTHR), LDS_BYTES, stream, a);
#endif
}
```

```cpp
#include <hip/hip_runtime.h>
#include <hip/hip_bf16.h>
#include <cstdint>
#include <cstdio>
#include <cmath>

#define DEVI __device__ __forceinline__
#define GAS __attribute__((address_space(1)))
#define LAS __attribute__((address_space(3)))
typedef unsigned short bf16_t;
typedef short bf16x8 __attribute__((ext_vector_type(8)));
typedef float f32x4 __attribute__((ext_vector_type(4)));
typedef float f32x16 __attribute__((ext_vector_type(16)));
typedef unsigned u32x4 __attribute__((ext_vector_type(4)));
typedef unsigned u32x2 __attribute__((ext_vector_type(2)));
typedef float cf32 __attribute__((ext_vector_type(2)));

#ifndef OPT_G1
#define OPT_G1 1
#endif
#ifndef G1_RAWQK
#define G1_RAWQK 0
#endif
#ifndef OPT_S5
#define OPT_S5 1
#endif
#ifndef OPT_G3
#define OPT_G3 1
#endif
#ifndef OPT_G4
#define OPT_G4 1
#endif
#ifndef OPT_G5
#define OPT_G5 1
#endif
#ifndef OPT_ATT
#define OPT_ATT 1
#endif
#ifndef REP_MASK
#define REP_MASK 0ull
#endif
#ifndef BAR_TWICE
#define BAR_TWICE 0
#endif
#ifndef G1_ALIGN
#define G1_ALIGN true
#endif
#ifndef OPT_RT
#define OPT_RT 1
#endif
#ifndef OPT_M1
#define OPT_M1 1
#endif
#ifndef OPT_M2
#define OPT_M2 1
#endif
#ifndef MK_PER_PHASE
#define MK_PER_PHASE 0
#endif

constexpr int D = 1024, BATCH = 8, SEQ = 4096, NTOK = BATCH * SEQ, DEPTH = 2;
constexpr int SSM_G = 32, SSM_C = 16, SSM_W = 512, SSM_P = 64;
constexpr int NH = 8, HD = 64, AW = 512, MOBA_B = 256, NBLK = SEQ / MOBA_B;
constexpr int D_IN = 4096;
constexpr int NEXP = 32, DEXP = 512;
constexpr int CHL = 32, NCH = SEQ / CHL, UK = 640, UROWS = BATCH * NCH;
constexpr int SLOT_CAP = 2 * NTOK + NEXP * 256;
constexpr int LIST_CAP = NTOK;
constexpr float NORM_EPS = 1e-6f;
constexpr float QSCALE = 0.125f * 1.4426950408889634f;
constexpr int NWAVES = 8, NTHR = 512;

constexpr size_t MiB = 1u << 20;
constexpr size_t WS_CTL = 0, CTL_BYTES = 1 * MiB;
constexpr size_t WS_ROPE = 1 * MiB;
constexpr size_t WS_MISC = 2 * MiB;
constexpr size_t WS_REC = 4 * MiB;
constexpr size_t WS_LIST = 5 * MiB;
constexpr size_t WS_S5TC = 16 * MiB;
constexpr size_t WS_S5BS = 56 * MiB;
constexpr size_t WS_WIN = 66 * MiB, WS_WGLU = 82 * MiB, WS_WATT = 86 * MiB, WS_WOUT = 88 * MiB, WS_WGU = 92 * MiB, WS_WDN = 220 * MiB;
constexpr size_t WS_H = 284 * MiB;
constexpr size_t WS_UCAT = 348 * MiB;
constexpr size_t WS_Q = 388 * MiB, WS_K = 420 * MiB, WS_V = 452 * MiB;
constexpr size_t WS_SG = 484 * MiB;
constexpr size_t WS_Z = 612 * MiB;
constexpr size_t WS_ATT = 644 * MiB;
constexpr size_t WS_MIXA = 676 * MiB, WS_MIXED = 740 * MiB;
constexpr size_t WS_SL = 804 * MiB;
constexpr size_t WS_XB = 820 * MiB;
constexpr size_t WS_END = 884 * MiB;
constexpr size_t WS_HMID = WS_UCAT;
constexpr size_t WS_YBUF = WS_SG;
constexpr size_t WS_QRAW = WS_MIXA, WS_KRAW = WS_MIXED;
constexpr size_t MISC_AL = 0;
constexpr size_t MISC_KSUM = 64 * 1024;
constexpr size_t MISC_SEL = 512 * 1024;
constexpr size_t MISC_WR = 1536 * 1024;
constexpr int CW_CNT = 64;
constexpr int CW_CVQ = 1024;
constexpr int CW_BAR = 4096;
constexpr int MAX_LAUNCHES = 64;

constexpr int RING_BYTES = 131072;
constexpr int GTAB_OFF = 160 * 1024 - 9 * 1024;
constexpr int LDSCTL_OFF = 160 * 1024 - 1024;
constexpr int SCRATCH_BYTES = GTAB_OFF;
constexpr int LDS_BYTES = 160 * 1024;

DEVI float bf2f(bf16_t v) { return __uint_as_float((unsigned)v << 16); }
DEVI bf16_t f2bf(float f) { unsigned u = __float_as_uint(f); return (bf16_t)((u + 0x7fffu + ((u >> 16) & 1u)) >> 16); }
DEVI unsigned pk2(float lo, float hi) { return (unsigned)f2bf(lo) | ((unsigned)f2bf(hi) << 16); }
typedef float g_f32x2 __attribute__((ext_vector_type(2))); typedef __bf16 g_bf16x2 __attribute__((ext_vector_type(2)));
DEVI unsigned cvtpk(float lo, float hi) { const g_f32x2 v = {lo, hi}; const g_bf16x2 b = __builtin_convertvector(v, g_bf16x2); return __builtin_bit_cast(unsigned, b); }
DEVI u32x4 pack8(f32x4 a, f32x4 b) { u32x4 w; w.x = cvtpk(a[0], a[1]); w.y = cvtpk(a[2], a[3]); w.z = cvtpk(b[0], b[1]); w.w = cvtpk(b[2], b[3]); return w; }
DEVI f32x4 unpk8(u32x4 w, int half) { const unsigned a = half ? w.z : w.x, b = half ? w.w : w.y; return (f32x4){__uint_as_float(a << 16), __uint_as_float(a & 0xffff0000u), __uint_as_float(b << 16), __uint_as_float(b & 0xffff0000u)}; }
DEVI float sigmoidf_(float x) { return 1.f / (1.f + __expf(-x)); }
DEVI float gelu_tanh(float x) { const float u2 = 1.5957691216057308f * (x + 0.044715f * x * x * x); return x * __builtin_amdgcn_rcpf(1.0f + __expf(-u2)); }
DEVI float xshfl(float v, int o, int lane) { return __int_as_float(__builtin_amdgcn_ds_bpermute((lane ^ o) << 2, __float_as_int(v))); }
DEVI float wave_sum(float v, int lane) {
#pragma unroll
    for (int o = 1; o < 64; o <<= 1) v += xshfl(v, o, lane);
    return v;
}
DEVI float wave_max(float v) {
#pragma unroll
    for (int o = 1; o < 64; o <<= 1) v = fmaxf(v, __shfl_xor(v, o));
    return v;
}

#define XB_TMO      128
#define XB_XCNT(j)  (256  + 64 * (j))
#define XB_XSUB(j)  (1280 + 64 * (j))
#define XB_XGEN(j)  (2304 + 64 * (j))
#define XB_TOP      3328
#define XB_TOPGEN   3392
#define XCD_BAR_WORDS 3456
#define XB_SPIN_CAP (1u << 18)
DEVI unsigned xb_ld(unsigned* p)              { return __hip_atomic_load(p, __ATOMIC_RELAXED, __HIP_MEMORY_SCOPE_AGENT); }
DEVI unsigned xb_add(unsigned* p, unsigned v) { return __hip_atomic_fetch_add(p, v, __ATOMIC_RELAXED, __HIP_MEMORY_SCOPE_AGENT); }
DEVI unsigned xb_xcc_id() { return (unsigned)__builtin_amdgcn_s_getreg((3 << 11) | 20) & 0xFu; }
#define XB_SPIN(cond, bar) do { unsigned _sp = 0; while (cond) { __builtin_amdgcn_s_sleep(1); \
    if ((++_sp & 255u) == 0u) { if (xb_ld(&(bar)[XB_TMO])) break; if (_sp > XB_SPIN_CAP) { atomicAdd(&(bar)[XB_TMO], 1u); break; } } } } while (0)
struct XcdBarrier { unsigned* bar; unsigned x; volatile LAS unsigned* st; };
DEVI XcdBarrier xcd_barrier_post(unsigned* bar, volatile LAS unsigned* st) {
    XcdBarrier b; b.bar = bar; b.x = xb_xcc_id(); b.st = st;
    if (threadIdx.x == 0) (void)xb_add(&bar[XB_XCNT(b.x)], 1u);
    return b;
}
DEVI void xcd_barrier_complete(unsigned* bar, unsigned x, unsigned& nloc, unsigned& nx) {
    const unsigned G = gridDim.x * gridDim.y * gridDim.z;
    unsigned sum, cnt, mine, sp = 0u;
    for (;;) {
        sum = 0u; cnt = 0u; mine = 0u;
#pragma unroll
        for (unsigned j = 0; j < 16; ++j) { const unsigned c = xb_ld(&bar[XB_XCNT(j)]); sum += c; cnt += (c > 0u) ? 1u : 0u; mine = (j == x) ? c : mine; }
        if (sum == G) break;
        __builtin_amdgcn_s_sleep(1);
        if ((++sp & 255u) == 0u) { if (xb_ld(&bar[XB_TMO])) break; if (sp > XB_SPIN_CAP) { atomicAdd(&bar[XB_TMO], 1u); break; } }
    }
    nloc = mine > 0u ? mine : 1u; nx = cnt > 0u ? cnt : 1u;
}
DEVI void xcd_barrier(const XcdBarrier& b) {
    asm volatile("s_waitcnt vmcnt(0)" ::: "memory");
    __syncthreads();
    if (threadIdx.x == 0) {
        unsigned* bar = b.bar;
        __builtin_amdgcn_s_waitcnt(0);
        unsigned nloc = b.st[0], nx = b.st[1];
        if (nloc == 0u) { xcd_barrier_complete(bar, b.x, nloc, nx); b.st[0] = nloc; b.st[1] = nx; }
        const unsigned old = xb_add(&bar[XB_XSUB(b.x)], 1u);
        const unsigned gen = old / nloc;
        if (old + 1u == (gen + 1u) * nloc) {
            __builtin_amdgcn_fence(__ATOMIC_RELEASE, "agent");
            asm volatile("s_waitcnt vmcnt(0)" ::: "memory");
            const unsigned og = xb_add(&bar[XB_TOP], 1u);
            const unsigned tg = og / nx;
            if (og + 1u == (tg + 1u) * nx) xb_add(&bar[XB_TOPGEN], 1u);
            else XB_SPIN(xb_ld(&bar[XB_TOPGEN]) == tg, bar);
            __builtin_amdgcn_fence(__ATOMIC_ACQUIRE, "agent");
            xb_add(&bar[XB_XGEN(b.x)], 1u);
            asm volatile("s_waitcnt vmcnt(0)" ::: "memory");
        } else {
            XB_SPIN(xb_ld(&bar[XB_XGEN(b.x)]) == gen, bar);
            __builtin_amdgcn_fence(__ATOMIC_ACQUIRE, "agent");
            asm volatile("s_waitcnt vmcnt(0)" ::: "memory");
        }
    }
    __syncthreads();
}

struct Args { const float* in[23]; float* out; unsigned char* ws; int ph_lo, ph_hi, li, pad; };
struct Frame { int tid, lane, wave, gw, NGW, gt, NGT, G; LAS unsigned char* lds; };

DEVI void ph_rope_table(const Frame& F, float* rope) {
    for (int idx = F.gt; idx < SEQ * 32; idx += F.NGT) {
        const int s = idx >> 5, i = idx & 31;
        const float inv = powf(10000.0f, -(float)(2 * i) / 64.0f);
        const float ang = (float)s * inv;
        float sn, cs; sincosf(ang, &sn, &cs);
        rope[2 * idx] = cs; rope[2 * idx + 1] = sn;
    }
}
DEVI void s5_tables_item(int l, int g, const float* a_re, const float* a_im, const float* log_dt, const float* b_re, const float* b_im,
                         const float* c_re, const float* c_im, bf16_t* TC, bf16_t* BS, float* AL, LAS float* lds, int tid, int nthr, int part) {
    LAS cf32* pw = (LAS cf32*)lds;
    LAS cf32* Cc = pw + 33 * 64;
    LAS cf32* Bb = Cc + 16 * 64;
    LAS cf32* fp = Bb + 64 * 16;
    LAS float* Kt = (LAS float*)(fp + 64);
    const int lg = l * SSM_G + g;
    const float dt = expf(log_dt[lg]);
    for (int i = tid; i < 33 * 64; i += nthr) {
        const int tau = i >> 6, p = i & 63;
        const float lr = a_re[lg * 64 + p], li = a_im[lg * 64 + p];
        const float mag = expf(lr * dt * (float)tau);
        float sn, cs; sincosf(li * dt * (float)tau, &sn, &cs);
        pw[i] = (cf32){mag * cs, mag * sn};
    }
    for (int i = tid; i < 16 * 64; i += nthr) Cc[i] = (cf32){c_re[(size_t)lg * 1024 + i], c_im[(size_t)lg * 1024 + i]};
    __syncthreads();
    for (int p = tid; p < 64; p += nthr) {
        const float lr = a_re[lg * 64 + p], li = a_im[lg * 64 + p];
        const cf32 ab = pw[64 + p];
        const float den = lr * lr + li * li, nre = ab.x - 1.0f;
        fp[p] = (cf32){(nre * lr + ab.y * li) / den, (ab.y * lr - nre * li) / den};
    }
    __syncthreads();
    for (int i = tid; i < 64 * 16; i += nthr) {
        const cf32 f = fp[i >> 4];
        const float br = b_re[(size_t)lg * 1024 + i], bi = b_im[(size_t)lg * 1024 + i];
        Bb[i] = (cf32){f.x * br - f.y * bi, f.x * bi + f.y * br};
    }
    __syncthreads();
    LAS cf32* Xc = (LAS cf32*)(Kt + 8 * 256);
    for (int i = tid; i < 8 * 16 * 64; i += nthr) { const int tl = i >> 10, co = (i >> 6) & 15, p = i & 63;
        const cf32 c = Cc[co * 64 + p], w = pw[(8 * part + tl) * 64 + p];
        Xc[i] = (cf32){c.x * w.x - c.y * w.y, c.x * w.y + c.y * w.x}; }
    __syncthreads();
    for (int i = tid; i < 8 * 256; i += nthr) {
        const int tl = i >> 8, co = (i >> 4) & 15, ci = i & 15;
        float acc = 0.f;
        for (int p = 0; p < 64; ++p) { const cf32 x = Xc[(tl * 16 + co) * 64 + p], b = Bb[p * 16 + ci]; acc += x.x * b.x - x.y * b.y; }
        Kt[i] = acc;
    }
    __syncthreads();
    for (int i = tid; i < 32 * 8 * 16 * 2; i += nthr) {
        const int t = i >> 8, tl = (i >> 5) & 7, co = (i >> 1) & 15, ch = i & 1, tp = t - (8 * part + tl);
        if (tp < 0) continue;
        const LAS float* kp = Kt + (tl * 16 + co) * 16 + 8 * ch;
        u32x4 o; o.x = pk2(kp[0], kp[1]); o.y = pk2(kp[2], kp[3]); o.z = pk2(kp[4], kp[5]); o.w = pk2(kp[6], kp[7]);
        *(u32x4*)(TC + (size_t)(t * 16 + co) * 640 + tp * 16 + 8 * ch) = o;
    }
    for (int i = tid; i < 128 * 64; i += nthr) {
        const int n = part * 128 + (i >> 6), col = 8 * (i & 63), t = n >> 4;
        if (col >= 16 * (t + 1)) *(u32x4*)(TC + (size_t)n * 640 + col) = (u32x4){0u, 0u, 0u, 0u};
    }
    for (int i = part * 128 * 128 + tid; i < (part + 1) * 128 * 128; i += nthr) {
        const int n = i >> 7, kc = i & 127, t = n >> 4, co = n & 15, p = kc & 63;
        const cf32 c = Cc[co * 64 + p], w = pw[(t + 1) * 64 + p];
        const float xr = c.x * w.x - c.y * w.y, xi = c.x * w.y + c.y * w.x;
        TC[(size_t)n * 640 + 512 + kc] = f2bf(kc < 64 ? xr : -xi);
    }
    for (int i = part * 32 * 512 + tid; i < (part + 1) * 32 * 512; i += nthr) {
        const int row = i >> 9, kk = i & 511, p = row & 63, tp = kk >> 4, ci = kk & 15;
        const cf32 w = pw[(31 - tp) * 64 + p], b = Bb[p * 16 + ci];
        BS[i] = f2bf(row < 64 ? (w.x * b.x - w.y * b.y) : (w.x * b.y + w.y * b.x));
    }
    if (part == 0) for (int i = tid; i < 64; i += nthr) { AL[2 * i] = pw[32 * 64 + i].x; AL[2 * i + 1] = pw[32 * 64 + i].y; }
    __syncthreads();
}

DEVI void ph_rmsnorm(const Frame& F, const float* x, const float* g, bf16_t* out) {
    constexpr int R = 4;
    for (int row0 = F.gw; row0 < NTOK; row0 += R * F.NGW) {
        f32x4 v[R][4];
#pragma unroll
        for (int u = 0; u < R; ++u) { const int row = (row0 + u * F.NGW < NTOK) ? row0 + u * F.NGW : row0; const f32x4* xr = (const f32x4*)(x + (size_t)row * D);
#pragma unroll
            for (int j = 0; j < 2; ++j) { v[u][2 * j] = xr[2 * (F.lane + 64 * j)]; v[u][2 * j + 1] = xr[2 * (F.lane + 64 * j) + 1]; } }
#pragma unroll
        for (int u = 0; u < R; ++u) { const int row = row0 + u * F.NGW; if (row >= NTOK) continue;
            float s = 0.f;
#pragma unroll
            for (int j = 0; j < 4; ++j) s += (v[u][j].x * v[u][j].x + v[u][j].y * v[u][j].y) + (v[u][j].z * v[u][j].z + v[u][j].w * v[u][j].w);
            const float rstd = 1.0f / sqrtf(wave_sum(s, F.lane) * (1.0f / D) + NORM_EPS);
#pragma unroll
            for (int j = 0; j < 2; ++j) { const f32x4 g0 = *((const f32x4*)g + 2 * (F.lane + 64 * j)), g1 = *((const f32x4*)g + 2 * (F.lane + 64 * j) + 1);
                *((u32x4*)(out + (size_t)row * D) + F.lane + 64 * j) = pack8(v[u][2 * j] * rstd * g0, v[u][2 * j + 1] * rstd * g1); } }
    }
}

template <int BMODE, class RowF, class Epi>
DEVI void sg_phase(const Frame& F, int ny, const RowF& rowf, const void* Bv, size_t bstride, int ldb, int K, int nct, int cstep, int off2, const Epi& epi) {
    const int lane = F.lane, r = lane & 31, h = lane >> 5;
    int base = 0;
    for (int y = 0; y < ny; ++y) {
        const int nrows = rowf.nrows(y), nrt = (nrows + 31) / 32, ntile = nrt * nct;
        const float* Bf = (const float*)Bv + (size_t)y * bstride;
        const bf16_t* Bt = (const bf16_t*)Bv + (size_t)y * bstride;
        int first = (F.gw - base % F.NGW + F.NGW) % F.NGW;
        for (int tile = first; tile < ntile; tile += F.NGW) {
            const int rt = tile / nct, ct = tile % nct, c0 = ct * cstep, c1 = c0 + off2;
            const int arow_i = rt * 32 + r;
            const bf16_t* arow = (arow_i < nrows) ? rowf(y, arow_i) : nullptr;
            f32x16 acc0 = {}, acc1 = {};
            for (int k = 0; k < K; k += 16) {
                bf16x8 a = {};
                if (arow) a = *(const bf16x8*)(arow + k + 8 * h);
                bf16x8 b0, b1;
                if (BMODE == 0) {
#pragma unroll
                    for (int j = 0; j < 8; ++j) { b0[j] = (short)f2bf(Bf[(size_t)(k + 8 * h + j) * ldb + c0 + r]); b1[j] = (short)f2bf(Bf[(size_t)(k + 8 * h + j) * ldb + c1 + r]); }
                } else {
                    b0 = *(const bf16x8*)(Bt + (size_t)(c0 + r) * ldb + k + 8 * h);
                    b1 = *(const bf16x8*)(Bt + (size_t)(c1 + r) * ldb + k + 8 * h);
                }
                acc0 = __builtin_amdgcn_mfma_f32_32x32x16_bf16(a, b0, acc0, 0, 0, 0);
                acc1 = __builtin_amdgcn_mfma_f32_32x32x16_bf16(a, b1, acc1, 0, 0, 0);
            }
#pragma unroll
            for (int reg = 0; reg < 16; ++reg) {
                const int row = rt * 32 + (reg & 3) + 8 * (reg >> 2) + 4 * h;
                if (row < nrows) epi(y, row, c0 + r, c1 + r, acc0[reg], acc1[reg]);
            }
        }
        base += ntile;
    }
}

struct RowPlain { const bf16_t* A; int lda; int n; size_t ystride;
    DEVI int nrows(int) const { return n; }
    DEVI const bf16_t* operator()(int y, int r) const { return A + (size_t)y * ystride + (size_t)r * lda; } };

struct EpiG1sPerm;
struct EpiG1s { bf16_t* ucat; float* qraw; float* kraw; bf16_t* v; bf16_t* sg;
    DEVI void one(int row, int c, float a) const {
        if (c < 512) { const int b = row >> 12, s = row & 4095, g = c >> 4, ci = c & 15;
            ucat[((size_t)g * UROWS + b * NCH + (s >> 5)) * UK + (s & 31) * 16 + ci] = f2bf(a); }
        else if (c < 1024) qraw[(size_t)row * 512 + (c - 512)] = a;
        else if (c < 1536) kraw[(size_t)row * 512 + (c - 1024)] = a;
        else if (c < 2048) v[(size_t)row * 512 + (c - 1536)] = f2bf(a);
        else sg[(size_t)row * 2048 + (c - 2048)] = f2bf(sigmoidf_(a));
    }
    DEVI void operator()(int, int row, int c0, int c1, float a0, float a1) const { one(row, c0, a0); one(row, c1, a1); } };

DEVI int g1_unperm(int cp) { const int pn = cp >> 8, tc = cp & 255; if (pn < 2 || pn >= 6) return cp; const int sec = pn < 4 ? 512 : 1024, hh = (pn & 1) * 4 + ((tc >> 5) & 3); return sec + hh * 64 + 32 * (tc >> 7) + (tc & 31); }
#ifndef G1_FIX_MASK
#define G1_FIX_MASK 0
#endif
DEVI bool g1_sel(int c) { const int sec = c < 512 ? 1 : c < 1024 ? 2 : c < 1536 ? 4 : c < 2048 ? 8 : 16; return (G1_FIX_MASK & sec) != 0; }
struct EpiG1sPerm { EpiG1s e; DEVI void operator()(int, int row, int c0, int c1, float a0, float a1) const { e.one(row, g1_unperm(c0), a0); e.one(row, g1_unperm(c1), a1); } };
struct EpiG1sFix { EpiG1s e; DEVI void operator()(int, int row, int c0, int c1, float a0, float a1) const { const int n0 = g1_unperm(c0), n1 = g1_unperm(c1); if (g1_sel(n0)) e.one(row, n0, a0); if (g1_sel(n1)) e.one(row, n1, a1); } };
DEVI void ph_qkpost(const Frame& F, const float* qraw, const float* kraw, const float* qg, const float* kg, const float* rope, bf16_t* Q, bf16_t* K) {
    for (int idx = F.gt; idx < NTOK * 16; idx += F.NGT) {
        const int which = idx & 1, hh = (idx >> 1) & 7, tok = idx >> 4;
        const float* src = (which ? kraw : qraw) + (size_t)tok * 512 + hh * 64;
        const float* gn = which ? kg : qg;
        float x[64]; float ss = 0.f;
#pragma unroll
        for (int i = 0; i < 16; ++i) { const f32x4 t = *((const f32x4*)src + i); x[4 * i] = t.x; x[4 * i + 1] = t.y; x[4 * i + 2] = t.z; x[4 * i + 3] = t.w; ss += (t.x * t.x + t.y * t.y) + (t.z * t.z + t.w * t.w); }
        const float rstd = 1.0f / sqrtf(ss * (1.0f / 64.0f) + NORM_EPS);
        const int s = tok & (SEQ - 1);
        const float sc = which ? 1.0f : QSCALE;
        bf16_t* dst = (which ? K : Q) + (size_t)tok * 512 + hh * 64;
#pragma unroll
        for (int i = 0; i < 32; ++i) {
            const float x1 = x[i] * rstd * gn[i], x2 = x[i + 32] * rstd * gn[i + 32];
            const float cs = rope[(s * 32 + i) * 2], sn = rope[(s * 32 + i) * 2 + 1];
            dst[i] = f2bf((x1 * cs - x2 * sn) * sc);
            dst[i + 32] = f2bf((x2 * cs + x1 * sn) * sc);
        }
    }
}
DEVI void ph_ksum(const Frame& F, const bf16_t* K, float* ksum) {
    const int lane = F.lane, rg = lane >> 3, c = lane & 7;
    for (int w = F.gw; w < BATCH * NH * NBLK; w += F.NGW) {
        const int blk = w & 15, hh = (w >> 4) & 7, b = w >> 7;
        const bf16_t* kp = K + ((size_t)b * SEQ + blk * 256 + rg) * 512 + hh * 64 + c * 8;
        float acc[8];
#pragma unroll
        for (int j = 0; j < 8; ++j) acc[j] = 0.f;
#pragma unroll 8
        for (int i = 0; i < 32; ++i) { const bf16x8 v = *(const bf16x8*)(kp + (size_t)i * 8 * 512);
#pragma unroll
            for (int j = 0; j < 8; ++j) acc[j] += bf2f((bf16_t)v[j]); }
#pragma unroll
        for (int j = 0; j < 8; ++j) { float t = acc[j]; t += xshfl(t, 8, lane); t += xshfl(t, 16, lane); t += xshfl(t, 32, lane); acc[j] = t; }
        if (rg == 0) { float* o = ksum + (size_t)w * 64 + c * 8; *(f32x4*)o = (f32x4){acc[0], acc[1], acc[2], acc[3]}; *(f32x4*)(o + 4) = (f32x4){acc[4], acc[5], acc[6], acc[7]}; }
    }
}

DEVI void ph_attn_simple(const Frame& F, const bf16_t* Q, const bf16_t* K, const bf16_t* V, const float* ksum, bf16_t* O) {
    const int lane = F.lane;
    for (int w = F.gw; w < BATCH * NH * SEQ; w += F.NGW) {
        const int s = w & (SEQ - 1), hh = (w >> 12) & 7, b = w >> 15;
        const int qb = s >> 8;
        const bf16_t* qp = Q + ((size_t)b * SEQ + s) * 512 + hh * 64;
        float q[64];
#pragma unroll
        for (int i = 0; i < 8; ++i) { const bf16x8 t = *((const bf16x8*)qp + i);
#pragma unroll
            for (int j = 0; j < 8; ++j) q[8 * i + j] = bf2f((bf16_t)t[j]); }
        float gsc = -INFINITY;
        if (lane < qb) { const float* km = ksum + ((size_t)(b * 8 + hh) * 16 + lane) * 64; float a = 0.f;
#pragma unroll
            for (int i = 0; i < 64; ++i) a += q[i] * km[i];
            gsc = a; }
        int blks[4]; int nsel = 0;
#pragma unroll
        for (int t = 0; t < 3; ++t) {
            float best = -INFINITY; int bi = -1;
            for (int j = 0; j < 15; ++j) { const float v = __shfl(gsc, j); const bool used = (t > 0 && j == blks[0]) || (t > 1 && j == blks[1]); if (j < qb && !used && v > best) { best = v; bi = j; } }
            blks[t] = bi; if (bi >= 0) nsel = t + 1;
        }
        blks[3] = qb;
        float sc[4][4]; float m = -INFINITY;
#pragma unroll
        for (int t = 0; t < 4; ++t) {
            const bool on = (t == 3) || (t < nsel);
            const int blk = on ? blks[t] : 0;
#pragma unroll
            for (int i = 0; i < 4; ++i) {
                const int key = blk * 256 + lane + 64 * i;
                float a = -INFINITY;
                if (on && (t < 3 || key <= s)) {
                    const bf16_t* kp = K + ((size_t)b * SEQ + key) * 512 + hh * 64; a = 0.f;
#pragma unroll
                    for (int c = 0; c < 8; ++c) { const bf16x8 kk = *((const bf16x8*)kp + c);
#pragma unroll
                        for (int j = 0; j < 8; ++j) a += q[8 * c + j] * bf2f((bf16_t)kk[j]); }
                }
                sc[t][i] = a; m = fmaxf(m, a);
            }
        }
        m = wave_max(m);
        float l = 0.f;
#pragma unroll
        for (int t = 0; t < 4; ++t)
#pragma unroll
            for (int i = 0; i < 4; ++i) { const float p = exp2f(sc[t][i] - m); sc[t][i] = p; l += p; }
        l = wave_sum(l, lane);
        float o = 0.f;
#pragma unroll
        for (int t = 0; t < 4; ++t) {
            const bool on = (t == 3) || (t < nsel);
            if (!on) continue;
            const int blk = blks[t];
#pragma unroll
            for (int i = 0; i < 4; ++i) {
                const float pv = sc[t][i];
                for (int j = 0; j < 64; ++j) {
                    const float p = __shfl(pv, j);
                    const int key = blk * 256 + j + 64 * i;
                    if (p != 0.f) o += p * bf2f(V[((size_t)b * SEQ + key) * 512 + hh * 64 + lane]);
                }
            }
        }
        O[((size_t)b * SEQ + s) * 512 + hh * 64 + lane] = f2bf(o / l);
    }
}

struct EpiS5A { float* sl; DEVI void operator()(int y, int row, int c0, int c1, float a0, float a1) const { float* p = sl + ((size_t)y * UROWS + row) * 128; p[c0] = a0; p[c1] = a1; } };
DEVI void ph_s5_scan(const Frame& F, const float* sl, const float* AL, bf16_t* ucat) {
    for (int idx = F.gt; idx < SSM_G * BATCH * 64; idx += F.NGT) {
        const int p = idx & 63, b = (idx >> 6) & 7, g = idx >> 9;
        const float ar = AL[(g * 64 + p) * 2], ai = AL[(g * 64 + p) * 2 + 1];
        float hr = 0.f, hi = 0.f;
        for (int c = 0; c < NCH; ++c) {
            const size_t row = (size_t)g * UROWS + b * NCH + c;
            ucat[row * UK + 512 + p] = f2bf(hr); ucat[row * UK + 576 + p] = f2bf(hi);
            const float sr = sl[row * 128 + p], si = sl[row * 128 + 64 + p];
            const float nr = ar * hr - ai * hi + sr, ni = ar * hi + ai * hr + si; hr = nr; hi = ni;
        }
    }
}
struct EpiS5C { const bf16_t* ucat; const float* dskip; bf16_t* z;
    DEVI void one(int g, int row, int n, float a) const {
        const int t = n >> 4, co = n & 15, b = row >> 7, c = row & 127;
        const float u = bf2f(ucat[((size_t)g * UROWS + row) * UK + n]);
        const float y = a + dskip[g * 16 + co] * u;
        z[((size_t)b * SEQ + c * CHL + t) * 512 + g * 16 + co] = f2bf(gelu_tanh(y));
    }
    DEVI void operator()(int y, int row, int c0, int c1, float a0, float a1) const { one(y, row, c0, a0); one(y, row, c1, a1); } };

struct EpiG3s { const bf16_t* sg; bf16_t* mixa;
    DEVI void operator()(int, int row, int c0, int c1, float val, float gate) const { mixa[(size_t)row * 1024 + c0] = f2bf(bf2f(sg[(size_t)row * 2048 + c0]) * val * sigmoidf_(gate)); } };
struct EpiG4s { const bf16_t* sg; const bf16_t* mixa; bf16_t* mixed;
    DEVI void one(int row, int c, float a) const { mixed[(size_t)row * 1024 + c] = f2bf(bf2f(mixa[(size_t)row * 1024 + c]) + bf2f(sg[(size_t)row * 2048 + 1024 + c]) * a); }
    DEVI void operator()(int, int row, int c0, int c1, float a0, float a1) const { one(row, c0, a0); one(row, c1, a1); } };
struct EpiG5s { const float* xin; float* xout;
    DEVI void operator()(int, int row, int c0, int c1, float a0, float a1) const { xout[(size_t)row * 1024 + c0] = xin[(size_t)row * 1024 + c0] + a0; xout[(size_t)row * 1024 + c1] = xin[(size_t)row * 1024 + c1] + a1; } };

DEVI void ph_norm_router(const Frame& F, const float* x, const float* g, const float* wg, const float* bg, const float* we, const float* be,
                         bf16_t* h2, unsigned* cnt, int* list, unsigned* rec) {
    const int lane = F.lane;
    for (int row = F.gw; row < NTOK; row += F.NGW) {
        const f32x4* xr = (const f32x4*)(x + (size_t)row * D) + lane;
        f32x4 v[4]; float s = 0.f;
#pragma unroll
        for (int j = 0; j < 4; ++j) { v[j] = xr[64 * j]; s += (v[j].x * v[j].x + v[j].y * v[j].y) + (v[j].z * v[j].z + v[j].w * v[j].w); }
        const float rstd = 1.0f / sqrtf(wave_sum(s, lane) * (1.0f / D) + NORM_EPS);
        float acc[36];
#pragma unroll
        for (int o = 0; o < 36; ++o) acc[o] = 0.f;
#pragma unroll
        for (int j = 0; j < 4; ++j) {
            const f32x4 gg = *((const f32x4*)g + lane + 64 * j);
            const float hv[4] = {v[j].x * rstd * gg.x, v[j].y * rstd * gg.y, v[j].z * rstd * gg.z, v[j].w * rstd * gg.w};
            u32x2 o; o.x = pk2(hv[0], hv[1]); o.y = pk2(hv[2], hv[3]);
            *((u32x2*)(h2 + (size_t)row * D) + lane + 64 * j) = o;
#pragma unroll
            for (int e = 0; e < 4; ++e) {
                const int k = 4 * lane + 256 * j + e;
                const f32x4 w4 = *(const f32x4*)(wg + (size_t)k * 4);
                acc[0] += hv[e] * w4.x; acc[1] += hv[e] * w4.y; acc[2] += hv[e] * w4.z; acc[3] += hv[e] * w4.w;
#pragma unroll
                for (int q = 0; q < 8; ++q) { const f32x4 w = *(const f32x4*)(we + (size_t)k * 32 + 4 * q);
                    acc[4 + 4 * q] += hv[e] * w.x; acc[5 + 4 * q] += hv[e] * w.y; acc[6 + 4 * q] += hv[e] * w.z; acc[7 + 4 * q] += hv[e] * w.w; }
            }
        }
#pragma unroll
        for (int o = 0; o < 36; ++o) acc[o] = wave_sum(acc[o], lane);
        if (lane == 0) {
            float gl[4]; int gt = 0; float gm = -INFINITY;
#pragma unroll
            for (int i = 0; i < 4; ++i) { gl[i] = acc[i] + bg[i]; if (gl[i] > gm) { gm = gl[i]; gt = i; } }
            float gs = 0.f;
#pragma unroll
            for (int i = 0; i < 4; ++i) gs += __expf(gl[i] - gm);
            const float pg = 1.0f / gs;
            float el[8]; float em = -INFINITY;
#pragma unroll
            for (int i = 0; i < 8; ++i) { float t = 0.f;
#pragma unroll
                for (int gq = 0; gq < 4; ++gq) t = (gq == gt) ? acc[4 + gq * 8 + i] + be[gq * 8 + i] : t;
                el[i] = t; em = fmaxf(em, t); }
            int i1 = 0; float v1 = -INFINITY;
#pragma unroll
            for (int i = 0; i < 8; ++i) if (el[i] > v1) { v1 = el[i]; i1 = i; }
            int i2 = 0; float v2 = -INFINITY;
#pragma unroll
            for (int i = 0; i < 8; ++i) if (i != i1 && el[i] > v2) { v2 = el[i]; i2 = i; }
            const float p1 = __expf(v1 - em), p2 = __expf(v2 - em);
            const float w0 = pg * p1 / (p1 + p2), w1 = pg * p2 / (p1 + p2);
            const int e0 = gt * 8 + i1, e1 = gt * 8 + i2;
            const unsigned pos0 = atomicAdd(cnt + e0, 1u), pos1 = atomicAdd(cnt + e1, 1u);
            list[(size_t)e0 * LIST_CAP + pos0] = row; list[(size_t)e1 * LIST_CAP + pos1] = row;
            unsigned* rp = rec + (size_t)row * 8;
            rp[0] = (unsigned)e0; rp[1] = (unsigned)e1; rp[2] = pos0; rp[3] = pos1; rp[4] = __float_as_uint(w0); rp[5] = __float_as_uint(w1);
        }
    }
}
DEVI void expert_prefix(const Frame& F, const unsigned* cnt, volatile LAS int* out, int mul) {
    if (F.wave == 0) { const int lane = F.lane;
        int c = (lane < NEXP) ? (int)((__hip_atomic_load(cnt + (lane & 31), __ATOMIC_RELAXED, __HIP_MEMORY_SCOPE_AGENT) + 255u) / 256u) : 0;
        int s = c;
#pragma unroll
        for (int d = 1; d < 32; d <<= 1) { const int t = __builtin_amdgcn_ds_bpermute(((lane - d) & 63) << 2, s); if (lane >= d) s += t; }
        if (lane < NEXP) out[lane] = (s - c) * mul;
        if (lane == NEXP - 1) out[NEXP] = s * mul; }
    __syncthreads();
}
DEVI void compute_pstart(const Frame& F, const unsigned* cnt, volatile LAS int* pstart) { expert_prefix(F, cnt, pstart, 256); }
struct RowM1 { const bf16_t* h2; const int* list; const unsigned* cnt;
    DEVI int nrows(int y) const { return (int)cnt[y]; }
    DEVI const bf16_t* operator()(int y, int r) const { return h2 + (size_t)list[(size_t)y * LIST_CAP + r] * D; } };
struct EpiM1s { bf16_t* hmid; volatile LAS int* pstart;
    DEVI void operator()(int y, int row, int c0, int c1, float gt, float up) const { hmid[((size_t)pstart[y] + row) * 512 + c0] = f2bf(gt * sigmoidf_(gt) * up); } };
struct RowM2 { const bf16_t* hmid; volatile LAS int* pstart; const unsigned* cnt;
    DEVI int nrows(int y) const { return (int)cnt[y]; }
    DEVI const bf16_t* operator()(int y, int r) const { return hmid + ((size_t)pstart[y] + r) * 512; } };
struct EpiM2s { bf16_t* ybuf; volatile LAS int* pstart;
    DEVI void operator()(int y, int row, int c0, int c1, float a0, float a1) const { bf16_t* p = ybuf + ((size_t)pstart[y] + row) * 1024; p[c0] = f2bf(a0); p[c1] = f2bf(a1); } };
template <bool LAST>
DEVI void ph_combine(const Frame& F, bf16_t* xb, float* out, const bf16_t* ybuf, const unsigned* rec, volatile LAS int* pstart, const float* gnext, bf16_t* hout) {
    const int lane = F.lane;
    u32x4 ra[2]; u32x2 rb[2];
#pragma unroll
    for (int u = 0; u < 2; ++u) { const int rr = (F.gw + u * F.NGW < NTOK) ? F.gw + u * F.NGW : 0; ra[u] = *(const u32x4*)(rec + (size_t)rr * 8); rb[u] = *(const u32x2*)(rec + (size_t)rr * 8 + 4); }
    for (int row0 = F.gw; row0 < NTOK; row0 += 2 * F.NGW) {
        int rw[2]; const bf16_t* y0[2]; const bf16_t* y1[2]; float w0[2], w1[2]; bool on[2];
#pragma unroll
        for (int u = 0; u < 2; ++u) { rw[u] = row0 + u * F.NGW; on[u] = rw[u] < NTOK;
            y0[u] = ybuf + ((size_t)pstart[(int)ra[u].x] + ra[u].z) * 1024; y1[u] = ybuf + ((size_t)pstart[(int)ra[u].y] + ra[u].w) * 1024;
            w0[u] = __uint_as_float(rb[u].x); w1[u] = __uint_as_float(rb[u].y); }
        u32x4 xw[2][2], ya[2][2], yb[2][2];
#pragma unroll
        for (int u = 0; u < 2; ++u)
#pragma unroll
            for (int j = 0; j < 2; ++j) { const int rr = on[u] ? rw[u] : row0;
                xw[u][j] = *((const u32x4*)(xb + (size_t)rr * D) + lane + 64 * j); ya[u][j] = *((const u32x4*)y0[u] + lane + 64 * j); yb[u][j] = *((const u32x4*)y1[u] + lane + 64 * j); }
#pragma unroll
        for (int u = 0; u < 2; ++u) { const int nr = row0 + (2 + u) * F.NGW, rr = nr < NTOK ? nr : 0; ra[u] = *(const u32x4*)(rec + (size_t)rr * 8); rb[u] = *(const u32x2*)(rec + (size_t)rr * 8 + 4); }
#pragma unroll
        for (int u = 0; u < 2; ++u) {
            if (!on[u]) continue;
            const int row = rw[u];
            f32x4 v[2][2]; float s = 0.f;
#pragma unroll
            for (int j = 0; j < 2; ++j) {
#pragma unroll
                for (int hf = 0; hf < 2; ++hf) { v[j][hf] = unpk8(xw[u][j], hf) + unpk8(ya[u][j], hf) * w0[u] + unpk8(yb[u][j], hf) * w1[u];
                    s += (v[j][hf][0] * v[j][hf][0] + v[j][hf][1] * v[j][hf][1]) + (v[j][hf][2] * v[j][hf][2] + v[j][hf][3] * v[j][hf][3]); }
                if (LAST) { f32x4* op = (f32x4*)(out + (size_t)row * D) + 2 * (lane + 64 * j); op[0] = v[j][0]; op[1] = v[j][1]; }
                else *((u32x4*)(xb + (size_t)row * D) + lane + 64 * j) = pack8(v[j][0], v[j][1]);
            }
            if (!LAST) {
                const float rstd = 1.0f / sqrtf(wave_sum(s, lane) * (1.0f / D) + NORM_EPS);
#pragma unroll
                for (int j = 0; j < 2; ++j) { const f32x4 g0 = *((const f32x4*)gnext + 2 * (lane + 64 * j)), g1 = *((const f32x4*)gnext + 2 * (lane + 64 * j) + 1);
                    *((u32x4*)(hout + (size_t)row * D) + lane + 64 * j) = pack8(v[j][0] * rstd * g0, v[j][1] * rstd * g1); }
            }
        }
    }
}

namespace pg8 {
constexpr int BM = 256, BK = 64, HALF = 128, HTB = HALF * BK * 2  , STAGE_BYTES = 8 * HTB;
__host__ __device__ __forceinline__ int lds_byte(int r, int c) { const int st = (r >> 4) * 2 + (c >> 5), rr = r & 15, cc = c & 31, ob = rr * 64 + cc * 2; return st * 1024 + (ob ^ (((ob >> 9) & 1) << 5)); }
__host__ __device__ __forceinline__ void stage_rc(int b, int& R, int& C) { const int st = b / 1024, sb = b % 1024, swz = sb ^ (((sb >> 9) & 1) << 5); R = (st >> 1) * 16 + swz / 64; C = (st & 1) * 32 + (swz % 64) / 2; }
__host__ __device__ __forceinline__ int perm32(int rho) { const int n = rho >> 4, i = rho & 15; return 8 * (i >> 2) + 4 * n + (i & 3); }

struct Unit { int pm, pn, g, ui; };
struct Gemm { const bf16_t* A; const bf16_t* Bt; int lda, ldb, K; size_t ags, bgs;
    DEVI const char* abase(const Unit& u) const { return (const char*)(A + (size_t)u.g * ags + (size_t)u.pm * BM * lda); }
    DEVI const char* bbase(const Unit& u) const { return (const char*)(Bt + (size_t)u.g * bgs + (size_t)u.pn * BM * ldb); } };
struct NoGather { static constexpr bool ON = false; DEVI unsigned rowoff(const Unit&, int) const { return 0u; } };
struct LdsGather { static constexpr bool ON = true; const LAS unsigned* tab;
    DEVI unsigned rowoff(const Unit& u, int r) const { return tab[u.ui * 256 + r]; } };

typedef float f32x2_t __attribute__((ext_vector_type(2))); typedef __bf16 bf16x2_t __attribute__((ext_vector_type(2)));
DEVI unsigned cvt_pk_bf16(float lo, float hi) { const f32x2_t v = {lo, hi}; const bf16x2_t b = __builtin_convertvector(v, bf16x2_t); return __builtin_bit_cast(unsigned, b); }

template <class Epi, class Sched, class GA, bool ALIGN_EPI>
DEVI void gemm_phase(LAS unsigned char* lds, const Gemm g, const Sched& S, const Epi& E, const GA& ga, int tid_in) {
    const int tid = tid_in, wid = __builtin_amdgcn_readfirstlane(tid >> 6), lane = tid & 63, wr = wid >> 2, wc = wid & 3, fr = lane & 15, fq = lane >> 4;
    const int K = g.K, nt = K / BK;
    unsigned voffA[2], voffB[2]; int RA[2]; unsigned CA[2];
#pragma unroll
    for (int i = 0; i < 2; ++i) { int R, C; stage_rc(tid * 16 + i * 8192, R, C); const int Rb = Epi::PERM ? ((R & ~31) + perm32(R & 31)) : R;
        voffA[i] = (unsigned)(R * g.lda + C) * 2u; voffB[i] = (unsigned)(Rb * g.ldb + C) * 2u; RA[i] = R; CA[i] = (unsigned)C * 2u; }
    const size_t kstep = (size_t)(BK * 2);
    const size_t hstepA = GA::ON ? (size_t)0 : (size_t)HALF * g.lda * 2, hstepB = (size_t)HALF * g.ldb * 2;
    const unsigned ldsw = (unsigned)wid * 1024u;
    const int aoff = lds_byte(wr * 64 + fr, fq * 8), boff = lds_byte(wc * 32 + fr, fq * 8);
#define PG8_SA(b, h) (((b) * 2 + (h)) * HTB)
#define PG8_SB(b, h) ((4 + (b) * 2 + (h)) * HTB)
#define PG8_STAGE2(bufoff, gbase, v0, v1) do { \
        __builtin_amdgcn_global_load_lds((const unsigned*)((const char*)(gbase) + (v0)), (LAS unsigned*)(lds + (bufoff) + ldsw), 16, 0, 0); \
        __builtin_amdgcn_global_load_lds((const unsigned*)((const char*)(gbase) + (v1)), (LAS unsigned*)(lds + (bufoff) + ldsw + 8192), 16, 0, 0); } while (0)
#define PG8_STAGE_B(b, h, bptr) PG8_STAGE2(PG8_SB(b, h), (bptr) + (h) * hstepB, voffB[0], voffB[1])
#define PG8_STAGE_A(b, h, aptr, NX) do { if constexpr (GA::ON) { const unsigned _o0 = (NX) ? vgn[h][0] : vgc[h][0], _o1 = (NX) ? vgn[h][1] : vgc[h][1]; PG8_STAGE2(PG8_SA(b, h), (aptr), _o0, _o1); } \
        else { PG8_STAGE2(PG8_SA(b, h), (aptr) + (h) * hstepA, voffA[0], voffA[1]); } } while (0)
#define PG8_LDA(dst, b, h) do { _Pragma("unroll") for (int m = 0; m < 4; ++m) _Pragma("unroll") for (int k = 0; k < 2; ++k) dst[m][k] = *(const LAS bf16x8*)(lds + PG8_SA(b, h) + aoff + m * 2048 + k * 1024); } while (0)
#define PG8_LDB(dst, b, h) do { _Pragma("unroll") for (int n = 0; n < 2; ++n) _Pragma("unroll") for (int k = 0; k < 2; ++k) dst[n][k] = *(const LAS bf16x8*)(lds + PG8_SB(b, h) + boff + n * 2048 + k * 1024); } while (0)
#define PG8_MMA(ai, bj, At, Bt) do { __builtin_amdgcn_s_setprio(1); _Pragma("unroll") for (int m = 0; m < 4; ++m) _Pragma("unroll") for (int n = 0; n < 2; ++n) _Pragma("unroll") for (int k = 0; k < 2; ++k) \
        acc[ai][bj][m][n] = __builtin_amdgcn_mfma_f32_16x16x32_bf16(Bt[n][k], At[m][k], acc[ai][bj][m][n], 0, 0, 0); __builtin_amdgcn_s_setprio(0); } while (0)
#define PG8_WAIT_V(n) asm volatile("s_waitcnt vmcnt(" #n ")" ::: "memory")
#define PG8_WAIT_L(n) asm volatile("s_waitcnt lgkmcnt(" #n ")" ::: "memory")
#define PG8_BAR __builtin_amdgcn_s_barrier()
#define PG8_SCHED __builtin_amdgcn_sched_barrier(0)
    Unit cur, nxt; int ui = 0;
    if (!S.next(0, cur)) return;
    f32x4 acc[2][2][4][2];
#pragma unroll
    for (int a = 0; a < 2; ++a)
#pragma unroll
        for (int b = 0; b < 2; ++b)
#pragma unroll
            for (int m = 0; m < 4; ++m)
#pragma unroll
                for (int n = 0; n < 2; ++n) acc[a][b][m][n] = (f32x4){0.f, 0.f, 0.f, 0.f};
    bf16x8 At[4][2], B0[2][2], B1[2][2];
    unsigned vgc[2][2] = {{0u, 0u}, {0u, 0u}}, vgn[2][2] = {{0u, 0u}, {0u, 0u}};
    if constexpr (GA::ON) {
#pragma unroll
        for (int h = 0; h < 2; ++h)
#pragma unroll
            for (int i = 0; i < 2; ++i) vgc[h][i] = ga.rowoff(cur, h * HALF + RA[i]) + CA[i];
    }
    const char* cA = GA::ON ? (const char*)g.A : g.abase(cur); const char* cB = g.bbase(cur);
    S.a_ready(cur);
    PG8_STAGE_B(0, 0, cB); PG8_STAGE_B(0, 1, cB); PG8_STAGE_A(0, 0, cA, false); PG8_STAGE_A(0, 1, cA, false);
    if (wr == 1) PG8_BAR;
    PG8_WAIT_V(2); PG8_BAR;
    PG8_STAGE_B(1, 0, cB + kstep); PG8_STAGE_A(1, 0, cA + kstep, false); PG8_STAGE_B(1, 1, cB + kstep);
    PG8_WAIT_V(6); PG8_BAR;
    for (;;) {
        const bool has_next = S.next(ui + 1, nxt);
        const char* nA = has_next ? (GA::ON ? (const char*)g.A : g.abase(nxt)) : cA; const char* nB = has_next ? g.bbase(nxt) : cB;
        if constexpr (GA::ON) {
#pragma unroll
            for (int h = 0; h < 2; ++h)
#pragma unroll
                for (int i = 0; i < 2; ++i) vgn[h][i] = has_next ? ga.rowoff(nxt, h * HALF + RA[i]) + CA[i] : vgc[h][i];
            asm volatile("" : "+v"(vgn[0][0]), "+v"(vgn[0][1]), "+v"(vgn[1][0]), "+v"(vgn[1][1]));
        }
        for (int t = 0; t < nt; t += 2) {
            const bool last = (t == nt - 2);
            const char* a1 = cA + (size_t)(t + 1) * kstep;
            const char* a2 = last ? nA : cA + (size_t)(t + 2) * kstep; const char* b2 = last ? nB : cB + (size_t)(t + 2) * kstep;
            const char* a3 = a2 + kstep; const char* b3 = b2 + kstep;
            if (last && has_next) S.a_ready(nxt);
            PG8_LDB(B0, 0, 0); PG8_LDB(B1, 0, 1); PG8_SCHED; PG8_LDA(At, 0, 0); PG8_STAGE_A(1, 1, a1, false);
            PG8_WAIT_V(8); PG8_WAIT_L(0); PG8_BAR; PG8_MMA(0, 0, At, B0); PG8_MMA(0, 1, At, B1); PG8_BAR; PG8_SCHED;
            PG8_LDA(At, 0, 1); PG8_STAGE_B(0, 0, b2); PG8_STAGE_B(0, 1, b2); PG8_STAGE_A(0, 0, a2, last);
            PG8_WAIT_V(8); PG8_WAIT_L(0); PG8_BAR; PG8_MMA(1, 0, At, B0); PG8_MMA(1, 1, At, B1); PG8_BAR; PG8_SCHED;
            PG8_LDB(B0, 1, 0); PG8_LDB(B1, 1, 1); PG8_SCHED; PG8_LDA(At, 1, 0); PG8_STAGE_A(0, 1, a2, last);
            PG8_WAIT_V(8); PG8_WAIT_L(0); PG8_BAR; PG8_MMA(0, 0, At, B0); PG8_MMA(0, 1, At, B1); PG8_BAR; PG8_SCHED;
            PG8_LDA(At, 1, 1); PG8_STAGE_B(1, 0, b3); PG8_STAGE_B(1, 1, b3); PG8_STAGE_A(1, 0, a3, last);
            PG8_WAIT_V(8); PG8_WAIT_L(0); PG8_BAR; PG8_MMA(1, 0, At, B0); PG8_MMA(1, 1, At, B1); PG8_BAR; PG8_SCHED;
        }
        if constexpr (ALIGN_EPI) { if (wr == 0) PG8_BAR; }
        if constexpr (!Epi::AFTER_DRAIN) { E(acc, cur, wr, wc, fr, fq); S.done(cur); }
        if (!has_next) break;
#pragma unroll
        for (int a = 0; a < 2; ++a)
#pragma unroll
            for (int b = 0; b < 2; ++b)
#pragma unroll
                for (int m = 0; m < 4; ++m)
#pragma unroll
                    for (int n = 0; n < 2; ++n) acc[a][b][m][n] = (f32x4){0.f, 0.f, 0.f, 0.f};
        cur = nxt; cA = nA; cB = nB; ++ui;
        if constexpr (GA::ON) {
#pragma unroll
            for (int h = 0; h < 2; ++h)
#pragma unroll
                for (int i = 0; i < 2; ++i) vgc[h][i] = vgn[h][i];
        }
        if constexpr (ALIGN_EPI) { if (wr == 1) PG8_BAR; }
    }
    PG8_WAIT_V(0);
    if constexpr (!ALIGN_EPI) { if (wr == 0) PG8_BAR; }
    PG8_BAR;
    if constexpr (Epi::AFTER_DRAIN) { E.fused(acc, cur, wr, wc, fr, fq, lds, wid, lane); S.done(cur); }
#undef PG8_SA
#undef PG8_SB
#undef PG8_STAGE2
#undef PG8_STAGE_A
#undef PG8_STAGE_B
#undef PG8_LDA
#undef PG8_LDB
#undef PG8_MMA
#undef PG8_WAIT_V
#undef PG8_WAIT_L
#undef PG8_BAR
#undef PG8_SCHED
}
}

namespace pg8 {
DEVI float fsig(float x) { return __builtin_amdgcn_rcpf(1.0f + __expf(-x)); }
DEVI f32x4 unpk_lo(u32x4 w, int half) {
    const unsigned a = half ? w.z : w.x, b = half ? w.w : w.y;
    return (f32x4){__uint_as_float(a << 16), __uint_as_float(a & 0xffff0000u), __uint_as_float(b << 16), __uint_as_float(b & 0xffff0000u)}; }
DEVI u32x4 pk8(f32x4 v0, f32x4 v1) { u32x4 w; w.x = cvt_pk_bf16(v0[0], v0[1]); w.y = cvt_pk_bf16(v0[2], v0[3]); w.z = cvt_pk_bf16(v1[0], v1[1]); w.w = cvt_pk_bf16(v1[2], v1[3]); return w; }

struct StaticOrder {
    int nM, nN, nwg, G, c;
    DEVI void init(int M, int N, int G_, int c_) { nM = M / BM; nN = N / BM; nwg = nM * nN; G = G_; c = c_; }
    DEVI bool next(int i, Unit& u) const {
        const long L = (long)i * G + c; if (L >= nwg) return false;
        int wgid = (int)L; { const int q = nwg / 8, r = nwg % 8, xcd = wgid % 8, off = wgid / 8; wgid = (xcd < r ? xcd * (q + 1) : r * (q + 1) + (xcd - r) * q) + off; }
        const int nig = 8 * nN, gid = wgid / nig, fm = gid * 8, gsz = (nM - fm) < 8 ? (nM - fm) : 8;
        u.pm = fm + ((wgid % nig) % gsz); u.pn = (wgid % nig) / gsz; u.g = 0; u.ui = i; return true;
    }
    DEVI void a_ready(const Unit&) const {}
    DEVI void done(const Unit&) const {}
};
struct OrderS5A { int G, c; DEVI bool next(int i, Unit& u) const { const int U = i * G + c; if (U >= SSM_G * 4) return false; u.g = U >> 2; u.pm = U & 3; u.pn = 0; u.ui = i; return true; }
    DEVI void a_ready(const Unit&) const {} DEVI void done(const Unit&) const {} };
struct OrderS5C { int G, c; DEVI bool next(int i, Unit& u) const { const int U = i * G + c; if (U >= SSM_G * 8) return false; u.g = U >> 3; u.pm = (U >> 1) & 3; u.pn = U & 1; u.ui = i; return true; }
    DEVI void a_ready(const Unit&) const {} DEVI void done(const Unit&) const {} };
struct OrderMoE { int G, v; const volatile LAS int* tstart;
    DEVI bool next(int i, Unit& u) const { const int U = i * G + v, rt = U >> 2; if (rt >= tstart[NEXP]) return false;
        int e = 0;
#pragma unroll 1
        for (int q = 1; q < NEXP; ++q) e = (rt >= tstart[q]) ? q : e;
        u.pm = rt; u.pn = U & 3; u.g = e; u.ui = i; return true; }
    DEVI void a_ready(const Unit&) const {} DEVI void done(const Unit&) const {} };

template <bool F32IN> struct EpiResBf16 { static constexpr bool PERM = true, AFTER_DRAIN = false; const float* xin32; bf16_t* xb; float* ssq;
    DEVI void operator()(const f32x4 (&acc)[2][2][4][2], const Unit& u, int wr, int wc, int fr, int fq) const {
        const int row0 = u.pm * BM + wr * 64 + fr, col0 = u.pn * BM + wc * 32 + 8 * fq;
        float sq[2][4] = {{0.f, 0.f, 0.f, 0.f}, {0.f, 0.f, 0.f, 0.f}};
#pragma unroll
        for (int ai = 0; ai < 2; ++ai)
#pragma unroll
            for (int m = 0; m < 4; ++m) { const size_t off = (size_t)(row0 + ai * HALF + m * 16) * D + col0;
#pragma unroll
                for (int bj = 0; bj < 2; ++bj) { f32x4 a0, a1;
                    if (F32IN) { a0 = *(const f32x4*)(xin32 + off + bj * HALF); a1 = *(const f32x4*)(xin32 + off + bj * HALF + 4); }
                    else { const u32x4 w = *(const u32x4*)(xb + off + bj * HALF); a0 = unpk_lo(w, 0); a1 = unpk_lo(w, 1); }
                    const f32x4 o0 = a0 + acc[ai][bj][m][0], o1 = a1 + acc[ai][bj][m][1];
                    sq[ai][m] += (o0[0] * o0[0] + o0[1] * o0[1]) + (o0[2] * o0[2] + o0[3] * o0[3]) + (o1[0] * o1[0] + o1[1] * o1[1]) + (o1[2] * o1[2] + o1[3] * o1[3]);
                    *(u32x4*)(xb + off + bj * HALF) = pk8(o0, o1); }
                  }
#pragma unroll
        for (int ai = 0; ai < 2; ++ai)
#pragma unroll
            for (int m = 0; m < 4; ++m) { float s = sq[ai][m]; s += xshfl(s, 16, fq * 16 + fr); s += xshfl(s, 32, fq * 16 + fr);
                if (fq == 0) ssq[(size_t)(row0 + ai * HALF + m * 16) * 16 + u.pn * 4 + wc] = s; }
    } };
struct EpiMix { static constexpr bool PERM = true, AFTER_DRAIN = false; const bf16_t* sg; const bf16_t* mixa; bf16_t* mixed;
    DEVI void operator()(const f32x4 (&acc)[2][2][4][2], const Unit& u, int wr, int wc, int fr, int fq) const {
        const int row0 = u.pm * BM + wr * 64 + fr, col0 = u.pn * BM + wc * 32 + 8 * fq;
#pragma unroll
        for (int ai = 0; ai < 2; ++ai)
#pragma unroll
            for (int m = 0; m < 4; ++m) { const size_t row = (size_t)(row0 + ai * HALF + m * 16);
#pragma unroll
                for (int bj = 0; bj < 2; ++bj) { const int col = col0 + bj * HALF;
                    const u32x4 a = *(const u32x4*)(mixa + row * 1024 + col), s = *(const u32x4*)(sg + row * 2048 + 1024 + col);
                    const f32x4 o0 = unpk_lo(a, 0) + unpk_lo(s, 0) * acc[ai][bj][m][0], o1 = unpk_lo(a, 1) + unpk_lo(s, 1) * acc[ai][bj][m][1];
                    *(u32x4*)(mixed + row * 1024 + col) = pk8(o0, o1); }
                if (m == 3) asm volatile("" ::: "memory");     }
    } };
struct EpiGlu { static constexpr bool PERM = true, AFTER_DRAIN = false; const bf16_t* sg; bf16_t* mixa;
    DEVI void operator()(const f32x4 (&acc)[2][2][4][2], const Unit& u, int wr, int wc, int fr, int fq) const {
        const int row0 = u.pm * BM + wr * 64 + fr, col = u.pn * HALF + wc * 32 + 8 * fq;
#pragma unroll
        for (int ai = 0; ai < 2; ++ai)
#pragma unroll
            for (int m = 0; m < 4; ++m) { const size_t row = (size_t)(row0 + ai * HALF + m * 16);
                const u32x4 s = *(const u32x4*)(sg + row * 2048 + col);
                f32x4 o[2];
#pragma unroll
                for (int n = 0; n < 2; ++n) { const f32x4 v = acc[ai][0][m][n], gt = acc[ai][1][m][n], sv = unpk_lo(s, n);
                    o[n] = (f32x4){sv[0] * v[0] * fsig(gt[0]), sv[1] * v[1] * fsig(gt[1]), sv[2] * v[2] * fsig(gt[2]), sv[3] * v[3] * fsig(gt[3])}; }
                *(u32x4*)(mixa + row * 1024 + col) = pk8(o[0], o[1]);
                  }
    } };
struct EpiSwiglu { static constexpr bool PERM = true, AFTER_DRAIN = false; bf16_t* hmid;
    DEVI void operator()(const f32x4 (&acc)[2][2][4][2], const Unit& u, int wr, int wc, int fr, int fq) const {
        const int row0 = u.pm * BM + wr * 64 + fr, col = u.pn * HALF + wc * 32 + 8 * fq;
#pragma unroll
        for (int ai = 0; ai < 2; ++ai)
#pragma unroll
            for (int m = 0; m < 4; ++m) { const size_t row = (size_t)(row0 + ai * HALF + m * 16);
                f32x4 o[2];
#pragma unroll
                for (int n = 0; n < 2; ++n) { const f32x4 gt = acc[ai][0][m][n], up = acc[ai][1][m][n];
                    o[n] = (f32x4){gt[0] * fsig(gt[0]) * up[0], gt[1] * fsig(gt[1]) * up[1], gt[2] * fsig(gt[2]) * up[2], gt[3] * fsig(gt[3]) * up[3]}; }
                *(u32x4*)(hmid + row * 512 + col) = pk8(o[0], o[1]); }
    } };
struct EpiStoreBf16 { static constexpr bool PERM = true, AFTER_DRAIN = false; bf16_t* out; int ldc;
    DEVI void operator()(const f32x4 (&acc)[2][2][4][2], const Unit& u, int wr, int wc, int fr, int fq) const {
        const int row0 = u.pm * BM + wr * 64 + fr, col0 = u.pn * BM + wc * 32 + 8 * fq;
#pragma unroll
        for (int ai = 0; ai < 2; ++ai)
#pragma unroll
            for (int m = 0; m < 4; ++m) { bf16_t* rp = out + (size_t)(row0 + ai * HALF + m * 16) * ldc + col0;
#pragma unroll
                for (int bj = 0; bj < 2; ++bj) *(u32x4*)(rp + bj * HALF) = pk8(acc[ai][bj][m][0], acc[ai][bj][m][1]); }
    } };
struct EpiS5Cm { static constexpr bool PERM = true, AFTER_DRAIN = false; const bf16_t* ucat; const float* dskip; bf16_t* z;
    DEVI void operator()(const f32x4 (&acc)[2][2][4][2], const Unit& u, int wr, int wc, int fr, int fq) const {
        const int g = u.g, row0 = u.pm * BM + wr * 64 + fr, col0 = u.pn * BM + wc * 32 + 8 * fq;
        const int co0 = col0 & 15;
        const f32x4 d0 = *(const f32x4*)(dskip + g * 16 + co0), d1 = *(const f32x4*)(dskip + g * 16 + co0 + 4);
#pragma unroll
        for (int ai = 0; ai < 2; ++ai)
#pragma unroll
            for (int m = 0; m < 4; ++m) { const int row = row0 + ai * HALF + m * 16, b = row >> 7, c = row & 127;
#pragma unroll
                for (int bj = 0; bj < 2; ++bj) { const int n = col0 + bj * HALF, t = n >> 4;
                    const u32x4 uu = *(const u32x4*)(ucat + ((size_t)g * UROWS + row) * UK + n);
                    const f32x4 y0 = acc[ai][bj][m][0] + d0 * unpk_lo(uu, 0), y1 = acc[ai][bj][m][1] + d1 * unpk_lo(uu, 1);
                    const f32x4 z0 = (f32x4){gelu_tanh(y0[0]), gelu_tanh(y0[1]), gelu_tanh(y0[2]), gelu_tanh(y0[3])}, z1 = (f32x4){gelu_tanh(y1[0]), gelu_tanh(y1[1]), gelu_tanh(y1[2]), gelu_tanh(y1[3])};
                    *(u32x4*)(z + ((size_t)b * SEQ + c * CHL + t) * 512 + g * 16 + co0) = pk8(z0, z1); } }
    } };
struct EpiS5Am { static constexpr bool PERM = false, AFTER_DRAIN = true; const float* AL; bf16_t* ucat;
    DEVI void fused(f32x4 (&acc)[2][2][4][2], const Unit& u, int wr, int wc, int fr, int fq, LAS unsigned char* lds, int wid, int lane) const {
        LAS float* sl = (LAS float*)lds;
#pragma unroll
        for (int ai = 0; ai < 2; ++ai)
#pragma unroll
            for (int m = 0; m < 4; ++m) { const int row = ai * HALF + wr * 64 + m * 16 + fr;
#pragma unroll
                for (int n = 0; n < 2; ++n) *(LAS f32x4*)(sl + row * 128 + wc * 32 + n * 16 + 4 * fq) = acc[ai][0][m][n]; }
        asm volatile("s_waitcnt lgkmcnt(0)" ::: "memory"); __builtin_amdgcn_s_barrier(); asm volatile("" ::: "memory");
        const int tid = wid * 64 + lane;
        if (tid < 128) { const int bb = tid >> 6, p = tid & 63, g = u.g;
            const float ar = AL[(g * 64 + p) * 2], ai_ = AL[(g * 64 + p) * 2 + 1];
            float hr = 0.f, hi = 0.f;
            for (int c = 0; c < NCH; ++c) { const int row = bb * NCH + c;
                bf16_t* up = ucat + ((size_t)g * UROWS + u.pm * BM + row) * UK + 512 + p;
                up[0] = f2bf(hr); up[64] = f2bf(hi);
                const float sr = sl[row * 128 + p], si = sl[row * 128 + 64 + p];
                const float nr = ar * hr - ai_ * hi + sr, ni = ar * hi + ai_ * hr + si; hr = nr; hi = ni; } }
        asm volatile("s_waitcnt lgkmcnt(0)" ::: "memory"); __builtin_amdgcn_s_barrier(); asm volatile("" ::: "memory");
    } };
struct EpiG1 { static constexpr bool PERM = true, AFTER_DRAIN = false; bf16_t* ucat; bf16_t* q; bf16_t* k; bf16_t* v; bf16_t* sg; const float* qg; const float* kg; const float* rope; float* qraw; float* kraw; float* ksum2;
    DEVI void operator()(const f32x4 (&acc)[2][2][4][2], const Unit& u, int wr, int wc, int fr, int fq) const {
        const int pn = u.pn, row0 = u.pm * BM + wr * 64 + fr;
        if (pn < 2) {
#pragma unroll
            for (int ai = 0; ai < 2; ++ai)
#pragma unroll
                for (int m = 0; m < 4; ++m) { const int row = row0 + ai * HALF + m * 16, b = row >> 12, s = row & 4095;
#pragma unroll
                    for (int bj = 0; bj < 2; ++bj) { const int c = pn * BM + bj * HALF + wc * 32 + 8 * fq, g = c >> 4, ci = c & 15;
                        *(u32x4*)(ucat + ((size_t)g * UROWS + b * NCH + (s >> 5)) * UK + (s & 31) * 16 + ci) = pk8(acc[ai][bj][m][0], acc[ai][bj][m][1]); } }
        } else if (pn < 6) {
            const bool isk = pn >= 4; const int hh = (pn & 1) * 4 + wc;
#if G1_RAWQK
            { float* raw = isk ? kraw : qraw;
#pragma unroll
              for (int ai = 0; ai < 2; ++ai)
#pragma unroll
                for (int m = 0; m < 4; ++m) { const int row = row0 + ai * HALF + m * 16;
#pragma unroll
                    for (int bj = 0; bj < 2; ++bj)
#pragma unroll
                        for (int n = 0; n < 2; ++n) *(f32x4*)(raw + (size_t)row * 512 + hh * 64 + 32 * bj + 8 * fq + 4 * n) = acc[ai][bj][m][n]; }
              return; }
#endif
            const float* gn = isk ? kg : qg; bf16_t* dst = isk ? k : q; const float sc = isk ? 1.0f : QSCALE;
            f32x4 gv[2][2];
#pragma unroll
            for (int bj = 0; bj < 2; ++bj)
#pragma unroll
                for (int n = 0; n < 2; ++n) gv[bj][n] = *(const f32x4*)(gn + 32 * bj + 8 * fq + 4 * n);
            f32x4 cs[2][2] = {{(f32x4){0.f, 0.f, 0.f, 0.f}, (f32x4){0.f, 0.f, 0.f, 0.f}}, {(f32x4){0.f, 0.f, 0.f, 0.f}, (f32x4){0.f, 0.f, 0.f, 0.f}}};
#pragma unroll
            for (int ai = 0; ai < 2; ++ai)
#pragma unroll
                for (int m = 0; m < 4; ++m) { const int row = row0 + ai * HALF + m * 16, s = row & 4095;
                    float ss = 0.f;
#pragma unroll
                    for (int bj = 0; bj < 2; ++bj)
#pragma unroll
                        for (int n = 0; n < 2; ++n) { const f32x4 x = acc[ai][bj][m][n]; ss += (x[0] * x[0] + x[1] * x[1]) + (x[2] * x[2] + x[3] * x[3]); }
                    ss += xshfl(ss, 16, fq * 16 + fr); ss += xshfl(ss, 32, fq * 16 + fr);
                    const float rstd = 1.0f / sqrtf(ss * (1.0f / 64.0f) + NORM_EPS);
                    f32x4 o1[2], o2[2];
#pragma unroll
                    for (int n = 0; n < 2; ++n) { const float* rp = rope + ((size_t)s * 32 + 8 * fq + 4 * n) * 2;
                        const f32x4 r0 = *(const f32x4*)rp, r1 = *(const f32x4*)(rp + 4);
                        const f32x4 cv = (f32x4){r0[0], r0[2], r1[0], r1[2]}, sv = (f32x4){r0[1], r0[3], r1[1], r1[3]};
                        const f32x4 x1 = acc[ai][0][m][n] * rstd * gv[0][n], x2 = acc[ai][1][m][n] * rstd * gv[1][n];
                        o1[n] = (x1 * cv - x2 * sv) * sc; o2[n] = (x2 * cv + x1 * sv) * sc; }
                    const u32x4 w1 = pk8(o1[0], o1[1]), w2 = pk8(o2[0], o2[1]);
                    bf16_t* dp = dst + (size_t)row * 512 + hh * 64 + 8 * fq;
                    *(u32x4*)dp = w1; *(u32x4*)(dp + 32) = w2;
                    if (isk) { cs[0][0] += unpk_lo(w1, 0); cs[0][1] += unpk_lo(w1, 1); cs[1][0] += unpk_lo(w2, 0); cs[1][1] += unpk_lo(w2, 1); }
                    if (m & 1) asm volatile("" ::: "memory"); }
            if (isk) {
#pragma unroll
                for (int bj = 0; bj < 2; ++bj)
#pragma unroll
                    for (int n = 0; n < 2; ++n)
#pragma unroll
                        for (int e = 0; e < 4; ++e) { float t = cs[bj][n][e]; const int ln = fq * 16 + fr; t += xshfl(t, 1, ln); t += xshfl(t, 2, ln); t += xshfl(t, 4, ln); t += xshfl(t, 8, ln); cs[bj][n][e] = t; }
                if (fr == 0) { float* kp = ksum2 + ((((size_t)(u.pm >> 4) * 8 + hh) * 16 + (u.pm & 15)) * 2 + wr) * 64 + 8 * fq;
#pragma unroll
                    for (int bj = 0; bj < 2; ++bj)
#pragma unroll
                        for (int n = 0; n < 2; ++n) *(f32x4*)(kp + 32 * bj + 4 * n) = cs[bj][n]; }
            }
        } else if (pn < 8) {
#pragma unroll
            for (int ai = 0; ai < 2; ++ai)
#pragma unroll
                for (int m = 0; m < 4; ++m) { bf16_t* rp = v + (size_t)(row0 + ai * HALF + m * 16) * 512 + (pn - 6) * BM + wc * 32 + 8 * fq;
#pragma unroll
                    for (int bj = 0; bj < 2; ++bj) *(u32x4*)(rp + bj * HALF) = pk8(acc[ai][bj][m][0], acc[ai][bj][m][1]); }
        } else {
#pragma unroll
            for (int ai = 0; ai < 2; ++ai)
#pragma unroll
                for (int m = 0; m < 4; ++m) { bf16_t* rp = sg + (size_t)(row0 + ai * HALF + m * 16) * 2048 + (pn - 8) * BM + wc * 32 + 8 * fq;
#pragma unroll
                    for (int bj = 0; bj < 2; ++bj) { const f32x4 a = acc[ai][bj][m][0], b = acc[ai][bj][m][1];
                        *(u32x4*)(rp + bj * HALF) = pk8((f32x4){fsig(a[0]), fsig(a[1]), fsig(a[2]), fsig(a[3])}, (f32x4){fsig(b[0]), fsig(b[1]), fsig(b[2]), fsig(b[3])}); } }
        }
    } };
}

struct CvtItem { const float* src; bf16_t* dst; int N, K; };
DEVI void cvt_load(const CvtItem& it, float (&v)[32], int lane) {
#pragma unroll
    for (int i = 0; i < 32; ++i) v[i] = it.src[(size_t)(2 * i + (lane >> 5)) * it.N + (lane & 31)];
}
DEVI void cvt_store(const CvtItem& it, const float (&v)[32], LAS float* scr, int lane) {
#pragma unroll
    for (int i = 0; i < 32; ++i) scr[(2 * i + (lane >> 5)) * 33 + (lane & 31)] = v[i];
    asm volatile("s_waitcnt lgkmcnt(0)" ::: "memory");
    const int c = lane & 7;
#pragma unroll
    for (int j = 0; j < 4; ++j) { const int n = (lane >> 3) + 8 * j; const LAS float* s = scr + (8 * c) * 33 + n;
        u32x4 o; o.x = pk2(s[0 * 33], s[1 * 33]); o.y = pk2(s[2 * 33], s[3 * 33]); o.z = pk2(s[4 * 33], s[5 * 33]); o.w = pk2(s[6 * 33], s[7 * 33]);
        *(u32x4*)(it.dst + (size_t)n * it.K + 8 * c) = o; }
    asm volatile("s_waitcnt lgkmcnt(0)" ::: "memory");
}
constexpr int CV_IN = 16 * 128, CV_GLU = 8 * 64, CV_ATT = 8 * 32, CV_OUT = 16 * 32, CV_GU1 = 16 * 32, CV_DN1 = 8 * 32;
constexpr int CV_PER_LAYER = CV_IN + CV_GLU + CV_ATT + CV_OUT + NEXP * (CV_GU1 + CV_DN1);
DEVI CvtItem cvt_decode(int it, const float* w_in, const float* w_glu, const float* w_attn, const float* w_out, const float* w_gu, const float* w_dn,
                        bf16_t* WIN, bf16_t* WGLU, bf16_t* WATT, bf16_t* WOUT, bf16_t* WGU, bf16_t* WDN) {
    const int l = it / CV_PER_LAYER; int r = it % CV_PER_LAYER;
    const float* W; bf16_t* WT; int K, N, mode;
    if (r < CV_IN) { W = w_in + (size_t)l * D * D_IN; WT = WIN + (size_t)l * D_IN * D; K = D; N = D_IN; mode = 1; }
    else if ((r -= CV_IN) < CV_GLU) { W = w_glu + (size_t)l * 512 * 2048; WT = WGLU + (size_t)l * 2048 * 512; K = 512; N = 2048; mode = 2; }
    else if ((r -= CV_GLU) < CV_ATT) { W = w_attn + (size_t)l * 512 * 1024; WT = WATT + (size_t)l * 1024 * 512; K = 512; N = 1024; mode = 0; }
    else if ((r -= CV_ATT) < CV_OUT) { W = w_out + (size_t)l * 1024 * 1024; WT = WOUT + (size_t)l * 1024 * 1024; K = 1024; N = 1024; mode = 0; }
    else if ((r -= CV_OUT) < NEXP * CV_GU1) { const int e = r / CV_GU1; r %= CV_GU1; W = w_gu + ((size_t)l * NEXP + e) * 1024 * 1024; WT = WGU + ((size_t)l * NEXP + e) * 1024 * 1024; K = 1024; N = 1024; mode = 3; }
    else { r -= NEXP * CV_GU1; const int e = r / CV_DN1; r %= CV_DN1; W = w_dn + ((size_t)l * NEXP + e) * 512 * 1024; WT = WDN + ((size_t)l * NEXP + e) * 1024 * 512; K = 512; N = 1024; mode = 0; }
    const int nblk = N / 32, kb = r / nblk, nb = r % nblk, nd = 32 * nb;
    int ns = nd;
    if (mode == 1) { const int pn = nd >> 8, tc = nd & 255; if (pn >= 2 && pn < 6) { const int sec = pn < 4 ? 512 : 1024, hh = (pn & 1) * 4 + ((tc >> 5) & 3); ns = sec + hh * 64 + 32 * (tc >> 7); } }
    else if (mode == 2) { const int pn = nd >> 8, tc = nd & 255; ns = (tc < 128) ? 128 * pn + tc : 1024 + 128 * pn + (tc - 128); }
    else if (mode == 3) { const int pn = nd >> 8, tc = nd & 255; ns = (tc < 128) ? 128 * pn + tc : 512 + 128 * pn + (tc - 128); }
    return CvtItem{W + (size_t)(64 * kb) * N + ns, WT + (size_t)nd * K + 64 * kb, N, K};
}
constexpr int CVQ_BASE = CV_IN + CV_GLU + CV_ATT + CV_OUT;
constexpr int CVQ_PER_BARRIER = 2;
constexpr int CVQ_TOTAL = DEPTH * CV_PER_LAYER - CVQ_BASE;
constexpr int CVQ_LIM_MOE0 = CV_PER_LAYER - CVQ_BASE;
constexpr int CVQ_LIM_PROJ1 = CVQ_LIM_MOE0 + CVQ_BASE;
struct CvtQ { const float* w_in; const float* w_glu; const float* w_attn; const float* w_out; const float* w_gu; const float* w_dn;
              bf16_t* WIN_; bf16_t* WGLU_; bf16_t* WATT_; bf16_t* WOUT_; bf16_t* WGU_; bf16_t* WDN_; LAS unsigned* head; LAS unsigned char* lds; int wave, lane, c, G;
    DEVI void item(int q) const { const CvtItem c = cvt_decode(q + CVQ_BASE, w_in, w_glu, w_attn, w_out, w_gu, w_dn, WIN_, WGLU_, WATT_, WOUT_, WGU_, WDN_);
        float v[32]; cvt_load(c, v, lane); cvt_store(c, v, (LAS float*)(lds + wave * 16384), lane); }
    DEVI int take() const { unsigned j = 0u; if (lane == 0) j = __hip_atomic_fetch_add(head, 1u, __ATOMIC_RELAXED, __HIP_MEMORY_SCOPE_WORKGROUP); return c + G * __builtin_amdgcn_readfirstlane((int)j); }
    DEVI int peek() const { return c + G * __builtin_amdgcn_readfirstlane((int)__hip_atomic_load(head, __ATOMIC_RELAXED, __HIP_MEMORY_SCOPE_WORKGROUP)); }
    DEVI void run_until(volatile LAS unsigned* genw, unsigned n) const {
        bool empty = peek() >= CVQ_TOTAL; int budget = CVQ_PER_BARRIER;
        while (*genw < n) {
            if (empty || budget == 0) { __builtin_amdgcn_s_sleep(4); continue; }
            --budget;
            const int q = take();
            if (q >= CVQ_TOTAL) { empty = true; continue; }
            item(q);
        }
    }
    DEVI void catchup(int limit) const { for (;;) { if (peek() >= limit) break; const int q = take(); if (q >= CVQ_TOTAL) break; item(q); } }
};
DEVI int fresh_lane() { int l = (int)__builtin_amdgcn_mbcnt_hi(~0u, __builtin_amdgcn_mbcnt_lo(~0u, 0u)); asm volatile("" : "+v"(l)); return l; }
DEVI CvtQ make_cvtq(const Args& a, LAS unsigned char* lds, int wave, int lane) {
    unsigned char* w = a.ws;
    return CvtQ{a.in[2], a.in[11], a.in[14], a.in[15], a.in[21], a.in[22], (bf16_t*)(w + WS_WIN), (bf16_t*)(w + WS_WGLU), (bf16_t*)(w + WS_WATT), (bf16_t*)(w + WS_WOUT), (bf16_t*)(w + WS_WGU), (bf16_t*)(w + WS_WDN),
                (LAS unsigned*)(lds + LDSCTL_OFF) + 5, lds, wave, lane, (int)blockIdx.x, (int)gridDim.x};
}
DEVI void ph_convert_first(const Frame& F, const CvtQ& Q) { for (int it = F.gw; it < CVQ_BASE; it += F.NGW) Q.item(it - CVQ_BASE); }
DEVI void xcd_barrier_w(const XcdBarrier& b, unsigned n, volatile LAS unsigned* genw, const CvtQ& Q) {
    asm volatile("s_waitcnt vmcnt(0)" ::: "memory");
    __syncthreads();
    if (Q.wave == 0) {
        if (threadIdx.x == 0) {
            unsigned* bar = b.bar;
            __builtin_amdgcn_s_waitcnt(0);
            unsigned nloc = b.st[0], nx = b.st[1];
            if (nloc == 0u) { xcd_barrier_complete(bar, b.x, nloc, nx); b.st[0] = nloc; b.st[1] = nx; }
            const unsigned old = xb_add(&bar[XB_XSUB(b.x)], 1u);
            const unsigned gen = old / nloc;
            if (old + 1u == (gen + 1u) * nloc) {
                __builtin_amdgcn_fence(__ATOMIC_RELEASE, "agent");
                asm volatile("s_waitcnt vmcnt(0)" ::: "memory");
                const unsigned og = xb_add(&bar[XB_TOP], 1u);
                const unsigned tg = og / nx;
                if (og + 1u == (tg + 1u) * nx) xb_add(&bar[XB_TOPGEN], 1u);
                else XB_SPIN(xb_ld(&bar[XB_TOPGEN]) == tg, bar);
                __builtin_amdgcn_fence(__ATOMIC_ACQUIRE, "agent");
                xb_add(&bar[XB_XGEN(b.x)], 1u);
                asm volatile("s_waitcnt vmcnt(0)" ::: "memory");
            } else {
                XB_SPIN(xb_ld(&bar[XB_XGEN(b.x)]) == gen, bar);
                __builtin_amdgcn_fence(__ATOMIC_ACQUIRE, "agent");
                asm volatile("s_waitcnt vmcnt(0)" ::: "memory");
            }
            *genw = n;
        }
    } else Q.run_until(genw, n);
    __syncthreads();
}


DEVI void moe_tstart(const Frame& F, const unsigned* cnt, volatile LAS int* tstart) { expert_prefix(F, cnt, tstart, 1); }
DEVI void moe_gather_table(const Frame& F, int v, const unsigned* cnt, const int* list, volatile LAS int* tstart, LAS unsigned* tab) {
    for (int j = F.tid; j < 8 * 256; j += NTHR) {
        const int i = j >> 8, r = j & 255, U = i * F.G + v, rt = U >> 2; if (rt >= tstart[NEXP]) continue;
        int e = 0;
        for (int q = 1; q < NEXP; ++q) e = (rt >= tstart[q]) ? q : e;
        const int n = (int)cnt[e], idx = (rt - tstart[e]) * 256 + r;
        tab[j] = (unsigned)list[(size_t)e * LIST_CAP + (idx < n ? idx : 0)] * (unsigned)(D * 2);
    }
    __syncthreads();
}
DEVI void ph_zero_ksum(const Frame& F, float* ksum) { for (int i = F.gt; i < BATCH * NH * NBLK * 64; i += F.NGT) ksum[i] = 0.f; }

namespace attn_body {
using bf16=__hip_bfloat16;
using bf16x8=__attribute__((ext_vector_type(8)))short;
using s16x4=__attribute__((ext_vector_type(4)))short;
using f32x16=__attribute__((ext_vector_type(16)))float;
using f32x4=__attribute__((ext_vector_type(4)))float;
using u32x4=__attribute__((ext_vector_type(4)))unsigned;
constexpr int BATCH=8,NHEAD=8,SEQ=4096,D=64,DM=NHEAD*D;
constexpr int NW=8,QBLK=32,QB=QBLK*NW,KVBLK=64,NQB=SEQ/QB;
constexpr int ATTN_PITCH=DM, ATTN_UNIT_ROWS=QB;
__device__ __forceinline__ int crow(int r,int hi){return (r&3)+8*(r>>2)+4*hi;}
#define SBAR() __builtin_amdgcn_sched_barrier(0)
__device__ __forceinline__ void cmask(f32x16&p0,f32x16&p1,int jb,int qrel,int hi){
  const float NEG=-INFINITY; int kb=64*jb+4*hi;
  #pragma unroll
  for(int r=0;r<16;++r){int kv=kb+(r&3)+8*(r>>2); if(kv>qrel)p0[r]=NEG; if(kv+32>qrel)p1[r]=NEG;}
}

constexpr int NSLOT=3, SLOTB=8192;
constexpr int LDS_K=0, LDS_V=NSLOT*SLOTB, LDS_WS=2*NSLOT*SLOTB, LDS_OST=LDS_WS+NW*64*4, LDS_BYTES=LDS_OST+NW*4096;
constexpr float C2=0.125f*1.4426950408889634f;
__device__ __forceinline__ void glds16(const void*gsrc,unsigned lds_dst){unsigned keep;
  asm volatile("s_mov_b32 %0, m0\n\ts_mov_b32 m0, %2\n\ts_nop 0\n\tglobal_load_lds_dwordx4 %1, off\n\ts_mov_b32 m0, %0":"=&s"(keep):"v"(gsrc),"s"(lds_dst):"memory");}
__device__ __forceinline__ float max3f(float a,float b,float c){float r;asm("v_max3_f32 %0, %1, %2, %3":"=v"(r):"v"(a),"v"(b),"v"(c));return r;}
__device__ __forceinline__ float max2f(float a,float b){float r;asm("v_max_f32_e32 %0, %1, %2":"=v"(r):"v"(a),"v"(b));return r;}
__device__ __forceinline__ float fadd_s(float a,float b){float r;asm("v_add_f32_e32 %0, %1, %2":"=v"(r):"v"(a),"v"(b));return r;}
__device__ __forceinline__ float fsub_s(float a,float b){float r;asm("v_sub_f32_e32 %0, %1, %2":"=v"(r):"v"(a),"v"(b));return r;}
typedef float f32x2_t __attribute__((ext_vector_type(2))); typedef __bf16 bf16x2_t __attribute__((ext_vector_type(2)));
__device__ __forceinline__ unsigned cvtpk_s(float lo,float hi){f32x2_t v={lo,hi};bf16x2_t b=__builtin_convertvector(v,bf16x2_t);return __builtin_bit_cast(unsigned,b);}
#define WAIT_BAR(N) asm volatile("s_waitcnt vmcnt(" #N ") lgkmcnt(0)\n\ts_barrier":::"memory")

__device__ __forceinline__ void qkt(f32x16&p0,f32x16&p1,const char*Kslot,const bf16x8*qr,const f32x16&negm,int r32,int hi){
  const char*kb=Kslot+hi*1024+r32*16;
  #pragma unroll
  for(int d0=0;d0<4;++d0){
    const bf16x8 b0=*reinterpret_cast<const bf16x8*>(kb+d0*2048);
    const bf16x8 b1=*reinterpret_cast<const bf16x8*>(kb+d0*2048+512);
    if(d0==0){p0=__builtin_amdgcn_mfma_f32_32x32x16_bf16(b0,qr[0],negm,0,0,0);p1=__builtin_amdgcn_mfma_f32_32x32x16_bf16(b1,qr[0],negm,0,0,0);}
    else{p0=__builtin_amdgcn_mfma_f32_32x32x16_bf16(b0,qr[d0],p0,0,0,0);p1=__builtin_amdgcn_mfma_f32_32x32x16_bf16(b1,qr[d0],p1,0,0,0);}}
}
typedef __attribute__((address_space(3))) const char* lds_cptr;
typedef short v4i16_t __attribute__((ext_vector_type(4)));
__device__ __forceinline__ void kload8(bf16x8*kf,lds_cptr kp){
  kf[0]=*(const __attribute__((address_space(3))) bf16x8*)(kp);      kf[1]=*(const __attribute__((address_space(3))) bf16x8*)(kp+512);
  kf[2]=*(const __attribute__((address_space(3))) bf16x8*)(kp+2048); kf[3]=*(const __attribute__((address_space(3))) bf16x8*)(kp+2560);
  kf[4]=*(const __attribute__((address_space(3))) bf16x8*)(kp+4096); kf[5]=*(const __attribute__((address_space(3))) bf16x8*)(kp+4608);
  kf[6]=*(const __attribute__((address_space(3))) bf16x8*)(kp+6144); kf[7]=*(const __attribute__((address_space(3))) bf16x8*)(kp+6656);
}
__device__ __forceinline__ void kload2(bf16x8*kf,lds_cptr kp,int j){ kf[2*j]=*(const __attribute__((address_space(3))) bf16x8*)(kp+j*2048); kf[2*j+1]=*(const __attribute__((address_space(3))) bf16x8*)(kp+j*2048+512); }
__device__ __forceinline__ s16x4 vtr(lds_cptr p){ return __builtin_bit_cast(s16x4,__builtin_amdgcn_ds_read_tr16_b64_v4i16((__attribute__((address_space(3))) v4i16_t*)p)); }
__device__ __forceinline__ float rowmax(const f32x16&p0,const f32x16&p1){
  float a=max3f(p0[0],p0[1],p1[0]),b=max3f(p0[2],p0[3],p1[1]);a=max3f(a,p1[2],p1[3]);
  #pragma unroll
  for(int r=4;r<16;r+=4){a=max3f(a,p0[r],p0[r+1]);b=max3f(b,p0[r+2],p0[r+3]);a=max3f(a,p1[r],p1[r+1]);b=max3f(b,p1[r+2],p1[r+3]);}
  const float m=max2f(a,b);
  auto rr=__builtin_amdgcn_permlane32_swap(__float_as_uint(m),__float_as_uint(m),false,false);
  return max2f(__uint_as_float(rr[0]),__uint_as_float(rr[1]));
}
__device__ __forceinline__ void pv(f32x16*o,int vb,bf16x8 pa0,bf16x8 pa1,bf16x8 pa2,bf16x8 pa3){
  #pragma unroll
  for(int d0=0;d0<2;++d0){s16x4 lo[4],hi[4];
    #pragma unroll
    for(int ks=0;ks<4;++ks){
      asm volatile("ds_read_b64_tr_b16 %0,%1 offset:%c2":"=&v"(lo[ks]):"v"(vb),"i"(d0*4096+ks*1024):"memory");
      asm volatile("ds_read_b64_tr_b16 %0,%1 offset:%c2":"=&v"(hi[ks]):"v"(vb),"i"(d0*4096+ks*1024+512):"memory");}
    asm volatile("s_waitcnt lgkmcnt(0)":::"memory");SBAR();
    #define PK(k) (bf16x8){lo[k][0],lo[k][1],lo[k][2],lo[k][3],hi[k][0],hi[k][1],hi[k][2],hi[k][3]}
    o[d0]=__builtin_amdgcn_mfma_f32_32x32x16_bf16(pa0,PK(0),o[d0],0,0,0);
    o[d0]=__builtin_amdgcn_mfma_f32_32x32x16_bf16(pa1,PK(1),o[d0],0,0,0);
    o[d0]=__builtin_amdgcn_mfma_f32_32x32x16_bf16(pa2,PK(2),o[d0],0,0,0);
    o[d0]=__builtin_amdgcn_mfma_f32_32x32x16_bf16(pa3,PK(3),o[d0],0,0,0);
    #undef PK
  }
}

#ifndef ATTN_STORE16
#define ATTN_STORE16(p,v) (*(u32x4*)(p)=(v))
#endif
template<int THRL> __device__ __forceinline__ void attn_unit(int b,int h,int qb,const bf16*Q,const bf16*__restrict__ K,const bf16*__restrict__ V,bf16*O,const unsigned*__restrict__ sel,char*shm,int tid_in){
  const int tid=tid_in,lane=tid&63,r32=lane&31,hi=lane>>5; const int wid=__builtin_amdgcn_readfirstlane(tid>>6);
  const long rowbase=(long)b*SEQ; const int q0=qb*QB;
  const bf16*Qw=Q+(rowbase+q0+wid*QBLK)*DM+h*D;
  const bf16*Kh=K+rowbase*DM+h*D,*Vh=V+rowbase*DM+h*D;
  const unsigned lds0=(unsigned)(uintptr_t)shm;
  float*wsf=(float*)(shm+LDS_WS)+wid*64;
  const bf16*ksrc=Kh+(long)lane*DM+wid*8;
  const bf16*vsrc=Vh+(long)(16*(wid&3)+(lane>>2))*DM+(wid>>2)*32+(lane&3)*8;
  const unsigned kdst=lds0+LDS_K+wid*1024, vdst=lds0+LDS_V+wid*1024;
  #define DMA_K(t,slot) glds16(ksrc+(long)(t)*KVBLK*DM,(unsigned)__builtin_amdgcn_readfirstlane(kdst+(slot)))
  #define DMA_V(t,slot) glds16(vsrc+(long)(t)*KVBLK*DM,(unsigned)__builtin_amdgcn_readfirstlane(vdst+(slot)))
  const int vb0=(int)(lds0+LDS_V)+((lane>>4)&1)*32+(lane&3)*8+(4*hi+((lane&15)>>2))*64;
  const char*Kbase=shm+LDS_K; bf16x8 kf[8];
  const lds_cptr shm3=(lds_cptr)shm; const lds_cptr kp0=shm3+LDS_K+hi*1024+r32*16; const lds_cptr vp0=shm3+LDS_V+((lane>>4)&1)*32+(lane&3)*8+(4*hi+((lane&15)>>2))*64;
  const int NT=(q0+QB)/KVBLK;
  DMA_K(0,0);DMA_V(0,0);DMA_K(1,SLOTB);
  bf16x8 qr[4];
  #pragma unroll
  for(int d0=0;d0<4;++d0)qr[d0]=*reinterpret_cast<const bf16x8*>(&Qw[(long)r32*DM+d0*16+hi*8]);
  const unsigned selmask=sel[((size_t)(b*NHEAD+h))*SEQ+q0+wid*QBLK+r32];
  const float NEGINF=-INFINITY;
  float mhat=0.f,l_reg=0.f;f32x16 o[2];o[0]=f32x16{};o[1]=f32x16{};f32x16 negm=f32x16{};asm volatile("":"+v"(negm));
  const int qrel=wid*QBLK+r32;
  #define CMASK(P0,P1,t) do{int jb_=(t)-(NT-4); if(jb_>=0)cmask(P0,P1,jb_,qrel,hi);}while(0)
  bool resc=false;
  #define START(P0,P1) do{ const float rm=rowmax(P0,P1); resc=false; \
    { const float dl=__builtin_fmaxf(rm,-64.f); mhat=fadd_s(mhat,dl); \
      _Pragma("unroll") for(int r=0;r<16;++r){P0[r]=fsub_s(P0[r],dl);P1[r]=fsub_s(P1[r],dl);} \
      _Pragma("unroll") for(int r=0;r<16;++r)negm[r]=-mhat; asm volatile("":"+v"(negm)); } \
    _Pragma("unroll") for(int r=0;r<16;++r)P0[r]=__builtin_amdgcn_exp2f(P0[r]); }while(0)
  #define RESC() do{ if(resc){ asm volatile("s_waitcnt lgkmcnt(0)":::"memory"); \
      _Pragma("unroll") for(int d_=0;d_<2;++d_) _Pragma("unroll") for(int r=0;r<16;++r)o[d_][r]*=wsf[crow(r,hi)]; } }while(0)
  f32x16 pA0,pA1,pB0,pB1;
  int sl_prev=0,sl_cur=0,sl_next=SLOTB;
  #define ROT() do{sl_prev=sl_cur;sl_cur=sl_next;sl_next=(sl_next==(NSLOT-1)*SLOTB)?0:sl_next+SLOTB;}while(0)
  DMA_K(2,2*SLOTB);
  WAIT_BAR(3);
  #define SETNEGM(t) do{ const bool keep_=((t)>=NT-4)||(((selmask>>((t)>>2))&1u)!=0u); const float nm_=keep_?-mhat:NEGINF; _Pragma("unroll") for(int r=0;r<16;++r)negm[r]=nm_; asm volatile("":"+v"(negm)); }while(0)
  SETNEGM(0);
  qkt(pA0,pA1,Kbase,qr,negm,r32,hi);asm volatile("s_nop 15\n\ts_nop 7":"+v"(pA0),"+v"(pA1));CMASK(pA0,pA1,0);
  START(pA0,pA1);
  _Pragma("unroll") for(int r=0;r<16;++r)pA1[r]=__builtin_amdgcn_exp2f(pA1[r]);
  WAIT_BAR(0);
  DMA_K(3,0);DMA_V(1,SLOTB);
  ROT();
  kload8(kf,kp0+sl_cur);
  WAIT_BAR(2);
  s16x4 vlo[8],vhi[8]; u32x4 pw0,pw1,pw2,pw3;
  #define PKW(P,B) cvtpk_s(P[B],P[B+1])
  #define PAF(k) __builtin_bit_cast(bf16x8,pw##k)
  #define VFR(i) (bf16x8){vlo[i][0],vlo[i][1],vlo[i][2],vlo[i][3],vhi[i][0],vhi[i][1],vhi[i][2],vhi[i][3]}
  #define PIN(x) asm volatile("":"+v"(x))
  #define MX3(a,b,c) __builtin_fmaxf(__builtin_fmaxf((a),(b)),(c))
  #define GAPA(MF,A0,A1,A2,A3,W0,W1,PW) do{ MF; sacc+=A0; sacc+=A1; sacc+=A2; sacc+=A3; PIN(sacc); W0; W1; PIN(PW); SBAR(); }while(0)
  #define EX(v) __builtin_amdgcn_exp2f(v)
  #define GAPB(MF,X,B) do{ MF; X[B]=EX(X[B]); X[B+1]=EX(X[B+1]); X[B+2]=EX(X[B+2]); X[B+3]=EX(X[B+3]); PIN(X); SBAR(); }while(0)
  #define VRD(i) do{ vlo[i]=vtr(vp_+(((i)>>2)*4096+((i)&3)*1024)); vhi[i]=vtr(vp_+(((i)>>2)*4096+((i)&3)*1024+512)); }while(0)
  #define KRD(G,j) do{ if(G){ kload2(kf,kp0+sl_next,j); SBAR(); } }while(0)
  #define STEP(C0,C1,P0,P1,t,GK,GV,GL) do{ SBAR(); SETNEGM(t); SBAR(); \
    const lds_cptr vp_=vp0+sl_prev; \
    VRD(0); SBAR(); float sacc=(P0[0]+P0[1]); \
    GAPA(C0=__builtin_amdgcn_mfma_f32_32x32x16_bf16(kf[0],qr[0],negm,0,0,0), P0[2],P0[3],P0[4],P0[5],     pw0[0]=PKW(P0,0), pw0[1]=PKW(P0,2), pw0); \
    VRD(4); SBAR(); GAPA(C1=__builtin_amdgcn_mfma_f32_32x32x16_bf16(kf[1],qr[0],negm,0,0,0), P0[6],P0[7],P0[8],P0[9],     pw0[2]=PKW(P0,4), pw0[3]=PKW(P0,6), pw0); \
    VRD(1); SBAR(); GAPA(C0=__builtin_amdgcn_mfma_f32_32x32x16_bf16(kf[2],qr[1],C0,0,0,0),   P0[10],P0[11],P0[12],P0[13], pw1[0]=PKW(P0,8), pw1[1]=PKW(P0,10), pw1); \
    VRD(5); SBAR(); GAPA(C1=__builtin_amdgcn_mfma_f32_32x32x16_bf16(kf[3],qr[1],C1,0,0,0),   P0[14],P0[15],P1[0],P1[1],   pw1[2]=PKW(P0,12),pw1[3]=PKW(P0,14), pw1); \
    VRD(2); SBAR(); GAPA(C0=__builtin_amdgcn_mfma_f32_32x32x16_bf16(kf[4],qr[2],C0,0,0,0),   P1[2],P1[3],P1[4],P1[5],     pw2[0]=PKW(P1,0), pw2[1]=PKW(P1,2), pw2); \
    VRD(6); SBAR(); GAPA(C1=__builtin_amdgcn_mfma_f32_32x32x16_bf16(kf[5],qr[2],C1,0,0,0),   P1[6],P1[7],P1[8],P1[9],     pw2[2]=PKW(P1,4), pw2[3]=PKW(P1,6), pw2); \
    VRD(3); SBAR(); GAPA(C0=__builtin_amdgcn_mfma_f32_32x32x16_bf16(kf[6],qr[3],C0,0,0,0),   P1[10],P1[11],P1[12],P1[13], pw3[0]=PKW(P1,8), pw3[1]=PKW(P1,10), pw3); \
    VRD(7); SBAR(); GAPA(C1=__builtin_amdgcn_mfma_f32_32x32x16_bf16(kf[7],qr[3],C1,0,0,0),   P1[14],P1[15],0.f,0.f,       pw3[2]=PKW(P1,12),pw3[3]=PKW(P1,14), pw3); \
    l_reg+=sacc; \
    if(GK){DMA_K((t)+3,sl_cur);} if(GV){DMA_V((t)+1,sl_next);} \
    CMASK(C0,C1,t); \
    { float a=MX3(C0[0],C0[1],C1[0]),b=MX3(C0[2],C0[3],C1[1]); a=MX3(a,C1[2],C1[3]); \
      _Pragma("unroll") for(int r=4;r<16;r+=4){a=MX3(a,C0[r],C0[r+1]);b=MX3(b,C0[r+2],C0[r+3]);a=MX3(a,C1[r],C1[r+1]);b=MX3(b,C1[r+2],C1[r+3]);} \
      float rm=__builtin_fmaxf(a,b); { auto rr=__builtin_amdgcn_permlane32_swap(__float_as_uint(rm),__float_as_uint(rm),false,false); rm=__builtin_fmaxf(__uint_as_float(rr[0]),__uint_as_float(rr[1])); } \
      resc=false; \
      if(__builtin_expect(__any(rm>(float)THRL),0)){ const float dl=__builtin_fmaxf(rm,0.f); mhat+=dl; \
        _Pragma("unroll") for(int r=0;r<16;++r){C0[r]-=dl;C1[r]-=dl;} \
        const float f=__builtin_amdgcn_exp2f(-dl); l_reg*=f; if(hi==0)wsf[r32]=f; resc=true; } } \
    SBAR(); \
    GAPB(o[0]=__builtin_amdgcn_mfma_f32_32x32x16_bf16(PAF(0),VFR(0),o[0],0,0,0), C0,0); \
    GAPB(o[1]=__builtin_amdgcn_mfma_f32_32x32x16_bf16(PAF(0),VFR(4),o[1],0,0,0), C0,4); \
    KRD(GL,0); GAPB(o[0]=__builtin_amdgcn_mfma_f32_32x32x16_bf16(PAF(1),VFR(1),o[0],0,0,0), C0,8); \
    KRD(GL,1); GAPB(o[1]=__builtin_amdgcn_mfma_f32_32x32x16_bf16(PAF(1),VFR(5),o[1],0,0,0), C0,12); \
    KRD(GL,2); GAPB(o[0]=__builtin_amdgcn_mfma_f32_32x32x16_bf16(PAF(2),VFR(2),o[0],0,0,0), C1,0); \
    KRD(GL,3); GAPB(o[1]=__builtin_amdgcn_mfma_f32_32x32x16_bf16(PAF(2),VFR(6),o[1],0,0,0), C1,4); \
    GAPB(o[0]=__builtin_amdgcn_mfma_f32_32x32x16_bf16(PAF(3),VFR(3),o[0],0,0,0), C1,8); \
    GAPB(o[1]=__builtin_amdgcn_mfma_f32_32x32x16_bf16(PAF(3),VFR(7),o[1],0,0,0), C1,12); \
    }while(0)
  int t=1;
  #undef CMASK
  #define CMASK(P0,P1,t) do{}while(0)
  for(;t+5<NT;t+=2){
    STEP(pB0,pB1,pA0,pA1,t,true,true,true);     WAIT_BAR(2); RESC(); ROT();
    STEP(pA0,pA1,pB0,pB1,t+1,true,true,true);   WAIT_BAR(2); RESC(); ROT();
  }
  #undef CMASK
  #define CMASK(P0,P1,t) do{int jb_=(t)-(NT-4); if(jb_>=0)cmask(P0,P1,jb_,qrel,hi);}while(0)
  #define ENDW(tt) do{ if((tt)+3<NT){WAIT_BAR(2);} else if((tt)+2<NT){WAIT_BAR(1);} else {WAIT_BAR(0);} }while(0)
  for(;t+1<NT;t+=2){
    STEP(pB0,pB1,pA0,pA1,t,(t+3<NT),(t+1<NT),(t+1<NT));       ENDW(t);   RESC(); ROT();
    STEP(pA0,pA1,pB0,pB1,t+1,(t+4<NT),(t+2<NT),(t+2<NT));     ENDW(t+1); RESC(); ROT();
  }
  STEP(pB0,pB1,pA0,pA1,NT-1,false,false,false); RESC();
  { float sacc=pB0[0]+pB0[1]; _Pragma("unroll") for(int r=2;r<16;++r)sacc+=pB0[r]; _Pragma("unroll") for(int r=0;r<16;++r)sacc+=pB1[r]; l_reg+=sacc;
    pw0=(u32x4){PKW(pB0,0),PKW(pB0,2),PKW(pB0,4),PKW(pB0,6)};pw1=(u32x4){PKW(pB0,8),PKW(pB0,10),PKW(pB0,12),PKW(pB0,14)};pw2=(u32x4){PKW(pB1,0),PKW(pB1,2),PKW(pB1,4),PKW(pB1,6)};pw3=(u32x4){PKW(pB1,8),PKW(pB1,10),PKW(pB1,12),PKW(pB1,14)};
    SBAR(); pv(o,vb0+sl_cur,PAF(0),PAF(1),PAF(2),PAF(3)); }
  #undef PKW
  #undef PAF
  #undef VFR
  #undef PIN
  #undef MX3
  #undef GAPA
  #undef GAPB
  #undef EX
  #undef VRD
  #undef KRD
  #undef STEP
  #undef ENDW
  {auto rr=__builtin_amdgcn_permlane32_swap(__float_as_uint(l_reg),__float_as_uint(l_reg),false,false);l_reg=__uint_as_float(rr[0])+__uint_as_float(rr[1]);}
  if(hi==0)wsf[32+r32]=l_reg;asm volatile("s_waitcnt lgkmcnt(0)":::"memory");
  float rli[16];
  #pragma unroll
  for(int r=0;r<16;++r)rli[r]=__builtin_amdgcn_rcpf(wsf[32+crow(r,hi)]);
  bf16*Ow=O+(rowbase+q0+wid*QBLK)*DM+h*D;
  { bf16*stg=(bf16*)(shm+LDS_OST)+wid*2048;
    #pragma unroll
    for(int r=0;r<16;++r){const int orow=crow(r,hi);
      #pragma unroll
      for(int d0=0;d0<2;++d0)stg[orow*64+d0*32+r32]=__float2bfloat16(o[d0][r]*rli[r]);}
    asm volatile("s_waitcnt lgkmcnt(0)":::"memory");
    #pragma unroll
    for(int i=0;i<4;++i){const int row=i*8+(lane>>3),ch=lane&7; const u32x4 v=*(const u32x4*)(stg+row*64+ch*8); ATTN_STORE16(Ow+(long)row*DM+ch*8,v);} }
  asm volatile("s_waitcnt lgkmcnt(0)\n\ts_barrier":::"memory");
  #undef DMA_K
  #undef DMA_V
  #undef CMASK
  #undef START
  #undef SETNEGM
  #undef RESC
  #undef ROT
}
constexpr int ATTN_LDS_BYTES=LDS_BYTES;
struct AttnTensors { const bf16* Q; const bf16* K; const bf16* V; bf16* O; const unsigned* sel; };
struct AttnUnit { int bh; int qb; };
struct StaticOrder {
  int vcu,grid;
  __device__ __forceinline__ explicit StaticOrder(int grid_,int block):vcu((grid_%8==0)?(block%8)*(grid_/8)+block/8:block),grid(grid_){}
  __device__ __forceinline__ bool next(int i,AttnUnit&u)const{
    if(grid==256){ if(i>=4)return false; const int s=vcu&3; u.bh=vcu>>2; u.qb=(i==0)?s:(i==1)?7-s:(i==2)?8+s:15-s; return true; }
    const int U=i*grid+vcu; if(U>=BATCH*NHEAD*NQB)return false; u.bh=U/NQB; u.qb=U%NQB; return true; }
  __device__ __forceinline__ void a_ready(const AttnUnit&)const{}
  __device__ __forceinline__ void done(const AttnUnit&)const{}
};
template<class Sched,int THRL=8> __device__ __forceinline__ void attn_phase(char*lds,const AttnTensors&T,const Sched&S,int tid_in){
  AttnUnit u;
  for(int i=0;S.next(i,u);++i){ S.a_ready(u); attn_unit<THRL>(u.bh/NHEAD,u.bh%NHEAD,u.qb,T.Q,T.K,T.V,T.O,T.sel,lds,tid_in); S.done(u); }
}
#undef SBAR
#undef WAIT_BAR
}


DEVI void ph_moba_select(const Frame& F, const bf16_t* Q, const float* ksum, unsigned* sel) {
    for (int idx = F.gt; idx < BATCH * NH * SEQ; idx += F.NGT) {
        const int s = idx & (SEQ - 1), bh = idx >> 12, b = bh >> 3, hh = bh & 7, qb = s >> 8;
        const bf16_t* qp = Q + ((size_t)b * SEQ + s) * 512 + hh * 64;
        float q[64];
#pragma unroll
        for (int i = 0; i < 8; ++i) { const bf16x8 t = *((const bf16x8*)qp + i);
#pragma unroll
            for (int j = 0; j < 8; ++j) q[8 * i + j] = bf2f((bf16_t)t[j]); }
        float gsc[15];
#pragma unroll
        for (int j = 0; j < 15; ++j) { gsc[j] = -INFINITY;
            if (j < qb) { const float* km = ksum + ((size_t)bh * 16 + j) * 64; float a = 0.f;
#pragma unroll
                for (int i = 0; i < 64; ++i) a += q[i] * km[i];
                gsc[j] = a; } }
        unsigned m = 0u;
#pragma unroll
        for (int t = 0; t < 3; ++t) { float best = -INFINITY; int bi = -1;
#pragma unroll
            for (int j = 0; j < 15; ++j) { const bool ok = (j < qb) && !((m >> j) & 1u) && (gsc[j] > best); best = ok ? gsc[j] : best; bi = ok ? j : bi; }
            if (bi >= 0) m |= 1u << bi; }
        sel[idx] = m;
    }
}


DEVI void ph_router_weights(const Frame& F, const float* wg, const float* we, bf16_t* wr) {
    for (int idx = F.gt; idx < DEPTH * 48 * 1024; idx += F.NGT) {
        const int l = idx / (48 * 1024), r = idx % (48 * 1024), o = r >> 10, kk = r & 1023;
        const float v = (o < 4) ? wg[((size_t)l * D + kk) * 4 + o] : (o < 36) ? we[((size_t)l * D + kk) * 32 + (o - 4)] : 0.f;
        const bf16_t hi = f2bf(v), lo = f2bf(v - bf2f(hi));
        wr[((size_t)l * 2 + 0) * 48 * 1024 + r] = hi; wr[((size_t)l * 2 + 1) * 48 * 1024 + r] = lo;
    }
}
DEVI void ph_norm_router_mfma(const Frame& F, const bf16_t* x, const float* ssq, const float* g, const bf16_t* wr, const float* bg, const float* be, bf16_t* h2, unsigned* cnt, int* list, unsigned* rec) {
    const int lane = F.lane, ri = lane & 15, q = lane >> 4;
    constexpr int WPITCH = 2064, WLO_OFF = 36 * WPITCH, LG_OFF = 2 * 36 * WPITCH;
    static_assert(LG_OFF <= SCRATCH_BYTES, "router LDS");
    LAS unsigned char* wl = F.lds;
    LAS float* lg = (LAS float*)(F.lds + F.wave * 3072);
    volatile LAS unsigned* hist = (volatile LAS unsigned*)(F.lds + 8 * 3072);
    for (int tile = blockIdx.x; tile < NTOK / 128; tile += F.G) {
        for (int i = F.tid; i < 2 * 36 * 128; i += NTHR) { const int hl = i / (36 * 128), r = (i / 128) % 36, c = i % 128;
            *(LAS u32x4*)(wl + hl * WLO_OFF + r * WPITCH + c * 16) = *(const u32x4*)(wr + (size_t)hl * 48 * 1024 + (size_t)r * 1024 + c * 8); }
        __syncthreads();
        const int row = tile * 128 + F.wave * 16 + ri;
        const bf16_t* xr = x + (size_t)row * D + 8 * q;
        float ss;
        { const f32x4* sp = (const f32x4*)(ssq + (size_t)row * 16); const f32x4 s0 = sp[0], s1 = sp[1], s2 = sp[2], s3 = sp[3];
          ss = ((s0[0] + s0[1]) + (s0[2] + s0[3])) + ((s1[0] + s1[1]) + (s1[2] + s1[3])) + ((s2[0] + s2[1]) + (s2[2] + s2[3])) + ((s3[0] + s3[1]) + (s3[2] + s3[3])); }
        const float rstd = 1.0f / sqrtf(ss * (1.0f / D) + NORM_EPS);
        f32x4 acc[3] = {(f32x4){0.f, 0.f, 0.f, 0.f}, (f32x4){0.f, 0.f, 0.f, 0.f}, (f32x4){0.f, 0.f, 0.f, 0.f}};
#pragma unroll 2
        for (int kk = 0; kk < 32; ++kk) {
            const int k0 = 32 * kk + 8 * q;
            const u32x4 xw = *(const u32x4*)(xr + 32 * kk); const f32x4 a = pg8::unpk_lo(xw, 0), b = pg8::unpk_lo(xw, 1);
            const f32x4 ga = *(const f32x4*)(g + k0), gb = *(const f32x4*)(g + k0 + 4);
            const f32x4 ha = a * rstd * ga, hb = b * rstd * gb;
            const u32x4 hi = pg8::pk8(ha, hb);
            const f32x4 ra = ha - pg8::unpk_lo(hi, 0), rb = hb - pg8::unpk_lo(hi, 1);
            const u32x4 lo = pg8::pk8(ra, rb);
            *(u32x4*)(h2 + (size_t)row * D + k0) = hi;
            const bf16x8 ahi = __builtin_bit_cast(bf16x8, hi), alo = __builtin_bit_cast(bf16x8, lo);
#pragma unroll
            for (int t = 0; t < 3; ++t) {
                const int wrow = 16 * t + ri; bf16x8 bh = {}, bl = {};
                if (wrow < 36) { bh = *(const LAS bf16x8*)(wl + wrow * WPITCH + k0 * 2); bl = *(const LAS bf16x8*)(wl + WLO_OFF + wrow * WPITCH + k0 * 2); }
                acc[t] = __builtin_amdgcn_mfma_f32_16x16x32_bf16(ahi, bh, acc[t], 0, 0, 0);
                acc[t] = __builtin_amdgcn_mfma_f32_16x16x32_bf16(alo, bh, acc[t], 0, 0, 0);
                acc[t] = __builtin_amdgcn_mfma_f32_16x16x32_bf16(ahi, bl, acc[t], 0, 0, 0);
            }
        }
        __syncthreads();
        if (F.tid < 64) hist[F.tid] = 0u;
#pragma unroll
        for (int t = 0; t < 3; ++t)
#pragma unroll
            for (int e = 0; e < 4; ++e) lg[(4 * q + e) * 48 + 16 * t + ri] = acc[t][e];
        __syncthreads();
        int e0 = 0, e1 = 0; float w0 = 0.f, w1 = 0.f; unsigned r0 = 0u, r1 = 0u;
        if (lane < 16) {
            const LAS float* L = lg + lane * 48;
            float gl[4]; int gt = 0; float gm = -INFINITY;
#pragma unroll
            for (int i = 0; i < 4; ++i) { gl[i] = L[i] + bg[i]; if (gl[i] > gm) { gm = gl[i]; gt = i; } }
            float gs = 0.f;
#pragma unroll
            for (int i = 0; i < 4; ++i) gs += __expf(gl[i] - gm);
            const float pgv = 1.0f / gs;
            float el[8]; float em = -INFINITY;
#pragma unroll
            for (int i = 0; i < 8; ++i) { el[i] = L[4 + gt * 8 + i] + be[gt * 8 + i]; em = fmaxf(em, el[i]); }
            int i1 = 0; float v1 = -INFINITY;
#pragma unroll
            for (int i = 0; i < 8; ++i) if (el[i] > v1) { v1 = el[i]; i1 = i; }
            int i2 = 0; float v2 = -INFINITY;
#pragma unroll
            for (int i = 0; i < 8; ++i) if (i != i1 && el[i] > v2) { v2 = el[i]; i2 = i; }
            const float p1 = __expf(v1 - em), p2 = __expf(v2 - em);
            w0 = pgv * p1 / (p1 + p2); w1 = pgv * p2 / (p1 + p2);
            e0 = gt * 8 + i1; e1 = gt * 8 + i2;
            r0 = __hip_atomic_fetch_add((LAS unsigned*)hist + e0, 1u, __ATOMIC_RELAXED, __HIP_MEMORY_SCOPE_WORKGROUP); r1 = __hip_atomic_fetch_add((LAS unsigned*)hist + e1, 1u, __ATOMIC_RELAXED, __HIP_MEMORY_SCOPE_WORKGROUP);
        }
        __syncthreads();
        if (F.tid < 32) { const unsigned n = hist[F.tid]; hist[32 + F.tid] = n ? atomicAdd(cnt + F.tid, n) : 0u; }
        __syncthreads();
        if (lane < 16) {
            const int tok = tile * 128 + F.wave * 16 + lane;
            const unsigned pos0 = hist[32 + e0] + r0, pos1 = hist[32 + e1] + r1;
            list[(size_t)e0 * LIST_CAP + pos0] = tok; list[(size_t)e1 * LIST_CAP + pos1] = tok;
            unsigned* rp = rec + (size_t)tok * 8;
            rp[0] = (unsigned)e0; rp[1] = (unsigned)e1; rp[2] = pos0; rp[3] = pos1; rp[4] = __float_as_uint(w0); rp[5] = __float_as_uint(w1);
        }
        __syncthreads();
    }
}


DEVI void ph_moba_select_mfma(const Frame& F, const bf16_t* Q, const float* ksum, unsigned* sel) {
    const int lane = F.lane, r = lane & 31, h = lane >> 5;
    for (int item = F.gw; item < BATCH * NH * (SEQ / 32); item += F.NGW) {
        const int qt = item & 127, bh = item >> 7, b = bh >> 3, hh = bh & 7, s0 = qt * 32, qb = s0 >> 8;
        if (qb == 0) { if (h == 0) sel[(size_t)bh * SEQ + s0 + r] = 0u; continue; }
        f32x16 acc = {};
#pragma unroll
        for (int s = 0; s < 4; ++s) {
            const bf16x8 bq = *(const bf16x8*)(Q + ((size_t)b * SEQ + s0 + r) * 512 + hh * 64 + 16 * s + 8 * h);
            f32x4 k0 = (f32x4){0.f, 0.f, 0.f, 0.f}, k1 = k0;
            if (r < 16) { const float* kp = ksum + (((size_t)bh * 16 + r) * 2) * 64 + 16 * s + 8 * h; k0 = *(const f32x4*)kp + *(const f32x4*)(kp + 64); k1 = *(const f32x4*)(kp + 4) + *(const f32x4*)(kp + 68); }
            const u32x4 hi = pg8::pk8(k0, k1), lo = pg8::pk8(k0 - pg8::unpk_lo(hi, 0), k1 - pg8::unpk_lo(hi, 1));
            acc = __builtin_amdgcn_mfma_f32_32x32x16_bf16(__builtin_bit_cast(bf16x8, hi), bq, acc, 0, 0, 0);
            acc = __builtin_amdgcn_mfma_f32_32x32x16_bf16(__builtin_bit_cast(bf16x8, lo), bq, acc, 0, 0, 0);
        }
        float sc[16];
#pragma unroll
        for (int reg = 0; reg < 8; ++reg) { const float mine = acc[reg], other = xshfl(acc[reg], 32, lane); const int base = (reg & 3) + 8 * (reg >> 2);
            sc[base] = h ? other : mine; sc[base + 4] = h ? mine : other; }
        unsigned m = 0u;
#pragma unroll
        for (int t = 0; t < 3; ++t) { float best = -INFINITY; int bi = -1;
#pragma unroll
            for (int j = 0; j < 15; ++j) { const bool ok = (j < qb) && !((m >> j) & 1u) && (sc[j] > best); best = ok ? sc[j] : best; bi = ok ? j : bi; }
            if (bi >= 0) m |= 1u << bi; }
        if (h == 0) sel[(size_t)bh * SEQ + s0 + r] = m;
    }
}

constexpr int PH_PER_LAYER = 10, N_PHASES = 1 + DEPTH * PH_PER_LAYER;
__global__ void __launch_bounds__(NTHR, 2) mk_fwd(Args a) {
    extern __shared__ __attribute__((aligned(16))) unsigned char lds_raw[];
    Frame F0;
    F0.lds = (LAS unsigned char*)lds_raw;
    F0.tid = threadIdx.x; F0.lane = F0.tid & 63; F0.wave = __builtin_amdgcn_readfirstlane(F0.tid >> 6);
    F0.G = gridDim.x; F0.gw = blockIdx.x * NWAVES + F0.wave; F0.NGW = F0.G * NWAVES; F0.gt = blockIdx.x * NTHR + F0.tid; F0.NGT = F0.G * NTHR;
    volatile LAS unsigned* LCTL = (volatile LAS unsigned*)(F0.lds + LDSCTL_OFF);
    volatile LAS int* pstart = (volatile LAS int*)(F0.lds + LDSCTL_OFF + 256);
    for (int u = F0.tid; u < 256; u += NTHR) LCTL[u] = 0u;
    __syncthreads();
    unsigned* ctl = (unsigned*)(a.ws + WS_CTL);
    XcdBarrier bar = xcd_barrier_post(ctl + CW_BAR + a.li * XCD_BAR_WORDS, LCTL);

#define x_in (a.in[0])
#define norm1_g (a.in[1])
#define w_in (a.in[2])
#define ssm_d (a.in[10])
#define w_glu (a.in[11])
#define qng (a.in[12])
#define kng (a.in[13])
#define w_attn (a.in[14])
#define w_out (a.in[15])
#define norm2_g (a.in[16])
#define wgrp (a.in[17])
#define bgrp (a.in[18])
#define wexp (a.in[19])
#define bexp (a.in[20])
#define w_gu (a.in[21])
#define w_dn (a.in[22])
#define X (a.out)
#define rope ((float*)(ws + WS_ROPE))
#define AL ((float*)(ws + WS_MISC + MISC_AL))
#define ksum ((float*)(ws + WS_SL + 4 * MiB))
#define SEL ((unsigned*)(ws + WS_MISC + MISC_SEL))
#define rec ((unsigned*)(ws + WS_REC))
#define list ((int*)(ws + WS_LIST))
#define TC ((bf16_t*)(ws + WS_S5TC))
#define BS ((bf16_t*)(ws + WS_S5BS))
#define H ((bf16_t*)(ws + WS_H))
#define UCAT ((bf16_t*)(ws + WS_UCAT))
#define Qb ((bf16_t*)(ws + WS_Q))
#define Kb ((bf16_t*)(ws + WS_K))
#define Vb ((bf16_t*)(ws + WS_V))
#define SG ((bf16_t*)(ws + WS_SG))
#define Z ((bf16_t*)(ws + WS_Z))
#define ATT ((bf16_t*)(ws + WS_ATT))
#define MIXA ((bf16_t*)(ws + WS_MIXA))
#define MIXED ((bf16_t*)(ws + WS_MIXED))
#define SL ((float*)(ws + WS_SL))
#define HMID ((bf16_t*)(ws + WS_HMID))
#define YBUF ((bf16_t*)(ws + WS_YBUF))
#define QRAW ((float*)(ws + WS_QRAW))
#define KRAW ((float*)(ws + WS_KRAW))
#define WIN ((bf16_t*)(ws + WS_WIN))
#define WGLU ((bf16_t*)(ws + WS_WGLU))
#define WATT ((bf16_t*)(ws + WS_WATT))
#define WOUT ((bf16_t*)(ws + WS_WOUT))
#define WGU ((bf16_t*)(ws + WS_WGU))
#define WDN ((bf16_t*)(ws + WS_WDN))
#define WR ((bf16_t*)(ws + WS_MISC + MISC_WR))
#define XB ((bf16_t*)(ws + WS_XB))
#define SSQ ((float*)(ws + WS_SL))
    const int lo = a.ph_lo, hi = a.ph_hi;
    int ph = 0; unsigned bgen = 0u;
#define PH_BEGIN if (ph >= lo && ph < hi) { for (int rep_ = 0; rep_ < ((((unsigned long long)REP_MASK >> ph) & 1ull) ? 2 : 1); ++rep_) { if (rep_) __syncthreads(); Frame P = F0; unsigned long long wz_ = 0ull; asm volatile("" : "+s"(wz_)); unsigned char* ws = a.ws + wz_;     { int t_ = F0.wave * 64 + (int)__builtin_amdgcn_mbcnt_hi(~0u, __builtin_amdgcn_mbcnt_lo(~0u, 0u)); asm volatile("" : "+v"(t_));     P.tid = t_; P.lane = t_ & 63; P.gt = (int)blockIdx.x * NTHR + t_; P.wave = __builtin_amdgcn_readfirstlane(t_ >> 6); P.gw = (int)blockIdx.x * NWAVES + P.wave; }
#define PH_END   } if (ph + 1 < hi) { ++bgen; xcd_barrier_w(bar, bgen, LCTL + 4, make_cvtq(a, F0.lds, F0.wave, fresh_lane())); } } ++ph;

    const int vcu = (F0.G % 8 == 0) ? ((int)blockIdx.x % 8) * (F0.G / 8) + (int)blockIdx.x / 8 : (int)blockIdx.x;
    LAS unsigned char* ring = F0.lds;
    volatile LAS int* tstart = (volatile LAS int*)(F0.lds + LDSCTL_OFF + 512);
    LAS unsigned* gtab = (LAS unsigned*)(F0.lds + GTAB_OFF);

    PH_BEGIN
        ph_rope_table(P, rope);
        for (int it4 = blockIdx.x; it4 < DEPTH * SSM_G * 4; it4 += P.G) { const int it = it4 >> 2;
            s5_tables_item(it / SSM_G, it % SSM_G, a.in[3], a.in[4], a.in[5], a.in[6], a.in[7], a.in[8], a.in[9],
                           TC + (size_t)it * 512 * 640, BS + (size_t)it * 128 * 512, AL + (size_t)it * 128, (LAS float*)P.lds, P.tid, NTHR, it4 & 3); }
        ph_rmsnorm(P, x_in, norm1_g, H);
        ph_convert_first(P, make_cvtq(a, F0.lds, P.wave, P.lane));
        ph_router_weights(P, wgrp, wexp, WR);
    PH_END

    for (int l = 0; l < DEPTH; ++l) {
#define xin ((l == 0) ? x_in : (const float*)X)
#define cnt ((unsigned*)(ws + WS_CTL) + CW_CNT + l * NEXP)
        PH_BEGIN
            pg8::Gemm g{H, WIN + (size_t)l * D_IN * D, D, D, D, 0, 0}; pg8::StaticOrder S; S.init(NTOK, D_IN, P.G, (int)blockIdx.x);
            pg8::EpiG1 E{UCAT, Qb, Kb, Vb, SG, qng + l * 64, kng + l * 64, rope, QRAW, KRAW, ksum};
            pg8::gemm_phase<pg8::EpiG1, pg8::StaticOrder, pg8::NoGather, G1_ALIGN>(ring, g, S, E, pg8::NoGather{}, P.tid);
        PH_END
        PH_BEGIN
            if (P.G == 256) { if (vcu >= 128) { Frame Q2 = P; Q2.gw = (vcu - 128) * NWAVES + P.wave; Q2.NGW = 128 * NWAVES; ph_moba_select_mfma(Q2, Qb, ksum, SEL); } } else ph_moba_select_mfma(P, Qb, ksum, SEL);
            { pg8::Gemm g{UCAT, BS + (size_t)l * SSM_G * 128 * 512, UK, 512, 512, (size_t)UROWS * UK, (size_t)128 * 512}; pg8::OrderS5A S{P.G, vcu};
              pg8::EpiS5Am E{AL + (size_t)l * SSM_G * 128, UCAT};
              pg8::gemm_phase<pg8::EpiS5Am, pg8::OrderS5A, pg8::NoGather, false>(ring, g, S, E, pg8::NoGather{}, P.tid); }
        PH_END
        PH_BEGIN
            { pg8::Gemm g{UCAT, TC + (size_t)l * SSM_G * 512 * 640, UK, UK, UK, (size_t)UROWS * UK, (size_t)512 * 640}; pg8::OrderS5C S{P.G, vcu};
              pg8::EpiS5Cm E{UCAT, ssm_d + l * SSM_W, Z};
              pg8::gemm_phase<pg8::EpiS5Cm, pg8::OrderS5C, pg8::NoGather, false>(ring, g, S, E, pg8::NoGather{}, P.tid); }
        PH_END
        PH_BEGIN
            { const attn_body::AttnTensors AT{(const attn_body::bf16*)Qb, (const attn_body::bf16*)Kb, (const attn_body::bf16*)Vb, (attn_body::bf16*)ATT, SEL};
              const attn_body::StaticOrder SA((int)P.G, (int)blockIdx.x);
              attn_body::attn_phase<attn_body::StaticOrder>((char*)lds_raw, AT, SA, P.tid); }
            { pg8::Gemm g{Z, WGLU + (size_t)l * 2048 * 512, 512, 512, 512, 0, 0}; pg8::StaticOrder S; S.init(NTOK, 2048, P.G, (int)blockIdx.x);
              pg8::EpiGlu E{SG, MIXA};
              pg8::gemm_phase<pg8::EpiGlu, pg8::StaticOrder, pg8::NoGather, true>(ring, g, S, E, pg8::NoGather{}, P.tid); }
        PH_END
        PH_BEGIN
            pg8::Gemm g{ATT, WATT + (size_t)l * 1024 * 512, 512, 512, 512, 0, 0}; pg8::StaticOrder S; S.init(NTOK, 1024, P.G, (int)blockIdx.x);
            pg8::EpiMix E{SG, MIXA, MIXED};
            pg8::gemm_phase<pg8::EpiMix, pg8::StaticOrder, pg8::NoGather, true>(ring, g, S, E, pg8::NoGather{}, P.tid);
        PH_END
        PH_BEGIN
            pg8::Gemm g{MIXED, WOUT + (size_t)l * 1024 * 1024, 1024, 1024, 1024, 0, 0}; pg8::StaticOrder S; S.init(NTOK, 1024, P.G, (int)blockIdx.x);
            if (l == 0) { pg8::EpiResBf16<true> E{x_in, XB, SSQ}; pg8::gemm_phase<pg8::EpiResBf16<true>, pg8::StaticOrder, pg8::NoGather, true>(ring, g, S, E, pg8::NoGather{}, P.tid); }
            else { pg8::EpiResBf16<false> E{nullptr, XB, SSQ}; pg8::gemm_phase<pg8::EpiResBf16<false>, pg8::StaticOrder, pg8::NoGather, true>(ring, g, S, E, pg8::NoGather{}, P.tid); }
        PH_END
        PH_BEGIN make_cvtq(a, F0.lds, P.wave, P.lane).catchup(l == 0 ? CVQ_LIM_MOE0 : CVQ_TOTAL); __syncthreads(); ph_norm_router_mfma(P, XB, SSQ, norm2_g + l * D, WR + (size_t)l * 2 * 48 * 1024, bgrp + l * 4, bexp + l * 32, H, cnt, list, rec); PH_END
        PH_BEGIN
            moe_tstart(P, cnt, tstart); moe_gather_table(P, vcu, cnt, list, tstart, gtab);
            pg8::Gemm g{H, WGU + (size_t)l * NEXP * 1024 * 1024, D, 1024, 1024, 0, (size_t)1024 * 1024}; pg8::OrderMoE S{P.G, vcu, tstart};
            pg8::EpiSwiglu E{HMID};
            pg8::gemm_phase<pg8::EpiSwiglu, pg8::OrderMoE, pg8::LdsGather, true>(ring, g, S, E, pg8::LdsGather{gtab}, P.tid);
        PH_END
        PH_BEGIN
            moe_tstart(P, cnt, tstart);
            pg8::Gemm g{HMID, WDN + (size_t)l * NEXP * 1024 * 512, 512, 512, 512, 0, (size_t)1024 * 512}; pg8::OrderMoE S{P.G, vcu, tstart};
            pg8::EpiStoreBf16 E{YBUF, 1024};
            pg8::gemm_phase<pg8::EpiStoreBf16, pg8::OrderMoE, pg8::NoGather, true>(ring, g, S, E, pg8::NoGather{}, P.tid);
        PH_END
        PH_BEGIN
            if (l + 1 < DEPTH) { make_cvtq(a, F0.lds, P.wave, P.lane).catchup(CVQ_LIM_PROJ1); __syncthreads(); }
            compute_pstart(P, cnt, pstart);
            if (l + 1 < DEPTH) ph_combine<false>(P, XB, X, YBUF, rec, pstart, norm1_g + (l + 1) * D, H);
            else ph_combine<true>(P, XB, X, YBUF, rec, pstart, nullptr, H);
        PH_END
    }
#undef PH_BEGIN
#undef PH_END
#undef x_in
#undef norm1_g
#undef w_in
#undef ssm_d
#undef w_glu
#undef qng
#undef kng
#undef w_attn
#undef w_out
#undef norm2_g
#undef wgrp
#undef bgrp
#undef wexp
#undef bexp
#undef w_gu
#undef w_dn
#undef X
#undef rope
#undef AL
#undef ksum
#undef SEL
#undef rec
#undef list
#undef TC
#undef BS
#undef H
#undef UCAT
#undef Qb
#undef Kb
#undef Vb
#undef SG
#undef Z
#undef ATT
#undef MIXA
#undef MIXED
#undef SL
#undef HMID
#undef YBUF
#undef QRAW
#undef KRAW
#undef WIN
#undef WGLU
#undef WATT
#undef WOUT
#undef WGU
#undef WDN
#undef WR
#undef XB
#undef SSQ
#undef xin
#undef cnt
}

extern "C" void kernel_launch(void* const* d_in, const int* in_sizes, int n_in, void* d_out, int out_size, void* d_ws, size_t ws_size, hipStream_t stream) {
    static int grid = 0;
    if (grid == 0) {
        if (n_in != 23 || ws_size < WS_END || out_size != NTOK * D) { fprintf(stderr, "kernel_launch: unexpected n_in %d / ws_size %zu / out_size %d; nothing launched\n", n_in, ws_size, out_size); grid = -1; return; }
        int dev = 0, cus = 0, per_cu = 0;
        if (hipGetDevice(&dev) != hipSuccess || hipDeviceGetAttribute(&cus, hipDeviceAttributeMultiprocessorCount, dev) != hipSuccess) { grid = -1; return; }
        if (hipFuncSetAttribute((const void*)mk_fwd, hipFuncAttributeMaxDynamicSharedMemorySize, LDS_BYTES) != hipSuccess) { fprintf(stderr, "kernel_launch: hipFuncSetAttribute failed\n"); grid = -1; return; }
        if (hipOccupancyMaxActiveBlocksPerMultiprocessor(&per_cu, (const void*)mk_fwd, NTHR, LDS_BYTES) != hipSuccess || per_cu < 1) { fprintf(stderr, "kernel_launch: occupancy query says %d\n", per_cu); }
        (void)hipGetLastError();
        grid = cus;
    }
    if (grid < 0) return;
    if (hipMemsetAsync((char*)d_ws + WS_CTL, 0, CTL_BYTES, stream) != hipSuccess) return;
    Args a{};
    for (int i = 0; i < 23; ++i) a.in[i] = (const float*)d_in[i];
    a.out = (float*)d_out; a.ws = (unsigned char*)d_ws;
#if MK_PER_PHASE
    for (int p = 0; p < N_PHASES; ++p) { a.ph_lo = p; a.ph_hi = p + 1; a.li = p; hipLaunchKernelGGL(mk_fwd, dim3(grid), dim3(NTHR), LDS_BYTES, stream, a); }
#else
    a.ph_lo = 0; a.ph_hi = N_PHASES; a.li = 0;
    hipLaunchKernelGGL(mk_fwd, dim3(grid), dim3(NTHR), LDS_BYTES, stream, a);
#endif
}
```
